# Optimizing an MI355X kernel written in HIP

```python
import jax, jax.numpy as jnp
from jax import lax
import numpy as np

D_MODEL = 2048
BATCH = 2
SEQ = 16384
DEPTH = 1

HEAD_DIM = 128
N_ATTN_HEADS = D_MODEL // (2 * HEAD_DIM)
ATTN_W = N_ATTN_HEADS * HEAD_DIM
N_MEM_HEADS = 4
MEM_W = N_MEM_HEADS * HEAD_DIM
CONV_W = D_MODEL - ATTN_W - MEM_W
CONV_K = 3
N_MEM = 256
DILATED_BRANCHES = ((128, 1), (512, 4), (2048, 16))
ATTN_BLOCK = 128
PROJ_W = 3 * ATTN_W + 3 * CONV_W + MEM_W
SPLITS = (ATTN_W, 2 * ATTN_W, 3 * ATTN_W, 3 * ATTN_W + CONV_W,
          3 * ATTN_W + 2 * CONV_W, 3 * ATTN_W + 3 * CONV_W)
N_GROUPS = 8
EXPERTS_PER_GROUP = 8
N_EXPERTS = N_GROUPS * EXPERTS_PER_GROUP
TOP_K_IN_GROUP = 2
D_EXPERT = D_MODEL // 2
MOE_BLOCK = 128
EPS = 1e-6
NEG_INF = -1e30

kernel_name = "hymba_dilated_conv_memory_hmoe"


def rms_norm(x, g):
    xf = x.astype(jnp.float32)
    y = xf * lax.rsqrt(jnp.mean(xf * xf, axis=-1, keepdims=True) + EPS)
    return (y * g.astype(jnp.float32)).astype(x.dtype)


def alibi_slopes(n):
    return 2.0 ** (-8.0 * jnp.arange(1, n + 1, dtype=jnp.float32) / n)


def banded_causal_attention(q, k, v, span, step, slopes):
    N, L, H, hd = q.shape
    blk = ATTN_BLOCK
    nb = -(-L // blk)
    Lp = nb * blk
    pad = ((0, 0), (0, Lp - L), (0, 0), (0, 0))
    qb = jnp.pad(q, pad).reshape(N, nb, blk, H, hd).astype(jnp.float32)
    kb = jnp.pad(k, pad).reshape(N, nb, blk, H, hd).astype(jnp.float32)
    vb = jnp.pad(v, pad).reshape(N, nb, blk, H, hd).astype(jnp.float32)
    shift = ((0, 0), (1, 0), (0, 0), (0, 0), (0, 0))
    kk = jnp.concatenate([jnp.pad(kb, shift)[:, :-1], kb], axis=2)
    vv = jnp.concatenate([jnp.pad(vb, shift)[:, :-1], vb], axis=2)
    s = jnp.einsum('nbqhd,nbkhd->nbhqk', qb, kk) * (hd ** -0.5)
    qpos = jnp.arange(nb)[:, None] * blk + jnp.arange(blk)[None, :]
    kpos = jnp.arange(nb)[:, None] * blk - blk + jnp.arange(2 * blk)[None, :]
    dist = qpos[:, :, None] - kpos[:, None, :]
    valid = (dist >= 0) & (dist <= span) & (kpos[:, None, :] >= 0)
    bias = -slopes[None, :, None, None] * (dist * step).astype(jnp.float32)[:, None]
    s = jnp.where(valid[None, :, None], s + bias[None], NEG_INF)
    lse = jax.nn.logsumexp(s, axis=-1)
    p = jnp.exp(s - lse[..., None])
    o = jnp.einsum('nbhqk,nbkhd->nbqhd', p, vv).reshape(N, Lp, H, hd)[:, :L]
    lse = jnp.transpose(lse, (0, 1, 3, 2)).reshape(N, Lp, H)[:, :L]
    return o, lse


def dilated_attention(q, k, v, slopes):
    B, S, H, hd = q.shape
    outs, lses = [], []
    for window, dil in DILATED_BRANCHES:
        Ls = S // dil
        def to_res(t):
            return t.reshape(B, Ls, dil, H, hd).transpose(0, 2, 1, 3, 4).reshape(B * dil, Ls, H, hd)
        o, lse = banded_causal_attention(to_res(q), to_res(k), to_res(v), window // dil, dil, slopes)
        outs.append(o.reshape(B, dil, Ls, H, hd).transpose(0, 2, 1, 3, 4).reshape(B, S, H, hd))
        lses.append(lse.reshape(B, dil, Ls, H).transpose(0, 2, 1, 3).reshape(B, S, H))
    w = jax.nn.softmax(jnp.stack(lses, axis=0), axis=0)
    return jnp.sum(w[..., None] * jnp.stack(outs, axis=0), axis=0)


def gated_short_conv(b_gate, c_gate, u, conv_w):
    z = c_gate * u
    C = z.shape[-1]
    y = lax.conv_general_dilated(z, conv_w[:, None, :].astype(z.dtype), window_strides=(1,),
                                 padding=((CONV_K - 1, 0),),
                                 dimension_numbers=('NWC', 'WIO', 'NWC'),
                                 feature_group_count=C)
    return b_gate * y


def memory_attention(q, mk, mv):
    s = jnp.einsum('bshd,bmhd->bhsm', q.astype(jnp.float32), mk.astype(jnp.float32)) * (HEAD_DIM ** -0.5)
    p = jax.nn.softmax(s, axis=-1)
    return jnp.einsum('bhsm,bmhd->bshd', p, mv.astype(jnp.float32))


def hierarchical_moe(h, w_rg, b_rg, w_re, b_re, w_gate, w_up, w_down):
    T, D = h.shape
    hf = h.astype(jnp.float32)
    g_prob = jax.nn.softmax(hf @ w_rg.astype(jnp.float32) + b_rg.astype(jnp.float32), axis=-1)
    g_w, g_idx = lax.top_k(g_prob, 1)
    e_logits = (hf @ w_re.astype(jnp.float32) + b_re.astype(jnp.float32)).reshape(T, N_GROUPS, EXPERTS_PER_GROUP)
    e_logits = jnp.take_along_axis(e_logits, g_idx[:, :, None], axis=1)[:, 0]
    e_prob = jax.nn.softmax(e_logits, axis=-1)
    top_p, top_i = lax.top_k(e_prob, TOP_K_IN_GROUP)
    top_p = top_p / jnp.sum(top_p, axis=-1, keepdims=True)
    gates = (g_w * top_p).reshape(-1)
    experts = (g_idx * EXPERTS_PER_GROUP + top_i).reshape(-1)
    tokens = jnp.repeat(jnp.arange(T), TOP_K_IN_GROUP)
    A = T * TOP_K_IN_GROUP
    order = jnp.argsort(experts)
    e_sorted, tok_sorted, gate_sorted = experts[order], tokens[order], gates[order]
    counts = jnp.bincount(experts, length=N_EXPERTS)
    padded = (counts + MOE_BLOCK - 1) // MOE_BLOCK * MOE_BLOCK
    starts = jnp.cumsum(counts) - counts
    pends = jnp.cumsum(padded)
    pstarts = pends - padded
    dest = pstarts[e_sorted] + (jnp.arange(A) - starts[e_sorted])
    n_blocks = (A + N_EXPERTS * (MOE_BLOCK - 1) + MOE_BLOCK - 1) // MOE_BLOCK
    R = n_blocks * MOE_BLOCK
    xbuf = jnp.zeros((R, D), h.dtype).at[dest].set(h[tok_sorted])
    block_expert = jnp.minimum(
        jnp.searchsorted(pends, jnp.arange(n_blocks) * MOE_BLOCK, side='right'), N_EXPERTS - 1)

    def expert_block(args):
        xb, e = args
        a = xb @ w_gate[e]
        u = xb @ w_up[e]
        return (jax.nn.silu(a) * u) @ w_down[e]

    ybuf = lax.map(expert_block, (xbuf.reshape(n_blocks, MOE_BLOCK, D), block_expert)).reshape(R, D)
    y = ybuf[dest] * gate_sorted[:, None].astype(ybuf.dtype)
    return jax.ops.segment_sum(y, tok_sorted, num_segments=T)


def hybrid_layer(x, mem, norm1_g, w_in, q_norm_g, k_norm_g, conv_w, mem_norm_g, w_mem_kv,
                 mem_q_norm_g, mem_k_norm_g, out_norm_g, w_out, norm2_g,
                 w_rg, b_rg, w_re, b_re, w_gate, w_up, w_down):
    B, S, D = x.shape
    h = rms_norm(x, norm1_g)
    proj = jnp.einsum('bsd,de->bse', h, w_in)
    q, k, v, b_gate, c_gate, u, mq = jnp.split(proj, SPLITS, axis=-1)
    q = rms_norm(q.reshape(B, S, N_ATTN_HEADS, HEAD_DIM), q_norm_g)
    k = rms_norm(k.reshape(B, S, N_ATTN_HEADS, HEAD_DIM), k_norm_g)
    v = v.reshape(B, S, N_ATTN_HEADS, HEAD_DIM)
    attn_o = dilated_attention(q, k, v, alibi_slopes(N_ATTN_HEADS)).reshape(B, S, ATTN_W).astype(x.dtype)
    conv_o = gated_short_conv(b_gate, c_gate, u, conv_w)
    mem_h = rms_norm(mem, mem_norm_g)
    mk, mv = jnp.split(jnp.einsum('bmd,de->bme', mem_h, w_mem_kv), 2, axis=-1)
    mk = rms_norm(mk.reshape(B, N_MEM, N_MEM_HEADS, HEAD_DIM), mem_k_norm_g)
    mv = mv.reshape(B, N_MEM, N_MEM_HEADS, HEAD_DIM)
    mq = rms_norm(mq.reshape(B, S, N_MEM_HEADS, HEAD_DIM), mem_q_norm_g)
    mem_o = memory_attention(mq, mk, mv).reshape(B, S, MEM_W).astype(x.dtype)
    y = jnp.concatenate([rms_norm(attn_o, out_norm_g[:ATTN_W]),
                         rms_norm(conv_o, out_norm_g[ATTN_W:ATTN_W + CONV_W]),
                         rms_norm(mem_o, out_norm_g[ATTN_W + CONV_W:])], axis=-1)
    x = x + jnp.einsum('bse,ed->bsd', y, w_out)
    h2 = rms_norm(x, norm2_g).reshape(B * S, D)
    x = x + hierarchical_moe(h2, w_rg, b_rg, w_re, b_re, w_gate, w_up, w_down).reshape(B, S, D).astype(x.dtype)
    return x


def setup_inputs(seed: int = 0) -> dict:
    key = jax.random.key(seed)
    ks = jax.random.split(key, 24)
    f32 = jnp.float32
    nrm = lambda k, shape, scale: jax.random.normal(k, shape, f32) * scale
    gain = lambda k, shape: 1.0 + 0.05 * jax.random.normal(k, shape, f32)
    L = DEPTH
    return {
        "x": jax.random.normal(ks[0], (BATCH, SEQ, D_MODEL), f32),
        "mem": jax.random.normal(ks[1], (BATCH, N_MEM, D_MODEL), f32),
        "norm1_g": gain(ks[2], (L, D_MODEL)),
        "w_in": nrm(ks[3], (L, D_MODEL, PROJ_W), D_MODEL ** -0.5),
        "q_norm_g": gain(ks[4], (L, HEAD_DIM)),
        "k_norm_g": gain(ks[5], (L, HEAD_DIM)),
        "conv_w": nrm(ks[6], (L, CONV_K, CONV_W), CONV_K ** -0.5),
        "mem_norm_g": gain(ks[7], (L, D_MODEL)),
        "w_mem_kv": nrm(ks[8], (L, D_MODEL, 2 * MEM_W), D_MODEL ** -0.5),
        "mem_q_norm_g": gain(ks[9], (L, HEAD_DIM)),
        "mem_k_norm_g": gain(ks[10], (L, HEAD_DIM)),
        "out_norm_g": gain(ks[11], (L, D_MODEL)),
        "w_out": nrm(ks[12], (L, D_MODEL, D_MODEL), D_MODEL ** -0.5),
        "norm2_g": gain(ks[13], (L, D_MODEL)),
        "w_router_group": nrm(ks[14], (L, D_MODEL, N_GROUPS), D_MODEL ** -0.5),
        "b_router_group": nrm(ks[15], (L, N_GROUPS), 0.01),
        "w_router_expert": nrm(ks[16], (L, D_MODEL, N_EXPERTS), D_MODEL ** -0.5),
        "b_router_expert": nrm(ks[17], (L, N_EXPERTS), 0.01),
        "w_gate": nrm(ks[18], (L, N_EXPERTS, D_MODEL, D_EXPERT), D_MODEL ** -0.5),
        "w_up": nrm(ks[19], (L, N_EXPERTS, D_MODEL, D_EXPERT), D_MODEL ** -0.5),
        "w_down": nrm(ks[20], (L, N_EXPERTS, D_EXPERT, D_MODEL), D_EXPERT ** -0.5),
    }


def reference(x, mem, norm1_g, w_in, q_norm_g, k_norm_g, conv_w, mem_norm_g, w_mem_kv,
              mem_q_norm_g, mem_k_norm_g, out_norm_g, w_out, norm2_g,
              w_router_group, b_router_group, w_router_expert, b_router_expert,
              w_gate, w_up, w_down):
    for l in range(DEPTH):
        x = hybrid_layer(x, mem, norm1_g[l], w_in[l], q_norm_g[l], k_norm_g[l], conv_w[l],
                         mem_norm_g[l], w_mem_kv[l], mem_q_norm_g[l], mem_k_norm_g[l],
                         out_norm_g[l], w_out[l], norm2_g[l],
                         w_router_group[l], b_router_group[l], w_router_expert[l], b_router_expert[l],
                         w_gate[l], w_up[l], w_down[l])
    return x
```

```cpp
#include <hip/hip_runtime.h>
#include <cstdio>
#include <cstdint>

#ifndef MK_N_LAUNCHES
#define MK_N_LAUNCHES 1
#endif

#define GAS __attribute__((address_space(1)))
#define LAS __attribute__((address_space(3)))
typedef unsigned short bf16;
typedef unsigned v4u __attribute__((ext_vector_type(4)));
typedef unsigned v2u __attribute__((ext_vector_type(2)));
typedef float f32x4 __attribute__((ext_vector_type(4)));
typedef float f32x16 __attribute__((ext_vector_type(16)));
typedef short bf16x8 __attribute__((ext_vector_type(8)));
typedef short s16x4 __attribute__((ext_vector_type(4)));
#define LDS_WAIT() asm volatile("s_waitcnt lgkmcnt(0)" ::: "memory")
#define VM_WAIT() asm volatile("s_waitcnt vmcnt(0)" ::: "memory")
#define RLX_AGENT __ATOMIC_RELAXED, __HIP_MEMORY_SCOPE_AGENT

constexpr int BATCH = 2, SEQ = 16384, T = BATCH * SEQ, D = 2048, PROJ = 5120;
constexpr int NH = 8, HD = 128, ATTN_W = 1024, CONV_W = 512, MEM_W = 512, NMEM = 256, NMH = 4;
constexpr int COL_Q = 0, COL_K = 1024, COL_V = 2048, COL_B = 3072, COL_C = 3584, COL_U = 4096, COL_MQ = 4608;
constexpr int NEXP = 64, DEXP = 1024;
constexpr int RMAX = 81920;
constexpr int MAXTILES = RMAX / 256;
constexpr float EPS = 1e-6f;
constexpr float LOG2E = 1.4426950408889634f;

constexpr size_t MiB = 1u << 20;
constexpr size_t WS_CTL = 0, CTL_ZERO_BYTES = 1 * MiB;
constexpr size_t WS_WIN = 1 * MiB;
constexpr size_t WS_WMKV = WS_WIN + (size_t)PROJ * D * 2;
constexpr size_t WS_WOUT = 25 * MiB;
constexpr size_t WS_WR = 33 * MiB;
constexpr size_t WS_WGU = 34 * MiB;
constexpr size_t WS_WD = WS_WGU + 512 * MiB;
constexpr size_t WS_H = WS_WD + 256 * MiB;
constexpr size_t WS_MEMKV = WS_H + 130 * MiB;
constexpr size_t WS_R1 = WS_MEMKV + 1 * MiB;
constexpr size_t WS_OPART = WS_R1 + 320 * MiB;
constexpr size_t WS_LSE = WS_OPART + 192 * MiB;
constexpr size_t WS_MEMO = WS_LSE + 3 * MiB;
constexpr size_t WS_Y = WS_MEMO + 32 * MiB;
constexpr size_t WS_TOK = WS_Y + 128 * MiB;
constexpr size_t WS_LIST = WS_TOK + 4 * MiB;
constexpr size_t WS_END = WS_LIST + 24 * MiB;
constexpr int CAP = T;
constexpr size_t LIST_TOK = 0, LIST_RSTD = 8 * MiB, LIST_GATE = 16 * MiB;
constexpr size_t TOK_E = 0, TOK_RANK = 256 * 1024, TOK_GATE = 512 * 1024, TOK_RSTD = 768 * 1024, TOK_SLOT = 1024 * 1024, SLOT_RSTD = 1536 * 1024, SLOT_GATE = 2048 * 1024;
static_assert(WS_WMKV + 1024 * (size_t)D * 2 <= WS_WOUT && WS_WOUT + 8 * MiB <= WS_WR && WS_WR + 2048 * 72 * 4 <= WS_WGU, "ws map");
static_assert((size_t)(T + 512) * D * 2 <= 130 * MiB && (size_t)RMAX * D * 2 <= 320 * MiB && (size_t)RMAX * DEXP * 2 <= 192 * MiB && SLOT_GATE + RMAX * 4 <= 4 * MiB, "ws map");

constexpr int CW_TMO = 0, CW_CODE = 1;
constexpr int CW_CNT = 8192;
constexpr int CW_BAR = 16384;
constexpr int CW_KVREADY = 512, CW_ATTQ = 576;

constexpr int RING_BYTES = 131072;
constexpr int LDS_EXTRA = RING_BYTES;
constexpr int MISC_OFF = 163840 - 2048;
constexpr int LDS_BYTES = 163840;

__device__ __forceinline__ unsigned f2bf(float f) { unsigned u = __builtin_bit_cast(unsigned, f); return (u + 0x7fffu + ((u >> 16) & 1u)) >> 16; }
__device__ __forceinline__ unsigned pk2(float lo, float hi) { return f2bf(lo) | (f2bf(hi) << 16); }
__device__ __forceinline__ unsigned cvtpk(float lo, float hi) { unsigned r; asm volatile("v_cvt_pk_bf16_f32 %0, %1, %2" : "=v"(r) : "v"(lo), "v"(hi)); return r; }
__device__ __forceinline__ unsigned pk_fp8x4(float a, float b, float c, float d) { unsigned w = 0u; w = __builtin_amdgcn_cvt_pk_fp8_f32(a, b, w, false); w = __builtin_amdgcn_cvt_pk_fp8_f32(c, d, w, true); return w; }
constexpr float SC_WGU = 128.0f, SC_ACT = 4.0f, SC_WD = 64.0f;
__device__ __forceinline__ float bflo(unsigned w) { return __builtin_bit_cast(float, w << 16); }
__device__ __forceinline__ float bfhi(unsigned w) { return __builtin_bit_cast(float, w & 0xffff0000u); }
__device__ __forceinline__ float wave_sum(float v) {
#pragma unroll
    for (int o = 1; o < 64; o <<= 1) v += __shfl_xor(v, o);
    return v;
}

namespace pg8 {
#define PG8_LAS __attribute__((address_space(3)))
typedef unsigned short bf16_t;
typedef unsigned u32x4 __attribute__((ext_vector_type(4)));
typedef int i32x4 __attribute__((ext_vector_type(4)));
typedef int i32x8 __attribute__((ext_vector_type(8)));
constexpr int BM = 256, BK = 64, HALF = 128, HTB = HALF * BK * 2, STAGE_BYTES = 8 * HTB, NXCD = 8, WGM = 8;
__host__ __device__ __forceinline__ int lds_byte(int r, int c) { const int st = (r >> 4) * 2 + (c >> 5), rr = r & 15, cc = c & 31, ob = rr * 64 + cc * 2; return st * 1024 + (ob ^ (((ob >> 9) & 1) << 5)); }
__host__ __device__ __forceinline__ void stage_rc(int b, int& R, int& C) { const int st = b / 1024, sb = b % 1024, swz = sb ^ (((sb >> 9) & 1) << 5); R = (st >> 1) * 16 + swz / 64; C = (st & 1) * 32 + (swz % 64) / 2; }
__host__ __device__ __forceinline__ int perm32(int rho) { const int n = rho >> 4, i = rho & 15; return 8 * (i >> 2) + 4 * n + (i & 3); }

struct Unit { int pm, pn, pb; };
struct Gemm { const bf16_t* A; const bf16_t* Bt; int K; const PG8_LAS int* ut; };

__device__ __forceinline__ void tile_of(int L, int nM, int nN, int& pm, int& pn) {
    const int nwg = nM * nN;
    int wgid = L; { const int q = nwg / NXCD, r = nwg % NXCD, xcd = wgid % NXCD, off = wgid / NXCD; wgid = (xcd < r ? xcd * (q + 1) : r * (q + 1) + (xcd - r) * q) + off; }
    const int nig = WGM * nN, gid = wgid / nig, fm = gid * WGM, gsz = (nM - fm) < WGM ? (nM - fm) : WGM;
    pm = fm + ((wgid % nig) % gsz); pn = (wgid % nig) / gsz;
}
struct StaticOrder {
    int nM, nN, G, c;
    __device__ __forceinline__ bool next(int i, Unit& u) const { const long L = (long)i * G + c; if (L >= (long)nM * nN) return false; tile_of((int)L, nM, nN, u.pm, u.pn); u.pb = u.pn; return true; }
    __device__ __forceinline__ void a_ready(const Unit&) const {}
    __device__ __forceinline__ void done(const Unit&) const {}
};
struct P1Order {
    int G, c, lo, hi;
    __device__ __forceinline__ bool next(int i, Unit& u) const { const long L = (long)lo + (long)i * G + c; if (L >= hi) return false;
        if (L < 2560) tile_of((int)L, 128, 20, u.pm, u.pn); else { const int k = (int)L - 2560; u.pm = 128 + (k >> 2); u.pn = 20 + (k & 3); }
        u.pb = u.pn; return true; }
    __device__ __forceinline__ void a_ready(const Unit&) const {}
    __device__ __forceinline__ void done(const Unit&) const {}
};
struct MoeOrder {
    int nM, G, c; const LAS int* te;
    __device__ __forceinline__ bool next(int i, Unit& u) const { const long L = (long)i * G + c; if (L >= (long)nM * 8) return false; tile_of((int)L, nM, 8, u.pm, u.pn); u.pb = te[u.pm] * 8 + u.pn; return true; }
    __device__ __forceinline__ void a_ready(const Unit&) const {}
    __device__ __forceinline__ void done(const Unit&) const {}
};

struct EpiProj {
    static constexpr bool PERM = true, AFTER_DRAIN = false;
    bf16_t* O; bf16_t* O2;
    __device__ __forceinline__ void operator()(const f32x4 (&acc)[2][2][4][2], const Unit& u, int wr, int wc, int fr, int fq) const {
        int row0 = u.pm * BM + wr * 64 + fr, col0 = u.pn * BM + wc * 32 + 8 * fq, ldc = PROJ; bf16_t* base = O;
        if (u.pm >= 128) { row0 -= 128 * BM; col0 -= 20 * BM; ldc = 1024; base = O2; }
#pragma unroll
        for (int ai = 0; ai < 2; ++ai)
#pragma unroll
            for (int m = 0; m < 4; ++m) { bf16_t* rowp = base + (size_t)(row0 + ai * HALF + m * 16) * ldc + col0;
#pragma unroll
                for (int bj = 0; bj < 2; ++bj) { const f32x4 v0 = acc[ai][bj][m][0], v1 = acc[ai][bj][m][1];
                    u32x4 w; w.x = cvtpk(v0[0], v0[1]); w.y = cvtpk(v0[2], v0[3]); w.z = cvtpk(v1[0], v1[1]); w.w = cvtpk(v1[2], v1[3]);
                    *(u32x4*)(rowp + bj * HALF) = w; } }
    }
};
struct EpiResid {
    static constexpr bool PERM = true, AFTER_DRAIN = false;
    const float* X; float* X1; bf16_t* X1B;
    __device__ __forceinline__ void operator()(const f32x4 (&acc)[2][2][4][2], const Unit& u, int wr, int wc, int fr, int fq) const {
        const int row0 = u.pm * BM + wr * 64 + fr, col0 = u.pn * BM + wc * 32 + 8 * fq;
#pragma unroll
        for (int ai = 0; ai < 2; ++ai)
#pragma unroll
            for (int m = 0; m < 4; ++m) { const size_t off = (size_t)(row0 + ai * HALF + m * 16) * D + col0;
#pragma unroll
                for (int bj = 0; bj < 2; ++bj) { const f32x4 xa = __builtin_nontemporal_load((const f32x4*)(X + off + bj * HALF)), xb = __builtin_nontemporal_load((const f32x4*)(X + off + bj * HALF + 4));
                    const f32x4 v0 = acc[ai][bj][m][0] + xa, v1 = acc[ai][bj][m][1] + xb;
                    *(f32x4*)(X1 + off + bj * HALF) = v0; *(f32x4*)(X1 + off + bj * HALF + 4) = v1;
                    v2u w; w.x = pk_fp8x4(v0[0], v0[1], v0[2], v0[3]); w.y = pk_fp8x4(v1[0], v1[1], v1[2], v1[3]);
                    *(v2u*)((unsigned char*)X1B + off + bj * HALF) = w; }
                asm volatile("" ::: "memory"); }
    }
};
struct EpiSwiGLU {
    static constexpr bool PERM = true, AFTER_DRAIN = false;
    bf16_t* ACT; const float* RS; const PG8_LAS int* tb;
    __device__ __forceinline__ void operator()(const f32x4 (&acc)[2][2][4][2], const Unit& u, int wr, int wc, int fr, int fq) const {
        const int row0 = u.pm * BM + wr * 64 + fr, col0 = u.pn * HALF + wc * 32 + 8 * fq, lb = tb[u.pm] - u.pm * BM;
#pragma unroll
        for (int ai = 0; ai < 2; ++ai)
#pragma unroll
            for (int m = 0; m < 4; ++m) { const int row = row0 + ai * HALF + m * 16; const float rs = RS[lb + row] * (1.0f / SC_WGU); float o[8];
#pragma unroll
                for (int n = 0; n < 2; ++n)
#pragma unroll
                    for (int j = 0; j < 4; ++j) { const float g = acc[ai][0][m][n][j] * rs, uu = acc[ai][1][m][n][j] * rs;
                        o[n * 4 + j] = g * __builtin_amdgcn_rcpf(1.0f + __builtin_amdgcn_exp2f(-g * LOG2E)) * uu * SC_ACT; }
                v2u w; w.x = pk_fp8x4(o[0], o[1], o[2], o[3]); w.y = pk_fp8x4(o[4], o[5], o[6], o[7]);
                *(v2u*)((unsigned char*)ACT + (size_t)row * DEXP + col0) = w; }
    }
};
struct EpiDown {
    static constexpr bool PERM = true, AFTER_DRAIN = false;
    bf16_t* Y; const float* GT; const PG8_LAS int* tb;
    __device__ __forceinline__ void operator()(const f32x4 (&acc)[2][2][4][2], const Unit& u, int wr, int wc, int fr, int fq) const {
        const int row0 = u.pm * BM + wr * 64 + fr, col0 = u.pn * BM + wc * 32 + 8 * fq, lb = tb[u.pm] - u.pm * BM;
#pragma unroll
        for (int ai = 0; ai < 2; ++ai)
#pragma unroll
            for (int m = 0; m < 4; ++m) { const int row = row0 + ai * HALF + m * 16; const float gt = GT[lb + row] * (1.0f / (SC_ACT * SC_WD)); bf16_t* rowp = Y + (size_t)row * D + col0;
#pragma unroll
                for (int bj = 0; bj < 2; ++bj) { const f32x4 v0 = acc[ai][bj][m][0] * gt, v1 = acc[ai][bj][m][1] * gt;
                    u32x4 w; w.x = cvtpk(v0[0], v0[1]); w.y = cvtpk(v0[2], v0[3]); w.z = cvtpk(v1[0], v1[1]); w.w = cvtpk(v1[2], v1[3]);
                    *(u32x4*)(rowp + bj * HALF) = w; } }
    }
};

template <class Epi, class Sched, bool ALIGN_EPI = true, bool GATHER = false, bool BKN = false, bool FP8 = false>
__device__ __forceinline__ void gemm_phase(PG8_LAS unsigned char* lds, const Gemm g, const Sched& S, const Epi& E) {
    static_assert(!(FP8 && BKN), "the fp8 path takes N-major B");
    const int tid = threadIdx.x, wid = __builtin_amdgcn_readfirstlane(tid >> 6), lane = tid & 63, wr = wid >> 2, wc = wid & 3, fr = lane & 15, fq = lane >> 4;
    const int K = FP8 ? g.K / 2 : g.K, nt = K / BK;
    unsigned voffA[2], voffB[2]; int gR[2], gC[2];
#pragma unroll
    for (int i = 0; i < 2; ++i) { int R, C; stage_rc(tid * 16 + i * 8192, R, C); const int Rb = Epi::PERM ? ((R & ~31) + perm32(R & 31)) : R; gR[i] = R; gC[i] = C;
        voffA[i] = (unsigned)(R * K + C) * 2u; voffB[i] = (unsigned)(Rb * K + C) * 2u; }
    unsigned vA0[2], vA1[2], vN0[2], vN1[2];
#define PG8_GOFF(dst0, dst1, ui_) do { _Pragma("unroll") for (int _i = 0; _i < 2; ++_i) { \
        dst0[_i] = ((unsigned)g.ut[(ui_) * 256 + gR[_i]] * (unsigned)K + (unsigned)gC[_i]) * 2u; dst1[_i] = ((unsigned)g.ut[(ui_) * 256 + 128 + gR[_i]] * (unsigned)K + (unsigned)gC[_i]) * 2u; } } while (0)
    const size_t kstep = (size_t)(BK * 2);
    const size_t hstep = (size_t)HALF * K * 2;
    const size_t tstep = 2 * hstep;
    const size_t kstepB = BKN ? (size_t)BK * 4096 : kstep, hstepB = BKN ? (size_t)256 : hstep;
    if constexpr (BKN) {
#pragma unroll
        for (int i = 0; i < 2; ++i) { const int p = tid * 16 + i * 8192, kk = p >> 8, c16p = (p & 255) >> 4, sw = (kk & 3) | (((kk >> 3) & 1) << 2);
            voffB[i] = (unsigned)(kk * 4096 + ((c16p ^ (sw << 1)) << 4)); } }
    int bbase[2];
    { const int q = fr >> 2, p = fr & 3, sw = q | ((fq & 1) << 2);
#pragma unroll
      for (int n = 0; n < 2; ++n) bbase[n] = (int)(uintptr_t)lds + (8 * fq + q) * 256 + (((4 * wc + 2 * n + (p >> 1)) ^ (sw << 1)) << 4) + 8 * (p & 1); }
    const unsigned ldsw = (unsigned)wid * 1024u;
    const int aoff = lds_byte(wr * 64 + fr, fq * 8), boff = lds_byte(wc * 32 + fr, fq * 8);
    const int aoq0 = lds_byte(wr * 64 + fr, fq * 16), aoq1 = lds_byte(wr * 64 + fr, fq * 16 + 8), boq0 = lds_byte(wc * 32 + fr, fq * 16), boq1 = lds_byte(wc * 32 + fr, fq * 16 + 8);
#define PG8_SA(b, h) (((b) * 2 + (h)) * HTB)
#define PG8_SB(b, h) ((4 + (b) * 2 + (h)) * HTB)
#define PG8_STAGE(bufoff, gbase, voff) do { _Pragma("unroll") for (int _i = 0; _i < 2; ++_i) \
        __builtin_amdgcn_global_load_lds((const unsigned*)((const char*)(gbase) + (voff)[_i]), (PG8_LAS unsigned*)(lds + (bufoff) + ldsw + _i * 8192), 16, 0, 0); } while (0)
#define PG8_Q_At Aq
#define PG8_Q_B0 Bq0
#define PG8_Q_B1 Bq1
#define PG8_LD8(p0_, p1_) __builtin_shufflevector(*(const PG8_LAS i32x4*)(p0_), *(const PG8_LAS i32x4*)(p1_), 0, 1, 2, 3, 4, 5, 6, 7)
#define PG8_LDA(dst, b, h) do { if constexpr (FP8) { _Pragma("unroll") for (int m = 0; m < 4; ++m) PG8_Q_##dst[m] = PG8_LD8(lds + PG8_SA(b, h) + aoq0 + m * 2048, lds + PG8_SA(b, h) + aoq1 + m * 2048); } \
        else { _Pragma("unroll") for (int m = 0; m < 4; ++m) _Pragma("unroll") for (int k = 0; k < 2; ++k) dst[m][k] = *(const PG8_LAS bf16x8*)(lds + PG8_SA(b, h) + aoff + m * 2048 + k * 1024); } } while (0)
#define PG8_TR(dst, addr, OFF) asm volatile("ds_read_b64_tr_b16 %0, %1 offset:%2" : "=&v"(dst) : "v"(addr), "i"(OFF) : "memory")
#define PG8_LDB(dst, b, h) do { if constexpr (BKN) { _Pragma("unroll") for (int n = 0; n < 2; ++n) { const int ad_ = bbase[n] + PG8_SB(b, h); s16x4 l0_, h0_, l1_, h1_; \
            PG8_TR(l0_, ad_, 0); PG8_TR(h0_, ad_, 1024); PG8_TR(l1_, ad_, 8192); PG8_TR(h1_, ad_, 9216); \
            dst[n][0] = (bf16x8){l0_[0], l0_[1], l0_[2], l0_[3], h0_[0], h0_[1], h0_[2], h0_[3]}; dst[n][1] = (bf16x8){l1_[0], l1_[1], l1_[2], l1_[3], h1_[0], h1_[1], h1_[2], h1_[3]}; } } \
        else if constexpr (FP8) { _Pragma("unroll") for (int n = 0; n < 2; ++n) PG8_Q_##dst[n] = PG8_LD8(lds + PG8_SB(b, h) + boq0 + n * 2048, lds + PG8_SB(b, h) + boq1 + n * 2048); } \
        else { _Pragma("unroll") for (int n = 0; n < 2; ++n) _Pragma("unroll") for (int k = 0; k < 2; ++k) dst[n][k] = *(const PG8_LAS bf16x8*)(lds + PG8_SB(b, h) + boff + n * 2048 + k * 1024); } } while (0)
#define PG8_MMA(ai, bj, At, Bt) do { __builtin_amdgcn_s_setprio(1); if constexpr (FP8) { _Pragma("unroll") for (int m = 0; m < 4; ++m) _Pragma("unroll") for (int n = 0; n < 2; ++n) \
            asm volatile("v_mfma_scale_f32_16x16x128_f8f6f4 %0, %1, %2, %0, %3, %3 op_sel_hi:[0,0,0]" : "+v"(acc[ai][bj][m][n]) : "v"(PG8_Q_##Bt[n]), "v"(PG8_Q_##At[m]), "v"(sc1_)); } \
        else { _Pragma("unroll") for (int m = 0; m < 4; ++m) _Pragma("unroll") for (int n = 0; n < 2; ++n) _Pragma("unroll") for (int k = 0; k < 2; ++k) \
            acc[ai][bj][m][n] = __builtin_amdgcn_mfma_f32_16x16x32_bf16(Bt[n][k], At[m][k], acc[ai][bj][m][n], 0, 0, 0); } __builtin_amdgcn_s_setprio(0); } while (0)
#define PG8_WAIT_V(n) asm volatile("s_waitcnt vmcnt(" #n ")" ::: "memory")
#define PG8_WAIT_L(n) asm volatile("s_waitcnt lgkmcnt(" #n ")" ::: "memory")
#define PG8_BAR __builtin_amdgcn_s_barrier()
#define PG8_SCHED __builtin_amdgcn_sched_barrier(0)
    Unit cur, nxt; int ui = 0;
    if (!S.next(0, cur)) return;
    f32x4 acc[2][2][4][2];
#pragma unroll
    for (int a = 0; a < 2; ++a)
#pragma unroll
        for (int b = 0; b < 2; ++b)
#pragma unroll
            for (int m = 0; m < 4; ++m)
#pragma unroll
                for (int n = 0; n < 2; ++n) acc[a][b][m][n] = (f32x4){0.f, 0.f, 0.f, 0.f};
    bf16x8 At[4][2], B0[2][2], B1[2][2];
    i32x8 Aq[4], Bq0[2], Bq1[2]; const int sc1_ = 0x7F7F7F7F;
    const char* cA = GATHER ? (const char*)g.A : (const char*)g.A + (size_t)cur.pm * tstep; const char* cB = BKN ? (const char*)g.Bt + (size_t)(cur.pb >> 3) * ((size_t)K * 4096) + (size_t)(cur.pb & 7) * 512 : (const char*)g.Bt + (size_t)cur.pb * tstep;
    const size_t hA = GATHER ? 0 : hstep;
    if constexpr (GATHER) { PG8_GOFF(vA0, vA1, 0); } else {
#pragma unroll
        for (int i = 0; i < 2; ++i) { vA0[i] = voffA[i]; vA1[i] = voffA[i]; vN0[i] = voffA[i]; vN1[i] = voffA[i]; } }
    S.a_ready(cur);
    PG8_STAGE(PG8_SB(0, 0), cB, voffB); PG8_STAGE(PG8_SB(0, 1), cB + hstepB, voffB); PG8_STAGE(PG8_SA(0, 0), cA, vA0); PG8_STAGE(PG8_SA(0, 1), cA + hA, vA1);
    if (wr == 1) PG8_BAR;
    PG8_WAIT_V(2); PG8_BAR;
    PG8_STAGE(PG8_SB(1, 0), cB + kstepB, voffB); PG8_STAGE(PG8_SA(1, 0), cA + kstep, vA0); PG8_STAGE(PG8_SB(1, 1), cB + hstepB + kstepB, voffB);
    PG8_WAIT_V(6); PG8_BAR;
    for (;;) {
        const bool has_next = S.next(ui + 1, nxt);
        const char* nA = GATHER ? cA : (has_next ? (const char*)g.A + (size_t)nxt.pm * tstep : cA); const char* nB = has_next ? (BKN ? (const char*)g.Bt + (size_t)(nxt.pb >> 3) * ((size_t)K * 4096) + (size_t)(nxt.pb & 7) * 512 : (const char*)g.Bt + (size_t)nxt.pb * tstep) : cB;
        if constexpr (GATHER) { if (has_next) { PG8_GOFF(vN0, vN1, ui + 1); } else {
#pragma unroll
            for (int i = 0; i < 2; ++i) { vN0[i] = vA0[i]; vN1[i] = vA1[i]; } } }
#pragma unroll 1
        for (int t = 0; t < nt; t += 2) {
            const bool last = (t == nt - 2);
            unsigned s0[2], s1[2];
#pragma unroll
            for (int i = 0; i < 2; ++i) { s0[i] = (GATHER && last) ? vN0[i] : vA0[i]; s1[i] = (GATHER && last) ? vN1[i] : vA1[i]; }
            const char* a1 = cA + (size_t)(t + 1) * kstep;
            const char* a2 = last ? nA : cA + (size_t)(t + 2) * kstep; const char* b2 = last ? nB : cB + (size_t)(t + 2) * kstepB;
            const char* a3 = a2 + kstep; const char* b3 = b2 + kstepB;
            if (last && has_next) S.a_ready(nxt);
            PG8_LDB(B0, 0, 0); PG8_LDB(B1, 0, 1); PG8_SCHED; PG8_LDA(At, 0, 0); PG8_STAGE(PG8_SA(1, 1), a1 + hA, vA1);
            PG8_WAIT_V(8); PG8_WAIT_L(0); PG8_BAR; PG8_SCHED; PG8_MMA(0, 0, At, B0); PG8_MMA(0, 1, At, B1); PG8_BAR; PG8_SCHED;
            PG8_LDA(At, 0, 1); PG8_STAGE(PG8_SB(0, 0), b2, voffB); PG8_STAGE(PG8_SB(0, 1), b2 + hstepB, voffB); PG8_STAGE(PG8_SA(0, 0), a2, s0);
            PG8_WAIT_V(8); PG8_WAIT_L(0); PG8_BAR; PG8_SCHED; PG8_MMA(1, 0, At, B0); PG8_MMA(1, 1, At, B1); PG8_BAR; PG8_SCHED;
            PG8_LDB(B0, 1, 0); PG8_LDB(B1, 1, 1); PG8_SCHED; PG8_LDA(At, 1, 0); PG8_STAGE(PG8_SA(0, 1), a2 + hA, s1);
            PG8_WAIT_V(8); PG8_WAIT_L(0); PG8_BAR; PG8_SCHED; PG8_MMA(0, 0, At, B0); PG8_MMA(0, 1, At, B1); PG8_BAR; PG8_SCHED;
            PG8_LDA(At, 1, 1); PG8_STAGE(PG8_SB(1, 0), b3, voffB); PG8_STAGE(PG8_SB(1, 1), b3 + hstepB, voffB); PG8_STAGE(PG8_SA(1, 0), a3, s0);
            PG8_WAIT_V(8); PG8_WAIT_L(0); PG8_BAR; PG8_SCHED; PG8_MMA(1, 0, At, B0); PG8_MMA(1, 1, At, B1); PG8_BAR; PG8_SCHED;
        }
        if constexpr (ALIGN_EPI) { if (wr == 0) PG8_BAR; }
        if constexpr (FP8) asm volatile("s_nop 15\n\ts_nop 15" ::: "memory");
        { int ln_ = lane; asm volatile("" : "+v"(ln_)); E(acc, cur, wr, wc, ln_ & 15, ln_ >> 4); } S.done(cur);
        if (!has_next) break;
#pragma unroll
        for (int a = 0; a < 2; ++a)
#pragma unroll
            for (int b = 0; b < 2; ++b)
#pragma unroll
                for (int m = 0; m < 4; ++m)
#pragma unroll
                    for (int n = 0; n < 2; ++n) acc[a][b][m][n] = (f32x4){0.f, 0.f, 0.f, 0.f};
        cur = nxt; cA = nA; cB = nB; ++ui;
#pragma unroll
        for (int i = 0; i < 2; ++i) { vA0[i] = vN0[i]; vA1[i] = vN1[i]; }
        if constexpr (ALIGN_EPI) { if (wr == 1) PG8_BAR; }
    }
    PG8_WAIT_V(0);
    if constexpr (!ALIGN_EPI) { if (wr == 0) PG8_BAR; }
    PG8_BAR;
#undef PG8_GOFF
#undef PG8_Q_At
#undef PG8_Q_B0
#undef PG8_Q_B1
#undef PG8_LD8
#undef PG8_TR
#undef PG8_SA
#undef PG8_SB
#undef PG8_STAGE
#undef PG8_LDA
#undef PG8_LDB
#undef PG8_MMA
#undef PG8_WAIT_V
#undef PG8_WAIT_L
#undef PG8_BAR
#undef PG8_SCHED
}
}

#define XB_TMO      128
#define XB_XCNT(j)  (256  + 64 * (j))
#define XB_XSUB(j)  (1280 + 64 * (j))
#define XB_XGEN(j)  (2304 + 64 * (j))
#define XB_TOP      3328
#define XB_TOPGEN   3392
#define XCD_BAR_WORDS 3456
#define XB_SPIN_CAP (1u << 18)
__device__ __forceinline__ unsigned xb_ld(unsigned* p)              { return __hip_atomic_load(p, __ATOMIC_RELAXED, __HIP_MEMORY_SCOPE_AGENT); }
__device__ __forceinline__ unsigned xb_add(unsigned* p, unsigned v) { return __hip_atomic_fetch_add(p, v, __ATOMIC_RELAXED, __HIP_MEMORY_SCOPE_AGENT); }
__device__ __forceinline__ unsigned xb_xcc_id() { return (unsigned)__builtin_amdgcn_s_getreg((3 << 11) | 20) & 0xFu; }
#define XB_SPIN(cond, bar) do { unsigned _sp = 0; while (cond) { __builtin_amdgcn_s_sleep(1); \
    if ((++_sp & 255u) == 0u) { if (xb_ld(&(bar)[XB_TMO])) break; if (_sp > XB_SPIN_CAP) { atomicAdd(&(bar)[XB_TMO], 1u); break; } } } } while (0)
struct XcdBarrier { unsigned* bar; unsigned x; volatile LAS unsigned* st; };
__device__ __forceinline__ XcdBarrier xcd_barrier_post(unsigned* bar, volatile LAS unsigned* st) {
    XcdBarrier b; b.bar = bar; b.x = xb_xcc_id(); b.st = st;
    if (threadIdx.x == 0) (void)xb_add(&bar[XB_XCNT(b.x)], 1u);
    return b;
}
__device__ __forceinline__ void xcd_barrier_complete(unsigned* bar, unsigned x, unsigned& nloc, unsigned& nx) {
    const unsigned G = gridDim.x * gridDim.y * gridDim.z;
    unsigned sum, cnt, mine, sp = 0u;
    for (;;) {
        sum = 0u; cnt = 0u; mine = 0u;
#pragma unroll
        for (unsigned j = 0; j < 16; ++j) { const unsigned c = xb_ld(&bar[XB_XCNT(j)]); sum += c; cnt += (c > 0u) ? 1u : 0u; mine = (j == x) ? c : mine; }
        if (sum == G) break;
        __builtin_amdgcn_s_sleep(1);
        if ((++sp & 255u) == 0u) { if (xb_ld(&bar[XB_TMO])) break; if (sp > XB_SPIN_CAP) { atomicAdd(&bar[XB_TMO], 1u); break; } }
    }
    nloc = mine > 0u ? mine : 1u; nx = cnt > 0u ? cnt : 1u;
}
__device__ __forceinline__ void xcd_barrier(const XcdBarrier& b) {
    asm volatile("s_waitcnt vmcnt(0)" ::: "memory");
    __syncthreads();
    if (threadIdx.x == 0) {
        unsigned* bar = b.bar;
        __builtin_amdgcn_s_waitcnt(0);
        unsigned nloc = b.st[0], nx = b.st[1];
        if (nloc == 0u) { xcd_barrier_complete(bar, b.x, nloc, nx); b.st[0] = nloc; b.st[1] = nx; }
        const unsigned old = xb_add(&bar[XB_XSUB(b.x)], 1u);
        const unsigned gen = old / nloc;
        if (old + 1u == (gen + 1u) * nloc) {
            __builtin_amdgcn_fence(__ATOMIC_RELEASE, "agent");
            asm volatile("s_waitcnt vmcnt(0)" ::: "memory");
            const unsigned og = xb_add(&bar[XB_TOP], 1u);
            const unsigned tg = og / nx;
            if (og + 1u == (tg + 1u) * nx) xb_add(&bar[XB_TOPGEN], 1u);
            else XB_SPIN(xb_ld(&bar[XB_TOPGEN]) == tg, bar);
            __builtin_amdgcn_fence(__ATOMIC_ACQUIRE, "agent");
            xb_add(&bar[XB_XGEN(b.x)], 1u);
            asm volatile("s_waitcnt vmcnt(0)" ::: "memory");
        } else {
            XB_SPIN(xb_ld(&bar[XB_XGEN(b.x)]) == gen, bar);
            __builtin_amdgcn_fence(__ATOMIC_ACQUIRE, "agent");
            asm volatile("s_waitcnt vmcnt(0)" ::: "memory");
        }
    }
    __syncthreads();
}

constexpr int NWAVES = 8;
struct Frame {
    LAS unsigned char* lds;
    unsigned* ctl;
    int tid, lane, wave, vcu, G;
    const float *x, *mem, *norm1_g, *w_in, *q_norm_g, *k_norm_g, *conv_w, *mem_norm_g, *w_mem_kv, *mem_q_norm_g, *mem_k_norm_g, *out_norm_g, *w_out, *norm2_g,
                *w_rg, *b_rg, *w_re, *b_re, *w_gate, *w_up, *w_down;
    float* out; unsigned char* ws;
};

__device__ __forceinline__ void p0_transpose_item(const float* W, int N, int k0, int n0, const float* ks, bf16* dst, int pitch, LAS float* scr, int lane) {
#pragma unroll 8
    for (int i = 0; i < 32; ++i) { const int kk = 2 * i + (lane >> 5); scr[kk * 33 + (lane & 31)] = __builtin_nontemporal_load(W + (size_t)(k0 + kk) * N + n0 + (lane & 31)); }
    const int c = lane & 7;
    float g[8];
#pragma unroll
    for (int j = 0; j < 8; ++j) g[j] = ks ? ks[k0 + 8 * c + j] : 1.0f;
    LDS_WAIT(); asm volatile("" ::: "memory");
#pragma unroll
    for (int j = 0; j < 4; ++j) { const int n = (lane >> 3) + 8 * j; const LAS float* s = scr + (8 * c) * 33 + n;
        v4u o; o.x = pk2(s[0 * 33] * g[0], s[1 * 33] * g[1]); o.y = pk2(s[2 * 33] * g[2], s[3 * 33] * g[3]); o.z = pk2(s[4 * 33] * g[4], s[5 * 33] * g[5]); o.w = pk2(s[6 * 33] * g[6], s[7 * 33] * g[7]);
        *(GAS v4u*)(dst + (size_t)n * pitch + k0 + 8 * c) = o; }
    LDS_WAIT(); asm volatile("" ::: "memory");
}
__device__ __forceinline__ void rms_row_to_bf16(const float* xrow, const float* gain, bf16* orow, int lane) {
    const GAS f32x4* xr = (const GAS f32x4*)xrow + lane; const GAS f32x4* gr = (const GAS f32x4*)gain + lane;
    f32x4 v[8]; float s = 0.f;
#pragma unroll
    for (int j = 0; j < 8; ++j) { v[j] = __builtin_nontemporal_load(xr + 64 * j); s += (v[j].x * v[j].x + v[j].y * v[j].y) + (v[j].z * v[j].z + v[j].w * v[j].w); }
    const float rstd = 1.0f / sqrtf(wave_sum(s) * (1.f / D) + EPS);
    GAS v2u* o8 = (GAS v2u*)orow + lane;
#pragma unroll
    for (int j = 0; j < 8; ++j) { const f32x4 gg = gr[64 * j]; v2u o; o.x = pk2(v[j].x * rstd * gg.x, v[j].y * rstd * gg.y); o.y = pk2(v[j].z * rstd * gg.z, v[j].w * rstd * gg.w); o8[64 * j] = o; }
}
__device__ __forceinline__ void p0_transpose_item_q(const float* W, int N, int k0, int n0, const float* ks, float sc, unsigned char* dst, int pitch, LAS float* scr, int lane) {
#pragma unroll 8
    for (int i = 0; i < 64; ++i) { const int kk = 2 * i + (lane >> 5); scr[kk * 33 + (lane & 31)] = __builtin_nontemporal_load(W + (size_t)(k0 + kk) * N + n0 + (lane & 31)); }
    const int c = lane & 15;
    float g[8];
#pragma unroll
    for (int j = 0; j < 8; ++j) g[j] = ks ? ks[k0 + 8 * c + j] * sc : sc;
    LDS_WAIT(); asm volatile("" ::: "memory");
#pragma unroll
    for (int j = 0; j < 8; ++j) { const int n = (lane >> 4) + 4 * j; const LAS float* s = scr + (8 * c) * 33 + n;
        v2u o; o.x = pk_fp8x4(s[0 * 33] * g[0], s[1 * 33] * g[1], s[2 * 33] * g[2], s[3 * 33] * g[3]); o.y = pk_fp8x4(s[4 * 33] * g[4], s[5 * 33] * g[5], s[6 * 33] * g[6], s[7 * 33] * g[7]);
        __builtin_nontemporal_store(o, (GAS v2u*)(dst + (size_t)n * pitch + k0 + 8 * c)); }
    LDS_WAIT(); asm volatile("" ::: "memory");
}
__device__ __forceinline__ void p0_prologue(Frame& F) {
    LAS float* scr = (LAS float*)(F.lds + F.wave * 16896);
    const int gw = F.vcu * NWAVES + F.wave, NGW = F.G * NWAVES;
    bf16* Win_t = (bf16*)(F.ws + WS_WIN); bf16* Wmkv_t = (bf16*)(F.ws + WS_WMKV); bf16* Wout_t = (bf16*)(F.ws + WS_WOUT);
    constexpr int I_IN = 32 * 160, I_MKV = 32 * 32, I_OUT = 32 * 64;
    constexpr int NITEMS = I_IN + I_MKV + I_OUT;
    for (int it = gw; it < NITEMS; it += NGW) {
        int r = it;
        if (r < I_IN) { const int kb = r / 160, nb = r % 160; p0_transpose_item(F.w_in, PROJ, 64 * kb, 32 * nb, nullptr, Win_t + (size_t)(32 * nb) * D, D, scr, F.lane); continue; } r -= I_IN;
        if (r < I_MKV) { const int kb = r / 32, nb = r % 32; p0_transpose_item(F.w_mem_kv, 1024, 64 * kb, 32 * nb, nullptr, Wmkv_t + (size_t)(32 * nb) * D, D, scr, F.lane); continue; } r -= I_MKV;
        { const int kb = r / 64, nb = r % 64; p0_transpose_item(F.w_out, D, 64 * kb, 32 * nb, nullptr, Wout_t + (size_t)(32 * nb) * D, D, scr, F.lane); }
    }
    { LAS float* scq = (LAS float*)(F.lds + F.wave * 16896);
      unsigned char* Wgu_q = (unsigned char*)(F.ws + WS_WGU); unsigned char* Wd_q = (unsigned char*)(F.ws + WS_WD);
      constexpr int IPE = 512 + 512 + 512;
      for (int it = gw; it < 64 * IPE; it += NGW) { const int e = it / IPE; int r = it - e * IPE;
          if (r < 1024) { const int up = r >> 9, q = r & 511, kb = q >> 5, nb = q & 31, n0 = 32 * nb;
              const float* W = (up ? F.w_up : F.w_gate) + (size_t)e * D * DEXP; const int drow = 256 * (n0 >> 7) + 128 * up + (n0 & 127);
              p0_transpose_item_q(W, DEXP, 128 * kb, n0, F.norm2_g, SC_WGU, Wgu_q + ((size_t)e * 2048 + drow) * D, D, scq, F.lane); }
          else { const int q = r - 1024, kb = q >> 6, nb = q & 63;
              p0_transpose_item_q(F.w_down + (size_t)e * DEXP * D, D, 128 * kb, 32 * nb, nullptr, SC_WD, Wd_q + ((size_t)e * 2048 + 32 * nb) * DEXP, DEXP, scq, F.lane); } } }
    { bf16* WT = (bf16*)(F.ws + WS_WR); const int gt = (F.vcu * NWAVES + F.wave) * 64 + F.lane, NT = F.G * NWAVES * 64;
      for (int i = gt; i < 96 * 2048; i += NT) { const int n = i >> 11, k = i & 2047;
          float w = n < 64 ? F.w_re[k * 64 + n] : (n < 72 ? F.w_rg[k * 8 + (n - 64)] : 0.f); w *= F.norm2_g[k];
          const unsigned h = f2bf(w); const float hf = __builtin_bit_cast(float, h << 16);
          WT[i] = (bf16)h; WT[96 * 2048 + i] = (bf16)f2bf(w - hf); } }
    bf16* H = (bf16*)(F.ws + WS_H);
    for (int m = gw; m < T + 512; m += NGW) {
        if (m < T) rms_row_to_bf16(F.x + (size_t)m * D, F.norm1_g, H + (size_t)m * D, F.lane);
        else rms_row_to_bf16(F.mem + (size_t)(m - T) * D, F.mem_norm_g, H + (size_t)m * D, F.lane);
    }
}

namespace att {
constexpr int LDS_K = 0, LDS_V = 65536, LDS_STG = 131072, LDS_LI = LDS_STG + 16384, LDS_GT = LDS_LI + 8 * 256;
constexpr float CS = 0.08838834764831845f * LOG2E;
#define KSWZ(row, colB) ((row) * 256 + ((colB) ^ (((row) & 7) << 4)))
__device__ __forceinline__ int crow(int r, int hi) { return (r & 3) + 8 * (r >> 2) + 4 * hi; }
__device__ __forceinline__ int v_rd_base(int lane) { return ((lane & 3) << 3) | (((lane >> 2) & 3) << 6) | (((lane >> 4) & 1) << 5) | (((lane >> 5) & 1) << 8); }
template <int OFF> __device__ __forceinline__ s16x4 tr_read(int vb) { s16x4 r; asm volatile("ds_read_b64_tr_b16 %0, %1 offset:%2" : "=&v"(r) : "v"(vb), "i"(OFF) : "memory"); return r; }

struct RowMap { const char* base; long stride; int win0; bool wrap; };
__device__ __forceinline__ const char* rowptr(const RowMap& m, int p) { int sp = m.wrap ? m.win0 + ((p - m.win0) & 255) : p; sp = sp < 0 ? 0 : sp; return m.base + (long)sp * m.stride; }

__device__ __forceinline__ void dma_k(LAS unsigned char* Kl, int p0, int nrows, const RowMap& m, int wave, int lane) {
    asm volatile("" : "+v"(lane));
#pragma unroll 1
    for (int i = 0; i < nrows / 32; ++i) {
        const int prow0 = p0 + 32 * i + 4 * wave, prow = prow0 + (lane >> 4);
        const char* src = rowptr(m, prow) + (((lane & 15) ^ (prow & 7)) << 4);
        __builtin_amdgcn_global_load_lds((const unsigned*)src, (LAS unsigned*)(Kl + prow0 * 256), 16, 0, 0);
    }
}
__device__ __forceinline__ void dma_v(LAS unsigned char* Vl, int p0, int nrows, const RowMap& m, int wave, int lane) {
    asm volatile("" : "+v"(lane));
#pragma unroll 1
    for (int i = 0; i < nrows / 32; ++i) {
        const int ii = wave + 8 * i, g = (p0 >> 4) + (ii >> 2), q = ii & 3;
        const int kk = ((q >> 1) << 3) + ((lane & 31) >> 2), k = (kk & ~0xC) | ((kk & 4) << 1) | ((kk & 8) >> 1);
        const int c = 32 * (2 * (q & 1) + (lane >> 5)) + 8 * (lane & 3);
        const char* src = rowptr(m, 16 * g + k) + c * 2;
        __builtin_amdgcn_global_load_lds((const unsigned*)src, (LAS unsigned*)(Vl + g * 4096 + q * 1024), 16, 0, 0);
    }
}
__device__ __forceinline__ void dma_v2(LAS unsigned char* Vl, int p0, int nrows, const RowMap& m, int wave, int lane) {
    asm volatile("" : "+v"(lane));
#pragma unroll 1
    for (int i = 0; i < nrows / 32; ++i) {
        const int prow0 = p0 + 32 * i + 4 * wave, prow = prow0 + (lane >> 4);
        const char* src = rowptr(m, prow) + (((lane & 15) ^ ((prow & 7) << 1)) << 4);
        __builtin_amdgcn_global_load_lds((const unsigned*)src, (LAS unsigned*)(Vl + prow0 * 256), 16, 0, 0);
    }
}
__device__ __forceinline__ void load_q16(v4u (&raw)[4], const char* qrow, int kg) {
#pragma unroll
    for (int s = 0; s < 4; ++s) raw[s] = *(const GAS v4u*)(qrow + (32 * s + 8 * kg) * 2);
}
__device__ __forceinline__ void norm_q16(const v4u (&raw)[4], bf16x8 (&qr)[4], const LAS float* gt, int kg) {
    float ss = 0.f;
#pragma unroll
    for (int s = 0; s < 4; ++s)
#pragma unroll
        for (int j = 0; j < 4; ++j) { const float a = bflo(raw[s][j]), b = bfhi(raw[s][j]); ss += a * a + b * b; }
    ss += __shfl_xor(ss, 16); ss += __shfl_xor(ss, 32);
    const float rstd = 1.0f / sqrtf(ss * (1.f / HD) + EPS);
#pragma unroll
    for (int s = 0; s < 4; ++s) { const LAS f32x4* gp = (const LAS f32x4*)(gt + 32 * s + 8 * kg); const f32x4 g0 = gp[0], g1 = gp[1]; v4u o;
        o.x = cvtpk(bflo(raw[s].x) * rstd * g0.x, bfhi(raw[s].x) * rstd * g0.y); o.y = cvtpk(bflo(raw[s].y) * rstd * g0.z, bfhi(raw[s].y) * rstd * g0.w);
        o.z = cvtpk(bflo(raw[s].z) * rstd * g1.x, bfhi(raw[s].z) * rstd * g1.y); o.w = cvtpk(bflo(raw[s].w) * rstd * g1.z, bfhi(raw[s].w) * rstd * g1.w);
        qr[s] = __builtin_bit_cast(bf16x8, o); }
}
__device__ __forceinline__ void norm_k(LAS unsigned char* Kl, int p0, int nrows, const LAS float* gt, int tid) {
    asm volatile("" : "+v"(tid));
#pragma unroll 1
    for (int idx = tid; idx < nrows * 4; idx += 512) {
        const int row = p0 + (idx >> 2), qd = idx & 3;
        v4u w[4]; float ss = 0.f;
#pragma unroll
        for (int i = 0; i < 4; ++i) { w[i] = *(const LAS v4u*)(Kl + KSWZ(row, (4 * qd + i) * 16));
#pragma unroll
            for (int j = 0; j < 4; ++j) { const float a = bflo(w[i][j]), b = bfhi(w[i][j]); ss += a * a + b * b; } }
        ss += __shfl_xor(ss, 1); ss += __shfl_xor(ss, 2);
        const float rstd = 1.0f / sqrtf(ss * (1.f / HD) + EPS);
#pragma unroll
        for (int i = 0; i < 4; ++i) { const LAS f32x4* gp = (const LAS f32x4*)(gt + (4 * qd + i) * 8); const f32x4 g0 = gp[0], g1 = gp[1]; v4u o;
            o.x = cvtpk(bflo(w[i].x) * rstd * g0.x, bfhi(w[i].x) * rstd * g0.y); o.y = cvtpk(bflo(w[i].y) * rstd * g0.z, bfhi(w[i].y) * rstd * g0.w);
            o.z = cvtpk(bflo(w[i].z) * rstd * g1.x, bfhi(w[i].z) * rstd * g1.y); o.w = cvtpk(bflo(w[i].w) * rstd * g1.z, bfhi(w[i].w) * rstd * g1.w);
            *(LAS v4u*)(Kl + KSWZ(row, (4 * qd + i) * 16)) = o; }
    }
}
__device__ __forceinline__ float xsum32(float v) { unsigned a = __builtin_bit_cast(unsigned, v), b = a; asm volatile("s_nop 1\n\tv_permlane32_swap_b32 %0, %1" : "+v"(a), "+v"(b)); return __builtin_bit_cast(float, a) + __builtin_bit_cast(float, b); }
__device__ __forceinline__ void load_q(v4u (&raw)[8], const char* qrow, int hi) {
#pragma unroll
    for (int d0 = 0; d0 < 8; ++d0) raw[d0] = *(const GAS v4u*)(qrow + (d0 * 16 + hi * 8) * 2);
}
__device__ __forceinline__ void norm_q(const v4u (&raw)[8], bf16x8 (&qr)[8], const LAS float* gt, int hi) {
    float ss = 0.f;
#pragma unroll
    for (int d0 = 0; d0 < 8; ++d0)
#pragma unroll
        for (int j = 0; j < 4; ++j) { const float a = bflo(raw[d0][j]), b = bfhi(raw[d0][j]); ss += a * a + b * b; }
    ss = xsum32(ss);
    const float rstd = 1.0f / sqrtf(ss * (1.f / HD) + EPS);
#pragma unroll
    for (int d0 = 0; d0 < 8; ++d0) { const LAS f32x4* gp = (const LAS f32x4*)(gt + d0 * 16 + hi * 8); const f32x4 g0 = gp[0], g1 = gp[1]; v4u o;
        o.x = cvtpk(bflo(raw[d0].x) * rstd * g0.x, bfhi(raw[d0].x) * rstd * g0.y); o.y = cvtpk(bflo(raw[d0].y) * rstd * g0.z, bfhi(raw[d0].y) * rstd * g0.w);
        o.z = cvtpk(bflo(raw[d0].z) * rstd * g1.x, bfhi(raw[d0].z) * rstd * g1.y); o.w = cvtpk(bflo(raw[d0].w) * rstd * g1.z, bfhi(raw[d0].w) * rstd * g1.w);
        qr[d0] = __builtin_bit_cast(bf16x8, o); }
}
__device__ __forceinline__ f32x16 qk_tile(const LAS unsigned char* Kl, int pb, const bf16x8 (&qr)[8], int r32, int hi) {
    f32x16 p = {};
#pragma unroll
    for (int d0 = 0; d0 < 8; ++d0) { const bf16x8 kf = *(const LAS bf16x8*)(Kl + KSWZ(pb + r32, (d0 * 16 + hi * 8) * 2));
        p = __builtin_amdgcn_mfma_f32_32x32x16_bf16(kf, qr[d0], p, 0, 0, 0); }
    return p;
}
#define PK4(P, BASE, OUT) do { unsigned a0 = cvtpk(P[BASE + 0], P[BASE + 1]), a1 = cvtpk(P[BASE + 2], P[BASE + 3]);   \
    unsigned b0 = cvtpk(P[BASE + 4], P[BASE + 5]), b1 = cvtpk(P[BASE + 6], P[BASE + 7]);                              \
    auto r0 = __builtin_amdgcn_permlane32_swap(a0, b0, false, false); auto r1 = __builtin_amdgcn_permlane32_swap(a1, b1, false, false); \
    v4u w_ = {r0[0], r1[0], r0[1], r1[1]}; OUT = __builtin_bit_cast(bf16x8, w_); } while (0)
template <int OFF> __device__ __forceinline__ void pv_step(f32x16& o, int vb, bf16x8 pa) {
    const s16x4 l = tr_read<OFF>(vb), h = tr_read<OFF + 2048>(vb);
    asm volatile("s_waitcnt lgkmcnt(0)" ::: "memory"); __builtin_amdgcn_sched_barrier(0);
    o = __builtin_amdgcn_mfma_f32_32x32x16_bf16(pa, (bf16x8){l[0], l[1], l[2], l[3], h[0], h[1], h[2], h[3]}, o, 0, 0, 0);
}
__device__ __forceinline__ void store_block(const f32x16& o, const LAS float* il, LAS unsigned short* stg, char* dst0, long rstride, int lane) {
    asm volatile("" : "+v"(lane));
    const int r32 = lane & 31, hi = lane >> 5;
#pragma unroll
    for (int r = 0; r < 16; ++r) { const int row = crow(r, hi); stg[row * 32 + r32] = (unsigned short)f2bf(o[r] * il[row]); }
    LDS_WAIT(); asm volatile("" ::: "memory");
#pragma unroll
    for (int p = 0; p < 2; ++p) { const int row = 16 * p + (lane >> 2), ch = lane & 3;
        const v4u w = *(const LAS v4u*)((const LAS unsigned char*)stg + row * 64 + ch * 16);
        *(GAS v4u*)(dst0 + (long)row * rstride + ch * 16) = w; }
    LDS_WAIT(); asm volatile("" ::: "memory");
}
}

#define RAW_BAR() do { asm volatile("s_waitcnt lgkmcnt(0)" ::: "memory"); __builtin_amdgcn_s_barrier(); asm volatile("" ::: "memory"); } while (0)
__device__ __forceinline__ void p2_attention(Frame& F) {
    using namespace att;
    LAS unsigned char* Kl = F.lds + LDS_K; LAS unsigned char* Vl = F.lds + LDS_V;
    LAS unsigned short* stg = (LAS unsigned short*)(F.lds + LDS_STG + F.wave * 2048);
    LAS float* li = (LAS float*)(F.lds + LDS_LI + F.wave * 256);
    LAS float* gtab = (LAS float*)(F.lds + LDS_GT);
    LAS float* rk = (LAS float*)(F.lds + LDS_GT + 2048);
    volatile LAS int* QN = (volatile LAS int*)(F.lds + LDS_GT + 2048 + 1024);
    const int tid = F.tid, wave = F.wave;
    if (blockIdx.x < 8) {
        pg8::Gemm g{(const bf16*)(F.ws + WS_H), (const bf16*)(F.ws + WS_WIN), D, nullptr}; pg8::P1Order S{F.G, (int)blockIdx.x, 2560, 2568};
        pg8::EpiProj E{(bf16*)(F.ws + WS_R1), (bf16*)(F.ws + WS_MEMKV)};
        pg8::gemm_phase<pg8::EpiProj, pg8::P1Order>(F.lds, g, S, E);
        VM_WAIT(); __syncthreads();
        if (tid == 0) { __builtin_amdgcn_fence(__ATOMIC_RELEASE, "agent"); asm volatile("s_waitcnt vmcnt(0)" ::: "memory"); __hip_atomic_fetch_add(F.ctl + CW_KVREADY, 1u, RLX_AGENT); }
    }
    if (tid < 128) { gtab[tid] = F.q_norm_g[tid] * F.k_norm_g[tid]; gtab[128 + tid] = F.mem_q_norm_g[tid] * F.mem_k_norm_g[tid]; gtab[256 + tid] = F.mem_q_norm_g[tid]; gtab[384 + tid] = F.mem_k_norm_g[tid]; }
    if (tid == 0) QN[0] = 1 << 30;
    __syncthreads();
    float MD, MM;
    { float a = 0.f, c = 0.f;
#pragma unroll 1
      for (int i = 0; i < 128; ++i) { a = fmaxf(a, fabsf(gtab[i])); c = fmaxf(c, fabsf(gtab[128 + i])); }
      MD = a * (128.0f * 1.03f) * CS; MM = c * (128.0f * 1.03f) * CS; }
    const char* proj = (const char*)(F.ws + WS_R1);

    {
    const int j = wave & 3, dh = wave >> 2, w0 = 32 * j + 16 * dh;
    constexpr int NCHUNK = 6144 / 4;
    v4u qraw[4];
#define DECODE(u, br, b, h, r, nb, dil) const int br = (u) >> 11, _rem = (u) & 2047, b = _rem >> 10, h = (_rem >> 7) & 7, _w = _rem & 127, dil = 1 << (2 * br), _nps = 128 >> (2 * br), r = _w / _nps, nb = _w % _nps
    int u = 4 * F.vcu;
    bool have = F.vcu < NCHUNK;
    bool full = true;
    if (have) {
        DECODE(u, br, b, h, r, nb, dil);
        const long rs = (long)dil * PROJ * 2; const char* tb = proj + (size_t)(b * SEQ + r) * (PROJ * 2);
        RowMap mk{tb + (COL_K + h * HD) * 2, rs, 128 * nb - 128, true};
        dma_k(Kl, 0, 256, mk, wave, F.lane);
        load_q16(qraw, tb + (long)(128 * nb + w0 + (F.lane & 15)) * rs + (COL_Q + h * HD) * 2, F.lane >> 4);
    }
    while (have) {
        DECODE(u, br, b, h, r, nb, dil);
        int lane = F.lane; asm volatile("" : "+v"(lane));
        const int q16 = lane & 15, kg = lane >> 4;
        const int off = 128 * ((nb + 1) & 1);
        const long rs_ = (long)dil * PROJ * 2; const char* tb_ = proj + (size_t)(b * SEQ + r) * (PROJ * 2);
        asm volatile("s_waitcnt vmcnt(0)" ::: "memory"); RAW_BAR();
        { RowMap mv{tb_ + (COL_V + h * HD) * 2, rs_, 128 * nb - 128, true};
          if (full) dma_v2(Vl, 0, 256, mv, wave, lane); else dma_v2(Vl, 128 * (nb & 1), 128, mv, wave, lane); }
        if ((u & 3) == 0 && tid == 0) QN[0] = F.G + (int)__hip_atomic_fetch_add(F.ctl + CW_ATTQ, 1u, RLX_AGENT);
        { const int p0 = full ? 0 : 128 * (nb & 1), n4 = full ? 1024 : 512;
#pragma unroll 1
          for (int idx = tid; idx < n4; idx += 512) { const int row = p0 + (idx >> 2), qd = idx & 3; float ss = 0.f;
#pragma unroll
              for (int i = 0; i < 4; ++i) { const v4u w = *(const LAS v4u*)(Kl + KSWZ(row, (4 * qd + i) * 16));
#pragma unroll
                  for (int jj = 0; jj < 4; ++jj) { const float a = bflo(w[jj]), c = bfhi(w[jj]); ss += a * a + c * c; } }
              ss += __shfl_xor(ss, 1); ss += __shfl_xor(ss, 2);
              if (qd == 0) rk[row] = 1.0f / sqrtf(ss * (1.f / HD) + EPS); } }
        bf16x8 qr[4];
        norm_q16(qraw, qr, gtab, kg);
        f32x4 s[9];
#pragma unroll
        for (int t = 0; t < 9; ++t) { const int pb = (w0 + 16 * t + off) & 255; f32x4 a = {0.f, 0.f, 0.f, 0.f};
#pragma unroll
            for (int d = 0; d < 4; ++d) { const bf16x8 kf = *(const LAS bf16x8*)(Kl + KSWZ(pb + q16, 64 * d + 16 * kg));
                a = __builtin_amdgcn_mfma_f32_16x16x32_bf16(kf, qr[d], a, 0, 0, 0); }
            s[t] = a; }
        RAW_BAR();
        int un = u + 1; bool has_next = true;
        if ((un & 3) == 0) { const int nc = QN[0]; has_next = nc < NCHUNK; un = 4 * nc; }
        bool n_full = false;
        if (has_next) {
            DECODE(un, br2, b2, h2, r2, nb2, dil2);
            n_full = (un != u + 1) || (nb2 == 0);
            const long rs = (long)dil2 * PROJ * 2; const char* tb = proj + (size_t)(b2 * SEQ + r2) * (PROJ * 2);
            RowMap nmk{tb + (COL_K + h2 * HD) * 2, rs, 128 * nb2 - 128, true};
            if (n_full) dma_k(Kl, 0, 256, nmk, wave, lane); else dma_k(Kl, 128 * (nb2 & 1), 128, nmk, wave, lane);
            load_q16(qraw, tb + (long)(128 * nb2 + w0 + q16) * rs + (COL_Q + h2 * HD) * 2, kg);
        }
        const float bias2 = __builtin_amdgcn_exp2f(-(float)(h + 1)) * (float)dil * LOG2E;
        const float rowoff = bias2 * (float)(4 * kg - q16 - 128) - MD;
        float l = 0.f;
#pragma unroll
        for (int t = 0; t < 9; ++t) {
            const int pb = (w0 + 16 * t + off) & 255;
            const f32x4 rkv = *(const LAS f32x4*)(rk + pb + 4 * kg);
            const bool dead = (nb == 0) && (w0 + 16 * t < 128);
#pragma unroll
            for (int r_ = 0; r_ < 4; ++r_) {
                float v = fmaf(s[t][r_] * rkv[r_], CS, fmaf(bias2, (float)(16 * t + r_), rowoff));
                if (t == 0) v = (4 * kg + r_ >= q16) ? v : -1.0e30f;
                if (t == 8) v = (4 * kg + r_ <= q16) ? v : -1.0e30f;
                v = dead ? 0.f : __builtin_amdgcn_exp2f(v); s[t][r_] = v; l += v; }
        }
        l += __shfl_xor(l, 16); l += __shfl_xor(l, 32);
        bf16x8 pa[5];
#pragma unroll
        for (int sp = 0; sp < 5; ++sp) { v4u w; w.x = cvtpk(s[2 * sp][0], s[2 * sp][1]); w.y = cvtpk(s[2 * sp][2], s[2 * sp][3]);
            if (sp < 4) { w.z = cvtpk(s[2 * sp + 1][0], s[2 * sp + 1][1]); w.w = cvtpk(s[2 * sp + 1][2], s[2 * sp + 1][3]); } else { w.z = 0u; w.w = 0u; }
            pa[sp] = __builtin_bit_cast(bf16x8, w); }
        if (has_next) asm volatile("s_waitcnt vmcnt(8)" ::: "memory"); else asm volatile("s_waitcnt vmcnt(0)" ::: "memory");
        RAW_BAR();
        f32x4 o[8];
#pragma unroll
        for (int db = 0; db < 8; ++db) o[db] = (f32x4){0.f, 0.f, 0.f, 0.f};
        { const int qq = q16 >> 2, pp = q16 & 3;
#pragma unroll
          for (int sp = 0; sp < 5; ++sp) {
              const int ra = (w0 + 32 * sp + off + 4 * kg + qq) & 255, rb = (w0 + 32 * sp + 16 + off + 4 * kg + qq) & 255;
              const int va = (int)(uintptr_t)Vl + ra * 256 + 8 * pp, vb = (int)(uintptr_t)Vl + rb * 256 + 8 * pp, xa = (ra & 7) << 5, xb = (rb & 7) << 5;
#pragma unroll
              for (int dq = 0; dq < 2; ++dq) {
                  s16x4 la[4], lb[4];
#pragma unroll
                  for (int i = 0; i < 4; ++i) { const int db = 4 * dq + i;
                      asm volatile("ds_read_b64_tr_b16 %0, %1" : "=&v"(la[i]) : "v"(va + ((32 * db) ^ xa)) : "memory");
                      asm volatile("ds_read_b64_tr_b16 %0, %1" : "=&v"(lb[i]) : "v"(vb + ((32 * db) ^ xb)) : "memory"); }
                  asm volatile("s_waitcnt lgkmcnt(0)" ::: "memory"); __builtin_amdgcn_sched_barrier(0);
#pragma unroll
                  for (int i = 0; i < 4; ++i) { const int db = 4 * dq + i;
                      o[db] = __builtin_amdgcn_mfma_f32_16x16x32_bf16(pa[sp], (bf16x8){la[i][0], la[i][1], la[i][2], la[i][3], lb[i][0], lb[i][1], lb[i][2], lb[i][3]}, o[db], 0, 0, 0); }
              } } }
        const float il = 1.0f / l;
        if (kg == 0) li[q16] = il;
        LDS_WAIT(); asm volatile("" ::: "memory");
        const f32x4 ilr = *(const LAS f32x4*)(li + 4 * kg);
        const int tok0 = b * SEQ + r + dil * (128 * nb + w0);
        char* dst = (char*)(F.ws + WS_OPART) + ((size_t)br * T + tok0) * (ATTN_W * 2) + (h * HD) * 2;
#pragma unroll
        for (int hf = 0; hf < 2; ++hf) {
#pragma unroll
            for (int i = 0; i < 4; ++i)
#pragma unroll
                for (int r_ = 0; r_ < 4; ++r_) stg[(4 * kg + r_) * 64 + 16 * i + q16] = (unsigned short)f2bf(o[4 * hf + i][r_] * ilr[r_]);
            LDS_WAIT(); asm volatile("" ::: "memory");
#pragma unroll
            for (int p = 0; p < 2; ++p) { const int row = lane >> 2, ch = (lane & 3) + 4 * p;
                const v4u w = *(const LAS v4u*)((const LAS unsigned char*)stg + row * 128 + ch * 16);
                *(GAS v4u*)(dst + (long)row * ((long)dil * ATTN_W * 2) + hf * 128 + ch * 16) = w; }
            LDS_WAIT(); asm volatile("" ::: "memory");
        }
        if (kg == 0) ((float*)(F.ws + WS_LSE))[((size_t)br * T + tok0 + dil * q16) * 8 + h] = MD + __builtin_amdgcn_logf(l);
        have = has_next; u = un; full = n_full;
    }
#undef DECODE
    }

    VM_WAIT(); __syncthreads();
    if (wave == 0) { unsigned sp = 0;
        while (__builtin_amdgcn_readfirstlane(__hip_atomic_load(F.ctl + CW_KVREADY, RLX_AGENT)) < 8u) { __builtin_amdgcn_s_sleep(2); if (++sp > (1u << 22)) { if (F.lane == 0) __hip_atomic_store(F.ctl + CW_TMO, 1u, RLX_AGENT); break; } }
        __builtin_amdgcn_fence(__ATOMIC_ACQUIRE, "agent"); asm volatile("s_waitcnt vmcnt(0)" ::: "memory"); }
    __syncthreads();
    for (int it = F.vcu; it < 256; it += F.G) {
        const int combo = it >> 5, part = it & 31, b = combo >> 2, hm = combo & 3;
        const char* mkv = (const char*)(F.ws + WS_MEMKV) + (size_t)(b * NMEM) * 2048 + hm * 256;
        RowMap mk{mkv, 2048, 0, false}, mv{mkv + 1024, 2048, 0, false};
        __syncthreads();
        dma_k(Kl, 0, 256, mk, wave, F.lane); dma_v(Vl, 0, 256, mv, wave, F.lane);
        VM_WAIT(); __syncthreads();
        norm_k(Kl, 0, 256, gtab + 384, tid);
        __syncthreads();
        for (int qb = 0; qb < 2; ++qb) {
            int lane = F.lane; asm volatile("" : "+v"(lane));
            const int r32 = lane & 31, hi = lane >> 5, vbase = (int)(uintptr_t)Vl + v_rd_base(lane);
            const int tok = b * SEQ + part * 512 + qb * 256 + wave * 32 + r32;
            v4u raw[8]; bf16x8 qr[8];
            load_q(raw, proj + (size_t)tok * (PROJ * 2) + (COL_MQ + hm * HD) * 2, hi);
            norm_q(raw, qr, gtab + 256, hi);
            const float mc = -MM; float l = 0.f;
            f32x16 o[4] = {};
#pragma unroll 1
            for (int hk = 0; hk < 2; ++hk) {
                bf16x8 pa[8];
#pragma unroll
                for (int kt = 0; kt < 4; ++kt) { f32x16 s = qk_tile(Kl, 128 * hk + 32 * kt, qr, r32, hi);
#pragma unroll
                    for (int r = 0; r < 16; ++r) { s[r] = __builtin_amdgcn_exp2f(fmaf(s[r], CS, mc)); l += s[r]; }
                    PK4(s, 0, pa[2 * kt]); PK4(s, 8, pa[2 * kt + 1]); }
#pragma unroll
                for (int f = 0; f < 8; ++f) { const int vb = vbase + (8 * hk + f) * 4096;
                    pv_step<0>(o[0], vb, pa[f]); pv_step<512>(o[1], vb, pa[f]); pv_step<1024>(o[2], vb, pa[f]); pv_step<1536>(o[3], vb, pa[f]); }
            }
            l = xsum32(l);
            if (hi == 0) li[r32] = 1.0f / l;
            LDS_WAIT(); asm volatile("" ::: "memory");
            char* dst = (char*)(F.ws + WS_MEMO) + (size_t)(tok - r32) * (MEM_W * 2) + hm * 256;
#pragma unroll
            for (int d0 = 0; d0 < 4; ++d0) store_block(o[d0], li, stg, dst + d0 * 64, MEM_W * 2, lane);
        }
    }
}

__device__ __forceinline__ void unpack8(const v4u w, float (&f)[8]) { f[0] = bflo(w.x); f[1] = bfhi(w.x); f[2] = bflo(w.y); f[3] = bfhi(w.y); f[4] = bflo(w.z); f[5] = bfhi(w.z); f[6] = bflo(w.w); f[7] = bfhi(w.w); }
__device__ __forceinline__ void p3_combine(Frame& F) {
    const int gw = F.vcu * NWAVES + F.wave, NGW = F.G * NWAVES, lane = F.lane;
    const bf16* proj = (const bf16*)(F.ws + WS_R1); const bf16* opart = (const bf16*)(F.ws + WS_OPART); const float* lse = (const float*)(F.ws + WS_LSE);
    const bf16* memo = (const bf16*)(F.ws + WS_MEMO); bf16* Y = (bf16*)(F.ws + WS_Y);
    for (int t = gw; t < T; t += NGW) {
        float a[16]; float ssa = 0.f;
#pragma unroll
        for (int cc = 0; cc < 2; ++cc) { const int head = 4 * cc + (lane >> 4);
            const float l0 = lse[((size_t)0 * T + t) * 8 + head], l1 = lse[((size_t)1 * T + t) * 8 + head], l2 = lse[((size_t)2 * T + t) * 8 + head];
            const float mx = fmaxf(l0, fmaxf(l1, l2)); float w0 = __builtin_amdgcn_exp2f(l0 - mx), w1 = __builtin_amdgcn_exp2f(l1 - mx), w2 = __builtin_amdgcn_exp2f(l2 - mx);
            const float inv = 1.0f / (w0 + w1 + w2); w0 *= inv; w1 *= inv; w2 *= inv;
            float f0[8], f1[8], f2[8];
            unpack8(__builtin_nontemporal_load((const GAS v4u*)(opart + ((size_t)0 * T + t) * ATTN_W + cc * 512 + 8 * lane)), f0);
            unpack8(__builtin_nontemporal_load((const GAS v4u*)(opart + ((size_t)1 * T + t) * ATTN_W + cc * 512 + 8 * lane)), f1);
            unpack8(__builtin_nontemporal_load((const GAS v4u*)(opart + ((size_t)2 * T + t) * ATTN_W + cc * 512 + 8 * lane)), f2);
#pragma unroll
            for (int jj = 0; jj < 8; ++jj) { const float v = w0 * f0[jj] + w1 * f1[jj] + w2 * f2[jj]; a[8 * cc + jj] = v; ssa += v * v; } }
        float co[8]; float ssc = 0.f;
        { const int s = t & (SEQ - 1); float bg[8], c0[8], uu0[8], c1[8], uu1[8], c2[8], uu2[8];
          const bf16* p0 = proj + (size_t)t * PROJ + 8 * lane;
          unpack8(*(const GAS v4u*)(p0 + COL_B), bg); unpack8(*(const GAS v4u*)(p0 + COL_C), c0); unpack8(*(const GAS v4u*)(p0 + COL_U), uu0);
          if (s >= 1) { unpack8(*(const GAS v4u*)(p0 - PROJ + COL_C), c1); unpack8(*(const GAS v4u*)(p0 - PROJ + COL_U), uu1); }
          if (s >= 2) { unpack8(*(const GAS v4u*)(p0 - 2 * PROJ + COL_C), c2); unpack8(*(const GAS v4u*)(p0 - 2 * PROJ + COL_U), uu2); }
#pragma unroll
          for (int jj = 0; jj < 8; ++jj) { const int c = 8 * lane + jj;
              const float z0 = c0[jj] * uu0[jj], z1 = (s >= 1) ? c1[jj] * uu1[jj] : 0.f, z2 = (s >= 2) ? c2[jj] * uu2[jj] : 0.f;
              const float v = bg[jj] * (F.conv_w[c] * z2 + F.conv_w[CONV_W + c] * z1 + F.conv_w[2 * CONV_W + c] * z0); co[jj] = v; ssc += v * v; } }
        float mo[8]; float ssm = 0.f;
        unpack8(__builtin_nontemporal_load((const GAS v4u*)(memo + (size_t)t * MEM_W + 8 * lane)), mo);
#pragma unroll
        for (int jj = 0; jj < 8; ++jj) ssm += mo[jj] * mo[jj];
#pragma unroll
        for (int o = 1; o < 64; o <<= 1) { ssa += __shfl_xor(ssa, o); ssc += __shfl_xor(ssc, o); ssm += __shfl_xor(ssm, o); }
        const float ra = 1.0f / sqrtf(ssa * (1.f / ATTN_W) + EPS), rc = 1.0f / sqrtf(ssc * (1.f / CONV_W) + EPS), rm = 1.0f / sqrtf(ssm * (1.f / MEM_W) + EPS);
        bf16* yr = Y + (size_t)t * D;
#pragma unroll
        for (int cc = 0; cc < 2; ++cc) { const float* g = F.out_norm_g + cc * 512 + 8 * lane; v4u w;
            w.x = pk2(a[8 * cc + 0] * ra * g[0], a[8 * cc + 1] * ra * g[1]); w.y = pk2(a[8 * cc + 2] * ra * g[2], a[8 * cc + 3] * ra * g[3]);
            w.z = pk2(a[8 * cc + 4] * ra * g[4], a[8 * cc + 5] * ra * g[5]); w.w = pk2(a[8 * cc + 6] * ra * g[6], a[8 * cc + 7] * ra * g[7]);
            *(GAS v4u*)(yr + cc * 512 + 8 * lane) = w; }
        { const float* g = F.out_norm_g + ATTN_W + 8 * lane; v4u w;
          w.x = pk2(co[0] * rc * g[0], co[1] * rc * g[1]); w.y = pk2(co[2] * rc * g[2], co[3] * rc * g[3]); w.z = pk2(co[4] * rc * g[4], co[5] * rc * g[5]); w.w = pk2(co[6] * rc * g[6], co[7] * rc * g[7]);
          *(GAS v4u*)(yr + ATTN_W + 8 * lane) = w; }
        { const float* g = F.out_norm_g + ATTN_W + CONV_W + 8 * lane; v4u w;
          w.x = pk2(mo[0] * rm * g[0], mo[1] * rm * g[1]); w.y = pk2(mo[2] * rm * g[2], mo[3] * rm * g[3]); w.z = pk2(mo[4] * rm * g[4], mo[5] * rm * g[5]); w.w = pk2(mo[6] * rm * g[6], mo[7] * rm * g[7]);
          *(GAS v4u*)(yr + ATTN_W + CONV_W + 8 * lane) = w; }
    }
}

__device__ __forceinline__ float max8(float v) { v = fmaxf(v, __shfl_xor(v, 1)); v = fmaxf(v, __shfl_xor(v, 2)); v = fmaxf(v, __shfl_xor(v, 4)); return v; }
namespace rt {
constexpr int KC = 128, NCH = D / KC, BP = KC * 2 + 16, BUFB = 2 * 96 * BP;
__device__ __forceinline__ void issue_b(v4u (&bst)[6], const bf16* WT, int c, int tid) {
#pragma unroll
    for (int i = 0; i < 6; ++i) { const int p = tid + 512 * i, arr = p / 1536, rem = p - arr * 1536, n = rem >> 4, ch = rem & 15;
        bst[i] = *(const GAS v4u*)(WT + ((size_t)arr * 96 + n) * 2048 + c * KC + ch * 8); }
}
__device__ __forceinline__ void write_b(const v4u (&bst)[6], LAS unsigned char* buf, int tid) {
#pragma unroll
    for (int i = 0; i < 6; ++i) { const int p = tid + 512 * i, arr = p / 1536, rem = p - arr * 1536, n = rem >> 4, ch = rem & 15;
        *(LAS v4u*)(buf + arr * (96 * BP) + n * BP + ch * 16) = bst[i]; }
}
__device__ __forceinline__ void issue_a(f32x4 (&a)[4][2], const float* xrow, int c) {
#pragma unroll
    for (int ks = 0; ks < 4; ++ks) { a[ks][0] = *(const GAS f32x4*)(xrow + c * KC + ks * 32); a[ks][1] = *(const GAS f32x4*)(xrow + c * KC + ks * 32 + 4); }
}
__device__ __forceinline__ void compute(f32x4 (&acc)[6], float& ss, const f32x4 (&a)[4][2], const LAS unsigned char* buf, int fr, int kg) {
#pragma unroll
    for (int ks = 0; ks < 4; ++ks) {
        const f32x4 f0 = a[ks][0], f1 = a[ks][1];
        ss += (f0.x * f0.x + f0.y * f0.y) + (f0.z * f0.z + f0.w * f0.w) + (f1.x * f1.x + f1.y * f1.y) + (f1.z * f1.z + f1.w * f1.w);
        v4u h; h.x = cvtpk(f0.x, f0.y); h.y = cvtpk(f0.z, f0.w); h.z = cvtpk(f1.x, f1.y); h.w = cvtpk(f1.z, f1.w);
        v4u l; l.x = cvtpk(f0.x - bflo(h.x), f0.y - bfhi(h.x)); l.y = cvtpk(f0.z - bflo(h.y), f0.w - bfhi(h.y)); l.z = cvtpk(f1.x - bflo(h.z), f1.y - bfhi(h.z)); l.w = cvtpk(f1.z - bflo(h.w), f1.w - bfhi(h.w));
        const bf16x8 ah = __builtin_bit_cast(bf16x8, h), al = __builtin_bit_cast(bf16x8, l);
#pragma unroll
        for (int nb = 0; nb < 6; ++nb) { const LAS unsigned char* bp = buf + (nb * 16 + fr) * BP + (ks * 32 + 8 * kg) * 2;
            const bf16x8 bh = *(const LAS bf16x8*)bp, bl = *(const LAS bf16x8*)(bp + 96 * BP);
            acc[nb] = __builtin_amdgcn_mfma_f32_16x16x32_bf16(ah, bh, acc[nb], 0, 0, 0);
            acc[nb] = __builtin_amdgcn_mfma_f32_16x16x32_bf16(al, bh, acc[nb], 0, 0, 0);
            acc[nb] = __builtin_amdgcn_mfma_f32_16x16x32_bf16(ah, bl, acc[nb], 0, 0, 0); }
    }
}
}
__device__ __forceinline__ void p5_router(Frame& F) {
    using namespace rt;
    const int tid = F.tid, wave = F.wave;
    const float* X1 = F.out; const bf16* WT = (const bf16*)(F.ws + WS_WR);
    LAS unsigned char* Bl = F.lds;
    LAS float* Lg = (LAS float*)(F.lds + 2 * BUFB + wave * (16 * 97 * 4));
    unsigned* cnt = F.ctl + CW_CNT;
    int* tok_e = (int*)(F.ws + WS_TOK + TOK_E); int* tok_rank = (int*)(F.ws + WS_TOK + TOK_RANK);
    for (int mt = F.vcu; mt < T / 128; mt += F.G) {
        int lane = F.lane; asm volatile("" : "+v"(lane));
        const int fr = lane & 15, kg = lane >> 4;
        const int t0 = mt * 128 + wave * 16;
        const float* xrow = X1 + (size_t)(t0 + fr) * D + 8 * kg;
        f32x4 acc[6];
#pragma unroll
        for (int i = 0; i < 6; ++i) acc[i] = (f32x4){0.f, 0.f, 0.f, 0.f};
        float ss = 0.f;
        v4u bst[6]; f32x4 a0[4][2], a1[4][2];
        __syncthreads();
        issue_b(bst, WT, 0, tid); issue_a(a0, xrow, 0);
#pragma unroll 1
        for (int c = 0; c < NCH; c += 2) {
            write_b(bst, Bl, tid); __syncthreads();
            issue_b(bst, WT, c + 1, tid); issue_a(a1, xrow, c + 1);
            compute(acc, ss, a0, Bl, fr, kg);
            write_b(bst, Bl + BUFB, tid); __syncthreads();
            if (c + 2 < NCH) { issue_b(bst, WT, c + 2, tid); issue_a(a0, xrow, c + 2); }
            compute(acc, ss, a1, Bl + BUFB, fr, kg);
        }
        ss += __shfl_xor(ss, 16); ss += __shfl_xor(ss, 32);
        const float rs_row = 1.0f / sqrtf(ss * (1.f / D) + EPS);
#pragma unroll
        for (int r = 0; r < 4; ++r) { const float rr = __shfl(rs_row, 4 * kg + r);
#pragma unroll
            for (int nb = 0; nb < 6; ++nb) Lg[(4 * kg + r) * 97 + nb * 16 + fr] = acc[nb][r] * rr; }
        LDS_WAIT(); asm volatile("" ::: "memory");
        const float be = F.b_re[lane], bg = F.b_rg[lane & 7];
        int my_e1 = 0, my_e2 = 0; float my_g1 = 0.f, my_g2 = 0.f;
#pragma unroll 4
        for (int tk = 0; tk < 16; ++tk) {
            const float gl = Lg[tk * 97 + 64 + (lane & 7)] + bg;
            const float el = Lg[tk * 97 + lane] + be;
            const float gmax = max8(gl);
            const int gi = __builtin_ctzll(__ballot(gl == gmax) & 0xFFull);
            float gs = __builtin_amdgcn_exp2f((gl - gmax) * LOG2E); gs += __shfl_xor(gs, 1); gs += __shfl_xor(gs, 2); gs += __shfl_xor(gs, 4);
            const float gwt = 1.0f / gs;
            const float v1 = __shfl(max8(el), 8 * gi);
            const int i1 = __builtin_ctzll((__ballot(el == v1) >> (8 * gi)) & 0xFFull);
            const float el2 = (lane == 8 * gi + i1) ? -3.0e38f : el;
            const float v2 = __shfl(max8(el2), 8 * gi);
            const int i2 = __builtin_ctzll((__ballot(el2 == v2) >> (8 * gi)) & 0xFFull);
            const float pr = __builtin_amdgcn_exp2f((v2 - v1) * LOG2E), den = 1.0f / (1.0f + pr);
            if (lane == tk) { my_e1 = 8 * gi + i1; my_e2 = 8 * gi + i2; my_g1 = gwt * den; my_g2 = gwt * pr * den; }
        }
        LAS unsigned* hist = (LAS unsigned*)(F.lds + MISC_OFF + 256);
        if (tid < 64) hist[tid] = 0u;
        __syncthreads();
        unsigned lr1 = 0u, lr2 = 0u;
        if (lane < 16) { lr1 = __hip_atomic_fetch_add(hist + my_e1, 1u, __ATOMIC_RELAXED, __HIP_MEMORY_SCOPE_WORKGROUP); lr2 = __hip_atomic_fetch_add(hist + my_e2, 1u, __ATOMIC_RELAXED, __HIP_MEMORY_SCOPE_WORKGROUP); }
        __syncthreads();
        if (tid < 64) { const unsigned c = hist[tid]; hist[64 + tid] = c ? __hip_atomic_fetch_add(cnt + 64 * tid, c, RLX_AGENT) : 0u; }
        __syncthreads();
        if (lane < 16) {
            const int t = t0 + lane;
            const int k1 = (int)(hist[64 + my_e1] + lr1), k2 = (int)(hist[64 + my_e2] + lr2);
            tok_e[2 * t] = my_e1; tok_e[2 * t + 1] = my_e2; tok_rank[2 * t] = k1; tok_rank[2 * t + 1] = k2;
            int* ltok = (int*)(F.ws + WS_LIST + LIST_TOK); float* lrs = (float*)(F.ws + WS_LIST + LIST_RSTD); float* lgt = (float*)(F.ws + WS_LIST + LIST_GATE);
            ltok[my_e1 * CAP + k1] = t; ltok[my_e2 * CAP + k2] = t; lrs[my_e1 * CAP + k1] = rs_row; lrs[my_e2 * CAP + k2] = rs_row; lgt[my_e1 * CAP + k1] = my_g1; lgt[my_e2 * CAP + k2] = my_g2;
        }
    }
}

constexpr int MOE_MT = MISC_OFF + 48, MOE_PST = MISC_OFF + 64, MOE_TE = MOE_PST + 256;
constexpr int MOE_TB = LDS_EXTRA, MOE_VR = MOE_TB + MAXTILES * 4, MOE_UT = MOE_VR + MAXTILES * 4;
constexpr int MOE_MAXU = 12;
static_assert(MOE_UT + MOE_MAXU * 256 * 4 <= MISC_OFF && MOE_TE + MAXTILES * 4 <= LDS_BYTES, "LDS map");
__device__ __forceinline__ int moe_tables(Frame& F) {
    LAS int* PST = (LAS int*)(F.lds + MOE_PST); LAS int* TE = (LAS int*)(F.lds + MOE_TE); LAS int* MTp = (LAS int*)(F.lds + MOE_MT); LAS int* TB = (LAS int*)(F.lds + MOE_TB); LAS int* VR = (LAS int*)(F.lds + MOE_VR);
    __syncthreads();
    if (F.tid < 64) {
        const int c = (int)__hip_atomic_load(F.ctl + CW_CNT + 64 * F.tid, RLX_AGENT); const int nt = (c + 255) >> 8;
        int x = nt;
#pragma unroll
        for (int o = 1; o < 64; o <<= 1) { const int y = __shfl_up(x, o); if (F.lane >= o) x += y; }
        const int ex = x - nt; PST[F.tid] = ex; if (F.tid == 63) MTp[0] = x;
        for (int i = 0; i < nt; ++i) { TE[ex + i] = F.tid; TB[ex + i] = F.tid * CAP + 256 * i; VR[ex + i] = (c - 256 * i) < 256 ? (c - 256 * i) : 256; }
    }
    __syncthreads();
    return MTp[0];
}

__device__ __forceinline__ void p9_final(Frame& F) {
    (void)moe_tables(F);
    const LAS int* PST = (const LAS int*)(F.lds + MOE_PST);
    const int gw = F.vcu * NWAVES + F.wave, NGW = F.G * NWAVES, lane = F.lane;
    const int* tok_e = (const int*)(F.ws + WS_TOK + TOK_E); const int* tok_rank = (const int*)(F.ws + WS_TOK + TOK_RANK); const bf16* YB = (const bf16*)(F.ws + WS_R1);
    for (int t = gw; t < T; t += NGW) {
        const int s1 = PST[tok_e[2 * t]] * 256 + tok_rank[2 * t], s2 = PST[tok_e[2 * t + 1]] * 256 + tok_rank[2 * t + 1];
        const GAS v4u* y1 = (const GAS v4u*)(YB + (size_t)s1 * D) + lane; const GAS v4u* y2 = (const GAS v4u*)(YB + (size_t)s2 * D) + lane;
        GAS f32x4* o = (GAS f32x4*)(F.out + (size_t)t * D) + 2 * lane;
#pragma unroll
        for (int i = 0; i < 4; ++i) { float a[8], b[8]; unpack8(__builtin_nontemporal_load(y1 + 64 * i), a); unpack8(__builtin_nontemporal_load(y2 + 64 * i), b);
            f32x4 v0 = __builtin_nontemporal_load(o + 128 * i), v1 = __builtin_nontemporal_load(o + 128 * i + 1);
            v0.x += a[0] + b[0]; v0.y += a[1] + b[1]; v0.z += a[2] + b[2]; v0.w += a[3] + b[3]; v1.x += a[4] + b[4]; v1.y += a[5] + b[5]; v1.z += a[6] + b[6]; v1.w += a[7] + b[7];
            __builtin_nontemporal_store(v0, o + 128 * i); __builtin_nontemporal_store(v1, o + 128 * i + 1); }
    }
}

constexpr int PER_PHASE = 10;
constexpr int N_LAUNCHES = MK_N_LAUNCHES;
struct Args { const float* in[21]; float* out; unsigned char* ws; int ph_lo, ph_hi, li, pad; };
__global__ void __launch_bounds__(NWAVES * 64, 2) hymba_fwd(Args args) {
    extern __shared__ __attribute__((aligned(16))) unsigned char lds[];
    Frame F;
    F.lds = (LAS unsigned char*)lds;
    F.tid = threadIdx.x; F.lane = F.tid & 63; F.wave = __builtin_amdgcn_readfirstlane(F.tid >> 6);
    F.G = gridDim.x; { const int bx = blockIdx.x; F.vcu = (F.G % 8 == 0) ? (bx % 8) * (F.G / 8) + bx / 8 : bx; }
    F.ws = args.ws; F.ctl = (unsigned*)(args.ws + WS_CTL); F.out = args.out;
    F.x = args.in[0]; F.mem = args.in[1]; F.norm1_g = args.in[2]; F.w_in = args.in[3]; F.q_norm_g = args.in[4]; F.k_norm_g = args.in[5]; F.conv_w = args.in[6];
    F.mem_norm_g = args.in[7]; F.w_mem_kv = args.in[8]; F.mem_q_norm_g = args.in[9]; F.mem_k_norm_g = args.in[10]; F.out_norm_g = args.in[11]; F.w_out = args.in[12];
    F.norm2_g = args.in[13]; F.w_rg = args.in[14]; F.b_rg = args.in[15]; F.w_re = args.in[16]; F.b_re = args.in[17]; F.w_gate = args.in[18]; F.w_up = args.in[19]; F.w_down = args.in[20];
    volatile LAS unsigned* MISC = (volatile LAS unsigned*)(F.lds + MISC_OFF);
    if (F.tid < 16) MISC[F.tid] = 0u;
    __syncthreads();
    const int lo = args.ph_lo, hi = args.ph_hi;
    const bool multi = (hi - lo) > 1;
    XcdBarrier bar; bar.bar = F.ctl + CW_BAR + args.li * XCD_BAR_WORDS; bar.x = 0; bar.st = nullptr;
    if (multi) bar = xcd_barrier_post(F.ctl + CW_BAR + args.li * XCD_BAR_WORDS, MISC + 8);
#define GRID_BAR() do { if (multi) xcd_barrier(bar); } while (0)
#define IN(k) (lo <= (k) && (k) < hi)
#define BOTH(k) (IN(k) && IN((k) + 1))
    if (IN(0)) { p0_prologue(F); if (BOTH(0)) GRID_BAR(); }
    if (IN(1)) {
        pg8::Gemm g{(const bf16*)(F.ws + WS_H), (const bf16*)(F.ws + WS_WIN), D, nullptr}; pg8::P1Order S{F.G, (int)blockIdx.x, 0, 2560};
        pg8::EpiProj E{(bf16*)(F.ws + WS_R1), (bf16*)(F.ws + WS_MEMKV)};
        pg8::gemm_phase<pg8::EpiProj, pg8::P1Order>(F.lds, g, S, E);
        if (BOTH(1)) GRID_BAR();
    }
    if (IN(2)) { p2_attention(F); if (BOTH(2)) GRID_BAR(); }
    if (IN(3)) { p3_combine(F); if (BOTH(3)) GRID_BAR(); }
    if (IN(4)) {
        pg8::Gemm g{(const bf16*)(F.ws + WS_Y), (const bf16*)(F.ws + WS_WOUT), D, nullptr}; pg8::StaticOrder S{T / 256, D / 256, F.G, (int)blockIdx.x};
        pg8::EpiResid E{F.x, F.out, (bf16*)(F.ws + WS_H)};
        pg8::gemm_phase<pg8::EpiResid, pg8::StaticOrder, false>(F.lds, g, S, E);
        if (BOTH(4)) GRID_BAR();
    }
    if (IN(5)) { p5_router(F); if (BOTH(5)) GRID_BAR(); }
    if (IN(7)) {
        const int MT = moe_tables(F);
        pg8::MoeOrder S{MT, F.G, (int)blockIdx.x, (const LAS int*)(F.lds + MOE_TE)};
        { const LAS int* TB = (const LAS int*)(F.lds + MOE_TB); const LAS int* VR = (const LAS int*)(F.lds + MOE_VR); LAS int* UT = (LAS int*)(F.lds + MOE_UT);
          const int* ltok = (const int*)(F.ws + WS_LIST + LIST_TOK);
          for (int i = 0; i < MOE_MAXU; ++i) { pg8::Unit u; if (!S.next(i, u)) break;
              if (F.tid < 256) UT[i * 256 + F.tid] = (F.tid < VR[u.pm]) ? ltok[TB[u.pm] + F.tid] : 0; }
          __syncthreads(); }
        pg8::Gemm g{(const bf16*)(F.ws + WS_H), (const bf16*)(F.ws + WS_WGU), D, (const LAS int*)(F.lds + MOE_UT)};
        pg8::EpiSwiGLU E{(bf16*)(F.ws + WS_OPART), (const float*)(F.ws + WS_LIST + LIST_RSTD), (const LAS int*)(F.lds + MOE_TB)};
        pg8::gemm_phase<pg8::EpiSwiGLU, pg8::MoeOrder, true, true, false, true>(F.lds, g, S, E);
        if (BOTH(7)) GRID_BAR();
    }
    if (IN(8)) {
        const int MT = moe_tables(F);
        pg8::Gemm g{(const bf16*)(F.ws + WS_OPART), (const bf16*)(F.ws + WS_WD), DEXP, nullptr}; pg8::MoeOrder S{MT, F.G, (int)blockIdx.x, (const LAS int*)(F.lds + MOE_TE)};
        pg8::EpiDown E{(bf16*)(F.ws + WS_R1), (const float*)(F.ws + WS_LIST + LIST_GATE), (const LAS int*)(F.lds + MOE_TB)};
        pg8::gemm_phase<pg8::EpiDown, pg8::MoeOrder, true, false, false, true>(F.lds, g, S, E);
        if (BOTH(8)) GRID_BAR();
    }
    if (IN(9)) { p9_final(F); }
#undef IN
#undef BOTH
#undef GRID_BAR
}

extern "C" void kernel_launch(void* const* d_in, const int* in_sizes, int n_in, void* d_out, int out_size, void* d_ws, size_t ws_size, hipStream_t stream) {
    static int grid = 0;
    if (grid == 0) {
        if (n_in != 21 || in_sizes[0] != T * D || out_size != T * D || ws_size < WS_END) { fprintf(stderr, "kernel_launch: shape/workspace mismatch (n_in %d, ws %zu < %zu); nothing launched\n", n_in, ws_size, (size_t)WS_END); grid = -1; return; }
        int dev = 0, cus = 0, per_cu = 0;
        if (hipGetDevice(&dev) != hipSuccess || hipDeviceGetAttribute(&cus, hipDeviceAttributeMultiprocessorCount, dev) != hipSuccess) { grid = -1; return; }
        if (hipFuncSetAttribute((const void*)hymba_fwd, hipFuncAttributeMaxDynamicSharedMemorySize, LDS_BYTES) != hipSuccess) { fprintf(stderr, "kernel_launch: hipFuncSetAttribute failed\n"); grid = -1; return; }
        if (hipOccupancyMaxActiveBlocksPerMultiprocessor(&per_cu, (const void*)hymba_fwd, NWAVES * 64, LDS_BYTES) != hipSuccess || per_cu < 1) { fprintf(stderr, "kernel_launch: occupancy query reports %d\n", per_cu); }
        (void)hipGetLastError();
        grid = cus;
    }
    if (grid < 0) return;
    if (hipMemsetAsync((char*)d_ws + WS_CTL, 0, CTL_ZERO_BYTES, stream) != hipSuccess) { fprintf(stderr, "kernel_launch: memset failed\n"); return; }
    Args a{};
    for (int i = 0; i < 21; ++i) a.in[i] = (const float*)d_in[i];
    a.out = (float*)d_out; a.ws = (unsigned char*)d_ws;
    int los[4], his[4], nl = 0;
#if defined(PROBE_REPEAT)
    los[nl] = 0; his[nl] = PROBE_REPEAT + 1; ++nl; los[nl] = PROBE_REPEAT; his[nl] = PROBE_REPEAT + 1; ++nl; if (PROBE_REPEAT + 1 < PER_PHASE) { los[nl] = PROBE_REPEAT + 1; his[nl] = PER_PHASE; ++nl; }
#else
    los[nl] = 0; his[nl] = PER_PHASE; ++nl;
#endif
    for (int li = 0; li < nl; ++li) {
        a.ph_lo = los[li]; a.ph_hi = his[li]; a.li = li;
#if defined(PROBE_REPEAT)
        if (li == 1) { (void)hipMemsetAsync((char*)d_ws + WS_CTL + CW_ATTQ * 4, 0, 64, stream); if (PROBE_REPEAT == 5) (void)hipMemsetAsync((char*)d_ws + WS_CTL + CW_CNT * 4, 0, 64 * 256, stream); }
#endif
        hipLaunchKernelGGL(hymba_fwd, dim3(grid), dim3(NWAVES * 64), LDS_BYTES, stream, a);
        const hipError_t le = hipPeekAtLastError();
        if (le != hipSuccess) { fprintf(stderr, "kernel_launch: launch %d failed: %s\n", li, hipGetErrorName(le)); break; }
    }
}
```

```cpp
#include <hip/hip_runtime.h>
#include <cstdio>
#include <cstdint>

#ifndef MK_N_LAUNCHES
#define MK_N_LAUNCHES 1
#endif

#define GAS __attribute__((address_space(1)))
#define LAS __attribute__((address_space(3)))
typedef unsigned short bf16;
typedef unsigned v4u __attribute__((ext_vector_type(4)));
typedef unsigned v2u __attribute__((ext_vector_type(2)));
typedef float f32x4 __attribute__((ext_vector_type(4)));
typedef float f32x16 __attribute__((ext_vector_type(16)));
typedef short bf16x8 __attribute__((ext_vector_type(8)));
typedef short s16x4 __attribute__((ext_vector_type(4)));
#define LDS_WAIT() asm volatile("s_waitcnt lgkmcnt(0)" ::: "memory")
#define VM_WAIT() asm volatile("s_waitcnt vmcnt(0)" ::: "memory")
#define RLX_AGENT __ATOMIC_RELAXED, __HIP_MEMORY_SCOPE_AGENT

constexpr int BATCH = 2, SEQ = 16384, T = BATCH * SEQ, D = 2048, PROJ = 5120;
constexpr int NH = 8, HD = 128, ATTN_W = 1024, CONV_W = 512, MEM_W = 512, NMEM = 256, NMH = 4;
constexpr int COL_Q = 0, COL_K = 1024, COL_V = 2048, COL_B = 3072, COL_C = 3584, COL_U = 4096, COL_MQ = 4608;
constexpr int NEXP = 64, DEXP = 1024;
constexpr int RMAX = 81920;
constexpr int MAXTILES = RMAX / 256;
constexpr float EPS = 1e-6f;
constexpr float LOG2E = 1.4426950408889634f;

constexpr size_t MiB = 1u << 20;
constexpr size_t WS_CTL = 0, CTL_ZERO_BYTES = 1 * MiB;
constexpr size_t WS_WIN = 1 * MiB;
constexpr size_t WS_WMKV = WS_WIN + (size_t)PROJ * D * 2;
constexpr size_t WS_WOUT = 25 * MiB;
constexpr size_t WS_WR = 33 * MiB;
constexpr size_t WS_WGU = 34 * MiB;
constexpr size_t WS_WD = WS_WGU + 512 * MiB;
constexpr size_t WS_H = WS_WD + 256 * MiB;
constexpr size_t WS_MEMKV = WS_H + 130 * MiB;
constexpr size_t WS_R1 = WS_MEMKV + 1 * MiB;
constexpr size_t WS_OPART = WS_R1 + 320 * MiB;
constexpr size_t WS_LSE = WS_OPART + 192 * MiB;
constexpr size_t WS_MEMO = WS_LSE + 3 * MiB;
constexpr size_t WS_Y = WS_MEMO + 32 * MiB;
constexpr size_t WS_TOK = WS_Y + 128 * MiB;
constexpr size_t WS_LIST = WS_TOK + 4 * MiB;
constexpr size_t WS_END = WS_LIST + 24 * MiB;
constexpr int CAP = T;
constexpr size_t LIST_TOK = 0, LIST_RSTD = 8 * MiB, LIST_GATE = 16 * MiB;
constexpr size_t TOK_E = 0, TOK_RANK = 256 * 1024, TOK_GATE = 512 * 1024, TOK_RSTD = 768 * 1024, TOK_SLOT = 1024 * 1024, SLOT_RSTD = 1536 * 1024, SLOT_GATE = 2048 * 1024;
static_assert(WS_WMKV + 1024 * (size_t)D * 2 <= WS_WOUT && WS_WOUT + 8 * MiB <= WS_WR && WS_WR + 2048 * 72 * 4 <= WS_WGU, "ws map");
static_assert((size_t)(T + 512) * D * 2 <= 130 * MiB && (size_t)RMAX * D * 2 <= 320 * MiB && (size_t)RMAX * DEXP * 2 <= 192 * MiB && SLOT_GATE + RMAX * 4 <= 4 * MiB, "ws map");

constexpr int CW_TMO = 0, CW_CODE = 1;
constexpr int CW_CNT = 8192;
constexpr int CW_BAR = 16384;
constexpr int CW_KVREADY = 512, CW_ATTQ = 576;

constexpr int RING_BYTES = 131072;
constexpr int LDS_EXTRA = RING_BYTES;
constexpr int MISC_OFF = 163840 - 2048;
constexpr int LDS_BYTES = 163840;

__device__ __forceinline__ unsigned f2bf(float f) { unsigned u = __builtin_bit_cast(unsigned, f); return (u + 0x7fffu + ((u >> 16) & 1u)) >> 16; }
__device__ __forceinline__ unsigned pk2(float lo, float hi) { return f2bf(lo) | (f2bf(hi) << 16); }
__device__ __forceinline__ unsigned cvtpk(float lo, float hi) { unsigned r; asm volatile("v_cvt_pk_bf16_f32 %0, %1, %2" : "=v"(r) : "v"(lo), "v"(hi)); return r; }
__device__ __forceinline__ unsigned pk_fp8x4(float a, float b, float c, float d) { unsigned w = 0u; w = __builtin_amdgcn_cvt_pk_fp8_f32(a, b, w, false); w = __builtin_amdgcn_cvt_pk_fp8_f32(c, d, w, true); return w; }
constexpr float SC_WGU = 128.0f, SC_ACT = 4.0f, SC_WD = 64.0f;
__device__ __forceinline__ float bflo(unsigned w) { return __builtin_bit_cast(float, w << 16); }
__device__ __forceinline__ float bfhi(unsigned w) { return __builtin_bit_cast(float, w & 0xffff0000u); }
__device__ __forceinline__ float wave_sum(float v) {
#pragma unroll
    for (int o = 1; o < 64; o <<= 1) v += __shfl_xor(v, o);
    return v;
}

namespace pg8 {
#define PG8_LAS __attribute__((address_space(3)))
typedef unsigned short bf16_t;
typedef unsigned u32x4 __attribute__((ext_vector_type(4)));
typedef int i32x4 __attribute__((ext_vector_type(4)));
typedef int i32x8 __attribute__((ext_vector_type(8)));
constexpr int BM = 256, BK = 64, HALF = 128, HTB = HALF * BK * 2, STAGE_BYTES = 8 * HTB, NXCD = 8, WGM = 8;
__host__ __device__ __forceinline__ int lds_byte(int r, int c) { const int st = (r >> 4) * 2 + (c >> 5), rr = r & 15, cc = c & 31, ob = rr * 64 + cc * 2; return st * 1024 + (ob ^ (((ob >> 9) & 1) << 5)); }
__host__ __device__ __forceinline__ void stage_rc(int b, int& R, int& C) { const int st = b / 1024, sb = b % 1024, swz = sb ^ (((sb >> 9) & 1) << 5); R = (st >> 1) * 16 + swz / 64; C = (st & 1) * 32 + (swz % 64) / 2; }
__host__ __device__ __forceinline__ int perm32(int rho) { const int n = rho >> 4, i = rho & 15; return 8 * (i >> 2) + 4 * n + (i & 3); }

struct Unit { int pm, pn, pb; };
struct Gemm { const bf16_t* A; const bf16_t* Bt; int K; const PG8_LAS int* ut; };

__device__ __forceinline__ void tile_of(int L, int nM, int nN, int& pm, int& pn) {
    const int nwg = nM * nN;
    int wgid = L; { const int q = nwg / NXCD, r = nwg % NXCD, xcd = wgid % NXCD, off = wgid / NXCD; wgid = (xcd < r ? xcd * (q + 1) : r * (q + 1) + (xcd - r) * q) + off; }
    const int nig = WGM * nN, gid = wgid / nig, fm = gid * WGM, gsz = (nM - fm) < WGM ? (nM - fm) : WGM;
    pm = fm + ((wgid % nig) % gsz); pn = (wgid % nig) / gsz;
}
struct StaticOrder {
    int nM, nN, G, c;
    __device__ __forceinline__ bool next(int i, Unit& u) const { const long L = (long)i * G + c; if (L >= (long)nM * nN) return false; tile_of((int)L, nM, nN, u.pm, u.pn); u.pb = u.pn; return true; }
    __device__ __forceinline__ void a_ready(const Unit&) const {}
    __device__ __forceinline__ void done(const Unit&) const {}
};
struct P1Order {
    int G, c, lo, hi;
    __device__ __forceinline__ bool next(int i, Unit& u) const { const long L = (long)lo + (long)i * G + c; if (L >= hi) return false;
        if (L < 2560) tile_of((int)L, 128, 20, u.pm, u.pn); else { const int k = (int)L - 2560; u.pm = 128 + (k >> 2); u.pn = 20 + (k & 3); }
        u.pb = u.pn; return true; }
    __device__ __forceinline__ void a_ready(const Unit&) const {}
    __device__ __forceinline__ void done(const Unit&) const {}
};
struct MoeOrder {
    int nM, G, c; const LAS int* te;
    __device__ __forceinline__ bool next(int i, Unit& u) const { const long L = (long)i * G + c; if (L >= (long)nM * 8) return false; tile_of((int)L, nM, 8, u.pm, u.pn); u.pb = te[u.pm] * 8 + u.pn; return true; }
    __device__ __forceinline__ void a_ready(const Unit&) const {}
    __device__ __forceinline__ void done(const Unit&) const {}
};

struct EpiProj {
    static constexpr bool PERM = true, AFTER_DRAIN = false;
    bf16_t* O; bf16_t* O2;
    __device__ __forceinline__ void operator()(const f32x4 (&acc)[2][2][4][2], const Unit& u, int wr, int wc, int fr, int fq) const {
        int row0 = u.pm * BM + wr * 64 + fr, col0 = u.pn * BM + wc * 32 + 8 * fq, ldc = PROJ; bf16_t* base = O;
        if (u.pm >= 128) { row0 -= 128 * BM; col0 -= 20 * BM; ldc = 1024; base = O2; }
#pragma unroll
        for (int ai = 0; ai < 2; ++ai)
#pragma unroll
            for (int m = 0; m < 4; ++m) { bf16_t* rowp = base + (size_t)(row0 + ai * HALF + m * 16) * ldc + col0;
#pragma unroll
                for (int bj = 0; bj < 2; ++bj) { const f32x4 v0 = acc[ai][bj][m][0], v1 = acc[ai][bj][m][1];
                    u32x4 w; w.x = cvtpk(v0[0], v0[1]); w.y = cvtpk(v0[2], v0[3]); w.z = cvtpk(v1[0], v1[1]); w.w = cvtpk(v1[2], v1[3]);
                    *(u32x4*)(rowp + bj * HALF) = w; } }
    }
};
struct EpiResid {
    static constexpr bool PERM = true, AFTER_DRAIN = false;
    const float* X; float* X1; bf16_t* X1B;
    __device__ __forceinline__ void operator()(const f32x4 (&acc)[2][2][4][2], const Unit& u, int wr, int wc, int fr, int fq) const {
        const int row0 = u.pm * BM + wr * 64 + fr, col0 = u.pn * BM + wc * 32 + 8 * fq;
#pragma unroll
        for (int ai = 0; ai < 2; ++ai)
#pragma unroll
            for (int m = 0; m < 4; ++m) { const size_t off = (size_t)(row0 + ai * HALF + m * 16) * D + col0;
#pragma unroll
                for (int bj = 0; bj < 2; ++bj) { const f32x4 xa = __builtin_nontemporal_load((const f32x4*)(X + off + bj * HALF)), xb = __builtin_nontemporal_load((const f32x4*)(X + off + bj * HALF + 4));
                    const f32x4 v0 = acc[ai][bj][m][0] + xa, v1 = acc[ai][bj][m][1] + xb;
                    *(f32x4*)(X1 + off + bj * HALF) = v0; *(f32x4*)(X1 + off + bj * HALF + 4) = v1;
                    v2u w; w.x = pk_fp8x4(v0[0], v0[1], v0[2], v0[3]); w.y = pk_fp8x4(v1[0], v1[1], v1[2], v1[3]);
                    *(v2u*)((unsigned char*)X1B + off + bj * HALF) = w; }
                asm volatile("" ::: "memory"); }
    }
};
struct EpiSwiGLU {
    static constexpr bool PERM = true, AFTER_DRAIN = false;
    bf16_t* ACT; const float* RS; const PG8_LAS int* tb;
    __device__ __forceinline__ void operator()(const f32x4 (&acc)[2][2][4][2], const Unit& u, int wr, int wc, int fr, int fq) const {
        const int row0 = u.pm * BM + wr * 64 + fr, col0 = u.pn * HALF + wc * 32 + 8 * fq, lb = tb[u.pm] - u.pm * BM;
#pragma unroll
        for (int ai = 0; ai < 2; ++ai)
#pragma unroll
            for (int m = 0; m < 4; ++m) { const int row = row0 + ai * HALF + m * 16; const float rs = RS[lb + row] * (1.0f / SC_WGU); float o[8];
#pragma unroll
                for (int n = 0; n < 2; ++n)
#pragma unroll
                    for (int j = 0; j < 4; ++j) { const float g = acc[ai][0][m][n][j] * rs, uu = acc[ai][1][m][n][j] * rs;
                        o[n * 4 + j] = g * __builtin_amdgcn_rcpf(1.0f + __builtin_amdgcn_exp2f(-g * LOG2E)) * uu * SC_ACT; }
                v2u w; w.x = pk_fp8x4(o[0], o[1], o[2], o[3]); w.y = pk_fp8x4(o[4], o[5], o[6], o[7]);
                *(v2u*)((unsigned char*)ACT + (size_t)row * DEXP + col0) = w; }
    }
};
struct EpiDown {
    static constexpr bool PERM = true, AFTER_DRAIN = false;
    bf16_t* Y; const float* GT; const PG8_LAS int* tb;
    __device__ __forceinline__ void operator()(const f32x4 (&acc)[2][2][4][2], const Unit& u, int wr, int wc, int fr, int fq) const {
        const int row0 = u.pm * BM + wr * 64 + fr, col0 = u.pn * BM + wc * 32 + 8 * fq, lb = tb[u.pm] - u.pm * BM;
#pragma unroll
        for (int ai = 0; ai < 2; ++ai)
#pragma unroll
            for (int m = 0; m < 4; ++m) { const int row = row0 + ai * HALF + m * 16; const float gt = GT[lb + row] * (1.0f / (SC_ACT * SC_WD)); bf16_t* rowp = Y + (size_t)row * D + col0;
#pragma unroll
                for (int bj = 0; bj < 2; ++bj) { const f32x4 v0 = acc[ai][bj][m][0] * gt, v1 = acc[ai][bj][m][1] * gt;
                    u32x4 w; w.x = cvtpk(v0[0], v0[1]); w.y = cvtpk(v0[2], v0[3]); w.z = cvtpk(v1[0], v1[1]); w.w = cvtpk(v1[2], v1[3]);
                    *(u32x4*)(rowp + bj * HALF) = w; } }
    }
};

template <class Epi, class Sched, bool ALIGN_EPI = true, bool GATHER = false, bool BKN = false, bool FP8 = false>
__device__ __forceinline__ void gemm_phase(PG8_LAS unsigned char* lds, const Gemm g, const Sched& S, const Epi& E) {
    static_assert(!(FP8 && BKN), "the fp8 path takes N-major B");
    const int tid = threadIdx.x, wid = __builtin_amdgcn_readfirstlane(tid >> 6), lane = tid & 63, wr = wid >> 2, wc = wid & 3, fr = lane & 15, fq = lane >> 4;
    const int K = FP8 ? g.K / 2 : g.K, nt = K / BK;
    unsigned voffA[2], voffB[2]; int gR[2], gC[2];
#pragma unroll
    for (int i = 0; i < 2; ++i) { int R, C; stage_rc(tid * 16 + i * 8192, R, C); const int Rb = Epi::PERM ? ((R & ~31) + perm32(R & 31)) : R; gR[i] = R; gC[i] = C;
        voffA[i] = (unsigned)(R * K + C) * 2u; voffB[i] = (unsigned)(Rb * K + C) * 2u; }
    unsigned vA0[2], vA1[2], vN0[2], vN1[2];
#define PG8_GOFF(dst0, dst1, ui_) do { _Pragma("unroll") for (int _i = 0; _i < 2; ++_i) { \
        dst0[_i] = ((unsigned)g.ut[(ui_) * 256 + gR[_i]] * (unsigned)K + (unsigned)gC[_i]) * 2u; dst1[_i] = ((unsigned)g.ut[(ui_) * 256 + 128 + gR[_i]] * (unsigned)K + (unsigned)gC[_i]) * 2u; } } while (0)
    const size_t kstep = (size_t)(BK * 2);
    const size_t hstep = (size_t)HALF * K * 2;
    const size_t tstep = 2 * hstep;
    const size_t kstepB = BKN ? (size_t)BK * 4096 : kstep, hstepB = BKN ? (size_t)256 : hstep;
    if constexpr (BKN) {
#pragma unroll
        for (int i = 0; i < 2; ++i) { const int p = tid * 16 + i * 8192, kk = p >> 8, c16p = (p & 255) >> 4, sw = (kk & 3) | (((kk >> 3) & 1) << 2);
            voffB[i] = (unsigned)(kk * 4096 + ((c16p ^ (sw << 1)) << 4)); } }
    int bbase[2];
    { const int q = fr >> 2, p = fr & 3, sw = q | ((fq & 1) << 2);
#pragma unroll
      for (int n = 0; n < 2; ++n) bbase[n] = (int)(uintptr_t)lds + (8 * fq + q) * 256 + (((4 * wc + 2 * n + (p >> 1)) ^ (sw << 1)) << 4) + 8 * (p & 1); }
    const unsigned ldsw = (unsigned)wid * 1024u;
    const int aoff = lds_byte(wr * 64 + fr, fq * 8), boff = lds_byte(wc * 32 + fr, fq * 8);
    const int aoq0 = lds_byte(wr * 64 + fr, fq * 16), aoq1 = lds_byte(wr * 64 + fr, fq * 16 + 8), boq0 = lds_byte(wc * 32 + fr, fq * 16), boq1 = lds_byte(wc * 32 + fr, fq * 16 + 8);
#define PG8_SA(b, h) (((b) * 2 + (h)) * HTB)
#define PG8_SB(b, h) ((4 + (b) * 2 + (h)) * HTB)
#define PG8_STAGE(bufoff, gbase, voff) do { _Pragma("unroll") for (int _i = 0; _i < 2; ++_i) \
        __builtin_amdgcn_global_load_lds((const unsigned*)((const char*)(gbase) + (voff)[_i]), (PG8_LAS unsigned*)(lds + (bufoff) + ldsw + _i * 8192), 16, 0, 0); } while (0)
#define PG8_Q_At Aq
#define PG8_Q_B0 Bq0
#define PG8_Q_B1 Bq1
#define PG8_LD8(p0_, p1_) __builtin_shufflevector(*(const PG8_LAS i32x4*)(p0_), *(const PG8_LAS i32x4*)(p1_), 0, 1, 2, 3, 4, 5, 6, 7)
#define PG8_LDA(dst, b, h) do { if constexpr (FP8) { _Pragma("unroll") for (int m = 0; m < 4; ++m) PG8_Q_##dst[m] = PG8_LD8(lds + PG8_SA(b, h) + aoq0 + m * 2048, lds + PG8_SA(b, h) + aoq1 + m * 2048); } \
        else { _Pragma("unroll") for (int m = 0; m < 4; ++m) _Pragma("unroll") for (int k = 0; k < 2; ++k) dst[m][k] = *(const PG8_LAS bf16x8*)(lds + PG8_SA(b, h) + aoff + m * 2048 + k * 1024); } } while (0)
#define PG8_TR(dst, addr, OFF) asm volatile("ds_read_b64_tr_b16 %0, %1 offset:%2" : "=&v"(dst) : "v"(addr), "i"(OFF) : "memory")
#define PG8_LDB(dst, b, h) do { if constexpr (BKN) { _Pragma("unroll") for (int n = 0; n < 2; ++n) { const int ad_ = bbase[n] + PG8_SB(b, h); s16x4 l0_, h0_, l1_, h1_; \
            PG8_TR(l0_, ad_, 0); PG8_TR(h0_, ad_, 1024); PG8_TR(l1_, ad_, 8192); PG8_TR(h1_, ad_, 9216); \
            dst[n][0] = (bf16x8){l0_[0], l0_[1], l0_[2], l0_[3], h0_[0], h0_[1], h0_[2], h0_[3]}; dst[n][1] = (bf16x8){l1_[0], l1_[1], l1_[2], l1_[3], h1_[0], h1_[1], h1_[2], h1_[3]}; } } \
        else if constexpr (FP8) { _Pragma("unroll") for (int n = 0; n < 2; ++n) PG8_Q_##dst[n] = PG8_LD8(lds + PG8_SB(b, h) + boq0 + n * 2048, lds + PG8_SB(b, h) + boq1 + n * 2048); } \
        else { _Pragma("unroll") for (int n = 0; n < 2; ++n) _Pragma("unroll") for (int k = 0; k < 2; ++k) dst[n][k] = *(const PG8_LAS bf16x8*)(lds + PG8_SB(b, h) + boff + n * 2048 + k * 1024); } } while (0)
#define PG8_MMA(ai, bj, At, Bt) do { __builtin_amdgcn_s_setprio(1); if constexpr (FP8) { _Pragma("unroll") for (int m = 0; m < 4; ++m) _Pragma("unroll") for (int n = 0; n < 2; ++n) \
            asm volatile("v_mfma_scale_f32_16x16x128_f8f6f4 %0, %1, %2, %0, %3, %3 op_sel_hi:[0,0,0]" : "+v"(acc[ai][bj][m][n]) : "v"(PG8_Q_##Bt[n]), "v"(PG8_Q_##At[m]), "v"(sc1_)); } \
        else { _Pragma("unroll") for (int m = 0; m < 4; ++m) _Pragma("unroll") for (int n = 0; n < 2; ++n) _Pragma("unroll") for (int k = 0; k < 2; ++k) \
            acc[ai][bj][m][n] = __builtin_amdgcn_mfma_f32_16x16x32_bf16(Bt[n][k], At[m][k], acc[ai][bj][m][n], 0, 0, 0); } __builtin_amdgcn_s_setprio(0); } while (0)
#define PG8_WAIT_V(n) asm volatile("s_waitcnt vmcnt(" #n ")" ::: "memory")
#define PG8_WAIT_L(n) asm volatile("s_waitcnt lgkmcnt(" #n ")" ::: "memory")
#define PG8_BAR __builtin_amdgcn_s_barrier()
#define PG8_SCHED __builtin_amdgcn_sched_barrier(0)
    Unit cur, nxt; int ui = 0;
    if (!S.next(0, cur)) return;
    f32x4 acc[2][2][4][2];
#pragma unroll
    for (int a = 0; a < 2; ++a)
#pragma unroll
        for (int b = 0; b < 2; ++b)
#pragma unroll
            for (int m = 0; m < 4; ++m)
#pragma unroll
                for (int n = 0; n < 2; ++n) acc[a][b][m][n] = (f32x4){0.f, 0.f, 0.f, 0.f};
    bf16x8 At[4][2], B0[2][2], B1[2][2];
    i32x8 Aq[4], Bq0[2], Bq1[2]; const int sc1_ = 0x7F7F7F7F;
    const char* cA = GATHER ? (const char*)g.A : (const char*)g.A + (size_t)cur.pm * tstep; const char* cB = BKN ? (const char*)g.Bt + (size_t)(cur.pb >> 3) * ((size_t)K * 4096) + (size_t)(cur.pb & 7) * 512 : (const char*)g.Bt + (size_t)cur.pb * tstep;
    const size_t hA = GATHER ? 0 : hstep;
    if constexpr (GATHER) { PG8_GOFF(vA0, vA1, 0); } else {
#pragma unroll
        for (int i = 0; i < 2; ++i) { vA0[i] = voffA[i]; vA1[i] = voffA[i]; vN0[i] = voffA[i]; vN1[i] = voffA[i]; } }
    S.a_ready(cur);
    PG8_STAGE(PG8_SB(0, 0), cB, voffB); PG8_STAGE(PG8_SB(0, 1), cB + hstepB, voffB); PG8_STAGE(PG8_SA(0, 0), cA, vA0); PG8_STAGE(PG8_SA(0, 1), cA + hA, vA1);
    if (wr == 1) PG8_BAR;
    PG8_WAIT_V(2); PG8_BAR;
    PG8_STAGE(PG8_SB(1, 0), cB + kstepB, voffB); PG8_STAGE(PG8_SA(1, 0), cA + kstep, vA0); PG8_STAGE(PG8_SB(1, 1), cB + hstepB + kstepB, voffB);
    PG8_WAIT_V(6); PG8_BAR;
    for (;;) {
        const bool has_next = S.next(ui + 1, nxt);
        const char* nA = GATHER ? cA : (has_next ? (const char*)g.A + (size_t)nxt.pm * tstep : cA); const char* nB = has_next ? (BKN ? (const char*)g.Bt + (size_t)(nxt.pb >> 3) * ((size_t)K * 4096) + (size_t)(nxt.pb & 7) * 512 : (const char*)g.Bt + (size_t)nxt.pb * tstep) : cB;
        if constexpr (GATHER) { if (has_next) { PG8_GOFF(vN0, vN1, ui + 1); } else {
#pragma unroll
            for (int i = 0; i < 2; ++i) { vN0[i] = vA0[i]; vN1[i] = vA1[i]; } } }
#pragma unroll 1
        for (int t = 0; t < nt; t += 2) {
            const bool last = (t == nt - 2);
            unsigned s0[2], s1[2];
#pragma unroll
            for (int i = 0; i < 2; ++i) { s0[i] = (GATHER && last) ? vN0[i] : vA0[i]; s1[i] = (GATHER && last) ? vN1[i] : vA1[i]; }
            const char* a1 = cA + (size_t)(t + 1) * kstep;
            const char* a2 = last ? nA : cA + (size_t)(t + 2) * kstep; const char* b2 = last ? nB : cB + (size_t)(t + 2) * kstepB;
            const char* a3 = a2 + kstep; const char* b3 = b2 + kstepB;
            if (last && has_next) S.a_ready(nxt);
            PG8_LDB(B0, 0, 0); PG8_LDB(B1, 0, 1); PG8_SCHED; PG8_LDA(At, 0, 0); PG8_STAGE(PG8_SA(1, 1), a1 + hA, vA1);
            PG8_WAIT_V(8); PG8_WAIT_L(0); PG8_BAR; PG8_SCHED; PG8_MMA(0, 0, At, B0); PG8_MMA(0, 1, At, B1); PG8_BAR; PG8_SCHED;
            PG8_LDA(At, 0, 1); PG8_STAGE(PG8_SB(0, 0), b2, voffB); PG8_STAGE(PG8_SB(0, 1), b2 + hstepB, voffB); PG8_STAGE(PG8_SA(0, 0), a2, s0);
            PG8_WAIT_V(8); PG8_WAIT_L(0); PG8_BAR; PG8_SCHED; PG8_MMA(1, 0, At, B0); PG8_MMA(1, 1, At, B1); PG8_BAR; PG8_SCHED;
            PG8_LDB(B0, 1, 0); PG8_LDB(B1, 1, 1); PG8_SCHED; PG8_LDA(At, 1, 0); PG8_STAGE(PG8_SA(0, 1), a2 + hA, s1);
            PG8_WAIT_V(8); PG8_WAIT_L(0); PG8_BAR; PG8_SCHED; PG8_MMA(0, 0, At, B0); PG8_MMA(0, 1, At, B1); PG8_BAR; PG8_SCHED;
            PG8_LDA(At, 1, 1); PG8_STAGE(PG8_SB(1, 0), b3, voffB); PG8_STAGE(PG8_SB(1, 1), b3 + hstepB, voffB); PG8_STAGE(PG8_SA(1, 0), a3, s0);
            PG8_WAIT_V(8); PG8_WAIT_L(0); PG8_BAR; PG8_SCHED; PG8_MMA(1, 0, At, B0); PG8_MMA(1, 1, At, B1); PG8_BAR; PG8_SCHED;
        }
        if constexpr (ALIGN_EPI) { if (wr == 0) PG8_BAR; }
        if constexpr (FP8) asm volatile("s_nop 15\n\ts_nop 15" ::: "memory");
        { int ln_ = lane; asm volatile("" : "+v"(ln_)); E(acc, cur, wr, wc, ln_ & 15, ln_ >> 4); } S.done(cur);
        if (!has_next) break;
#pragma unroll
        for (int a = 0; a < 2; ++a)
#pragma unroll
            for (int b = 0; b < 2; ++b)
#pragma unroll
                for (int m = 0; m < 4; ++m)
#pragma unroll
                    for (int n = 0; n < 2; ++n) acc[a][b][m][n] = (f32x4){0.f, 0.f, 0.f, 0.f};
        cur = nxt; cA = nA; cB = nB; ++ui;
#pragma unroll
        for (int i = 0; i < 2; ++i) { vA0[i] = vN0[i]; vA1[i] = vN1[i]; }
        if constexpr (ALIGN_EPI) { if (wr == 1) PG8_BAR; }
    }
    PG8_WAIT_V(0);
    if constexpr (!ALIGN_EPI) { if (wr == 0) PG8_BAR; }
    PG8_BAR;
#undef PG8_GOFF
#undef PG8_Q_At
#undef PG8_Q_B0
#undef PG8_Q_B1
#undef PG8_LD8
#undef PG8_TR
#undef PG8_SA
#undef PG8_SB
#undef PG8_STAGE
#undef PG8_LDA
#undef PG8_LDB
#undef PG8_MMA
#undef PG8_WAIT_V
#undef PG8_WAIT_L
#undef PG8_BAR
#undef PG8_SCHED
}
}

#define XB_TMO      128
#define XB_XCNT(j)  (256  + 64 * (j))
#define XB_XSUB(j)  (1280 + 64 * (j))
#define XB_XGEN(j)  (2304 + 64 * (j))
#define XB_TOP      3328
#define XB_TOPGEN   3392
#define XCD_BAR_WORDS 3456
#define XB_SPIN_CAP (1u << 18)
__device__ __forceinline__ unsigned xb_ld(unsigned* p)              { return __hip_atomic_load(p, __ATOMIC_RELAXED, __HIP_MEMORY_SCOPE_AGENT); }
__device__ __forceinline__ unsigned xb_add(unsigned* p, unsigned v) { return __hip_atomic_fetch_add(p, v, __ATOMIC_RELAXED, __HIP_MEMORY_SCOPE_AGENT); }
__device__ __forceinline__ unsigned xb_xcc_id() { return (unsigned)__builtin_amdgcn_s_getreg((3 << 11) | 20) & 0xFu; }
#define XB_SPIN(cond, bar) do { unsigned _sp = 0; while (cond) { __builtin_amdgcn_s_sleep(1); \
    if ((++_sp & 255u) == 0u) { if (xb_ld(&(bar)[XB_TMO])) break; if (_sp > XB_SPIN_CAP) { atomicAdd(&(bar)[XB_TMO], 1u); break; } } } } while (0)
struct XcdBarrier { unsigned* bar; unsigned x; volatile LAS unsigned* st; };
__device__ __forceinline__ XcdBarrier xcd_barrier_post(unsigned* bar, volatile LAS unsigned* st) {
    XcdBarrier b; b.bar = bar; b.x = xb_xcc_id(); b.st = st;
    if (threadIdx.x == 0) (void)xb_add(&bar[XB_XCNT(b.x)], 1u);
    return b;
}
__device__ __forceinline__ void xcd_barrier_complete(unsigned* bar, unsigned x, unsigned& nloc, unsigned& nx) {
    const unsigned G = gridDim.x * gridDim.y * gridDim.z;
    unsigned sum, cnt, mine, sp = 0u;
    for (;;) {
        sum = 0u; cnt = 0u; mine = 0u;
#pragma unroll
        for (unsigned j = 0; j < 16; ++j) { const unsigned c = xb_ld(&bar[XB_XCNT(j)]); sum += c; cnt += (c > 0u) ? 1u : 0u; mine = (j == x) ? c : mine; }
        if (sum == G) break;
        __builtin_amdgcn_s_sleep(1);
        if ((++sp & 255u) == 0u) { if (xb_ld(&bar[XB_TMO])) break; if (sp > XB_SPIN_CAP) { atomicAdd(&bar[XB_TMO], 1u); break; } }
    }
    nloc = mine > 0u ? mine : 1u; nx = cnt > 0u ? cnt : 1u;
}
__device__ __forceinline__ void xcd_barrier(const XcdBarrier& b) {
    asm volatile("s_waitcnt vmcnt(0)" ::: "memory");
    __syncthreads();
    if (threadIdx.x == 0) {
        unsigned* bar = b.bar;
        __builtin_amdgcn_s_waitcnt(0);
        unsigned nloc = b.st[0], nx = b.st[1];
        if (nloc == 0u) { xcd_barrier_complete(bar, b.x, nloc, nx); b.st[0] = nloc; b.st[1] = nx; }
        const unsigned old = xb_add(&bar[XB_XSUB(b.x)], 1u);
        const unsigned gen = old / nloc;
        if (old + 1u == (gen + 1u) * nloc) {
            __builtin_amdgcn_fence(__ATOMIC_RELEASE, "agent");
            asm volatile("s_waitcnt vmcnt(0)" ::: "memory");
            const unsigned og = xb_add(&bar[XB_TOP], 1u);
            const unsigned tg = og / nx;
            if (og + 1u == (tg + 1u) * nx) xb_add(&bar[XB_TOPGEN], 1u);
            else XB_SPIN(xb_ld(&bar[XB_TOPGEN]) == tg, bar);
            __builtin_amdgcn_fence(__ATOMIC_ACQUIRE, "agent");
            xb_add(&bar[XB_XGEN(b.x)], 1u);
            asm volatile("s_waitcnt vmcnt(0)" ::: "memory");
        } else {
            XB_SPIN(xb_ld(&bar[XB_XGEN(b.x)]) == gen, bar);
            __builtin_amdgcn_fence(__ATOMIC_ACQUIRE, "agent");
            asm volatile("s_waitcnt vmcnt(0)" ::: "memory");
        }
    }
    __syncthreads();
}

constexpr int NWAVES = 8;
struct Frame {
    LAS unsigned char* lds;
    unsigned* ctl;
    int tid, lane, wave, vcu, G;
    const float *x, *mem, *norm1_g, *w_in, *q_norm_g, *k_norm_g, *conv_w, *mem_norm_g, *w_mem_kv, *mem_q_norm_g, *mem_k_norm_g, *out_norm_g, *w_out, *norm2_g,
                *w_rg, *b_rg, *w_re, *b_re, *w_gate, *w_up, *w_down;
    float* out; unsigned char* ws;
};

__device__ __forceinline__ void p0_transpose_item(const float* W, int N, int k0, int n0, const float* ks, bf16* dst, int pitch, LAS float* scr, int lane) {
#pragma unroll 8
    for (int i = 0; i < 32; ++i) { const int kk = 2 * i + (lane >> 5); scr[kk * 33 + (lane & 31)] = __builtin_nontemporal_load(W + (size_t)(k0 + kk) * N + n0 + (lane & 31)); }
    const int c = lane & 7;
    float g[8];
#pragma unroll
    for (int j = 0; j < 8; ++j) g[j] = ks ? ks[k0 + 8 * c + j] : 1.0f;
    LDS_WAIT(); asm volatile("" ::: "memory");
#pragma unroll
    for (int j = 0; j < 4; ++j) { const int n = (lane >> 3) + 8 * j; const LAS float* s = scr + (8 * c) * 33 + n;
        v4u o; o.x = pk2(s[0 * 33] * g[0], s[1 * 33] * g[1]); o.y = pk2(s[2 * 33] * g[2], s[3 * 33] * g[3]); o.z = pk2(s[4 * 33] * g[4], s[5 * 33] * g[5]); o.w = pk2(s[6 * 33] * g[6], s[7 * 33] * g[7]);
        *(GAS v4u*)(dst + (size_t)n * pitch + k0 + 8 * c) = o; }
    LDS_WAIT(); asm volatile("" ::: "memory");
}
__device__ __forceinline__ void rms_row_to_bf16(const float* xrow, const float* gain, bf16* orow, int lane) {
    const GAS f32x4* xr = (const GAS f32x4*)xrow + lane; const GAS f32x4* gr = (const GAS f32x4*)gain + lane;
    f32x4 v[8]; float s = 0.f;
#pragma unroll
    for (int j = 0; j < 8; ++j) { v[j] = __builtin_nontemporal_load(xr + 64 * j); s += (v[j].x * v[j].x + v[j].y * v[j].y) + (v[j].z * v[j].z + v[j].w * v[j].w); }
    const float rstd = 1.0f / sqrtf(wave_sum(s) * (1.f / D) + EPS);
    GAS v2u* o8 = (GAS v2u*)orow + lane;
#pragma unroll
    for (int j = 0; j < 8; ++j) { const f32x4 gg = gr[64 * j]; v2u o; o.x = pk2(v[j].x * rstd * gg.x, v[j].y * rstd * gg.y); o.y = pk2(v[j].z * rstd * gg.z, v[j].w * rstd * gg.w); o8[64 * j] = o; }
}
__device__ __forceinline__ void p0_transpose_item_q(const float* W, int N, int k0, int n0, const float* ks, float sc, unsigned char* dst, int pitch, LAS float* scr, int lane) {
#pragma unroll 8
    for (int i = 0; i < 64; ++i) { const int kk = 2 * i + (lane >> 5); scr[kk * 33 + (lane & 31)] = __builtin_nontemporal_load(W + (size_t)(k0 + kk) * N + n0 + (lane & 31)); }
    const int c = lane & 15;
    float g[8];
#pragma unroll
    for (int j = 0; j < 8; ++j) g[j] = ks ? ks[k0 + 8 * c + j] * sc : sc;
    LDS_WAIT(); asm volatile("" ::: "memory");
#pragma unroll
    for (int j = 0; j < 8; ++j) { const int n = (lane >> 4) + 4 * j; const LAS float* s = scr + (8 * c) * 33 + n;
        v2u o; o.x = pk_fp8x4(s[0 * 33] * g[0], s[1 * 33] * g[1], s[2 * 33] * g[2], s[3 * 33] * g[3]); o.y = pk_fp8x4(s[4 * 33] * g[4], s[5 * 33] * g[5], s[6 * 33] * g[6], s[7 * 33] * g[7]);
        __builtin_nontemporal_store(o, (GAS v2u*)(dst + (size_t)n * pitch + k0 + 8 * c)); }
    LDS_WAIT(); asm volatile("" ::: "memory");
}
__device__ __forceinline__ void p0_prologue(Frame& F) {
    LAS float* scr = (LAS float*)(F.lds + F.wave * 16896);
    const int gw = F.vcu * NWAVES + F.wave, NGW = F.G * NWAVES;
    bf16* Win_t = (bf16*)(F.ws + WS_WIN); bf16* Wmkv_t = (bf16*)(F.ws + WS_WMKV); bf16* Wout_t = (bf16*)(F.ws + WS_WOUT);
    constexpr int I_IN = 32 * 160, I_MKV = 32 * 32, I_OUT = 32 * 64;
    constexpr int NITEMS = I_IN + I_MKV + I_OUT;
    for (int it = gw; it < NITEMS; it += NGW) {
        int r = it;
        if (r < I_IN) { const int kb = r / 160, nb = r % 160; p0_transpose_item(F.w_in, PROJ, 64 * kb, 32 * nb, nullptr, Win_t + (size_t)(32 * nb) * D, D, scr, F.lane); continue; } r -= I_IN;
        if (r < I_MKV) { const int kb = r / 32, nb = r % 32; p0_transpose_item(F.w_mem_kv, 1024, 64 * kb, 32 * nb, nullptr, Wmkv_t + (size_t)(32 * nb) * D, D, scr, F.lane); continue; } r -= I_MKV;
        { const int kb = r / 64, nb = r % 64; p0_transpose_item(F.w_out, D, 64 * kb, 32 * nb, nullptr, Wout_t + (size_t)(32 * nb) * D, D, scr, F.lane); }
    }
    { LAS float* scq = (LAS float*)(F.lds + F.wave * 16896);
      unsigned char* Wgu_q = (unsigned char*)(F.ws + WS_WGU); unsigned char* Wd_q = (unsigned char*)(F.ws + WS_WD);
      constexpr int IPE = 512 + 512 + 512;
      for (int it = gw; it < 64 * IPE; it += NGW) { const int e = it / IPE; int r = it - e * IPE;
          if (r < 1024) { const int up = r >> 9, q = r & 511, kb = q >> 5, nb = q & 31, n0 = 32 * nb;
              const float* W = (up ? F.w_up : F.w_gate) + (size_t)e * D * DEXP; const int drow = 256 * (n0 >> 7) + 128 * up + (n0 & 127);
              p0_transpose_item_q(W, DEXP, 128 * kb, n0, F.norm2_g, SC_WGU, Wgu_q + ((size_t)e * 2048 + drow) * D, D, scq, F.lane); }
          else { const int q = r - 1024, kb = q >> 6, nb = q & 63;
              p0_transpose_item_q(F.w_down + (size_t)e * DEXP * D, D, 128 * kb, 32 * nb, nullptr, SC_WD, Wd_q + ((size_t)e * 2048 + 32 * nb) * DEXP, DEXP, scq, F.lane); } } }
    { bf16* WT = (bf16*)(F.ws + WS_WR); const int gt = (F.vcu * NWAVES + F.wave) * 64 + F.lane, NT = F.G * NWAVES * 64;
      for (int i = gt; i < 96 * 2048; i += NT) { const int n = i >> 11, k = i & 2047;
          float w = n < 64 ? F.w_re[k * 64 + n] : (n < 72 ? F.w_rg[k * 8 + (n - 64)] : 0.f); w *= F.norm2_g[k];
          const unsigned h = f2bf(w); const float hf = __builtin_bit_cast(float, h << 16);
          WT[i] = (bf16)h; WT[96 * 2048 + i] = (bf16)f2bf(w - hf); } }
    bf16* H = (bf16*)(F.ws + WS_H);
    for (int m = gw; m < T + 512; m += NGW) {
        if (m < T) rms_row_to_bf16(F.x + (size_t)m * D, F.norm1_g, H + (size_t)m * D, F.lane);
        else rms_row_to_bf16(F.mem + (size_t)(m - T) * D, F.mem_norm_g, H + (size_t)m * D, F.lane);
    }
}

namespace att {
constexpr int LDS_K = 0, LDS_V = 65536, LDS_STG = 131072, LDS_LI = LDS_STG + 16384, LDS_GT = LDS_LI + 8 * 256;
constexpr float CS = 0.08838834764831845f * LOG2E;
#define KSWZ(row, colB) ((row) * 256 + ((colB) ^ (((row) & 7) << 4)))
__device__ __forceinline__ int crow(int r, int hi) { return (r & 3) + 8 * (r >> 2) + 4 * hi; }
__device__ __forceinline__ int v_rd_base(int lane) { return ((lane & 3) << 3) | (((lane >> 2) & 3) << 6) | (((lane >> 4) & 1) << 5) | (((lane >> 5) & 1) << 8); }
template <int OFF> __device__ __forceinline__ s16x4 tr_read(int vb) { s16x4 r; asm volatile("ds_read_b64_tr_b16 %0, %1 offset:%2" : "=&v"(r) : "v"(vb), "i"(OFF) : "memory"); return r; }

struct RowMap { const char* base; long stride; int win0; bool wrap; };
__device__ __forceinline__ const char* rowptr(const RowMap& m, int p) { int sp = m.wrap ? m.win0 + ((p - m.win0) & 255) : p; sp = sp < 0 ? 0 : sp; return m.base + (long)sp * m.stride; }

__device__ __forceinline__ void dma_k(LAS unsigned char* Kl, int p0, int nrows, const RowMap& m, int wave, int lane) {
    asm volatile("" : "+v"(lane));
#pragma unroll 1
    for (int i = 0; i < nrows / 32; ++i) {
        const int prow0 = p0 + 32 * i + 4 * wave, prow = prow0 + (lane >> 4);
        const char* src = rowptr(m, prow) + (((lane & 15) ^ (prow & 7)) << 4);
        __builtin_amdgcn_global_load_lds((const unsigned*)src, (LAS unsigned*)(Kl + prow0 * 256), 16, 0, 0);
    }
}
__device__ __forceinline__ void dma_v(LAS unsigned char* Vl, int p0, int nrows, const RowMap& m, int wave, int lane) {
    asm volatile("" : "+v"(lane));
#pragma unroll 1
    for (int i = 0; i < nrows / 32; ++i) {
        const int ii = wave + 8 * i, g = (p0 >> 4) + (ii >> 2), q = ii & 3;
        const int kk = ((q >> 1) << 3) + ((lane & 31) >> 2), k = (kk & ~0xC) | ((kk & 4) << 1) | ((kk & 8) >> 1);
        const int c = 32 * (2 * (q & 1) + (lane >> 5)) + 8 * (lane & 3);
        const char* src = rowptr(m, 16 * g + k) + c * 2;
        __builtin_amdgcn_global_load_lds((const unsigned*)src, (LAS unsigned*)(Vl + g * 4096 + q * 1024), 16, 0, 0);
    }
}
__device__ __forceinline__ void dma_v2(LAS unsigned char* Vl, int p0, int nrows, const RowMap& m, int wave, int lane) {
    asm volatile("" : "+v"(lane));
#pragma unroll 1
    for (int i = 0; i < nrows / 32; ++i) {
        const int prow0 = p0 + 32 * i + 4 * wave, prow = prow0 + (lane >> 4);
        const char* src = rowptr(m, prow) + (((lane & 15) ^ ((prow & 7) << 1)) << 4);
        __builtin_amdgcn_global_load_lds((const unsigned*)src, (LAS unsigned*)(Vl + prow0 * 256), 16, 0, 0);
    }
}
__device__ __forceinline__ void load_q16(v4u (&raw)[4], const char* qrow, int kg) {
#pragma unroll
    for (int s = 0; s < 4; ++s) raw[s] = *(const GAS v4u*)(qrow + (32 * s + 8 * kg) * 2);
}
__device__ __forceinline__ void norm_q16(const v4u (&raw)[4], bf16x8 (&qr)[4], const LAS float* gt, int kg) {
    float ss = 0.f;
#pragma unroll
    for (int s = 0; s < 4; ++s)
#pragma unroll
        for (int j = 0; j < 4; ++j) { const float a = bflo(raw[s][j]), b = bfhi(raw[s][j]); ss += a * a + b * b; }
    ss += __shfl_xor(ss, 16); ss += __shfl_xor(ss, 32);
    const float rstd = 1.0f / sqrtf(ss * (1.f / HD) + EPS);
#pragma unroll
    for (int s = 0; s < 4; ++s) { const LAS f32x4* gp = (const LAS f32x4*)(gt + 32 * s + 8 * kg); const f32x4 g0 = gp[0], g1 = gp[1]; v4u o;
        o.x = cvtpk(bflo(raw[s].x) * rstd * g0.x, bfhi(raw[s].x) * rstd * g0.y); o.y = cvtpk(bflo(raw[s].y) * rstd * g0.z, bfhi(raw[s].y) * rstd * g0.w);
        o.z = cvtpk(bflo(raw[s].z) * rstd * g1.x, bfhi(raw[s].z) * rstd * g1.y); o.w = cvtpk(bflo(raw[s].w) * rstd * g1.z, bfhi(raw[s].w) * rstd * g1.w);
        qr[s] = __builtin_bit_cast(bf16x8, o); }
}
__device__ __forceinline__ void norm_k(LAS unsigned char* Kl, int p0, int nrows, const LAS float* gt, int tid) {
    asm volatile("" : "+v"(tid));
#pragma unroll 1
    for (int idx = tid; idx < nrows * 4; idx += 512) {
        const int row = p0 + (idx >> 2), qd = idx & 3;
        v4u w[4]; float ss = 0.f;
#pragma unroll
        for (int i = 0; i < 4; ++i) { w[i] = *(const LAS v4u*)(Kl + KSWZ(row, (4 * qd + i) * 16));
#pragma unroll
            for (int j = 0; j < 4; ++j) { const float a = bflo(w[i][j]), b = bfhi(w[i][j]); ss += a * a + b * b; } }
        ss += __shfl_xor(ss, 1); ss += __shfl_xor(ss, 2);
        const float rstd = 1.0f / sqrtf(ss * (1.f / HD) + EPS);
#pragma unroll
        for (int i = 0; i < 4; ++i) { const LAS f32x4* gp = (const LAS f32x4*)(gt + (4 * qd + i) * 8); const f32x4 g0 = gp[0], g1 = gp[1]; v4u o;
            o.x = cvtpk(bflo(w[i].x) * rstd * g0.x, bfhi(w[i].x) * rstd * g0.y); o.y = cvtpk(bflo(w[i].y) * rstd * g0.z, bfhi(w[i].y) * rstd * g0.w);
            o.z = cvtpk(bflo(w[i].z) * rstd * g1.x, bfhi(w[i].z) * rstd * g1.y); o.w = cvtpk(bflo(w[i].w) * rstd * g1.z, bfhi(w[i].w) * rstd * g1.w);
            *(LAS v4u*)(Kl + KSWZ(row, (4 * qd + i) * 16)) = o; }
    }
}
__device__ __forceinline__ float xsum32(float v) { unsigned a = __builtin_bit_cast(unsigned, v), b = a; asm volatile("s_nop 1\n\tv_permlane32_swap_b32 %0, %1" : "+v"(a), "+v"(b)); return __builtin_bit_cast(float, a) + __builtin_bit_cast(float, b); }
__device__ __forceinline__ void load_q(v4u (&raw)[8], const char* qrow, int hi) {
#pragma unroll
    for (int d0 = 0; d0 < 8; ++d0) raw[d0] = *(const GAS v4u*)(qrow + (d0 * 16 + hi * 8) * 2);
}
__device__ __forceinline__ void norm_q(const v4u (&raw)[8], bf16x8 (&qr)[8], const LAS float* gt, int hi) {
    float ss = 0.f;
#pragma unroll
    for (int d0 = 0; d0 < 8; ++d0)
#pragma unroll
        for (int j = 0; j < 4; ++j) { const float a = bflo(raw[d0][j]), b = bfhi(raw[d0][j]); ss += a * a + b * b; }
    ss = xsum32(ss);
    const float rstd = 1.0f / sqrtf(ss * (1.f / HD) + EPS);
#pragma unroll
    for (int d0 = 0; d0 < 8; ++d0) { const LAS f32x4* gp = (const LAS f32x4*)(gt + d0 * 16 + hi * 8); const f32x4 g0 = gp[0], g1 = gp[1]; v4u o;
        o.x = cvtpk(bflo(raw[d0].x) * rstd * g0.x, bfhi(raw[d0].x) * rstd * g0.y); o.y = cvtpk(bflo(raw[d0].y) * rstd * g0.z, bfhi(raw[d0].y) * rstd * g0.w);
        o.z = cvtpk(bflo(raw[d0].z) * rstd * g1.x, bfhi(raw[d0].z) * rstd * g1.y); o.w = cvtpk(bflo(raw[d0].w) * rstd * g1.z, bfhi(raw[d0].w) * rstd * g1.w);
        qr[d0] = __builtin_bit_cast(bf16x8, o); }
}
__device__ __forceinline__ f32x16 qk_tile(const LAS unsigned char* Kl, int pb, const bf16x8 (&qr)[8], int r32, int hi) {
    f32x16 p = {};
#pragma unroll
    for (int d0 = 0; d0 < 8; ++d0) { const bf16x8 kf = *(const LAS bf16x8*)(Kl + KSWZ(pb + r32, (d0 * 16 + hi * 8) * 2));
        p = __builtin_amdgcn_mfma_f32_32x32x16_bf16(kf, qr[d0], p, 0, 0, 0); }
    return p;
}
#define PK4(P, BASE, OUT) do { unsigned a0 = cvtpk(P[BASE + 0], P[BASE + 1]), a1 = cvtpk(P[BASE + 2], P[BASE + 3]);   \
    unsigned b0 = cvtpk(P[BASE + 4], P[BASE + 5]), b1 = cvtpk(P[BASE + 6], P[BASE + 7]);                              \
    auto r0 = __builtin_amdgcn_permlane32_swap(a0, b0, false, false); auto r1 = __builtin_amdgcn_permlane32_swap(a1, b1, false, false); \
    v4u w_ = {r0[0], r1[0], r0[1], r1[1]}; OUT = __builtin_bit_cast(bf16x8, w_); } while (0)
template <int OFF> __device__ __forceinline__ void pv_step(f32x16& o, int vb, bf16x8 pa) {
    const s16x4 l = tr_read<OFF>(vb), h = tr_read<OFF + 2048>(vb);
    asm volatile("s_waitcnt lgkmcnt(0)" ::: "memory"); __builtin_amdgcn_sched_barrier(0);
    o = __builtin_amdgcn_mfma_f32_32x32x16_bf16(pa, (bf16x8){l[0], l[1], l[2], l[3], h[0], h[1], h[2], h[3]}, o, 0, 0, 0);
}
__device__ __forceinline__ void store_block(const f32x16& o, const LAS float* il, LAS unsigned short* stg, char* dst0, long rstride, int lane) {
    asm volatile("" : "+v"(lane));
    const int r32 = lane & 31, hi = lane >> 5;
#pragma unroll
    for (int r = 0; r < 16; ++r) { const int row = crow(r, hi); stg[row * 32 + r32] = (unsigned short)f2bf(o[r] * il[row]); }
    LDS_WAIT(); asm volatile("" ::: "memory");
#pragma unroll
    for (int p = 0; p < 2; ++p) { const int row = 16 * p + (lane >> 2), ch = lane & 3;
        const v4u w = *(const LAS v4u*)((const LAS unsigned char*)stg + row * 64 + ch * 16);
        *(GAS v4u*)(dst0 + (long)row * rstride + ch * 16) = w; }
    LDS_WAIT(); asm volatile("" ::: "memory");
}
}

#define RAW_BAR() do { asm volatile("s_waitcnt lgkmcnt(0)" ::: "memory"); __builtin_amdgcn_s_barrier(); asm volatile("" ::: "memory"); } while (0)
__device__ __forceinline__ void p2_attention(Frame& F) {
    using namespace att;
    LAS unsigned char* Kl = F.lds + LDS_K; LAS unsigned char* Vl = F.lds + LDS_V;
    LAS unsigned short* stg = (LAS unsigned short*)(F.lds + LDS_STG + F.wave * 2048);
    LAS float* li = (LAS float*)(F.lds + LDS_LI + F.wave * 256);
    LAS float* gtab = (LAS float*)(F.lds + LDS_GT);
    LAS float* rk = (LAS float*)(F.lds + LDS_GT + 2048);
    volatile LAS int* QN = (volatile LAS int*)(F.lds + LDS_GT + 2048 + 1024);
    const int tid = F.tid, wave = F.wave;
    if (blockIdx.x < 8) {
        pg8::Gemm g{(const bf16*)(F.ws + WS_H), (const bf16*)(F.ws + WS_WIN), D, nullptr}; pg8::P1Order S{F.G, (int)blockIdx.x, 2560, 2568};
        pg8::EpiProj E{(bf16*)(F.ws + WS_R1), (bf16*)(F.ws + WS_MEMKV)};
        pg8::gemm_phase<pg8::EpiProj, pg8::P1Order>(F.lds, g, S, E);
        VM_WAIT(); __syncthreads();
        if (tid == 0) { __builtin_amdgcn_fence(__ATOMIC_RELEASE, "agent"); asm volatile("s_waitcnt vmcnt(0)" ::: "memory"); __hip_atomic_fetch_add(F.ctl + CW_KVREADY, 1u, RLX_AGENT); }
    }
    if (tid < 128) { gtab[tid] = F.q_norm_g[tid] * F.k_norm_g[tid]; gtab[128 + tid] = F.mem_q_norm_g[tid] * F.mem_k_norm_g[tid]; gtab[256 + tid] = F.mem_q_norm_g[tid]; gtab[384 + tid] = F.mem_k_norm_g[tid]; }
    if (tid == 0) QN[0] = 1 << 30;
    __syncthreads();
    float MD, MM;
    { float a = 0.f, c = 0.f;
#pragma unroll 1
      for (int i = 0; i < 128; ++i) { a = fmaxf(a, fabsf(gtab[i])); c = fmaxf(c, fabsf(gtab[128 + i])); }
      MD = a * (128.0f * 1.03f) * CS; MM = c * (128.0f * 1.03f) * CS; }
    const char* proj = (const char*)(F.ws + WS_R1);

    {
    const int j = wave & 3, dh = wave >> 2, w0 = 32 * j + 16 * dh;
    constexpr int NCHUNK = 6144 / 4;
    v4u qraw[4];
#define DECODE(u, br, b, h, r, nb, dil) const int br = (u) >> 11, _rem = (u) & 2047, b = _rem >> 10, h = (_rem >> 7) & 7, _w = _rem & 127, dil = 1 << (2 * br), _nps = 128 >> (2 * br), r = _w / _nps, nb = _w % _nps
    int u = 4 * F.vcu;
    bool have = F.vcu < NCHUNK;
    bool full = true;
    if (have) {
        DECODE(u, br, b, h, r, nb, dil);
        const long rs = (long)dil * PROJ * 2; const char* tb = proj + (size_t)(b * SEQ + r) * (PROJ * 2);
        RowMap mk{tb + (COL_K + h * HD) * 2, rs, 128 * nb - 128, true};
        dma_k(Kl, 0, 256, mk, wave, F.lane);
        load_q16(qraw, tb + (long)(128 * nb + w0 + (F.lane & 15)) * rs + (COL_Q + h * HD) * 2, F.lane >> 4);
    }
    while (have) {
        DECODE(u, br, b, h, r, nb, dil);
        int lane = F.lane; asm volatile("" : "+v"(lane));
        const int q16 = lane & 15, kg = lane >> 4;
        const int off = 128 * ((nb + 1) & 1);
        const long rs_ = (long)dil * PROJ * 2; const char* tb_ = proj + (size_t)(b * SEQ + r) * (PROJ * 2);
        asm volatile("s_waitcnt vmcnt(0)" ::: "memory"); RAW_BAR();
        { RowMap mv{tb_ + (COL_V + h * HD) * 2, rs_, 128 * nb - 128, true};
          if (full) dma_v2(Vl, 0, 256, mv, wave, lane); else dma_v2(Vl, 128 * (nb & 1), 128, mv, wave, lane); }
        if ((u & 3) == 0 && tid == 0) QN[0] = F.G + (int)__hip_atomic_fetch_add(F.ctl + CW_ATTQ, 1u, RLX_AGENT);
        { const int p0 = full ? 0 : 128 * (nb & 1), n4 = full ? 1024 : 512;
#pragma unroll 1
          for (int idx = tid; idx < n4; idx += 512) { const int row = p0 + (idx >> 2), qd = idx & 3; float ss = 0.f;
#pragma unroll
              for (int i = 0; i < 4; ++i) { const v4u w = *(const LAS v4u*)(Kl + KSWZ(row, (4 * qd + i) * 16));
#pragma unroll
                  for (int jj = 0; jj < 4; ++jj) { const float a = bflo(w[jj]), c = bfhi(w[jj]); ss += a * a + c * c; } }
              ss += __shfl_xor(ss, 1); ss += __shfl_xor(ss, 2);
              if (qd == 0) rk[row] = 1.0f / sqrtf(ss * (1.f / HD) + EPS); } }
        bf16x8 qr[4];
        norm_q16(qraw, qr, gtab, kg);
        f32x4 s[9];
#pragma unroll
        for (int t = 0; t < 9; ++t) { const int pb = (w0 + 16 * t + off) & 255; f32x4 a = {0.f, 0.f, 0.f, 0.f};
#pragma unroll
            for (int d = 0; d < 4; ++d) { const bf16x8 kf = *(const LAS bf16x8*)(Kl + KSWZ(pb + q16, 64 * d + 16 * kg));
                a = __builtin_amdgcn_mfma_f32_16x16x32_bf16(kf, qr[d], a, 0, 0, 0); }
            s[t] = a; }
        RAW_BAR();
        int un = u + 1; bool has_next = true;
        if ((un & 3) == 0) { const int nc = QN[0]; has_next = nc < NCHUNK; un = 4 * nc; }
        bool n_full = false;
        if (has_next) {
            DECODE(un, br2, b2, h2, r2, nb2, dil2);
            n_full = (un != u + 1) || (nb2 == 0);
            const long rs = (long)dil2 * PROJ * 2; const char* tb = proj + (size_t)(b2 * SEQ + r2) * (PROJ * 2);
            RowMap nmk{tb + (COL_K + h2 * HD) * 2, rs, 128 * nb2 - 128, true};
            if (n_full) dma_k(Kl, 0, 256, nmk, wave, lane); else dma_k(Kl, 128 * (nb2 & 1), 128, nmk, wave, lane);
            load_q16(qraw, tb + (long)(128 * nb2 + w0 + q16) * rs + (COL_Q + h2 * HD) * 2, kg);
        }
        const float bias2 = __builtin_amdgcn_exp2f(-(float)(h + 1)) * (float)dil * LOG2E;
        const float rowoff = bias2 * (float)(4 * kg - q16 - 128) - MD;
        float l = 0.f;
#pragma unroll
        for (int t = 0; t < 9; ++t) {
            const int pb = (w0 + 16 * t + off) & 255;
            const f32x4 rkv = *(const LAS f32x4*)(rk + pb + 4 * kg);
            const bool dead = (nb == 0) && (w0 + 16 * t < 128);
#pragma unroll
            for (int r_ = 0; r_ < 4; ++r_) {
                float v = fmaf(s[t][r_] * rkv[r_], CS, fmaf(bias2, (float)(16 * t + r_), rowoff));
                if (t == 0) v = (4 * kg + r_ >= q16) ? v : -1.0e30f;
                if (t == 8) v = (4 * kg + r_ <= q16) ? v : -1.0e30f;
                v = dead ? 0.f : __builtin_amdgcn_exp2f(v); s[t][r_] = v; l += v; }
        }
        l += __shfl_xor(l, 16); l += __shfl_xor(l, 32);
        bf16x8 pa[5];
#pragma unroll
        for (int sp = 0; sp < 5; ++sp) { v4u w; w.x = cvtpk(s[2 * sp][0], s[2 * sp][1]); w.y = cvtpk(s[2 * sp][2], s[2 * sp][3]);
            if (sp < 4) { w.z = cvtpk(s[2 * sp + 1][0], s[2 * sp + 1][1]); w.w = cvtpk(s[2 * sp + 1][2], s[2 * sp + 1][3]); } else { w.z = 0u; w.w = 0u; }
            pa[sp] = __builtin_bit_cast(bf16x8, w); }
        if (has_next) asm volatile("s_waitcnt vmcnt(8)" ::: "memory"); else asm volatile("s_waitcnt vmcnt(0)" ::: "memory");
        RAW_BAR();
        f32x4 o[8];
#pragma unroll
        for (int db = 0; db < 8; ++db) o[db] = (f32x4){0.f, 0.f, 0.f, 0.f};
        { const int qq = q16 >> 2, pp = q16 & 3;
#pragma unroll
          for (int sp = 0; sp < 5; ++sp) {
              const int ra = (w0 + 32 * sp + off + 4 * kg + qq) & 255, rb = (w0 + 32 * sp + 16 + off + 4 * kg + qq) & 255;
              const int va = (int)(uintptr_t)Vl + ra * 256 + 8 * pp, vb = (int)(uintptr_t)Vl + rb * 256 + 8 * pp, xa = (ra & 7) << 5, xb = (rb & 7) << 5;
#pragma unroll
              for (int dq = 0; dq < 2; ++dq) {
                  s16x4 la[4], lb[4];
#pragma unroll
                  for (int i = 0; i < 4; ++i) { const int db = 4 * dq + i;
                      asm volatile("ds_read_b64_tr_b16 %0, %1" : "=&v"(la[i]) : "v"(va + ((32 * db) ^ xa)) : "memory");
                      asm volatile("ds_read_b64_tr_b16 %0, %1" : "=&v"(lb[i]) : "v"(vb + ((32 * db) ^ xb)) : "memory"); }
                  asm volatile("s_waitcnt lgkmcnt(0)" ::: "memory"); __builtin_amdgcn_sched_barrier(0);
#pragma unroll
                  for (int i = 0; i < 4; ++i) { const int db = 4 * dq + i;
                      o[db] = __builtin_amdgcn_mfma_f32_16x16x32_bf16(pa[sp], (bf16x8){la[i][0], la[i][1], la[i][2], la[i][3], lb[i][0], lb[i][1], lb[i][2], lb[i][3]}, o[db], 0, 0, 0); }
              } } }
        const float il = 1.0f / l;
        if (kg == 0) li[q16] = il;
        LDS_WAIT(); asm volatile("" ::: "memory");
        const f32x4 ilr = *(const LAS f32x4*)(li + 4 * kg);
        const int tok0 = b * SEQ + r + dil * (128 * nb + w0);
        char* dst = (char*)(F.ws + WS_OPART) + ((size_t)br * T + tok0) * (ATTN_W * 2) + (h * HD) * 2;
#pragma unroll
        for (int hf = 0; hf < 2; ++hf) {
#pragma unroll
            for (int i = 0; i < 4; ++i)
#pragma unroll
                for (int r_ = 0; r_ < 4; ++r_) stg[(4 * kg + r_) * 64 + 16 * i + q16] = (unsigned short)f2bf(o[4 * hf + i][r_] * ilr[r_]);
            LDS_WAIT(); asm volatile("" ::: "memory");
#pragma unroll
            for (int p = 0; p < 2; ++p) { const int row = lane >> 2, ch = (lane & 3) + 4 * p;
                const v4u w = *(const LAS v4u*)((const LAS unsigned char*)stg + row * 128 + ch * 16);
                *(GAS v4u*)(dst + (long)row * ((long)dil * ATTN_W * 2) + hf * 128 + ch * 16) = w; }
            LDS_WAIT(); asm volatile("" ::: "memory");
        }
        if (kg == 0) ((float*)(F.ws + WS_LSE))[((size_t)br * T + tok0 + dil * q16) * 8 + h] = MD + __builtin_amdgcn_logf(l);
        have = has_next; u = un; full = n_full;
    }
#undef DECODE
    }

    VM_WAIT(); __syncthreads();
    if (wave == 0) { unsigned sp = 0;
        while (__builtin_amdgcn_readfirstlane(__hip_atomic_load(F.ctl + CW_KVREADY, RLX_AGENT)) < 8u) { __builtin_amdgcn_s_sleep(2); if (++sp > (1u << 22)) { if (F.lane == 0) __hip_atomic_store(F.ctl + CW_TMO, 1u, RLX_AGENT); break; } }
        __builtin_amdgcn_fence(__ATOMIC_ACQUIRE, "agent"); asm volatile("s_waitcnt vmcnt(0)" ::: "memory"); }
    __syncthreads();
    for (int it = F.vcu; it < 256; it += F.G) {
        const int combo = it >> 5, part = it & 31, b = combo >> 2, hm = combo & 3;
        const char* mkv = (const char*)(F.ws + WS_MEMKV) + (size_t)(b * NMEM) * 2048 + hm * 256;
        RowMap mk{mkv, 2048, 0, false}, mv{mkv + 1024, 2048, 0, false};
        __syncthreads();
        dma_k(Kl, 0, 256, mk, wave, F.lane); dma_v(Vl, 0, 256, mv, wave, F.lane);
        VM_WAIT(); __syncthreads();
        norm_k(Kl, 0, 256, gtab + 384, tid);
        __syncthreads();
        for (int qb = 0; qb < 2; ++qb) {
            int lane = F.lane; asm volatile("" : "+v"(lane));
            const int r32 = lane & 31, hi = lane >> 5, vbase = (int)(uintptr_t)Vl + v_rd_base(lane);
            const int tok = b * SEQ + part * 512 + qb * 256 + wave * 32 + r32;
            v4u raw[8]; bf16x8 qr[8];
            load_q(raw, proj + (size_t)tok * (PROJ * 2) + (COL_MQ + hm * HD) * 2, hi);
            norm_q(raw, qr, gtab + 256, hi);
            const float mc = -MM; float l = 0.f;
            f32x16 o[4] = {};
#pragma unroll 1
            for (int hk = 0; hk < 2; ++hk) {
                bf16x8 pa[8];
#pragma unroll
                for (int kt = 0; kt < 4; ++kt) { f32x16 s = qk_tile(Kl, 128 * hk + 32 * kt, qr, r32, hi);
#pragma unroll
                    for (int r = 0; r < 16; ++r) { s[r] = __builtin_amdgcn_exp2f(fmaf(s[r], CS, mc)); l += s[r]; }
                    PK4(s, 0, pa[2 * kt]); PK4(s, 8, pa[2 * kt + 1]); }
#pragma unroll
                for (int f = 0; f < 8; ++f) { const int vb = vbase + (8 * hk + f) * 4096;
                    pv_step<0>(o[0], vb, pa[f]); pv_step<512>(o[1], vb, pa[f]); pv_step<1024>(o[2], vb, pa[f]); pv_step<1536>(o[3], vb, pa[f]); }
            }
            l = xsum32(l);
            if (hi == 0) li[r32] = 1.0f / l;
            LDS_WAIT(); asm volatile("" ::: "memory");
            char* dst = (char*)(F.ws + WS_MEMO) + (size_t)(tok - r32) * (MEM_W * 2) + hm * 256;
#pragma unroll
            for (int d0 = 0; d0 < 4; ++d0) store_block(o[d0], li, stg, dst + d0 * 64, MEM_W * 2, lane);
        }
    }
}

__device__ __forceinline__ void unpack8(const v4u w, float (&f)[8]) { f[0] = bflo(w.x); f[1] = bfhi(w.x); f[2] = bflo(w.y); f[3] = bfhi(w.y); f[4] = bflo(w.z); f[5] = bfhi(w.z); f[6] = bflo(w.w); f[7] = bfhi(w.w); }
__device__ __forceinline__ void p3_combine(Frame& F) {
    const int gw = F.vcu * NWAVES + F.wave, NGW = F.G * NWAVES, lane = F.lane;
    const bf16* proj = (const bf16*)(F.ws + WS_R1); const bf16* opart = (const bf16*)(F.ws + WS_OPART); const float* lse = (const float*)(F.ws + WS_LSE);
    const bf16* memo = (const bf16*)(F.ws + WS_MEMO); bf16* Y = (bf16*)(F.ws + WS_Y);
    for (int t = gw; t < T; t += NGW) {
        float a[16]; float ssa = 0.f;
#pragma unroll
        for (int cc = 0; cc < 2; ++cc) { const int head = 4 * cc + (lane >> 4);
            const float l0 = lse[((size_t)0 * T + t) * 8 + head], l1 = lse[((size_t)1 * T + t) * 8 + head], l2 = lse[((size_t)2 * T + t) * 8 + head];
            const float mx = fmaxf(l0, fmaxf(l1, l2)); float w0 = __builtin_amdgcn_exp2f(l0 - mx), w1 = __builtin_amdgcn_exp2f(l1 - mx), w2 = __builtin_amdgcn_exp2f(l2 - mx);
            const float inv = 1.0f / (w0 + w1 + w2); w0 *= inv; w1 *= inv; w2 *= inv;
            float f0[8], f1[8], f2[8];
            unpack8(__builtin_nontemporal_load((const GAS v4u*)(opart + ((size_t)0 * T + t) * ATTN_W + cc * 512 + 8 * lane)), f0);
            unpack8(__builtin_nontemporal_load((const GAS v4u*)(opart + ((size_t)1 * T + t) * ATTN_W + cc * 512 + 8 * lane)), f1);
            unpack8(__builtin_nontemporal_load((const GAS v4u*)(opart + ((size_t)2 * T + t) * ATTN_W + cc * 512 + 8 * lane)), f2);
#pragma unroll
            for (int jj = 0; jj < 8; ++jj) { const float v = w0 * f0[jj] + w1 * f1[jj] + w2 * f2[jj]; a[8 * cc + jj] = v; ssa += v * v; } }
        float co[8]; float ssc = 0.f;
        { const int s = t & (SEQ - 1); float bg[8], c0[8], uu0[8], c1[8], uu1[8], c2[8], uu2[8];
          const bf16* p0 = proj + (size_t)t * PROJ + 8 * lane;
          unpack8(*(const GAS v4u*)(p0 + COL_B), bg); unpack8(*(const GAS v4u*)(p0 + COL_C), c0); unpack8(*(const GAS v4u*)(p0 + COL_U), uu0);
          if (s >= 1) { unpack8(*(const GAS v4u*)(p0 - PROJ + COL_C), c1); unpack8(*(const GAS v4u*)(p0 - PROJ + COL_U), uu1); }
          if (s >= 2) { unpack8(*(const GAS v4u*)(p0 - 2 * PROJ + COL_C), c2); unpack8(*(const GAS v4u*)(p0 - 2 * PROJ + COL_U), uu2); }
#pragma unroll
          for (int jj = 0; jj < 8; ++jj) { const int c = 8 * lane + jj;
              const float z0 = c0[jj] * uu0[jj], z1 = (s >= 1) ? c1[jj] * uu1[jj] : 0.f, z2 = (s >= 2) ? c2[jj] * uu2[jj] : 0.f;
              const float v = bg[jj] * (F.conv_w[c] * z2 + F.conv_w[CONV_W + c] * z1 + F.conv_w[2 * CONV_W + c] * z0); co[jj] = v; ssc += v * v; } }
        float mo[8]; float ssm = 0.f;
        unpack8(__builtin_nontemporal_load((const GAS v4u*)(memo + (size_t)t * MEM_W + 8 * lane)), mo);
#pragma unroll
        for (int jj = 0; jj < 8; ++jj) ssm += mo[jj] * mo[jj];
#pragma unroll
        for (int o = 1; o < 64; o <<= 1) { ssa += __shfl_xor(ssa, o); ssc += __shfl_xor(ssc, o); ssm += __shfl_xor(ssm, o); }
        const float ra = 1.0f / sqrtf(ssa * (1.f / ATTN_W) + EPS), rc = 1.0f / sqrtf(ssc * (1.f / CONV_W) + EPS), rm = 1.0f / sqrtf(ssm * (1.f / MEM_W) + EPS);
        bf16* yr = Y + (size_t)t * D;
#pragma unroll
        for (int cc = 0; cc < 2; ++cc) { const float* g = F.out_norm_g + cc * 512 + 8 * lane; v4u w;
            w.x = pk2(a[8 * cc + 0] * ra * g[0], a[8 * cc + 1] * ra * g[1]); w.y = pk2(a[8 * cc + 2] * ra * g[2], a[8 * cc + 3] * ra * g[3]);
            w.z = pk2(a[8 * cc + 4] * ra * g[4], a[8 * cc + 5] * ra * g[5]); w.w = pk2(a[8 * cc + 6] * ra * g[6], a[8 * cc + 7] * ra * g[7]);
            *(GAS v4u*)(yr + cc * 512 + 8 * lane) = w; }
        { const float* g = F.out_norm_g + ATTN_W + 8 * lane; v4u w;
          w.x = pk2(co[0] * rc * g[0], co[1] * rc * g[1]); w.y = pk2(co[2] * rc * g[2], co[3] * rc * g[3]); w.z = pk2(co[4] * rc * g[4], co[5] * rc * g[5]); w.w = pk2(co[6] * rc * g[6], co[7] * rc * g[7]);
          *(GAS v4u*)(yr + ATTN_W + 8 * lane) = w; }
        { const float* g = F.out_norm_g + ATTN_W + CONV_W + 8 * lane; v4u w;
          w.x = pk2(mo[0] * rm * g[0], mo[1] * rm * g[1]); w.y = pk2(mo[2] * rm * g[2], mo[3] * rm * g[3]); w.z = pk2(mo[4] * rm * g[4], mo[5] * rm * g[5]); w.w = pk2(mo[6] * rm * g[6], mo[7] * rm * g[7]);
          *(GAS v4u*)(yr + ATTN_W + CONV_W + 8 * lane) = w; }
    }
}

__device__ __forceinline__ float max8(float v) { v = fmaxf(v, __shfl_xor(v, 1)); v = fmaxf(v, __shfl_xor(v, 2)); v = fmaxf(v, __shfl_xor(v, 4)); return v; }
namespace rt {
constexpr int KC = 128, NCH = D / KC, BP = KC * 2 + 16, BUFB = 2 * 96 * BP;
__device__ __forceinline__ void issue_b(v4u (&bst)[6], const bf16* WT, int c, int tid) {
#pragma unroll
    for (int i = 0; i < 6; ++i) { const int p = tid + 512 * i, arr = p / 1536, rem = p - arr * 1536, n = rem >> 4, ch = rem & 15;
        bst[i] = *(const GAS v4u*)(WT + ((size_t)arr * 96 + n) * 2048 + c * KC + ch * 8); }
}
__device__ __forceinline__ void write_b(const v4u (&bst)[6], LAS unsigned char* buf, int tid) {
#pragma unroll
    for (int i = 0; i < 6; ++i) { const int p = tid + 512 * i, arr = p / 1536, rem = p - arr * 1536, n = rem >> 4, ch = rem & 15;
        *(LAS v4u*)(buf + arr * (96 * BP) + n * BP + ch * 16) = bst[i]; }
}
__device__ __forceinline__ void issue_a(f32x4 (&a)[4][2], const float* xrow, int c) {
#pragma unroll
    for (int ks = 0; ks < 4; ++ks) { a[ks][0] = *(const GAS f32x4*)(xrow + c * KC + ks * 32); a[ks][1] = *(const GAS f32x4*)(xrow + c * KC + ks * 32 + 4); }
}
__device__ __forceinline__ void compute(f32x4 (&acc)[6], float& ss, const f32x4 (&a)[4][2], const LAS unsigned char* buf, int fr, int kg) {
#pragma unroll
    for (int ks = 0; ks < 4; ++ks) {
        const f32x4 f0 = a[ks][0], f1 = a[ks][1];
        ss += (f0.x * f0.x + f0.y * f0.y) + (f0.z * f0.z + f0.w * f0.w) + (f1.x * f1.x + f1.y * f1.y) + (f1.z * f1.z + f1.w * f1.w);
        asm volatile("" : "+v"(ss));
        v4u h; h.x = cvtpk(f0.x, f0.y); h.y = cvtpk(f0.z, f0.w); h.z = cvtpk(f1.x, f1.y); h.w = cvtpk(f1.z, f1.w);
        v4u l; l.x = cvtpk(f0.x - bflo(h.x), f0.y - bfhi(h.x)); l.y = cvtpk(f0.z - bflo(h.y), f0.w - bfhi(h.y)); l.z = cvtpk(f1.x - bflo(h.z), f1.y - bfhi(h.z)); l.w = cvtpk(f1.z - bflo(h.w), f1.w - bfhi(h.w));
        const bf16x8 ah = __builtin_bit_cast(bf16x8, h), al = __builtin_bit_cast(bf16x8, l);
#pragma unroll
        for (int nb = 0; nb < 6; ++nb) { const LAS unsigned char* bp = buf + (nb * 16 + fr) * BP + (ks * 32 + 8 * kg) * 2;
            const bf16x8 bh = *(const LAS bf16x8*)bp, bl = *(const LAS bf16x8*)(bp + 96 * BP);
            acc[nb] = __builtin_amdgcn_mfma_f32_16x16x32_bf16(ah, bh, acc[nb], 0, 0, 0);
            acc[nb] = __builtin_amdgcn_mfma_f32_16x16x32_bf16(al, bh, acc[nb], 0, 0, 0);
            acc[nb] = __builtin_amdgcn_mfma_f32_16x16x32_bf16(ah, bl, acc[nb], 0, 0, 0); }
    }
}
}
__device__ __forceinline__ void p5_router(Frame& F) {
    using namespace rt;
    const int tid = F.tid, wave = F.wave;
    const float* X1 = F.out; const bf16* WT = (const bf16*)(F.ws + WS_WR);
    LAS unsigned char* Bl = F.lds;
    LAS float* Lg = (LAS float*)(F.lds + 2 * BUFB + wave * (16 * 97 * 4));
    unsigned* cnt = F.ctl + CW_CNT;
    int* tok_e = (int*)(F.ws + WS_TOK + TOK_E); int* tok_rank = (int*)(F.ws + WS_TOK + TOK_RANK);
    for (int mt = F.vcu; mt < T / 128; mt += F.G) {
        int lane = F.lane; asm volatile("" : "+v"(lane));
        const int fr = lane & 15, kg = lane >> 4;
        const int t0 = mt * 128 + wave * 16;
        const float* xrow = X1 + (size_t)(t0 + fr) * D + 8 * kg;
        f32x4 acc[6];
#pragma unroll
        for (int i = 0; i < 6; ++i) acc[i] = (f32x4){0.f, 0.f, 0.f, 0.f};
        float ss = 0.f;
        v4u bst[6]; f32x4 a0[4][2], a1[4][2];
        __syncthreads();
        issue_b(bst, WT, 0, tid); issue_a(a0, xrow, 0);
#pragma unroll 1
        for (int c = 0; c < NCH; c += 2) {
            write_b(bst, Bl, tid); __syncthreads();
            issue_b(bst, WT, c + 1, tid); issue_a(a1, xrow, c + 1);
            compute(acc, ss, a0, Bl, fr, kg);
            write_b(bst, Bl + BUFB, tid); __syncthreads();
            if (c + 2 < NCH) { issue_b(bst, WT, c + 2, tid); issue_a(a0, xrow, c + 2); }
            compute(acc, ss, a1, Bl + BUFB, fr, kg);
        }
        ss += __shfl_xor(ss, 16); ss += __shfl_xor(ss, 32);
        const float rs_row = 1.0f / sqrtf(ss * (1.f / D) + EPS);
#pragma unroll
        for (int r = 0; r < 4; ++r) { const float rr = __shfl(rs_row, 4 * kg + r);
#pragma unroll
            for (int nb = 0; nb < 6; ++nb) Lg[(4 * kg + r) * 97 + nb * 16 + fr] = acc[nb][r] * rr; }
        LDS_WAIT(); asm volatile("" ::: "memory");
        const float be = F.b_re[lane], bg = F.b_rg[lane & 7];
        int my_e1 = 0, my_e2 = 0; float my_g1 = 0.f, my_g2 = 0.f;
#pragma unroll 4
        for (int tk = 0; tk < 16; ++tk) {
            const float gl = Lg[tk * 97 + 64 + (lane & 7)] + bg;
            const float el = Lg[tk * 97 + lane] + be;
            const float gmax = max8(gl);
            const int gi = __builtin_ctzll(__ballot(gl == gmax) & 0xFFull);
            float gs = __builtin_amdgcn_exp2f((gl - gmax) * LOG2E); gs += __shfl_xor(gs, 1); gs += __shfl_xor(gs, 2); gs += __shfl_xor(gs, 4);
            const float gwt = 1.0f / gs;
            const float v1 = __shfl(max8(el), 8 * gi);
            const int i1 = __builtin_ctzll((__ballot(el == v1) >> (8 * gi)) & 0xFFull);
            const float el2 = (lane == 8 * gi + i1) ? -3.0e38f : el;
            const float v2 = __shfl(max8(el2), 8 * gi);
            const int i2 = __builtin_ctzll((__ballot(el2 == v2) >> (8 * gi)) & 0xFFull);
            const float pr = __builtin_amdgcn_exp2f((v2 - v1) * LOG2E), den = 1.0f / (1.0f + pr);
            if (lane == tk) { my_e1 = 8 * gi + i1; my_e2 = 8 * gi + i2; my_g1 = gwt * den; my_g2 = gwt * pr * den; }
        }
        LAS unsigned* hist = (LAS unsigned*)(F.lds + MISC_OFF + 256);
        if (tid < 64) hist[tid] = 0u;
        __syncthreads();
        unsigned lr1 = 0u, lr2 = 0u;
        if (lane < 16) { lr1 = __hip_atomic_fetch_add(hist + my_e1, 1u, __ATOMIC_RELAXED, __HIP_MEMORY_SCOPE_WORKGROUP); lr2 = __hip_atomic_fetch_add(hist + my_e2, 1u, __ATOMIC_RELAXED, __HIP_MEMORY_SCOPE_WORKGROUP); }
        __syncthreads();
        if (tid < 64) { const unsigned c = hist[tid]; hist[64 + tid] = c ? __hip_atomic_fetch_add(cnt + 64 * tid, c, RLX_AGENT) : 0u; }
        __syncthreads();
        if (lane < 16) {
            const int t = t0 + lane;
            const int k1 = (int)(hist[64 + my_e1] + lr1), k2 = (int)(hist[64 + my_e2] + lr2);
            tok_e[2 * t] = my_e1; tok_e[2 * t + 1] = my_e2; tok_rank[2 * t] = k1; tok_rank[2 * t + 1] = k2;
            int* ltok = (int*)(F.ws + WS_LIST + LIST_TOK); float* lrs = (float*)(F.ws + WS_LIST + LIST_RSTD); float* lgt = (float*)(F.ws + WS_LIST + LIST_GATE);
            ltok[my_e1 * CAP + k1] = t; ltok[my_e2 * CAP + k2] = t; lrs[my_e1 * CAP + k1] = rs_row; lrs[my_e2 * CAP + k2] = rs_row; lgt[my_e1 * CAP + k1] = my_g1; lgt[my_e2 * CAP + k2] = my_g2;
        }
    }
}

constexpr int MOE_MT = MISC_OFF + 48, MOE_PST = MISC_OFF + 64, MOE_TE = MOE_PST + 256;
constexpr int MOE_TB = LDS_EXTRA, MOE_VR = MOE_TB + MAXTILES * 4, MOE_UT = MOE_VR + MAXTILES * 4;
constexpr int MOE_MAXU = 12;
static_assert(MOE_UT + MOE_MAXU * 256 * 4 <= MISC_OFF && MOE_TE + MAXTILES * 4 <= LDS_BYTES, "LDS map");
__device__ __forceinline__ int moe_tables(Frame& F) {
    LAS int* PST = (LAS int*)(F.lds + MOE_PST); LAS int* TE = (LAS int*)(F.lds + MOE_TE); LAS int* MTp = (LAS int*)(F.lds + MOE_MT); LAS int* TB = (LAS int*)(F.lds + MOE_TB); LAS int* VR = (LAS int*)(F.lds + MOE_VR);
    __syncthreads();
    if (F.tid < 64) {
        const int c = (int)__hip_atomic_load(F.ctl + CW_CNT + 64 * F.tid, RLX_AGENT); const int nt = (c + 255) >> 8;
        int x = nt;
#pragma unroll
        for (int o = 1; o < 64; o <<= 1) { const int y = __shfl_up(x, o); if (F.lane >= o) x += y; }
        const int ex = x - nt; PST[F.tid] = ex; if (F.tid == 63) MTp[0] = x;
        for (int i = 0; i < nt; ++i) { TE[ex + i] = F.tid; TB[ex + i] = F.tid * CAP + 256 * i; VR[ex + i] = (c - 256 * i) < 256 ? (c - 256 * i) : 256; }
    }
    __syncthreads();
    return MTp[0];
}

__device__ __forceinline__ void p9_final(Frame& F) {
    (void)moe_tables(F);
    const LAS int* PST = (const LAS int*)(F.lds + MOE_PST);
    const int gw = F.vcu * NWAVES + F.wave, NGW = F.G * NWAVES, lane = F.lane;
    const int* tok_e = (const int*)(F.ws + WS_TOK + TOK_E); const int* tok_rank = (const int*)(F.ws + WS_TOK + TOK_RANK); const bf16* YB = (const bf16*)(F.ws + WS_R1);
    for (int t = gw; t < T; t += NGW) {
        const int s1 = PST[tok_e[2 * t]] * 256 + tok_rank[2 * t], s2 = PST[tok_e[2 * t + 1]] * 256 + tok_rank[2 * t + 1];
        const GAS v4u* y1 = (const GAS v4u*)(YB + (size_t)s1 * D) + lane; const GAS v4u* y2 = (const GAS v4u*)(YB + (size_t)s2 * D) + lane;
        GAS f32x4* o = (GAS f32x4*)(F.out + (size_t)t * D) + 2 * lane;
#pragma unroll
        for (int i = 0; i < 4; ++i) { float a[8], b[8]; unpack8(__builtin_nontemporal_load(y1 + 64 * i), a); unpack8(__builtin_nontemporal_load(y2 + 64 * i), b);
            f32x4 v0 = __builtin_nontemporal_load(o + 128 * i), v1 = __builtin_nontemporal_load(o + 128 * i + 1);
            v0.x += a[0] + b[0]; v0.y += a[1] + b[1]; v0.z += a[2] + b[2]; v0.w += a[3] + b[3]; v1.x += a[4] + b[4]; v1.y += a[5] + b[5]; v1.z += a[6] + b[6]; v1.w += a[7] + b[7];
            __builtin_nontemporal_store(v0, o + 128 * i); __builtin_nontemporal_store(v1, o + 128 * i + 1); }
    }
}

constexpr int PER_PHASE = 10;
constexpr int N_LAUNCHES = MK_N_LAUNCHES;
struct Args { const float* in[21]; float* out; unsigned char* ws; int ph_lo, ph_hi, li, pad; };
__global__ void __launch_bounds__(NWAVES * 64, 2) hymba_fwd(Args args) {
    extern __shared__ __attribute__((aligned(16))) unsigned char lds[];
    Frame F;
    F.lds = (LAS unsigned char*)lds;
    F.tid = threadIdx.x; F.lane = F.tid & 63; F.wave = __builtin_amdgcn_readfirstlane(F.tid >> 6);
    F.G = gridDim.x; { const int bx = blockIdx.x; F.vcu = (F.G % 8 == 0) ? (bx % 8) * (F.G / 8) + bx / 8 : bx; }
    F.ws = args.ws; F.ctl = (unsigned*)(args.ws + WS_CTL); F.out = args.out;
    F.x = args.in[0]; F.mem = args.in[1]; F.norm1_g = args.in[2]; F.w_in = args.in[3]; F.q_norm_g = args.in[4]; F.k_norm_g = args.in[5]; F.conv_w = args.in[6];
    F.mem_norm_g = args.in[7]; F.w_mem_kv = args.in[8]; F.mem_q_norm_g = args.in[9]; F.mem_k_norm_g = args.in[10]; F.out_norm_g = args.in[11]; F.w_out = args.in[12];
    F.norm2_g = args.in[13]; F.w_rg = args.in[14]; F.b_rg = args.in[15]; F.w_re = args.in[16]; F.b_re = args.in[17]; F.w_gate = args.in[18]; F.w_up = args.in[19]; F.w_down = args.in[20];
    volatile LAS unsigned* MISC = (volatile LAS unsigned*)(F.lds + MISC_OFF);
    if (F.tid < 16) MISC[F.tid] = 0u;
    __syncthreads();
    const int lo = args.ph_lo, hi = args.ph_hi;
    const bool multi = (hi - lo) > 1;
    XcdBarrier bar; bar.bar = F.ctl + CW_BAR + args.li * XCD_BAR_WORDS; bar.x = 0; bar.st = nullptr;
    if (multi) bar = xcd_barrier_post(F.ctl + CW_BAR + args.li * XCD_BAR_WORDS, MISC + 8);
#define GRID_BAR() do { if (multi) xcd_barrier(bar); } while (0)
#define IN(k) (lo <= (k) && (k) < hi)
#define BOTH(k) (IN(k) && IN((k) + 1))
    if (IN(0)) { p0_prologue(F); if (BOTH(0)) GRID_BAR(); }
    if (IN(1)) {
        pg8::Gemm g{(const bf16*)(F.ws + WS_H), (const bf16*)(F.ws + WS_WIN), D, nullptr}; pg8::P1Order S{F.G, (int)blockIdx.x, 0, 2560};
        pg8::EpiProj E{(bf16*)(F.ws + WS_R1), (bf16*)(F.ws + WS_MEMKV)};
        pg8::gemm_phase<pg8::EpiProj, pg8::P1Order>(F.lds, g, S, E);
        if (BOTH(1)) GRID_BAR();
    }
    if (IN(2)) { p2_attention(F); if (BOTH(2)) GRID_BAR(); }
    if (IN(3)) { p3_combine(F); if (BOTH(3)) GRID_BAR(); }
    if (IN(4)) {
        pg8::Gemm g{(const bf16*)(F.ws + WS_Y), (const bf16*)(F.ws + WS_WOUT), D, nullptr}; pg8::StaticOrder S{T / 256, D / 256, F.G, (int)blockIdx.x};
        pg8::EpiResid E{F.x, F.out, (bf16*)(F.ws + WS_H)};
        pg8::gemm_phase<pg8::EpiResid, pg8::StaticOrder, false>(F.lds, g, S, E);
        if (BOTH(4)) GRID_BAR();
    }
    if (IN(5)) { p5_router(F); if (BOTH(5)) GRID_BAR(); }
    if (IN(7)) {
        const int MT = moe_tables(F);
        pg8::MoeOrder S{MT, F.G, (int)blockIdx.x, (const LAS int*)(F.lds + MOE_TE)};
        { const LAS int* TB = (const LAS int*)(F.lds + MOE_TB); const LAS int* VR = (const LAS int*)(F.lds + MOE_VR); LAS int* UT = (LAS int*)(F.lds + MOE_UT);
          const int* ltok = (const int*)(F.ws + WS_LIST + LIST_TOK);
          for (int i = 0; i < MOE_MAXU; ++i) { pg8::Unit u; if (!S.next(i, u)) break;
              if (F.tid < 256) UT[i * 256 + F.tid] = (F.tid < VR[u.pm]) ? ltok[TB[u.pm] + F.tid] : 0; }
          __syncthreads(); }
        pg8::Gemm g{(const bf16*)(F.ws + WS_H), (const bf16*)(F.ws + WS_WGU), D, (const LAS int*)(F.lds + MOE_UT)};
        pg8::EpiSwiGLU E{(bf16*)(F.ws + WS_OPART), (const float*)(F.ws + WS_LIST + LIST_RSTD), (const LAS int*)(F.lds + MOE_TB)};
        pg8::gemm_phase<pg8::EpiSwiGLU, pg8::MoeOrder, true, true, false, true>(F.lds, g, S, E);
        if (BOTH(7)) GRID_BAR();
    }
    if (IN(8)) {
        const int MT = moe_tables(F);
        pg8::Gemm g{(const bf16*)(F.ws + WS_OPART), (const bf16*)(F.ws + WS_WD), DEXP, nullptr}; pg8::MoeOrder S{MT, F.G, (int)blockIdx.x, (const LAS int*)(F.lds + MOE_TE)};
        pg8::EpiDown E{(bf16*)(F.ws + WS_R1), (const float*)(F.ws + WS_LIST + LIST_GATE), (const LAS int*)(F.lds + MOE_TB)};
        pg8::gemm_phase<pg8::EpiDown, pg8::MoeOrder, true, false, false, true>(F.lds, g, S, E);
        if (BOTH(8)) GRID_BAR();
    }
    if (IN(9)) { p9_final(F); }
#undef IN
#undef BOTH
#undef GRID_BAR
}

extern "C" void kernel_launch(void* const* d_in, const int* in_sizes, int n_in, void* d_out, int out_size, void* d_ws, size_t ws_size, hipStream_t stream) {
    static int grid = 0;
    if (grid == 0) {
        if (n_in != 21 || in_sizes[0] != T * D || out_size != T * D || ws_size < WS_END) { fprintf(stderr, "kernel_launch: shape/workspace mismatch (n_in %d, ws %zu < %zu); nothing launched\n", n_in, ws_size, (size_t)WS_END); grid = -1; return; }
        int dev = 0, cus = 0, per_cu = 0;
        if (hipGetDevice(&dev) != hipSuccess || hipDeviceGetAttribute(&cus, hipDeviceAttributeMultiprocessorCount, dev) != hipSuccess) { grid = -1; return; }
        if (hipFuncSetAttribute((const void*)hymba_fwd, hipFuncAttributeMaxDynamicSharedMemorySize, LDS_BYTES) != hipSuccess) { fprintf(stderr, "kernel_launch: hipFuncSetAttribute failed\n"); grid = -1; return; }
        if (hipOccupancyMaxActiveBlocksPerMultiprocessor(&per_cu, (const void*)hymba_fwd, NWAVES * 64, LDS_BYTES) != hipSuccess || per_cu < 1) { fprintf(stderr, "kernel_launch: occupancy query reports %d\n", per_cu); }
        (void)hipGetLastError();
        grid = cus;
    }
    if (grid < 0) return;
    if (hipMemsetAsync((char*)d_ws + WS_CTL, 0, CTL_ZERO_BYTES, stream) != hipSuccess) { fprintf(stderr, "kernel_launch: memset failed\n"); return; }
    Args a{};
    for (int i = 0; i < 21; ++i) a.in[i] = (const float*)d_in[i];
    a.out = (float*)d_out; a.ws = (unsigned char*)d_ws;
    int los[4], his[4], nl = 0;
#if defined(PROBE_REPEAT)
    los[nl] = 0; his[nl] = PROBE_REPEAT + 1; ++nl; los[nl] = PROBE_REPEAT; his[nl] = PROBE_REPEAT + 1; ++nl; if (PROBE_REPEAT + 1 < PER_PHASE) { los[nl] = PROBE_REPEAT + 1; his[nl] = PER_PHASE; ++nl; }
#else
    los[nl] = 0; his[nl] = PER_PHASE; ++nl;
#endif
    for (int li = 0; li < nl; ++li) {
        a.ph_lo = los[li]; a.ph_hi = his[li]; a.li = li;
#if defined(PROBE_REPEAT)
        if (li == 1) { (void)hipMemsetAsync((char*)d_ws + WS_CTL + CW_ATTQ * 4, 0, 64, stream); if (PROBE_REPEAT == 5) (void)hipMemsetAsync((char*)d_ws + WS_CTL + CW_CNT * 4, 0, 64 * 256, stream); }
#endif
        hipLaunchKernelGGL(hymba_fwd, dim3(grid), dim3(NWAVES * 64), LDS_BYTES, stream, a);
        const hipError_t le = hipPeekAtLastError();
        if (le != hipSuccess) { fprintf(stderr, "kernel_launch: launch %d failed: %s\n", li, hipGetErrorName(le)); break; }
    }
}
```

```cpp
#include <hip/hip_runtime.h>
#include <cstdio>
#include <cstdint>

#ifndef MK_N_LAUNCHES
#define MK_N_LAUNCHES 1
#endif

#define GAS __attribute__((address_space(1)))
#define LAS __attribute__((address_space(3)))
typedef unsigned short bf16;
typedef unsigned v4u __attribute__((ext_vector_type(4)));
typedef unsigned v2u __attribute__((ext_vector_type(2)));
typedef float f32x4 __attribute__((ext_vector_type(4)));
typedef float f32x16 __attribute__((ext_vector_type(16)));
typedef short bf16x8 __attribute__((ext_vector_type(8)));
typedef short s16x4 __attribute__((ext_vector_type(4)));
#define LDS_WAIT() asm volatile("s_waitcnt lgkmcnt(0)" ::: "memory")
#define VM_WAIT() asm volatile("s_waitcnt vmcnt(0)" ::: "memory")
#define RLX_AGENT __ATOMIC_RELAXED, __HIP_MEMORY_SCOPE_AGENT

constexpr int BATCH = 2, SEQ = 16384, T = BATCH * SEQ, D = 2048, PROJ = 5120;
constexpr int NH = 8, HD = 128, ATTN_W = 1024, CONV_W = 512, MEM_W = 512, NMEM = 256, NMH = 4;
constexpr int COL_Q = 0, COL_K = 1024, COL_V = 2048, COL_B = 3072, COL_C = 3584, COL_U = 4096, COL_MQ = 4608;
constexpr int NEXP = 64, DEXP = 1024;
constexpr int RMAX = 81920;
constexpr int MAXTILES = RMAX / 256;
constexpr float EPS = 1e-6f;
constexpr float LOG2E = 1.4426950408889634f;

constexpr size_t MiB = 1u << 20;
constexpr size_t WS_CTL = 0, CTL_ZERO_BYTES = 1 * MiB;
constexpr size_t WS_WIN = 1 * MiB;
constexpr size_t WS_WMKV = WS_WIN + (size_t)PROJ * D * 2;
constexpr size_t WS_WOUT = 25 * MiB;
constexpr size_t WS_WR = 33 * MiB;
constexpr size_t WS_WGU = 34 * MiB;
constexpr size_t WS_WD = WS_WGU + 512 * MiB;
constexpr size_t WS_H = WS_WD + 256 * MiB;
constexpr size_t WS_MEMKV = WS_H + 130 * MiB;
constexpr size_t WS_R1 = WS_MEMKV + 1 * MiB;
constexpr size_t WS_OPART = WS_R1 + 320 * MiB;
constexpr size_t WS_LSE = WS_OPART + 192 * MiB;
constexpr size_t WS_MEMO = WS_LSE + 3 * MiB;
constexpr size_t WS_Y = WS_MEMO + 32 * MiB;
constexpr size_t WS_TOK = WS_Y + 128 * MiB;
constexpr size_t WS_LIST = WS_TOK + 4 * MiB;
constexpr size_t WS_END = WS_LIST + 24 * MiB;
constexpr int CAP = T;
constexpr size_t LIST_TOK = 0, LIST_RSTD = 8 * MiB, LIST_GATE = 16 * MiB;
constexpr size_t TOK_E = 0, TOK_RANK = 256 * 1024, TOK_GATE = 512 * 1024, TOK_RSTD = 768 * 1024, TOK_SLOT = 1024 * 1024, SLOT_RSTD = 1536 * 1024, SLOT_GATE = 2048 * 1024;
static_assert(WS_WMKV + 1024 * (size_t)D * 2 <= WS_WOUT && WS_WOUT + 8 * MiB <= WS_WR && WS_WR + 2048 * 72 * 4 <= WS_WGU, "ws map");
static_assert((size_t)(T + 512) * D * 2 <= 130 * MiB && (size_t)RMAX * D * 2 <= 320 * MiB && (size_t)RMAX * DEXP * 2 <= 192 * MiB && SLOT_GATE + RMAX * 4 <= 4 * MiB, "ws map");

constexpr int CW_TMO = 0, CW_CODE = 1;
constexpr int CW_CNT = 8192;
constexpr int CW_BAR = 16384;
constexpr int CW_KVREADY = 512, CW_ATTQ = 576;

constexpr int RING_BYTES = 131072;
constexpr int LDS_EXTRA = RING_BYTES;
constexpr int MISC_OFF = 163840 - 2048;
constexpr int LDS_BYTES = 163840;

__device__ __forceinline__ unsigned f2bf(float f) { unsigned u = __builtin_bit_cast(unsigned, f); return (u + 0x7fffu + ((u >> 16) & 1u)) >> 16; }
__device__ __forceinline__ unsigned pk2(float lo, float hi) { return f2bf(lo) | (f2bf(hi) << 16); }
__device__ __forceinline__ unsigned cvtpk(float lo, float hi) { unsigned r; asm volatile("v_cvt_pk_bf16_f32 %0, %1, %2" : "=v"(r) : "v"(lo), "v"(hi)); return r; }
__device__ __forceinline__ unsigned pk_fp8x4(float a, float b, float c, float d) { unsigned w = 0u; w = __builtin_amdgcn_cvt_pk_fp8_f32(a, b, w, false); w = __builtin_amdgcn_cvt_pk_fp8_f32(c, d, w, true); return w; }
constexpr float SC_WGU = 128.0f, SC_ACT = 4.0f, SC_WD = 64.0f;
__device__ __forceinline__ float bflo(unsigned w) { return __builtin_bit_cast(float, w << 16); }
__device__ __forceinline__ float bfhi(unsigned w) { return __builtin_bit_cast(float, w & 0xffff0000u); }
__device__ __forceinline__ float wave_sum(float v) {
#pragma unroll
    for (int o = 1; o < 64; o <<= 1) v += __shfl_xor(v, o);
    return v;
}

namespace pg8 {
#define PG8_LAS __attribute__((address_space(3)))
typedef unsigned short bf16_t;
typedef unsigned u32x4 __attribute__((ext_vector_type(4)));
typedef int i32x4 __attribute__((ext_vector_type(4)));
typedef int i32x8 __attribute__((ext_vector_type(8)));
constexpr int BM = 256, BK = 64, HALF = 128, HTB = HALF * BK * 2, STAGE_BYTES = 8 * HTB, NXCD = 8, WGM = 8;
__host__ __device__ __forceinline__ int lds_byte(int r, int c) { const int st = (r >> 4) * 2 + (c >> 5), rr = r & 15, cc = c & 31, ob = rr * 64 + cc * 2; return st * 1024 + (ob ^ (((ob >> 9) & 1) << 5)); }
__host__ __device__ __forceinline__ void stage_rc(int b, int& R, int& C) { const int st = b / 1024, sb = b % 1024, swz = sb ^ (((sb >> 9) & 1) << 5); R = (st >> 1) * 16 + swz / 64; C = (st & 1) * 32 + (swz % 64) / 2; }
__host__ __device__ __forceinline__ int perm32(int rho) { const int n = rho >> 4, i = rho & 15; return 8 * (i >> 2) + 4 * n + (i & 3); }

struct Unit { int pm, pn, pb; };
struct Gemm { const bf16_t* A; const bf16_t* Bt; int K; const PG8_LAS int* ut; };

__device__ __forceinline__ void tile_of(int L, int nM, int nN, int& pm, int& pn) {
    const int nwg = nM * nN;
    int wgid = L; { const int q = nwg / NXCD, r = nwg % NXCD, xcd = wgid % NXCD, off = wgid / NXCD; wgid = (xcd < r ? xcd * (q + 1) : r * (q + 1) + (xcd - r) * q) + off; }
    const int nig = WGM * nN, gid = wgid / nig, fm = gid * WGM, gsz = (nM - fm) < WGM ? (nM - fm) : WGM;
    pm = fm + ((wgid % nig) % gsz); pn = (wgid % nig) / gsz;
}
struct StaticOrder {
    int nM, nN, G, c;
    __device__ __forceinline__ bool next(int i, Unit& u) const { const long L = (long)i * G + c; if (L >= (long)nM * nN) return false; tile_of((int)L, nM, nN, u.pm, u.pn); u.pb = u.pn; return true; }
    __device__ __forceinline__ void a_ready(const Unit&) const {}
    __device__ __forceinline__ void done(const Unit&) const {}
};
struct P1Order {
    int G, c, lo, hi;
    __device__ __forceinline__ bool next(int i, Unit& u) const { const long L = (long)lo + (long)i * G + c; if (L >= hi) return false;
        if (L < 2560) tile_of((int)L, 128, 20, u.pm, u.pn); else { const int k = (int)L - 2560; u.pm = 128 + (k >> 2); u.pn = 20 + (k & 3); }
        u.pb = u.pn; return true; }
    __device__ __forceinline__ void a_ready(const Unit&) const {}
    __device__ __forceinline__ void done(const Unit&) const {}
};
struct MoeOrder {
    int nM, G, c; const LAS int* te;
    __device__ __forceinline__ bool next(int i, Unit& u) const { const long L = (long)i * G + c; if (L >= (long)nM * 8) return false; tile_of((int)L, nM, 8, u.pm, u.pn); u.pb = te[u.pm] * 8 + u.pn; return true; }
    __device__ __forceinline__ void a_ready(const Unit&) const {}
    __device__ __forceinline__ void done(const Unit&) const {}
};

struct EpiProj {
    static constexpr bool PERM = true, AFTER_DRAIN = false;
    bf16_t* O; bf16_t* O2;
    __device__ __forceinline__ void operator()(const f32x4 (&acc)[2][2][4][2], const Unit& u, int wr, int wc, int fr, int fq) const {
        int row0 = u.pm * BM + wr * 64 + fr, col0 = u.pn * BM + wc * 32 + 8 * fq, ldc = PROJ; bf16_t* base = O;
        if (u.pm >= 128) { row0 -= 128 * BM; col0 -= 20 * BM; ldc = 1024; base = O2; }
#pragma unroll
        for (int ai = 0; ai < 2; ++ai)
#pragma unroll
            for (int m = 0; m < 4; ++m) { bf16_t* rowp = base + (size_t)(row0 + ai * HALF + m * 16) * ldc + col0;
#pragma unroll
                for (int bj = 0; bj < 2; ++bj) { const f32x4 v0 = acc[ai][bj][m][0], v1 = acc[ai][bj][m][1];
                    u32x4 w; w.x = cvtpk(v0[0], v0[1]); w.y = cvtpk(v0[2], v0[3]); w.z = cvtpk(v1[0], v1[1]); w.w = cvtpk(v1[2], v1[3]);
                    *(u32x4*)(rowp + bj * HALF) = w; } }
    }
};
struct EpiResid {
    static constexpr bool PERM = true, AFTER_DRAIN = false;
    const float* X; float* X1; bf16_t* X1B;
    __device__ __forceinline__ void operator()(const f32x4 (&acc)[2][2][4][2], const Unit& u, int wr, int wc, int fr, int fq) const {
        const int row0 = u.pm * BM + wr * 64 + fr, col0 = u.pn * BM + wc * 32 + 8 * fq;
#pragma unroll
        for (int ai = 0; ai < 2; ++ai)
#pragma unroll
            for (int m = 0; m < 4; ++m) { const size_t off = (size_t)(row0 + ai * HALF + m * 16) * D + col0;
#pragma unroll
                for (int bj = 0; bj < 2; ++bj) { const f32x4 xa = __builtin_nontemporal_load((const f32x4*)(X + off + bj * HALF)), xb = __builtin_nontemporal_load((const f32x4*)(X + off + bj * HALF + 4));
                    const f32x4 v0 = acc[ai][bj][m][0] + xa, v1 = acc[ai][bj][m][1] + xb;
                    *(f32x4*)(X1 + off + bj * HALF) = v0; *(f32x4*)(X1 + off + bj * HALF + 4) = v1;
                    v2u w; w.x = pk_fp8x4(v0[0], v0[1], v0[2], v0[3]); w.y = pk_fp8x4(v1[0], v1[1], v1[2], v1[3]);
                    *(v2u*)((unsigned char*)X1B + off + bj * HALF) = w; }
                asm volatile("" ::: "memory"); }
    }
};
struct EpiSwiGLU {
    static constexpr bool PERM = true, AFTER_DRAIN = false;
    bf16_t* ACT; const float* RS; const PG8_LAS int* tb;
    __device__ __forceinline__ void operator()(const f32x4 (&acc)[2][2][4][2], const Unit& u, int wr, int wc, int fr, int fq) const {
        const int row0 = u.pm * BM + wr * 64 + fr, col0 = u.pn * HALF + wc * 32 + 8 * fq, lb = tb[u.pm] - u.pm * BM;
#pragma unroll
        for (int ai = 0; ai < 2; ++ai)
#pragma unroll
            for (int m = 0; m < 4; ++m) { const int row = row0 + ai * HALF + m * 16; const float rs = RS[lb + row] * (1.0f / SC_WGU); float o[8];
#pragma unroll
                for (int n = 0; n < 2; ++n)
#pragma unroll
                    for (int j = 0; j < 4; ++j) { const float g = acc[ai][0][m][n][j] * rs, uu = acc[ai][1][m][n][j] * rs;
                        o[n * 4 + j] = g * __builtin_amdgcn_rcpf(1.0f + __builtin_amdgcn_exp2f(-g * LOG2E)) * uu * SC_ACT; }
                v2u w; w.x = pk_fp8x4(o[0], o[1], o[2], o[3]); w.y = pk_fp8x4(o[4], o[5], o[6], o[7]);
                *(v2u*)((unsigned char*)ACT + (size_t)row * DEXP + col0) = w; }
    }
};
struct EpiDown {
    static constexpr bool PERM = true, AFTER_DRAIN = false;
    bf16_t* Y; const float* GT; const PG8_LAS int* tb;
    __device__ __forceinline__ void operator()(const f32x4 (&acc)[2][2][4][2], const Unit& u, int wr, int wc, int fr, int fq) const {
        const int row0 = u.pm * BM + wr * 64 + fr, col0 = u.pn * BM + wc * 32 + 8 * fq, lb = tb[u.pm] - u.pm * BM;
#pragma unroll
        for (int ai = 0; ai < 2; ++ai)
#pragma unroll
            for (int m = 0; m < 4; ++m) { const int row = row0 + ai * HALF + m * 16; const float gt = GT[lb + row] * (1.0f / (SC_ACT * SC_WD)); bf16_t* rowp = Y + (size_t)row * D + col0;
#pragma unroll
                for (int bj = 0; bj < 2; ++bj) { const f32x4 v0 = acc[ai][bj][m][0] * gt, v1 = acc[ai][bj][m][1] * gt;
                    u32x4 w; w.x = cvtpk(v0[0], v0[1]); w.y = cvtpk(v0[2], v0[3]); w.z = cvtpk(v1[0], v1[1]); w.w = cvtpk(v1[2], v1[3]);
                    *(u32x4*)(rowp + bj * HALF) = w; } }
    }
};

template <class Epi, class Sched, bool ALIGN_EPI = true, bool GATHER = false, bool BKN = false, bool FP8 = false>
__device__ __forceinline__ void gemm_phase(PG8_LAS unsigned char* lds, const Gemm g, const Sched& S, const Epi& E) {
    static_assert(!(FP8 && BKN), "the fp8 path takes N-major B");
    const int tid = threadIdx.x, wid = __builtin_amdgcn_readfirstlane(tid >> 6), lane = tid & 63, wr = wid >> 2, wc = wid & 3, fr = lane & 15, fq = lane >> 4;
    const int K = FP8 ? g.K / 2 : g.K, nt = K / BK;
    unsigned voffA[2], voffB[2]; int gR[2], gC[2];
#pragma unroll
    for (int i = 0; i < 2; ++i) { int R, C; stage_rc(tid * 16 + i * 8192, R, C); const int Rb = Epi::PERM ? ((R & ~31) + perm32(R & 31)) : R; gR[i] = R; gC[i] = C;
        voffA[i] = (unsigned)(R * K + C) * 2u; voffB[i] = (unsigned)(Rb * K + C) * 2u; }
    unsigned vA0[2], vA1[2], vN0[2], vN1[2];
#define PG8_GOFF(dst0, dst1, ui_) do { _Pragma("unroll") for (int _i = 0; _i < 2; ++_i) { \
        dst0[_i] = ((unsigned)g.ut[(ui_) * 256 + gR[_i]] * (unsigned)K + (unsigned)gC[_i]) * 2u; dst1[_i] = ((unsigned)g.ut[(ui_) * 256 + 128 + gR[_i]] * (unsigned)K + (unsigned)gC[_i]) * 2u; } } while (0)
    const size_t kstep = (size_t)(BK * 2);
    const size_t hstep = (size_t)HALF * K * 2;
    const size_t tstep = 2 * hstep;
    const size_t kstepB = BKN ? (size_t)BK * 4096 : kstep, hstepB = BKN ? (size_t)256 : hstep;
    if constexpr (BKN) {
#pragma unroll
        for (int i = 0; i < 2; ++i) { const int p = tid * 16 + i * 8192, kk = p >> 8, c16p = (p & 255) >> 4, sw = (kk & 3) | (((kk >> 3) & 1) << 2);
            voffB[i] = (unsigned)(kk * 4096 + ((c16p ^ (sw << 1)) << 4)); } }
    int bbase[2];
    { const int q = fr >> 2, p = fr & 3, sw = q | ((fq & 1) << 2);
#pragma unroll
      for (int n = 0; n < 2; ++n) bbase[n] = (int)(uintptr_t)lds + (8 * fq + q) * 256 + (((4 * wc + 2 * n + (p >> 1)) ^ (sw << 1)) << 4) + 8 * (p & 1); }
    const unsigned ldsw = (unsigned)wid * 1024u;
    const int aoff = lds_byte(wr * 64 + fr, fq * 8), boff = lds_byte(wc * 32 + fr, fq * 8);
    const int aoq0 = lds_byte(wr * 64 + fr, fq * 16), aoq1 = lds_byte(wr * 64 + fr, fq * 16 + 8), boq0 = lds_byte(wc * 32 + fr, fq * 16), boq1 = lds_byte(wc * 32 + fr, fq * 16 + 8);
#define PG8_SA(b, h) (((b) * 2 + (h)) * HTB)
#define PG8_SB(b, h) ((4 + (b) * 2 + (h)) * HTB)
#define PG8_STAGE(bufoff, gbase, voff) do { _Pragma("unroll") for (int _i = 0; _i < 2; ++_i) \
        __builtin_amdgcn_global_load_lds((const unsigned*)((const char*)(gbase) + (voff)[_i]), (PG8_LAS unsigned*)(lds + (bufoff) + ldsw + _i * 8192), 16, 0, 0); } while (0)
#define PG8_Q_At Aq
#define PG8_Q_B0 Bq0
#define PG8_Q_B1 Bq1
#define PG8_LD8(p0_, p1_) __builtin_shufflevector(*(const PG8_LAS i32x4*)(p0_), *(const PG8_LAS i32x4*)(p1_), 0, 1, 2, 3, 4, 5, 6, 7)
#define PG8_LDA(dst, b, h) do { if constexpr (FP8) { _Pragma("unroll") for (int m = 0; m < 4; ++m) PG8_Q_##dst[m] = PG8_LD8(lds + PG8_SA(b, h) + aoq0 + m * 2048, lds + PG8_SA(b, h) + aoq1 + m * 2048); } \
        else { _Pragma("unroll") for (int m = 0; m < 4; ++m) _Pragma("unroll") for (int k = 0; k < 2; ++k) dst[m][k] = *(const PG8_LAS bf16x8*)(lds + PG8_SA(b, h) + aoff + m * 2048 + k * 1024); } } while (0)
#define PG8_TR(dst, addr, OFF) asm volatile("ds_read_b64_tr_b16 %0, %1 offset:%2" : "=&v"(dst) : "v"(addr), "i"(OFF) : "memory")
#define PG8_LDB(dst, b, h) do { if constexpr (BKN) { _Pragma("unroll") for (int n = 0; n < 2; ++n) { const int ad_ = bbase[n] + PG8_SB(b, h); s16x4 l0_, h0_, l1_, h1_; \
            PG8_TR(l0_, ad_, 0); PG8_TR(h0_, ad_, 1024); PG8_TR(l1_, ad_, 8192); PG8_TR(h1_, ad_, 9216); \
            dst[n][0] = (bf16x8){l0_[0], l0_[1], l0_[2], l0_[3], h0_[0], h0_[1], h0_[2], h0_[3]}; dst[n][1] = (bf16x8){l1_[0], l1_[1], l1_[2], l1_[3], h1_[0], h1_[1], h1_[2], h1_[3]}; } } \
        else if constexpr (FP8) { _Pragma("unroll") for (int n = 0; n < 2; ++n) PG8_Q_##dst[n] = PG8_LD8(lds + PG8_SB(b, h) + boq0 + n * 2048, lds + PG8_SB(b, h) + boq1 + n * 2048); } \
        else { _Pragma("unroll") for (int n = 0; n < 2; ++n) _Pragma("unroll") for (int k = 0; k < 2; ++k) dst[n][k] = *(const PG8_LAS bf16x8*)(lds + PG8_SB(b, h) + boff + n * 2048 + k * 1024); } } while (0)
#define PG8_MMA(ai, bj, At, Bt) do { __builtin_amdgcn_s_setprio(1); if constexpr (FP8) { _Pragma("unroll") for (int m = 0; m < 4; ++m) _Pragma("unroll") for (int n = 0; n < 2; ++n) \
            asm volatile("v_mfma_scale_f32_16x16x128_f8f6f4 %0, %1, %2, %0, %3, %3 op_sel_hi:[0,0,0]" : "+v"(acc[ai][bj][m][n]) : "v"(PG8_Q_##Bt[n]), "v"(PG8_Q_##At[m]), "v"(sc1_)); } \
        else { _Pragma("unroll") for (int m = 0; m < 4; ++m) _Pragma("unroll") for (int n = 0; n < 2; ++n) _Pragma("unroll") for (int k = 0; k < 2; ++k) \
            acc[ai][bj][m][n] = __builtin_amdgcn_mfma_f32_16x16x32_bf16(Bt[n][k], At[m][k], acc[ai][bj][m][n], 0, 0, 0); } __builtin_amdgcn_s_setprio(0); } while (0)
#define PG8_WAIT_V(n) asm volatile("s_waitcnt vmcnt(" #n ")" ::: "memory")
#define PG8_WAIT_L(n) asm volatile("s_waitcnt lgkmcnt(" #n ")" ::: "memory")
#define PG8_BAR __builtin_amdgcn_s_barrier()
#define PG8_SCHED __builtin_amdgcn_sched_barrier(0)
    Unit cur, nxt; int ui = 0;
    if (!S.next(0, cur)) return;
    f32x4 acc[2][2][4][2];
#pragma unroll
    for (int a = 0; a < 2; ++a)
#pragma unroll
        for (int b = 0; b < 2; ++b)
#pragma unroll
            for (int m = 0; m < 4; ++m)
#pragma unroll
                for (int n = 0; n < 2; ++n) acc[a][b][m][n] = (f32x4){0.f, 0.f, 0.f, 0.f};
    bf16x8 At[4][2], B0[2][2], B1[2][2];
    i32x8 Aq[4], Bq0[2], Bq1[2]; const int sc1_ = 0x7F7F7F7F;
    const char* cA = GATHER ? (const char*)g.A : (const char*)g.A + (size_t)cur.pm * tstep; const char* cB = BKN ? (const char*)g.Bt + (size_t)(cur.pb >> 3) * ((size_t)K * 4096) + (size_t)(cur.pb & 7) * 512 : (const char*)g.Bt + (size_t)cur.pb * tstep;
    const size_t hA = GATHER ? 0 : hstep;
    if constexpr (GATHER) { PG8_GOFF(vA0, vA1, 0); } else {
#pragma unroll
        for (int i = 0; i < 2; ++i) { vA0[i] = voffA[i]; vA1[i] = voffA[i]; vN0[i] = voffA[i]; vN1[i] = voffA[i]; } }
    S.a_ready(cur);
    PG8_STAGE(PG8_SB(0, 0), cB, voffB); PG8_STAGE(PG8_SB(0, 1), cB + hstepB, voffB); PG8_STAGE(PG8_SA(0, 0), cA, vA0); PG8_STAGE(PG8_SA(0, 1), cA + hA, vA1);
    if (wr == 1) PG8_BAR;
    PG8_WAIT_V(2); PG8_BAR;
    PG8_STAGE(PG8_SB(1, 0), cB + kstepB, voffB); PG8_STAGE(PG8_SA(1, 0), cA + kstep, vA0); PG8_STAGE(PG8_SB(1, 1), cB + hstepB + kstepB, voffB);
    PG8_WAIT_V(6); PG8_BAR;
    for (;;) {
        const bool has_next = S.next(ui + 1, nxt);
        const char* nA = GATHER ? cA : (has_next ? (const char*)g.A + (size_t)nxt.pm * tstep : cA); const char* nB = has_next ? (BKN ? (const char*)g.Bt + (size_t)(nxt.pb >> 3) * ((size_t)K * 4096) + (size_t)(nxt.pb & 7) * 512 : (const char*)g.Bt + (size_t)nxt.pb * tstep) : cB;
        if constexpr (GATHER) { if (has_next) { PG8_GOFF(vN0, vN1, ui + 1); } else {
#pragma unroll
            for (int i = 0; i < 2; ++i) { vN0[i] = vA0[i]; vN1[i] = vA1[i]; } } }
#pragma unroll 1
        for (int t = 0; t < nt; t += 2) {
            const bool last = (t == nt - 2);
            unsigned s0[2], s1[2];
#pragma unroll
            for (int i = 0; i < 2; ++i) { s0[i] = (GATHER && last) ? vN0[i] : vA0[i]; s1[i] = (GATHER && last) ? vN1[i] : vA1[i]; }
            const char* a1 = cA + (size_t)(t + 1) * kstep;
            const char* a2 = last ? nA : cA + (size_t)(t + 2) * kstep; const char* b2 = last ? nB : cB + (size_t)(t + 2) * kstepB;
            const char* a3 = a2 + kstep; const char* b3 = b2 + kstepB;
            if (last && has_next) S.a_ready(nxt);
            PG8_LDB(B0, 0, 0); PG8_LDB(B1, 0, 1); PG8_SCHED; PG8_LDA(At, 0, 0); PG8_STAGE(PG8_SA(1, 1), a1 + hA, vA1);
            PG8_WAIT_V(8); PG8_WAIT_L(0); PG8_BAR; PG8_SCHED; PG8_MMA(0, 0, At, B0); PG8_MMA(0, 1, At, B1); PG8_BAR; PG8_SCHED;
            PG8_LDA(At, 0, 1); PG8_STAGE(PG8_SB(0, 0), b2, voffB); PG8_STAGE(PG8_SB(0, 1), b2 + hstepB, voffB); PG8_STAGE(PG8_SA(0, 0), a2, s0);
            PG8_WAIT_V(8); PG8_WAIT_L(0); PG8_BAR; PG8_SCHED; PG8_MMA(1, 0, At, B0); PG8_MMA(1, 1, At, B1); PG8_BAR; PG8_SCHED;
            PG8_LDB(B0, 1, 0); PG8_LDB(B1, 1, 1); PG8_SCHED; PG8_LDA(At, 1, 0); PG8_STAGE(PG8_SA(0, 1), a2 + hA, s1);
            PG8_WAIT_V(8); PG8_WAIT_L(0); PG8_BAR; PG8_SCHED; PG8_MMA(0, 0, At, B0); PG8_MMA(0, 1, At, B1); PG8_BAR; PG8_SCHED;
            PG8_LDA(At, 1, 1); PG8_STAGE(PG8_SB(1, 0), b3, voffB); PG8_STAGE(PG8_SB(1, 1), b3 + hstepB, voffB); PG8_STAGE(PG8_SA(1, 0), a3, s0);
            PG8_WAIT_V(8); PG8_WAIT_L(0); PG8_BAR; PG8_SCHED; PG8_MMA(1, 0, At, B0); PG8_MMA(1, 1, At, B1); PG8_BAR; PG8_SCHED;
        }
        if constexpr (ALIGN_EPI) { if (wr == 0) PG8_BAR; }
        if constexpr (FP8) asm volatile("s_nop 15\n\ts_nop 15" ::: "memory");
        { int ln_ = lane; asm volatile("" : "+v"(ln_)); E(acc, cur, wr, wc, ln_ & 15, ln_ >> 4); } S.done(cur);
        if (!has_next) break;
#pragma unroll
        for (int a = 0; a < 2; ++a)
#pragma unroll
            for (int b = 0; b < 2; ++b)
#pragma unroll
                for (int m = 0; m < 4; ++m)
#pragma unroll
                    for (int n = 0; n < 2; ++n) acc[a][b][m][n] = (f32x4){0.f, 0.f, 0.f, 0.f};
        cur = nxt; cA = nA; cB = nB; ++ui;
#pragma unroll
        for (int i = 0; i < 2; ++i) { vA0[i] = vN0[i]; vA1[i] = vN1[i]; }
        if constexpr (ALIGN_EPI) { if (wr == 1) PG8_BAR; }
    }
    PG8_WAIT_V(0);
    if constexpr (!ALIGN_EPI) { if (wr == 0) PG8_BAR; }
    PG8_BAR;
#undef PG8_GOFF
#undef PG8_Q_At
#undef PG8_Q_B0
#undef PG8_Q_B1
#undef PG8_LD8
#undef PG8_TR
#undef PG8_SA
#undef PG8_SB
#undef PG8_STAGE
#undef PG8_LDA
#undef PG8_LDB
#undef PG8_MMA
#undef PG8_WAIT_V
#undef PG8_WAIT_L
#undef PG8_BAR
#undef PG8_SCHED
}
}

#define XB_TMO      128
#define XB_XCNT(j)  (256  + 64 * (j))
#define XB_XSUB(j)  (1280 + 64 * (j))
#define XB_XGEN(j)  (2304 + 64 * (j))
#define XB_TOP      3328
#define XB_TOPGEN   3392
#define XCD_BAR_WORDS 3456
#define XB_SPIN_CAP (1u << 18)
__device__ __forceinline__ unsigned xb_ld(unsigned* p)              { return __hip_atomic_load(p, __ATOMIC_RELAXED, __HIP_MEMORY_SCOPE_AGENT); }
__device__ __forceinline__ unsigned xb_add(unsigned* p, unsigned v) { return __hip_atomic_fetch_add(p, v, __ATOMIC_RELAXED, __HIP_MEMORY_SCOPE_AGENT); }
__device__ __forceinline__ unsigned xb_xcc_id() { return (unsigned)__builtin_amdgcn_s_getreg((3 << 11) | 20) & 0xFu; }
#define XB_SPIN(cond, bar) do { unsigned _sp = 0; while (cond) { __builtin_amdgcn_s_sleep(1); \
    if ((++_sp & 255u) == 0u) { if (xb_ld(&(bar)[XB_TMO])) break; if (_sp > XB_SPIN_CAP) { atomicAdd(&(bar)[XB_TMO], 1u); break; } } } } while (0)
struct XcdBarrier { unsigned* bar; unsigned x; volatile LAS unsigned* st; };
__device__ __forceinline__ XcdBarrier xcd_barrier_post(unsigned* bar, volatile LAS unsigned* st) {
    XcdBarrier b; b.bar = bar; b.x = xb_xcc_id(); b.st = st;
    if (threadIdx.x == 0) (void)xb_add(&bar[XB_XCNT(b.x)], 1u);
    return b;
}
__device__ __forceinline__ void xcd_barrier_complete(unsigned* bar, unsigned x, unsigned& nloc, unsigned& nx) {
    const unsigned G = gridDim.x * gridDim.y * gridDim.z;
    unsigned sum, cnt, mine, sp = 0u;
    for (;;) {
        sum = 0u; cnt = 0u; mine = 0u;
#pragma unroll
        for (unsigned j = 0; j < 16; ++j) { const unsigned c = xb_ld(&bar[XB_XCNT(j)]); sum += c; cnt += (c > 0u) ? 1u : 0u; mine = (j == x) ? c : mine; }
        if (sum == G) break;
        __builtin_amdgcn_s_sleep(1);
        if ((++sp & 255u) == 0u) { if (xb_ld(&bar[XB_TMO])) break; if (sp > XB_SPIN_CAP) { atomicAdd(&bar[XB_TMO], 1u); break; } }
    }
    nloc = mine > 0u ? mine : 1u; nx = cnt > 0u ? cnt : 1u;
}
__device__ __forceinline__ void xcd_barrier(const XcdBarrier& b) {
    asm volatile("s_waitcnt vmcnt(0)" ::: "memory");
    __syncthreads();
    if (threadIdx.x == 0) {
        unsigned* bar = b.bar;
        __builtin_amdgcn_s_waitcnt(0);
        unsigned nloc = b.st[0], nx = b.st[1];
        if (nloc == 0u) { xcd_barrier_complete(bar, b.x, nloc, nx); b.st[0] = nloc; b.st[1] = nx; }
        const unsigned old = xb_add(&bar[XB_XSUB(b.x)], 1u);
        const unsigned gen = old / nloc;
        if (old + 1u == (gen + 1u) * nloc) {
            __builtin_amdgcn_fence(__ATOMIC_RELEASE, "agent");
            asm volatile("s_waitcnt vmcnt(0)" ::: "memory");
            const unsigned og = xb_add(&bar[XB_TOP], 1u);
            const unsigned tg = og / nx;
            if (og + 1u == (tg + 1u) * nx) xb_add(&bar[XB_TOPGEN], 1u);
            else XB_SPIN(xb_ld(&bar[XB_TOPGEN]) == tg, bar);
            __builtin_amdgcn_fence(__ATOMIC_ACQUIRE, "agent");
            xb_add(&bar[XB_XGEN(b.x)], 1u);
            asm volatile("s_waitcnt vmcnt(0)" ::: "memory");
        } else {
            XB_SPIN(xb_ld(&bar[XB_XGEN(b.x)]) == gen, bar);
            __builtin_amdgcn_fence(__ATOMIC_ACQUIRE, "agent");
            asm volatile("s_waitcnt vmcnt(0)" ::: "memory");
        }
    }
    __syncthreads();
}

constexpr int NWAVES = 8;
struct Frame {
    LAS unsigned char* lds;
    unsigned* ctl;
    int tid, lane, wave, vcu, G;
    const float *x, *mem, *norm1_g, *w_in, *q_norm_g, *k_norm_g, *conv_w, *mem_norm_g, *w_mem_kv, *mem_q_norm_g, *mem_k_norm_g, *out_norm_g, *w_out, *norm2_g,
                *w_rg, *b_rg, *w_re, *b_re, *w_gate, *w_up, *w_down;
    float* out; unsigned char* ws;
};

__device__ __forceinline__ void p0_transpose_item(const float* W, int N, int k0, int n0, const float* ks, bf16* dst, int pitch, LAS float* scr, int lane) {
#pragma unroll 8
    for (int i = 0; i < 32; ++i) { const int kk = 2 * i + (lane >> 5); scr[kk * 33 + (lane & 31)] = __builtin_nontemporal_load(W + (size_t)(k0 + kk) * N + n0 + (lane & 31)); }
    const int c = lane & 7;
    float g[8];
#pragma unroll
    for (int j = 0; j < 8; ++j) g[j] = ks ? ks[k0 + 8 * c + j] : 1.0f;
    LDS_WAIT(); asm volatile("" ::: "memory");
#pragma unroll
    for (int j = 0; j < 4; ++j) { const int n = (lane >> 3) + 8 * j; const LAS float* s = scr + (8 * c) * 33 + n;
        v4u o; o.x = pk2(s[0 * 33] * g[0], s[1 * 33] * g[1]); o.y = pk2(s[2 * 33] * g[2], s[3 * 33] * g[3]); o.z = pk2(s[4 * 33] * g[4], s[5 * 33] * g[5]); o.w = pk2(s[6 * 33] * g[6], s[7 * 33] * g[7]);
        *(GAS v4u*)(dst + (size_t)n * pitch + k0 + 8 * c) = o; }
    LDS_WAIT(); asm volatile("" ::: "memory");
}
__device__ __forceinline__ void rms_row_to_bf16(const float* xrow, const float* gain, bf16* orow, int lane) {
    const GAS f32x4* xr = (const GAS f32x4*)xrow + lane; const GAS f32x4* gr = (const GAS f32x4*)gain + lane;
    f32x4 v[8]; float s = 0.f;
#pragma unroll
    for (int j = 0; j < 8; ++j) { v[j] = __builtin_nontemporal_load(xr + 64 * j); s += (v[j].x * v[j].x + v[j].y * v[j].y) + (v[j].z * v[j].z + v[j].w * v[j].w); }
    const float rstd = 1.0f / sqrtf(wave_sum(s) * (1.f / D) + EPS);
    GAS v2u* o8 = (GAS v2u*)orow + lane;
#pragma unroll
    for (int j = 0; j < 8; ++j) { const f32x4 gg = gr[64 * j]; v2u o; o.x = pk2(v[j].x * rstd * gg.x, v[j].y * rstd * gg.y); o.y = pk2(v[j].z * rstd * gg.z, v[j].w * rstd * gg.w); o8[64 * j] = o; }
}
__device__ __forceinline__ void p0_transpose_item_q(const float* W, int N, int k0, int n0, const float* ks, float sc, unsigned char* dst, int pitch, LAS float* scr, int lane) {
#pragma unroll 8
    for (int i = 0; i < 64; ++i) { const int kk = 2 * i + (lane >> 5); scr[kk * 33 + (lane & 31)] = __builtin_nontemporal_load(W + (size_t)(k0 + kk) * N + n0 + (lane & 31)); }
    const int c = lane & 15;
    float g[8];
#pragma unroll
    for (int j = 0; j < 8; ++j) g[j] = ks ? ks[k0 + 8 * c + j] * sc : sc;
    LDS_WAIT(); asm volatile("" ::: "memory");
#pragma unroll
    for (int j = 0; j < 8; ++j) { const int n = (lane >> 4) + 4 * j; const LAS float* s = scr + (8 * c) * 33 + n;
        v2u o; o.x = pk_fp8x4(s[0 * 33] * g[0], s[1 * 33] * g[1], s[2 * 33] * g[2], s[3 * 33] * g[3]); o.y = pk_fp8x4(s[4 * 33] * g[4], s[5 * 33] * g[5], s[6 * 33] * g[6], s[7 * 33] * g[7]);
        __builtin_nontemporal_store(o, (GAS v2u*)(dst + (size_t)n * pitch + k0 + 8 * c)); }
    LDS_WAIT(); asm volatile("" ::: "memory");
}
__device__ __forceinline__ void p0_item_q64(const float* W, int N, int k0, int n0, const float* ks, float sc, unsigned char* dst, int pitch, LAS unsigned char* scr, int lane) {
    const GAS float* src = (const GAS float*)(W + (size_t)k0 * N + n0 + lane);
    float g0 = sc, g1 = sc;
    if (ks) { g0 = ks[k0 + lane] * sc; g1 = ks[k0 + 64 + lane] * sc; }
#pragma unroll
    for (int h = 0; h < 2; ++h) {
        float v[64];
#pragma unroll
        for (int i = 0; i < 64; ++i) v[i] = __builtin_nontemporal_load(src + (size_t)(64 * h + i) * N);
        const float gh = h ? g1 : g0;
#pragma unroll
        for (int q = 0; q < 4; ++q) { v4u o;
#pragma unroll
            for (int d = 0; d < 4; ++d) { const int i = 16 * q + 4 * d;
                const float s0 = __builtin_bit_cast(float, __builtin_amdgcn_readlane(__builtin_bit_cast(int, gh), i)), s1 = __builtin_bit_cast(float, __builtin_amdgcn_readlane(__builtin_bit_cast(int, gh), i + 1));
                const float s2 = __builtin_bit_cast(float, __builtin_amdgcn_readlane(__builtin_bit_cast(int, gh), i + 2)), s3 = __builtin_bit_cast(float, __builtin_amdgcn_readlane(__builtin_bit_cast(int, gh), i + 3));
                o[d] = pk_fp8x4(v[i] * s0, v[i + 1] * s1, v[i + 2] * s2, v[i + 3] * s3); }
            *(LAS v4u*)(scr + lane * 144 + (4 * h + q) * 16) = o; }
    }
    LDS_WAIT(); asm volatile("" ::: "memory");
#pragma unroll
    for (int i = 0; i < 8; ++i) { const int row = 8 * i + (lane >> 3), ch = lane & 7;
        const v4u w = *(const LAS v4u*)(scr + row * 144 + ch * 16);
        __builtin_nontemporal_store(w, (GAS v4u*)(dst + (size_t)row * pitch + k0 + ch * 16)); }
    LDS_WAIT(); asm volatile("" ::: "memory");
}
__device__ __forceinline__ void p0_prologue(Frame& F) {
    LAS float* scr = (LAS float*)(F.lds + F.wave * 16896);
    const int gw = F.vcu * NWAVES + F.wave, NGW = F.G * NWAVES;
    bf16* Win_t = (bf16*)(F.ws + WS_WIN); bf16* Wmkv_t = (bf16*)(F.ws + WS_WMKV); bf16* Wout_t = (bf16*)(F.ws + WS_WOUT);
    constexpr int I_IN = 32 * 160, I_MKV = 32 * 32, I_OUT = 32 * 64;
    constexpr int NITEMS = I_IN + I_MKV + I_OUT;
    for (int it = gw; it < NITEMS; it += NGW) {
        int r = it;
        if (r < I_IN) { const int kb = r / 160, nb = r % 160; p0_transpose_item(F.w_in, PROJ, 64 * kb, 32 * nb, nullptr, Win_t + (size_t)(32 * nb) * D, D, scr, F.lane); continue; } r -= I_IN;
        if (r < I_MKV) { const int kb = r / 32, nb = r % 32; p0_transpose_item(F.w_mem_kv, 1024, 64 * kb, 32 * nb, nullptr, Wmkv_t + (size_t)(32 * nb) * D, D, scr, F.lane); continue; } r -= I_MKV;
        { const int kb = r / 64, nb = r % 64; p0_transpose_item(F.w_out, D, 64 * kb, 32 * nb, nullptr, Wout_t + (size_t)(32 * nb) * D, D, scr, F.lane); }
    }
    { unsigned char* Wgu_q = (unsigned char*)(F.ws + WS_WGU); unsigned char* Wd_q = (unsigned char*)(F.ws + WS_WD); LAS unsigned char* scq = F.lds + F.wave * 16896;
      constexpr int IPE = 256 + 256 + 256;
#pragma unroll 1
      for (int it = gw; it < 64 * IPE; it += NGW) { const int e = it / IPE; int r = it - e * IPE;
          if (r < 512) { const int up = r >> 8, q = r & 255, kb = q >> 4, nb = q & 15, n0 = 64 * nb;
              const float* W = (up ? F.w_up : F.w_gate) + (size_t)e * D * DEXP; const int drow = 256 * (n0 >> 7) + 128 * up + (n0 & 127);
              p0_item_q64(W, DEXP, 128 * kb, n0, F.norm2_g, SC_WGU, Wgu_q + ((size_t)e * 2048 + drow) * D, D, scq, F.lane); }
          else { const int q = r - 512, kb = q >> 5, nb = q & 31;
              p0_item_q64(F.w_down + (size_t)e * DEXP * D, D, 128 * kb, 64 * nb, nullptr, SC_WD, Wd_q + ((size_t)e * 2048 + 64 * nb) * DEXP, DEXP, scq, F.lane); } } }
    { bf16* WT = (bf16*)(F.ws + WS_WR); const int gt = (F.vcu * NWAVES + F.wave) * 64 + F.lane, NT = F.G * NWAVES * 64;
      for (int i = gt; i < 96 * 2048; i += NT) { const int n = i >> 11, k = i & 2047;
          float w = n < 64 ? F.w_re[k * 64 + n] : (n < 72 ? F.w_rg[k * 8 + (n - 64)] : 0.f); w *= F.norm2_g[k];
          const unsigned h = f2bf(w); const float hf = __builtin_bit_cast(float, h << 16);
          WT[i] = (bf16)h; WT[96 * 2048 + i] = (bf16)f2bf(w - hf); } }
    bf16* H = (bf16*)(F.ws + WS_H);
    for (int m = gw; m < T + 512; m += NGW) {
        if (m < T) rms_row_to_bf16(F.x + (size_t)m * D, F.norm1_g, H + (size_t)m * D, F.lane);
        else rms_row_to_bf16(F.mem + (size_t)(m - T) * D, F.mem_norm_g, H + (size_t)m * D, F.lane);
    }
}

namespace att {
constexpr int LDS_K = 0, LDS_V = 65536, LDS_STG = 131072, LDS_LI = LDS_STG + 16384, LDS_GT = LDS_LI + 8 * 256;
constexpr float CS = 0.08838834764831845f * LOG2E;
#define KSWZ(row, colB) ((row) * 256 + ((colB) ^ (((row) & 7) << 4)))
__device__ __forceinline__ int crow(int r, int hi) { return (r & 3) + 8 * (r >> 2) + 4 * hi; }
__device__ __forceinline__ int v_rd_base(int lane) { return ((lane & 3) << 3) | (((lane >> 2) & 3) << 6) | (((lane >> 4) & 1) << 5) | (((lane >> 5) & 1) << 8); }
template <int OFF> __device__ __forceinline__ s16x4 tr_read(int vb) { s16x4 r; asm volatile("ds_read_b64_tr_b16 %0, %1 offset:%2" : "=&v"(r) : "v"(vb), "i"(OFF) : "memory"); return r; }

struct RowMap { const char* base; long stride; int win0; bool wrap; };
__device__ __forceinline__ const char* rowptr(const RowMap& m, int p) { int sp = m.wrap ? m.win0 + ((p - m.win0) & 255) : p; sp = sp < 0 ? 0 : sp; return m.base + (long)sp * m.stride; }

__device__ __forceinline__ void dma_k(LAS unsigned char* Kl, int p0, int nrows, const RowMap& m, int wave, int lane) {
    asm volatile("" : "+v"(lane));
#pragma unroll 1
    for (int i = 0; i < nrows / 32; ++i) {
        const int prow0 = p0 + 32 * i + 4 * wave, prow = prow0 + (lane >> 4);
        const char* src = rowptr(m, prow) + (((lane & 15) ^ (prow & 7)) << 4);
        __builtin_amdgcn_global_load_lds((const unsigned*)src, (LAS unsigned*)(Kl + prow0 * 256), 16, 0, 0);
    }
}
__device__ __forceinline__ void dma_v(LAS unsigned char* Vl, int p0, int nrows, const RowMap& m, int wave, int lane) {
    asm volatile("" : "+v"(lane));
#pragma unroll 1
    for (int i = 0; i < nrows / 32; ++i) {
        const int ii = wave + 8 * i, g = (p0 >> 4) + (ii >> 2), q = ii & 3;
        const int kk = ((q >> 1) << 3) + ((lane & 31) >> 2), k = (kk & ~0xC) | ((kk & 4) << 1) | ((kk & 8) >> 1);
        const int c = 32 * (2 * (q & 1) + (lane >> 5)) + 8 * (lane & 3);
        const char* src = rowptr(m, 16 * g + k) + c * 2;
        __builtin_amdgcn_global_load_lds((const unsigned*)src, (LAS unsigned*)(Vl + g * 4096 + q * 1024), 16, 0, 0);
    }
}
__device__ __forceinline__ void dma_v2(LAS unsigned char* Vl, int p0, int nrows, const RowMap& m, int wave, int lane) {
    asm volatile("" : "+v"(lane));
#pragma unroll 1
    for (int i = 0; i < nrows / 32; ++i) {
        const int prow0 = p0 + 32 * i + 4 * wave, prow = prow0 + (lane >> 4);
        const char* src = rowptr(m, prow) + (((lane & 15) ^ ((prow & 7) << 1)) << 4);
        __builtin_amdgcn_global_load_lds((const unsigned*)src, (LAS unsigned*)(Vl + prow0 * 256), 16, 0, 0);
    }
}
__device__ __forceinline__ void load_q16(v4u (&raw)[4], const char* qrow, int kg) {
#pragma unroll
    for (int s = 0; s < 4; ++s) raw[s] = *(const GAS v4u*)(qrow + (32 * s + 8 * kg) * 2);
}
__device__ __forceinline__ void norm_q16(const v4u (&raw)[4], bf16x8 (&qr)[4], const LAS float* gt, int kg) {
    float ss = 0.f;
#pragma unroll
    for (int s = 0; s < 4; ++s)
#pragma unroll
        for (int j = 0; j < 4; ++j) { const float a = bflo(raw[s][j]), b = bfhi(raw[s][j]); ss += a * a + b * b; }
    ss += __shfl_xor(ss, 16); ss += __shfl_xor(ss, 32);
    const float rstd = 1.0f / sqrtf(ss * (1.f / HD) + EPS);
#pragma unroll
    for (int s = 0; s < 4; ++s) { const LAS f32x4* gp = (const LAS f32x4*)(gt + 32 * s + 8 * kg); const f32x4 g0 = gp[0], g1 = gp[1]; v4u o;
        o.x = cvtpk(bflo(raw[s].x) * rstd * g0.x, bfhi(raw[s].x) * rstd * g0.y); o.y = cvtpk(bflo(raw[s].y) * rstd * g0.z, bfhi(raw[s].y) * rstd * g0.w);
        o.z = cvtpk(bflo(raw[s].z) * rstd * g1.x, bfhi(raw[s].z) * rstd * g1.y); o.w = cvtpk(bflo(raw[s].w) * rstd * g1.z, bfhi(raw[s].w) * rstd * g1.w);
        qr[s] = __builtin_bit_cast(bf16x8, o); }
}
__device__ __forceinline__ void norm_k(LAS unsigned char* Kl, int p0, int nrows, const LAS float* gt, int tid) {
    asm volatile("" : "+v"(tid));
#pragma unroll 1
    for (int idx = tid; idx < nrows * 4; idx += 512) {
        const int row = p0 + (idx >> 2), qd = idx & 3;
        v4u w[4]; float ss = 0.f;
#pragma unroll
        for (int i = 0; i < 4; ++i) { w[i] = *(const LAS v4u*)(Kl + KSWZ(row, (4 * qd + i) * 16));
#pragma unroll
            for (int j = 0; j < 4; ++j) { const float a = bflo(w[i][j]), b = bfhi(w[i][j]); ss += a * a + b * b; } }
        ss += __shfl_xor(ss, 1); ss += __shfl_xor(ss, 2);
        const float rstd = 1.0f / sqrtf(ss * (1.f / HD) + EPS);
#pragma unroll
        for (int i = 0; i < 4; ++i) { const LAS f32x4* gp = (const LAS f32x4*)(gt + (4 * qd + i) * 8); const f32x4 g0 = gp[0], g1 = gp[1]; v4u o;
            o.x = cvtpk(bflo(w[i].x) * rstd * g0.x, bfhi(w[i].x) * rstd * g0.y); o.y = cvtpk(bflo(w[i].y) * rstd * g0.z, bfhi(w[i].y) * rstd * g0.w);
            o.z = cvtpk(bflo(w[i].z) * rstd * g1.x, bfhi(w[i].z) * rstd * g1.y); o.w = cvtpk(bflo(w[i].w) * rstd * g1.z, bfhi(w[i].w) * rstd * g1.w);
            *(LAS v4u*)(Kl + KSWZ(row, (4 * qd + i) * 16)) = o; }
    }
}
__device__ __forceinline__ float xsum32(float v) { unsigned a = __builtin_bit_cast(unsigned, v), b = a; asm volatile("s_nop 1\n\tv_permlane32_swap_b32 %0, %1" : "+v"(a), "+v"(b)); return __builtin_bit_cast(float, a) + __builtin_bit_cast(float, b); }
__device__ __forceinline__ void load_q(v4u (&raw)[8], const char* qrow, int hi) {
#pragma unroll
    for (int d0 = 0; d0 < 8; ++d0) raw[d0] = *(const GAS v4u*)(qrow + (d0 * 16 + hi * 8) * 2);
}
__device__ __forceinline__ void norm_q(const v4u (&raw)[8], bf16x8 (&qr)[8], const LAS float* gt, int hi) {
    float ss = 0.f;
#pragma unroll
    for (int d0 = 0; d0 < 8; ++d0)
#pragma unroll
        for (int j = 0; j < 4; ++j) { const float a = bflo(raw[d0][j]), b = bfhi(raw[d0][j]); ss += a * a + b * b; }
    ss = xsum32(ss);
    const float rstd = 1.0f / sqrtf(ss * (1.f / HD) + EPS);
#pragma unroll
    for (int d0 = 0; d0 < 8; ++d0) { const LAS f32x4* gp = (const LAS f32x4*)(gt + d0 * 16 + hi * 8); const f32x4 g0 = gp[0], g1 = gp[1]; v4u o;
        o.x = cvtpk(bflo(raw[d0].x) * rstd * g0.x, bfhi(raw[d0].x) * rstd * g0.y); o.y = cvtpk(bflo(raw[d0].y) * rstd * g0.z, bfhi(raw[d0].y) * rstd * g0.w);
        o.z = cvtpk(bflo(raw[d0].z) * rstd * g1.x, bfhi(raw[d0].z) * rstd * g1.y); o.w = cvtpk(bflo(raw[d0].w) * rstd * g1.z, bfhi(raw[d0].w) * rstd * g1.w);
        qr[d0] = __builtin_bit_cast(bf16x8, o); }
}
__device__ __forceinline__ f32x16 qk_tile(const LAS unsigned char* Kl, int pb, const bf16x8 (&qr)[8], int r32, int hi) {
    f32x16 p = {};
#pragma unroll
    for (int d0 = 0; d0 < 8; ++d0) { const bf16x8 kf = *(const LAS bf16x8*)(Kl + KSWZ(pb + r32, (d0 * 16 + hi * 8) * 2));
        p = __builtin_amdgcn_mfma_f32_32x32x16_bf16(kf, qr[d0], p, 0, 0, 0); }
    return p;
}
#define PK4(P, BASE, OUT) do { unsigned a0 = cvtpk(P[BASE + 0], P[BASE + 1]), a1 = cvtpk(P[BASE + 2], P[BASE + 3]);   \
    unsigned b0 = cvtpk(P[BASE + 4], P[BASE + 5]), b1 = cvtpk(P[BASE + 6], P[BASE + 7]);                              \
    auto r0 = __builtin_amdgcn_permlane32_swap(a0, b0, false, false); auto r1 = __builtin_amdgcn_permlane32_swap(a1, b1, false, false); \
    v4u w_ = {r0[0], r1[0], r0[1], r1[1]}; OUT = __builtin_bit_cast(bf16x8, w_); } while (0)
template <int OFF> __device__ __forceinline__ void pv_step(f32x16& o, int vb, bf16x8 pa) {
    const s16x4 l = tr_read<OFF>(vb), h = tr_read<OFF + 2048>(vb);
    asm volatile("s_waitcnt lgkmcnt(0)" ::: "memory"); __builtin_amdgcn_sched_barrier(0);
    o = __builtin_amdgcn_mfma_f32_32x32x16_bf16(pa, (bf16x8){l[0], l[1], l[2], l[3], h[0], h[1], h[2], h[3]}, o, 0, 0, 0);
}
__device__ __forceinline__ void store_block(const f32x16& o, const LAS float* il, LAS unsigned short* stg, char* dst0, long rstride, int lane) {
    asm volatile("" : "+v"(lane));
    const int r32 = lane & 31, hi = lane >> 5;
#pragma unroll
    for (int r = 0; r < 16; ++r) { const int row = crow(r, hi); stg[row * 32 + r32] = (unsigned short)f2bf(o[r] * il[row]); }
    LDS_WAIT(); asm volatile("" ::: "memory");
#pragma unroll
    for (int p = 0; p < 2; ++p) { const int row = 16 * p + (lane >> 2), ch = lane & 3;
        const v4u w = *(const LAS v4u*)((const LAS unsigned char*)stg + row * 64 + ch * 16);
        *(GAS v4u*)(dst0 + (long)row * rstride + ch * 16) = w; }
    LDS_WAIT(); asm volatile("" ::: "memory");
}
}

#define RAW_BAR() do { asm volatile("s_waitcnt lgkmcnt(0)" ::: "memory"); __builtin_amdgcn_s_barrier(); asm volatile("" ::: "memory"); } while (0)
__device__ __forceinline__ void p2_attention(Frame& F) {
    using namespace att;
    LAS unsigned char* Kl = F.lds + LDS_K; LAS unsigned char* Vl = F.lds + LDS_V;
    LAS unsigned short* stg = (LAS unsigned short*)(F.lds + LDS_STG + F.wave * 2048);
    LAS float* li = (LAS float*)(F.lds + LDS_LI + F.wave * 256);
    LAS float* gtab = (LAS float*)(F.lds + LDS_GT);
    LAS float* rk = (LAS float*)(F.lds + LDS_GT + 2048);
    volatile LAS int* QN = (volatile LAS int*)(F.lds + LDS_GT + 2048 + 1024);
    const int tid = F.tid, wave = F.wave;
    if (blockIdx.x < 8) {
        pg8::Gemm g{(const bf16*)(F.ws + WS_H), (const bf16*)(F.ws + WS_WIN), D, nullptr}; pg8::P1Order S{F.G, (int)blockIdx.x, 2560, 2568};
        pg8::EpiProj E{(bf16*)(F.ws + WS_R1), (bf16*)(F.ws + WS_MEMKV)};
        pg8::gemm_phase<pg8::EpiProj, pg8::P1Order>(F.lds, g, S, E);
        VM_WAIT(); __syncthreads();
        if (tid == 0) { __builtin_amdgcn_fence(__ATOMIC_RELEASE, "agent"); asm volatile("s_waitcnt vmcnt(0)" ::: "memory"); __hip_atomic_fetch_add(F.ctl + CW_KVREADY, 1u, RLX_AGENT); }
    }
    if (tid < 128) { gtab[tid] = F.q_norm_g[tid] * F.k_norm_g[tid]; gtab[128 + tid] = F.mem_q_norm_g[tid] * F.mem_k_norm_g[tid]; gtab[256 + tid] = F.mem_q_norm_g[tid]; gtab[384 + tid] = F.mem_k_norm_g[tid]; }
    if (tid == 0) QN[0] = 1 << 30;
    __syncthreads();
    float MD, MM;
    { float a = 0.f, c = 0.f;
#pragma unroll 1
      for (int i = 0; i < 128; ++i) { a = fmaxf(a, fabsf(gtab[i])); c = fmaxf(c, fabsf(gtab[128 + i])); }
      MD = a * (128.0f * 1.03f) * CS; MM = c * (128.0f * 1.03f) * CS; }
    const char* proj = (const char*)(F.ws + WS_R1);

    {
    const int j = wave & 3, dh = wave >> 2, w0 = 32 * j + 16 * dh;
    constexpr int NCHUNK = 6144 / 4;
    v4u qraw[4];
#define DECODE(u, br, b, h, r, nb, dil) const int br = (u) >> 11, _rem = (u) & 2047, b = _rem >> 10, h = (_rem >> 7) & 7, _w = _rem & 127, dil = 1 << (2 * br), _nps = 128 >> (2 * br), r = _w / _nps, nb = _w % _nps
    int u = 4 * F.vcu;
    bool have = F.vcu < NCHUNK;
    bool full = true;
    if (have) {
        DECODE(u, br, b, h, r, nb, dil);
        const long rs = (long)dil * PROJ * 2; const char* tb = proj + (size_t)(b * SEQ + r) * (PROJ * 2);
        RowMap mk{tb + (COL_K + h * HD) * 2, rs, 128 * nb - 128, true};
        dma_k(Kl, 0, 256, mk, wave, F.lane);
        load_q16(qraw, tb + (long)(128 * nb + w0 + (F.lane & 15)) * rs + (COL_Q + h * HD) * 2, F.lane >> 4);
    }
    while (have) {
        DECODE(u, br, b, h, r, nb, dil);
        int lane = F.lane; asm volatile("" : "+v"(lane));
        const int q16 = lane & 15, kg = lane >> 4;
        const int off = 128 * ((nb + 1) & 1);
        const long rs_ = (long)dil * PROJ * 2; const char* tb_ = proj + (size_t)(b * SEQ + r) * (PROJ * 2);
        asm volatile("s_waitcnt vmcnt(0)" ::: "memory"); RAW_BAR();
        { RowMap mv{tb_ + (COL_V + h * HD) * 2, rs_, 128 * nb - 128, true};
          if (full) dma_v2(Vl, 0, 256, mv, wave, lane); else dma_v2(Vl, 128 * (nb & 1), 128, mv, wave, lane); }
        if ((u & 3) == 0 && tid == 0) QN[0] = F.G + (int)__hip_atomic_fetch_add(F.ctl + CW_ATTQ, 1u, RLX_AGENT);
        { const int p0 = full ? 0 : 128 * (nb & 1), n4 = full ? 1024 : 512;
#pragma unroll 1
          for (int idx = tid; idx < n4; idx += 512) { const int row = p0 + (idx >> 2), qd = idx & 3; float ss = 0.f;
#pragma unroll
              for (int i = 0; i < 4; ++i) { const v4u w = *(const LAS v4u*)(Kl + KSWZ(row, (4 * qd + i) * 16));
#pragma unroll
                  for (int jj = 0; jj < 4; ++jj) { const float a = bflo(w[jj]), c = bfhi(w[jj]); ss += a * a + c * c; } }
              ss += __shfl_xor(ss, 1); ss += __shfl_xor(ss, 2);
              if (qd == 0) rk[row] = 1.0f / sqrtf(ss * (1.f / HD) + EPS); } }
        bf16x8 qr[4];
        norm_q16(qraw, qr, gtab, kg);
        f32x4 s[9];
#pragma unroll
        for (int t = 0; t < 9; ++t) { const int pb = (w0 + 16 * t + off) & 255; f32x4 a = {0.f, 0.f, 0.f, 0.f};
#pragma unroll
            for (int d = 0; d < 4; ++d) { const bf16x8 kf = *(const LAS bf16x8*)(Kl + KSWZ(pb + q16, 64 * d + 16 * kg));
                a = __builtin_amdgcn_mfma_f32_16x16x32_bf16(kf, qr[d], a, 0, 0, 0); }
            s[t] = a; }
        RAW_BAR();
        int un = u + 1; bool has_next = true;
        if ((un & 3) == 0) { const int nc = QN[0]; has_next = nc < NCHUNK; un = 4 * nc; }
        bool n_full = false;
        if (has_next) {
            DECODE(un, br2, b2, h2, r2, nb2, dil2);
            n_full = (un != u + 1) || (nb2 == 0);
            const long rs = (long)dil2 * PROJ * 2; const char* tb = proj + (size_t)(b2 * SEQ + r2) * (PROJ * 2);
            RowMap nmk{tb + (COL_K + h2 * HD) * 2, rs, 128 * nb2 - 128, true};
            if (n_full) dma_k(Kl, 0, 256, nmk, wave, lane); else dma_k(Kl, 128 * (nb2 & 1), 128, nmk, wave, lane);
            load_q16(qraw, tb + (long)(128 * nb2 + w0 + q16) * rs + (COL_Q + h2 * HD) * 2, kg);
        }
        const float bias2 = __builtin_amdgcn_exp2f(-(float)(h + 1)) * (float)dil * LOG2E;
        const float rowoff = bias2 * (float)(4 * kg - q16 - 128) - MD;
        float l = 0.f;
#pragma unroll
        for (int t = 0; t < 9; ++t) {
            const int pb = (w0 + 16 * t + off) & 255;
            const f32x4 rkv = *(const LAS f32x4*)(rk + pb + 4 * kg);
            const bool dead = (nb == 0) && (w0 + 16 * t < 128);
#pragma unroll
            for (int r_ = 0; r_ < 4; ++r_) {
                float v = fmaf(s[t][r_] * rkv[r_], CS, fmaf(bias2, (float)(16 * t + r_), rowoff));
                if (t == 0) v = (4 * kg + r_ >= q16) ? v : -1.0e30f;
                if (t == 8) v = (4 * kg + r_ <= q16) ? v : -1.0e30f;
                v = dead ? 0.f : __builtin_amdgcn_exp2f(v); s[t][r_] = v; l += v; }
        }
        l += __shfl_xor(l, 16); l += __shfl_xor(l, 32);
        bf16x8 pa[5];
#pragma unroll
        for (int sp = 0; sp < 5; ++sp) { v4u w; w.x = cvtpk(s[2 * sp][0], s[2 * sp][1]); w.y = cvtpk(s[2 * sp][2], s[2 * sp][3]);
            if (sp < 4) { w.z = cvtpk(s[2 * sp + 1][0], s[2 * sp + 1][1]); w.w = cvtpk(s[2 * sp + 1][2], s[2 * sp + 1][3]); } else { w.z = 0u; w.w = 0u; }
            pa[sp] = __builtin_bit_cast(bf16x8, w); }
        if (has_next) asm volatile("s_waitcnt vmcnt(8)" ::: "memory"); else asm volatile("s_waitcnt vmcnt(0)" ::: "memory");
        RAW_BAR();
        f32x4 o[8];
#pragma unroll
        for (int db = 0; db < 8; ++db) o[db] = (f32x4){0.f, 0.f, 0.f, 0.f};
        { const int qq = q16 >> 2, pp = q16 & 3;
#pragma unroll
          for (int sp = 0; sp < 5; ++sp) {
              const int ra = (w0 + 32 * sp + off + 4 * kg + qq) & 255, rb = (w0 + 32 * sp + 16 + off + 4 * kg + qq) & 255;
              const int va = (int)(uintptr_t)Vl + ra * 256 + 8 * pp, vb = (int)(uintptr_t)Vl + rb * 256 + 8 * pp, xa = (ra & 7) << 5, xb = (rb & 7) << 5;
#pragma unroll
              for (int dq = 0; dq < 2; ++dq) {
                  s16x4 la[4], lb[4];
#pragma unroll
                  for (int i = 0; i < 4; ++i) { const int db = 4 * dq + i;
                      asm volatile("ds_read_b64_tr_b16 %0, %1" : "=&v"(la[i]) : "v"(va + ((32 * db) ^ xa)) : "memory");
                      asm volatile("ds_read_b64_tr_b16 %0, %1" : "=&v"(lb[i]) : "v"(vb + ((32 * db) ^ xb)) : "memory"); }
                  asm volatile("s_waitcnt lgkmcnt(0)" ::: "memory"); __builtin_amdgcn_sched_barrier(0);
#pragma unroll
                  for (int i = 0; i < 4; ++i) { const int db = 4 * dq + i;
                      o[db] = __builtin_amdgcn_mfma_f32_16x16x32_bf16(pa[sp], (bf16x8){la[i][0], la[i][1], la[i][2], la[i][3], lb[i][0], lb[i][1], lb[i][2], lb[i][3]}, o[db], 0, 0, 0); }
              } } }
        const float il = 1.0f / l;
        if (kg == 0) li[q16] = il;
        LDS_WAIT(); asm volatile("" ::: "memory");
        const f32x4 ilr = *(const LAS f32x4*)(li + 4 * kg);
        const int tok0 = b * SEQ + r + dil * (128 * nb + w0);
        char* dst = (char*)(F.ws + WS_OPART) + ((size_t)br * T + tok0) * (ATTN_W * 2) + (h * HD) * 2;
#pragma unroll
        for (int hf = 0; hf < 2; ++hf) {
#pragma unroll
            for (int i = 0; i < 4; ++i)
#pragma unroll
                for (int r_ = 0; r_ < 4; ++r_) stg[(4 * kg + r_) * 64 + 16 * i + q16] = (unsigned short)f2bf(o[4 * hf + i][r_] * ilr[r_]);
            LDS_WAIT(); asm volatile("" ::: "memory");
#pragma unroll
            for (int p = 0; p < 2; ++p) { const int row = lane >> 2, ch = (lane & 3) + 4 * p;
                const v4u w = *(const LAS v4u*)((const LAS unsigned char*)stg + row * 128 + ch * 16);
                *(GAS v4u*)(dst + (long)row * ((long)dil * ATTN_W * 2) + hf * 128 + ch * 16) = w; }
            LDS_WAIT(); asm volatile("" ::: "memory");
        }
        if (kg == 0) ((float*)(F.ws + WS_LSE))[((size_t)br * T + tok0 + dil * q16) * 8 + h] = MD + __builtin_amdgcn_logf(l);
        have = has_next; u = un; full = n_full;
    }
#undef DECODE
    }

    VM_WAIT(); __syncthreads();
    if (wave == 0) { unsigned sp = 0;
        while (__builtin_amdgcn_readfirstlane(__hip_atomic_load(F.ctl + CW_KVREADY, RLX_AGENT)) < 8u) { __builtin_amdgcn_s_sleep(2); if (++sp > (1u << 22)) { if (F.lane == 0) __hip_atomic_store(F.ctl + CW_TMO, 1u, RLX_AGENT); break; } }
        __builtin_amdgcn_fence(__ATOMIC_ACQUIRE, "agent"); asm volatile("s_waitcnt vmcnt(0)" ::: "memory"); }
    __syncthreads();
    for (int it = F.vcu; it < 256; it += F.G) {
        const int combo = it >> 5, part = it & 31, b = combo >> 2, hm = combo & 3;
        const char* mkv = (const char*)(F.ws + WS_MEMKV) + (size_t)(b * NMEM) * 2048 + hm * 256;
        RowMap mk{mkv, 2048, 0, false}, mv{mkv + 1024, 2048, 0, false};
        __syncthreads();
        dma_k(Kl, 0, 256, mk, wave, F.lane); dma_v(Vl, 0, 256, mv, wave, F.lane);
        VM_WAIT(); __syncthreads();
        norm_k(Kl, 0, 256, gtab + 384, tid);
        __syncthreads();
        for (int qb = 0; qb < 2; ++qb) {
            int lane = F.lane; asm volatile("" : "+v"(lane));
            const int r32 = lane & 31, hi = lane >> 5, vbase = (int)(uintptr_t)Vl + v_rd_base(lane);
            const int tok = b * SEQ + part * 512 + qb * 256 + wave * 32 + r32;
            v4u raw[8]; bf16x8 qr[8];
            load_q(raw, proj + (size_t)tok * (PROJ * 2) + (COL_MQ + hm * HD) * 2, hi);
            norm_q(raw, qr, gtab + 256, hi);
            const float mc = -MM; float l = 0.f;
            f32x16 o[4] = {};
#pragma unroll 1
            for (int hk = 0; hk < 2; ++hk) {
                bf16x8 pa[8];
#pragma unroll
                for (int kt = 0; kt < 4; ++kt) { f32x16 s = qk_tile(Kl, 128 * hk + 32 * kt, qr, r32, hi);
#pragma unroll
                    for (int r = 0; r < 16; ++r) { s[r] = __builtin_amdgcn_exp2f(fmaf(s[r], CS, mc)); l += s[r]; }
                    PK4(s, 0, pa[2 * kt]); PK4(s, 8, pa[2 * kt + 1]); }
#pragma unroll
                for (int f = 0; f < 8; ++f) { const int vb = vbase + (8 * hk + f) * 4096;
                    pv_step<0>(o[0], vb, pa[f]); pv_step<512>(o[1], vb, pa[f]); pv_step<1024>(o[2], vb, pa[f]); pv_step<1536>(o[3], vb, pa[f]); }
            }
            l = xsum32(l);
            if (hi == 0) li[r32] = 1.0f / l;
            LDS_WAIT(); asm volatile("" ::: "memory");
            char* dst = (char*)(F.ws + WS_MEMO) + (size_t)(tok - r32) * (MEM_W * 2) + hm * 256;
#pragma unroll
            for (int d0 = 0; d0 < 4; ++d0) store_block(o[d0], li, stg, dst + d0 * 64, MEM_W * 2, lane);
        }
    }
}

__device__ __forceinline__ void unpack8(const v4u w, float (&f)[8]) { f[0] = bflo(w.x); f[1] = bfhi(w.x); f[2] = bflo(w.y); f[3] = bfhi(w.y); f[4] = bflo(w.z); f[5] = bfhi(w.z); f[6] = bflo(w.w); f[7] = bfhi(w.w); }
__device__ __forceinline__ void p3_combine(Frame& F) {
    const int gw = F.vcu * NWAVES + F.wave, NGW = F.G * NWAVES, lane = F.lane;
    const bf16* proj = (const bf16*)(F.ws + WS_R1); const bf16* opart = (const bf16*)(F.ws + WS_OPART); const float* lse = (const float*)(F.ws + WS_LSE);
    const bf16* memo = (const bf16*)(F.ws + WS_MEMO); bf16* Y = (bf16*)(F.ws + WS_Y);
    for (int t = gw; t < T; t += NGW) {
        float a[16]; float ssa = 0.f;
#pragma unroll
        for (int cc = 0; cc < 2; ++cc) { const int head = 4 * cc + (lane >> 4);
            const float l0 = lse[((size_t)0 * T + t) * 8 + head], l1 = lse[((size_t)1 * T + t) * 8 + head], l2 = lse[((size_t)2 * T + t) * 8 + head];
            const float mx = fmaxf(l0, fmaxf(l1, l2)); float w0 = __builtin_amdgcn_exp2f(l0 - mx), w1 = __builtin_amdgcn_exp2f(l1 - mx), w2 = __builtin_amdgcn_exp2f(l2 - mx);
            const float inv = 1.0f / (w0 + w1 + w2); w0 *= inv; w1 *= inv; w2 *= inv;
            float f0[8], f1[8], f2[8];
            unpack8(__builtin_nontemporal_load((const GAS v4u*)(opart + ((size_t)0 * T + t) * ATTN_W + cc * 512 + 8 * lane)), f0);
            unpack8(__builtin_nontemporal_load((const GAS v4u*)(opart + ((size_t)1 * T + t) * ATTN_W + cc * 512 + 8 * lane)), f1);
            unpack8(__builtin_nontemporal_load((const GAS v4u*)(opart + ((size_t)2 * T + t) * ATTN_W + cc * 512 + 8 * lane)), f2);
#pragma unroll
            for (int jj = 0; jj < 8; ++jj) { const float v = w0 * f0[jj] + w1 * f1[jj] + w2 * f2[jj]; a[8 * cc + jj] = v; ssa += v * v; } }
        float co[8]; float ssc = 0.f;
        { const int s = t & (SEQ - 1); float bg[8], c0[8], uu0[8], c1[8], uu1[8], c2[8], uu2[8];
          const bf16* p0 = proj + (size_t)t * PROJ + 8 * lane;
          unpack8(*(const GAS v4u*)(p0 + COL_B), bg); unpack8(*(const GAS v4u*)(p0 + COL_C), c0); unpack8(*(const GAS v4u*)(p0 + COL_U), uu0);
          if (s >= 1) { unpack8(*(const GAS v4u*)(p0 - PROJ + COL_C), c1); unpack8(*(const GAS v4u*)(p0 - PROJ + COL_U), uu1); }
          if (s >= 2) { unpack8(*(const GAS v4u*)(p0 - 2 * PROJ + COL_C), c2); unpack8(*(const GAS v4u*)(p0 - 2 * PROJ + COL_U), uu2); }
#pragma unroll
          for (int jj = 0; jj < 8; ++jj) { const int c = 8 * lane + jj;
              const float z0 = c0[jj] * uu0[jj], z1 = (s >= 1) ? c1[jj] * uu1[jj] : 0.f, z2 = (s >= 2) ? c2[jj] * uu2[jj] : 0.f;
              const float v = bg[jj] * (F.conv_w[c] * z2 + F.conv_w[CONV_W + c] * z1 + F.conv_w[2 * CONV_W + c] * z0); co[jj] = v; ssc += v * v; } }
        float mo[8]; float ssm = 0.f;
        unpack8(__builtin_nontemporal_load((const GAS v4u*)(memo + (size_t)t * MEM_W + 8 * lane)), mo);
#pragma unroll
        for (int jj = 0; jj < 8; ++jj) ssm += mo[jj] * mo[jj];
#pragma unroll
        for (int o = 1; o < 64; o <<= 1) { ssa += __shfl_xor(ssa, o); ssc += __shfl_xor(ssc, o); ssm += __shfl_xor(ssm, o); }
        const float ra = 1.0f / sqrtf(ssa * (1.f / ATTN_W) + EPS), rc = 1.0f / sqrtf(ssc * (1.f / CONV_W) + EPS), rm = 1.0f / sqrtf(ssm * (1.f / MEM_W) + EPS);
        bf16* yr = Y + (size_t)t * D;
#pragma unroll
        for (int cc = 0; cc < 2; ++cc) { const float* g = F.out_norm_g + cc * 512 + 8 * lane; v4u w;
            w.x = pk2(a[8 * cc + 0] * ra * g[0], a[8 * cc + 1] * ra * g[1]); w.y = pk2(a[8 * cc + 2] * ra * g[2], a[8 * cc + 3] * ra * g[3]);
            w.z = pk2(a[8 * cc + 4] * ra * g[4], a[8 * cc + 5] * ra * g[5]); w.w = pk2(a[8 * cc + 6] * ra * g[6], a[8 * cc + 7] * ra * g[7]);
            *(GAS v4u*)(yr + cc * 512 + 8 * lane) = w; }
        { const float* g = F.out_norm_g + ATTN_W + 8 * lane; v4u w;
          w.x = pk2(co[0] * rc * g[0], co[1] * rc * g[1]); w.y = pk2(co[2] * rc * g[2], co[3] * rc * g[3]); w.z = pk2(co[4] * rc * g[4], co[5] * rc * g[5]); w.w = pk2(co[6] * rc * g[6], co[7] * rc * g[7]);
          *(GAS v4u*)(yr + ATTN_W + 8 * lane) = w; }
        { const float* g = F.out_norm_g + ATTN_W + CONV_W + 8 * lane; v4u w;
          w.x = pk2(mo[0] * rm * g[0], mo[1] * rm * g[1]); w.y = pk2(mo[2] * rm * g[2], mo[3] * rm * g[3]); w.z = pk2(mo[4] * rm * g[4], mo[5] * rm * g[5]); w.w = pk2(mo[6] * rm * g[6], mo[7] * rm * g[7]);
          *(GAS v4u*)(yr + ATTN_W + CONV_W + 8 * lane) = w; }
    }
}

__device__ __forceinline__ float max8(float v) { v = fmaxf(v, __shfl_xor(v, 1)); v = fmaxf(v, __shfl_xor(v, 2)); v = fmaxf(v, __shfl_xor(v, 4)); return v; }
namespace rt {
constexpr int KC = 128, NCH = D / KC, BP = KC * 2 + 16, BUFB = 2 * 96 * BP;
__device__ __forceinline__ void issue_b(v4u (&bst)[6], const bf16* WT, int c, int tid) {
#pragma unroll
    for (int i = 0; i < 6; ++i) { const int p = tid + 512 * i, arr = p / 1536, rem = p - arr * 1536, n = rem >> 4, ch = rem & 15;
        bst[i] = *(const GAS v4u*)(WT + ((size_t)arr * 96 + n) * 2048 + c * KC + ch * 8); }
}
__device__ __forceinline__ void write_b(const v4u (&bst)[6], LAS unsigned char* buf, int tid) {
#pragma unroll
    for (int i = 0; i < 6; ++i) { const int p = tid + 512 * i, arr = p / 1536, rem = p - arr * 1536, n = rem >> 4, ch = rem & 15;
        *(LAS v4u*)(buf + arr * (96 * BP) + n * BP + ch * 16) = bst[i]; }
}
__device__ __forceinline__ void issue_a(f32x4 (&a)[4][2], const float* xrow, int c) {
#pragma unroll
    for (int ks = 0; ks < 4; ++ks) { a[ks][0] = *(const GAS f32x4*)(xrow + c * KC + ks * 32); a[ks][1] = *(const GAS f32x4*)(xrow + c * KC + ks * 32 + 4); }
}
__device__ __forceinline__ void compute(f32x4 (&acc)[6], float& ss, const f32x4 (&a)[4][2], const LAS unsigned char* buf, int fr, int kg) {
#pragma unroll
    for (int ks = 0; ks < 4; ++ks) {
        const f32x4 f0 = a[ks][0], f1 = a[ks][1];
        ss += (f0.x * f0.x + f0.y * f0.y) + (f0.z * f0.z + f0.w * f0.w) + (f1.x * f1.x + f1.y * f1.y) + (f1.z * f1.z + f1.w * f1.w);
        asm volatile("" : "+v"(ss));
        v4u h; h.x = cvtpk(f0.x, f0.y); h.y = cvtpk(f0.z, f0.w); h.z = cvtpk(f1.x, f1.y); h.w = cvtpk(f1.z, f1.w);
        v4u l; l.x = cvtpk(f0.x - bflo(h.x), f0.y - bfhi(h.x)); l.y = cvtpk(f0.z - bflo(h.y), f0.w - bfhi(h.y)); l.z = cvtpk(f1.x - bflo(h.z), f1.y - bfhi(h.z)); l.w = cvtpk(f1.z - bflo(h.w), f1.w - bfhi(h.w));
        const bf16x8 ah = __builtin_bit_cast(bf16x8, h), al = __builtin_bit_cast(bf16x8, l);
#pragma unroll
        for (int nb = 0; nb < 6; ++nb) { const LAS unsigned char* bp = buf + (nb * 16 + fr) * BP + (ks * 32 + 8 * kg) * 2;
            const bf16x8 bh = *(const LAS bf16x8*)bp, bl = *(const LAS bf16x8*)(bp + 96 * BP);
            acc[nb] = __builtin_amdgcn_mfma_f32_16x16x32_bf16(ah, bh, acc[nb], 0, 0, 0);
            acc[nb] = __builtin_amdgcn_mfma_f32_16x16x32_bf16(al, bh, acc[nb], 0, 0, 0);
            acc[nb] = __builtin_amdgcn_mfma_f32_16x16x32_bf16(ah, bl, acc[nb], 0, 0, 0); }
    }
}
}
__device__ __forceinline__ void p5_router(Frame& F) {
    using namespace rt;
    const int tid = F.tid, wave = F.wave;
    const float* X1 = F.out; const bf16* WT = (const bf16*)(F.ws + WS_WR);
    LAS unsigned char* Bl = F.lds;
    LAS float* Lg = (LAS float*)(F.lds + 2 * BUFB + wave * (16 * 97 * 4));
    unsigned* cnt = F.ctl + CW_CNT;
    int* tok_e = (int*)(F.ws + WS_TOK + TOK_E); int* tok_rank = (int*)(F.ws + WS_TOK + TOK_RANK);
    for (int mt = F.vcu; mt < T / 128; mt += F.G) {
        int lane = F.lane; asm volatile("" : "+v"(lane));
        const int fr = lane & 15, kg = lane >> 4;
        const int t0 = mt * 128 + wave * 16;
        const float* xrow = X1 + (size_t)(t0 + fr) * D + 8 * kg;
        f32x4 acc[6];
#pragma unroll
        for (int i = 0; i < 6; ++i) acc[i] = (f32x4){0.f, 0.f, 0.f, 0.f};
        float ss = 0.f;
        v4u bst[6]; f32x4 a0[4][2], a1[4][2];
        __syncthreads();
        issue_b(bst, WT, 0, tid); issue_a(a0, xrow, 0);
#pragma unroll 1
        for (int c = 0; c < NCH; c += 2) {
            write_b(bst, Bl, tid); __syncthreads();
            issue_b(bst, WT, c + 1, tid); issue_a(a1, xrow, c + 1);
            compute(acc, ss, a0, Bl, fr, kg);
            write_b(bst, Bl + BUFB, tid); __syncthreads();
            if (c + 2 < NCH) { issue_b(bst, WT, c + 2, tid); issue_a(a0, xrow, c + 2); }
            compute(acc, ss, a1, Bl + BUFB, fr, kg);
        }
        ss += __shfl_xor(ss, 16); ss += __shfl_xor(ss, 32);
        const float rs_row = 1.0f / sqrtf(ss * (1.f / D) + EPS);
#pragma unroll
        for (int r = 0; r < 4; ++r) { const float rr = __shfl(rs_row, 4 * kg + r);
#pragma unroll
            for (int nb = 0; nb < 6; ++nb) Lg[(4 * kg + r) * 97 + nb * 16 + fr] = acc[nb][r] * rr; }
        LDS_WAIT(); asm volatile("" ::: "memory");
        const float be = F.b_re[lane], bg = F.b_rg[lane & 7];
        int my_e1 = 0, my_e2 = 0; float my_g1 = 0.f, my_g2 = 0.f;
#pragma unroll 4
        for (int tk = 0; tk < 16; ++tk) {
            const float gl = Lg[tk * 97 + 64 + (lane & 7)] + bg;
            const float el = Lg[tk * 97 + lane] + be;
            const float gmax = max8(gl);
            const int gi = __builtin_ctzll(__ballot(gl == gmax) & 0xFFull);
            float gs = __builtin_amdgcn_exp2f((gl - gmax) * LOG2E); gs += __shfl_xor(gs, 1); gs += __shfl_xor(gs, 2); gs += __shfl_xor(gs, 4);
            const float gwt = 1.0f / gs;
            const float v1 = __shfl(max8(el), 8 * gi);
            const int i1 = __builtin_ctzll((__ballot(el == v1) >> (8 * gi)) & 0xFFull);
            const float el2 = (lane == 8 * gi + i1) ? -3.0e38f : el;
            const float v2 = __shfl(max8(el2), 8 * gi);
            const int i2 = __builtin_ctzll((__ballot(el2 == v2) >> (8 * gi)) & 0xFFull);
            const float pr = __builtin_amdgcn_exp2f((v2 - v1) * LOG2E), den = 1.0f / (1.0f + pr);
            if (lane == tk) { my_e1 = 8 * gi + i1; my_e2 = 8 * gi + i2; my_g1 = gwt * den; my_g2 = gwt * pr * den; }
        }
        LAS unsigned* hist = (LAS unsigned*)(F.lds + MISC_OFF + 256);
        if (tid < 64) hist[tid] = 0u;
        __syncthreads();
        unsigned lr1 = 0u, lr2 = 0u;
        if (lane < 16) { lr1 = __hip_atomic_fetch_add(hist + my_e1, 1u, __ATOMIC_RELAXED, __HIP_MEMORY_SCOPE_WORKGROUP); lr2 = __hip_atomic_fetch_add(hist + my_e2, 1u, __ATOMIC_RELAXED, __HIP_MEMORY_SCOPE_WORKGROUP); }
        __syncthreads();
        if (tid < 64) { const unsigned c = hist[tid]; hist[64 + tid] = c ? __hip_atomic_fetch_add(cnt + 64 * tid, c, RLX_AGENT) : 0u; }
        __syncthreads();
        if (lane < 16) {
            const int t = t0 + lane;
            const int k1 = (int)(hist[64 + my_e1] + lr1), k2 = (int)(hist[64 + my_e2] + lr2);
            tok_e[2 * t] = my_e1; tok_e[2 * t + 1] = my_e2; tok_rank[2 * t] = k1; tok_rank[2 * t + 1] = k2;
            int* ltok = (int*)(F.ws + WS_LIST + LIST_TOK); float* lrs = (float*)(F.ws + WS_LIST + LIST_RSTD); float* lgt = (float*)(F.ws + WS_LIST + LIST_GATE);
            ltok[my_e1 * CAP + k1] = t; ltok[my_e2 * CAP + k2] = t; lrs[my_e1 * CAP + k1] = rs_row; lrs[my_e2 * CAP + k2] = rs_row; lgt[my_e1 * CAP + k1] = my_g1; lgt[my_e2 * CAP + k2] = my_g2;
        }
    }
}

constexpr int MOE_MT = MISC_OFF + 48, MOE_PST = MISC_OFF + 64, MOE_TE = MOE_PST + 256;
constexpr int MOE_TB = LDS_EXTRA, MOE_VR = MOE_TB + MAXTILES * 4, MOE_UT = MOE_VR + MAXTILES * 4;
constexpr int MOE_MAXU = 12;
static_assert(MOE_UT + MOE_MAXU * 256 * 4 <= MISC_OFF && MOE_TE + MAXTILES * 4 <= LDS_BYTES, "LDS map");
__device__ __forceinline__ int moe_tables(Frame& F) {
    LAS int* PST = (LAS int*)(F.lds + MOE_PST); LAS int* TE = (LAS int*)(F.lds + MOE_TE); LAS int* MTp = (LAS int*)(F.lds + MOE_MT); LAS int* TB = (LAS int*)(F.lds + MOE_TB); LAS int* VR = (LAS int*)(F.lds + MOE_VR);
    __syncthreads();
    if (F.tid < 64) {
        const int c = (int)__hip_atomic_load(F.ctl + CW_CNT + 64 * F.tid, RLX_AGENT); const int nt = (c + 255) >> 8;
        int x = nt;
#pragma unroll
        for (int o = 1; o < 64; o <<= 1) { const int y = __shfl_up(x, o); if (F.lane >= o) x += y; }
        const int ex = x - nt; PST[F.tid] = ex; if (F.tid == 63) MTp[0] = x;
        for (int i = 0; i < nt; ++i) { TE[ex + i] = F.tid; TB[ex + i] = F.tid * CAP + 256 * i; VR[ex + i] = (c - 256 * i) < 256 ? (c - 256 * i) : 256; }
    }
    __syncthreads();
    return MTp[0];
}

__device__ __forceinline__ void p9_final(Frame& F) {
    (void)moe_tables(F);
    const LAS int* PST = (const LAS int*)(F.lds + MOE_PST);
    const int gw = F.vcu * NWAVES + F.wave, NGW = F.G * NWAVES, lane = F.lane;
    const int* tok_e = (const int*)(F.ws + WS_TOK + TOK_E); const int* tok_rank = (const int*)(F.ws + WS_TOK + TOK_RANK); const bf16* YB = (const bf16*)(F.ws + WS_R1);
    for (int t = gw; t < T; t += NGW) {
        const int s1 = PST[tok_e[2 * t]] * 256 + tok_rank[2 * t], s2 = PST[tok_e[2 * t + 1]] * 256 + tok_rank[2 * t + 1];
        const GAS v4u* y1 = (const GAS v4u*)(YB + (size_t)s1 * D) + lane; const GAS v4u* y2 = (const GAS v4u*)(YB + (size_t)s2 * D) + lane;
        GAS f32x4* o = (GAS f32x4*)(F.out + (size_t)t * D) + 2 * lane;
#pragma unroll
        for (int i = 0; i < 4; ++i) { float a[8], b[8]; unpack8(__builtin_nontemporal_load(y1 + 64 * i), a); unpack8(__builtin_nontemporal_load(y2 + 64 * i), b);
            f32x4 v0 = __builtin_nontemporal_load(o + 128 * i), v1 = __builtin_nontemporal_load(o + 128 * i + 1);
            v0.x += a[0] + b[0]; v0.y += a[1] + b[1]; v0.z += a[2] + b[2]; v0.w += a[3] + b[3]; v1.x += a[4] + b[4]; v1.y += a[5] + b[5]; v1.z += a[6] + b[6]; v1.w += a[7] + b[7];
            __builtin_nontemporal_store(v0, o + 128 * i); __builtin_nontemporal_store(v1, o + 128 * i + 1); }
    }
}

constexpr int PER_PHASE = 10;
constexpr int N_LAUNCHES = MK_N_LAUNCHES;
struct Args { const float* in[21]; float* out; unsigned char* ws; int ph_lo, ph_hi, li, pad; };
__global__ void __launch_bounds__(NWAVES * 64, 2) hymba_fwd(Args args) {
    extern __shared__ __attribute__((aligned(16))) unsigned char lds[];
    Frame F;
    F.lds = (LAS unsigned char*)lds;
    F.tid = threadIdx.x; F.lane = F.tid & 63; F.wave = __builtin_amdgcn_readfirstlane(F.tid >> 6);
    F.G = gridDim.x; { const int bx = blockIdx.x; F.vcu = (F.G % 8 == 0) ? (bx % 8) * (F.G / 8) + bx / 8 : bx; }
    F.ws = args.ws; F.ctl = (unsigned*)(args.ws + WS_CTL); F.out = args.out;
    F.x = args.in[0]; F.mem = args.in[1]; F.norm1_g = args.in[2]; F.w_in = args.in[3]; F.q_norm_g = args.in[4]; F.k_norm_g = args.in[5]; F.conv_w = args.in[6];
    F.mem_norm_g = args.in[7]; F.w_mem_kv = args.in[8]; F.mem_q_norm_g = args.in[9]; F.mem_k_norm_g = args.in[10]; F.out_norm_g = args.in[11]; F.w_out = args.in[12];
    F.norm2_g = args.in[13]; F.w_rg = args.in[14]; F.b_rg = args.in[15]; F.w_re = args.in[16]; F.b_re = args.in[17]; F.w_gate = args.in[18]; F.w_up = args.in[19]; F.w_down = args.in[20];
    volatile LAS unsigned* MISC = (volatile LAS unsigned*)(F.lds + MISC_OFF);
    if (F.tid < 16) MISC[F.tid] = 0u;
    __syncthreads();
    const int lo = args.ph_lo, hi = args.ph_hi;
    const bool multi = (hi - lo) > 1;
    XcdBarrier bar; bar.bar = F.ctl + CW_BAR + args.li * XCD_BAR_WORDS; bar.x = 0; bar.st = nullptr;
    if (multi) bar = xcd_barrier_post(F.ctl + CW_BAR + args.li * XCD_BAR_WORDS, MISC + 8);
#define GRID_BAR() do { if (multi) xcd_barrier(bar); } while (0)
#define IN(k) (lo <= (k) && (k) < hi)
#define BOTH(k) (IN(k) && IN((k) + 1))
    if (IN(0)) { p0_prologue(F); if (BOTH(0)) GRID_BAR(); }
    if (IN(1)) {
        pg8::Gemm g{(const bf16*)(F.ws + WS_H), (const bf16*)(F.ws + WS_WIN), D, nullptr}; pg8::P1Order S{F.G, (int)blockIdx.x, 0, 2560};
        pg8::EpiProj E{(bf16*)(F.ws + WS_R1), (bf16*)(F.ws + WS_MEMKV)};
        pg8::gemm_phase<pg8::EpiProj, pg8::P1Order>(F.lds, g, S, E);
        if (BOTH(1)) GRID_BAR();
    }
    if (IN(2)) { p2_attention(F); if (BOTH(2)) GRID_BAR(); }
    if (IN(3)) { p3_combine(F); if (BOTH(3)) GRID_BAR(); }
    if (IN(4)) {
        pg8::Gemm g{(const bf16*)(F.ws + WS_Y), (const bf16*)(F.ws + WS_WOUT), D, nullptr}; pg8::StaticOrder S{T / 256, D / 256, F.G, (int)blockIdx.x};
        pg8::EpiResid E{F.x, F.out, (bf16*)(F.ws + WS_H)};
        pg8::gemm_phase<pg8::EpiResid, pg8::StaticOrder, false>(F.lds, g, S, E);
        if (BOTH(4)) GRID_BAR();
    }
    if (IN(5)) { p5_router(F); if (BOTH(5)) GRID_BAR(); }
    if (IN(7)) {
        const int MT = moe_tables(F);
        pg8::MoeOrder S{MT, F.G, (int)blockIdx.x, (const LAS int*)(F.lds + MOE_TE)};
        { const LAS int* TB = (const LAS int*)(F.lds + MOE_TB); const LAS int* VR = (const LAS int*)(F.lds + MOE_VR); LAS int* UT = (LAS int*)(F.lds + MOE_UT);
          const int* ltok = (const int*)(F.ws + WS_LIST + LIST_TOK);
          for (int i = 0; i < MOE_MAXU; ++i) { pg8::Unit u; if (!S.next(i, u)) break;
              if (F.tid < 256) UT[i * 256 + F.tid] = (F.tid < VR[u.pm]) ? ltok[TB[u.pm] + F.tid] : 0; }
          __syncthreads(); }
        pg8::Gemm g{(const bf16*)(F.ws + WS_H), (const bf16*)(F.ws + WS_WGU), D, (const LAS int*)(F.lds + MOE_UT)};
        pg8::EpiSwiGLU E{(bf16*)(F.ws + WS_OPART), (const float*)(F.ws + WS_LIST + LIST_RSTD), (const LAS int*)(F.lds + MOE_TB)};
        pg8::gemm_phase<pg8::EpiSwiGLU, pg8::MoeOrder, true, true, false, true>(F.lds, g, S, E);
        if (BOTH(7)) GRID_BAR();
    }
    if (IN(8)) {
        const int MT = moe_tables(F);
        pg8::Gemm g{(const bf16*)(F.ws + WS_OPART), (const bf16*)(F.ws + WS_WD), DEXP, nullptr}; pg8::MoeOrder S{MT, F.G, (int)blockIdx.x, (const LAS int*)(F.lds + MOE_TE)};
        pg8::EpiDown E{(bf16*)(F.ws + WS_R1), (const float*)(F.ws + WS_LIST + LIST_GATE), (const LAS int*)(F.lds + MOE_TB)};
        pg8::gemm_phase<pg8::EpiDown, pg8::MoeOrder, true, false, false, true>(F.lds, g, S, E);
        if (BOTH(8)) GRID_BAR();
    }
    if (IN(9)) { p9_final(F); }
#undef IN
#undef BOTH
#undef GRID_BAR
}

extern "C" void kernel_launch(void* const* d_in, const int* in_sizes, int n_in, void* d_out, int out_size, void* d_ws, size_t ws_size, hipStream_t stream) {
    static int grid = 0;
    if (grid == 0) {
        if (n_in != 21 || in_sizes[0] != T * D || out_size != T * D || ws_size < WS_END) { fprintf(stderr, "kernel_launch: shape/workspace mismatch (n_in %d, ws %zu < %zu); nothing launched\n", n_in, ws_size, (size_t)WS_END); grid = -1; return; }
        int dev = 0, cus = 0, per_cu = 0;
        if (hipGetDevice(&dev) != hipSuccess || hipDeviceGetAttribute(&cus, hipDeviceAttributeMultiprocessorCount, dev) != hipSuccess) { grid = -1; return; }
        if (hipFuncSetAttribute((const void*)hymba_fwd, hipFuncAttributeMaxDynamicSharedMemorySize, LDS_BYTES) != hipSuccess) { fprintf(stderr, "kernel_launch: hipFuncSetAttribute failed\n"); grid = -1; return; }
        if (hipOccupancyMaxActiveBlocksPerMultiprocessor(&per_cu, (const void*)hymba_fwd, NWAVES * 64, LDS_BYTES) != hipSuccess || per_cu < 1) { fprintf(stderr, "kernel_launch: occupancy query reports %d\n", per_cu); }
        (void)hipGetLastError();
        grid = cus;
    }
    if (grid < 0) return;
    if (hipMemsetAsync((char*)d_ws + WS_CTL, 0, CTL_ZERO_BYTES, stream) != hipSuccess) { fprintf(stderr, "kernel_launch: memset failed\n"); return; }
    Args a{};
    for (int i = 0; i < 21; ++i) a.in[i] = (const float*)d_in[i];
    a.out = (float*)d_out; a.ws = (unsigned char*)d_ws;
    int los[4], his[4], nl = 0;
#if defined(PROBE_REPEAT)
    los[nl] = 0; his[nl] = PROBE_REPEAT + 1; ++nl; los[nl] = PROBE_REPEAT; his[nl] = PROBE_REPEAT + 1; ++nl; if (PROBE_REPEAT + 1 < PER_PHASE) { los[nl] = PROBE_REPEAT + 1; his[nl] = PER_PHASE; ++nl; }
#else
    los[nl] = 0; his[nl] = PER_PHASE; ++nl;
#endif
    for (int li = 0; li < nl; ++li) {
        a.ph_lo = los[li]; a.ph_hi = his[li]; a.li = li;
#if defined(PROBE_REPEAT)
        if (li == 1) { (void)hipMemsetAsync((char*)d_ws + WS_CTL + CW_ATTQ * 4, 0, 64, stream); if (PROBE_REPEAT == 5) (void)hipMemsetAsync((char*)d_ws + WS_CTL + CW_CNT * 4, 0, 64 * 256, stream); }
#endif
        hipLaunchKernelGGL(hymba_fwd, dim3(grid), dim3(NWAVES * 64), LDS_BYTES, stream, a);
        const hipError_t le = hipPeekAtLastError();
        if (le != hipSuccess) { fprintf(stderr, "kernel_launch: launch %d failed: %s\n", li, hipGetErrorName(le)); break; }
    }
}
```

```cpp
#include <hip/hip_runtime.h>
#include <cstdio>
#include <cstdint>

#ifndef MK_N_LAUNCHES
#define MK_N_LAUNCHES 1
#endif

#define GAS __attribute__((address_space(1)))
#define LAS __attribute__((address_space(3)))
typedef unsigned short bf16;
typedef unsigned v4u __attribute__((ext_vector_type(4)));
typedef unsigned v2u __attribute__((ext_vector_type(2)));
typedef float f32x4 __attribute__((ext_vector_type(4)));
typedef float f32x16 __attribute__((ext_vector_type(16)));
typedef short bf16x8 __attribute__((ext_vector_type(8)));
typedef short s16x4 __attribute__((ext_vector_type(4)));
#define LDS_WAIT() asm volatile("s_waitcnt lgkmcnt(0)" ::: "memory")
#define VM_WAIT() asm volatile("s_waitcnt vmcnt(0)" ::: "memory")
#define RLX_AGENT __ATOMIC_RELAXED, __HIP_MEMORY_SCOPE_AGENT

constexpr int BATCH = 2, SEQ = 16384, T = BATCH * SEQ, D = 2048, PROJ = 5120;
constexpr int NH = 8, HD = 128, ATTN_W = 1024, CONV_W = 512, MEM_W = 512, NMEM = 256, NMH = 4;
constexpr int COL_Q = 0, COL_K = 1024, COL_V = 2048, COL_B = 3072, COL_C = 3584, COL_U = 4096, COL_MQ = 4608;
constexpr int NEXP = 64, DEXP = 1024;
constexpr int RMAX = 81920;
constexpr int MAXTILES = RMAX / 256;
constexpr float EPS = 1e-6f;
constexpr float LOG2E = 1.4426950408889634f;

constexpr size_t MiB = 1u << 20;
constexpr size_t WS_CTL = 0, CTL_ZERO_BYTES = 1 * MiB;
constexpr size_t WS_WIN = 1 * MiB;
constexpr size_t WS_WMKV = WS_WIN + (size_t)PROJ * D * 2;
constexpr size_t WS_WOUT = 25 * MiB;
constexpr size_t WS_WR = 33 * MiB;
constexpr size_t WS_WGU = 34 * MiB;
constexpr size_t WS_WD = WS_WGU + 512 * MiB;
constexpr size_t WS_H = WS_WD + 256 * MiB;
constexpr size_t WS_MEMKV = WS_H + 130 * MiB;
constexpr size_t WS_R1 = WS_MEMKV + 1 * MiB;
constexpr size_t WS_OPART = WS_R1 + 320 * MiB;
constexpr size_t WS_LSE = WS_OPART + 192 * MiB;
constexpr size_t WS_MEMO = WS_LSE + 3 * MiB;
constexpr size_t WS_Y = WS_MEMO + 32 * MiB;
constexpr size_t WS_TOK = WS_Y + 128 * MiB;
constexpr size_t WS_LIST = WS_TOK + 4 * MiB;
constexpr size_t WS_END = WS_LIST + 24 * MiB;
constexpr int CAP = T;
constexpr size_t LIST_TOK = 0, LIST_RSTD = 8 * MiB, LIST_GATE = 16 * MiB;
constexpr size_t TOK_E = 0, TOK_RANK = 256 * 1024, TOK_GATE = 512 * 1024, TOK_RSTD = 768 * 1024, TOK_SLOT = 1024 * 1024, SLOT_RSTD = 1536 * 1024, SLOT_GATE = 2048 * 1024;
static_assert(WS_WMKV + 1024 * (size_t)D * 2 <= WS_WOUT && WS_WOUT + 8 * MiB <= WS_WR && WS_WR + 2048 * 72 * 4 <= WS_WGU, "ws map");
static_assert((size_t)(T + 512) * D * 2 <= 130 * MiB && (size_t)RMAX * D * 2 <= 320 * MiB && (size_t)RMAX * DEXP * 2 <= 192 * MiB && SLOT_GATE + RMAX * 4 <= 4 * MiB, "ws map");

constexpr int CW_TMO = 0, CW_CODE = 1;
constexpr int CW_CNT = 8192;
constexpr int CW_BAR = 16384;
constexpr int CW_KVREADY = 512, CW_ATTQ = 576;

constexpr int RING_BYTES = 131072;
constexpr int LDS_EXTRA = RING_BYTES;
constexpr int MISC_OFF = 163840 - 2048;
constexpr int LDS_BYTES = 163840;

__device__ __forceinline__ unsigned f2bf(float f) { unsigned u = __builtin_bit_cast(unsigned, f); return (u + 0x7fffu + ((u >> 16) & 1u)) >> 16; }
__device__ __forceinline__ unsigned pk2(float lo, float hi) { return f2bf(lo) | (f2bf(hi) << 16); }
__device__ __forceinline__ unsigned cvtpk(float lo, float hi) { unsigned r; asm volatile("v_cvt_pk_bf16_f32 %0, %1, %2" : "=v"(r) : "v"(lo), "v"(hi)); return r; }
__device__ __forceinline__ unsigned pk_fp8x4(float a, float b, float c, float d) { unsigned w = 0u; w = __builtin_amdgcn_cvt_pk_fp8_f32(a, b, w, false); w = __builtin_amdgcn_cvt_pk_fp8_f32(c, d, w, true); return w; }
constexpr float SC_WGU = 128.0f, SC_ACT = 4.0f, SC_WD = 64.0f;
__device__ __forceinline__ float bflo(unsigned w) { return __builtin_bit_cast(float, w << 16); }
__device__ __forceinline__ float bfhi(unsigned w) { return __builtin_bit_cast(float, w & 0xffff0000u); }
__device__ __forceinline__ float wave_sum(float v) {
#pragma unroll
    for (int o = 1; o < 64; o <<= 1) v += __shfl_xor(v, o);
    return v;
}

namespace pg8 {
#define PG8_LAS __attribute__((address_space(3)))
typedef unsigned short bf16_t;
typedef unsigned u32x4 __attribute__((ext_vector_type(4)));
typedef int i32x4 __attribute__((ext_vector_type(4)));
typedef int i32x8 __attribute__((ext_vector_type(8)));
constexpr int BM = 256, BK = 64, HALF = 128, HTB = HALF * BK * 2, STAGE_BYTES = 8 * HTB, NXCD = 8, WGM = 8;
__host__ __device__ __forceinline__ int lds_byte(int r, int c) { const int st = (r >> 4) * 2 + (c >> 5), rr = r & 15, cc = c & 31, ob = rr * 64 + cc * 2; return st * 1024 + (ob ^ (((ob >> 9) & 1) << 5)); }
__host__ __device__ __forceinline__ void stage_rc(int b, int& R, int& C) { const int st = b / 1024, sb = b % 1024, swz = sb ^ (((sb >> 9) & 1) << 5); R = (st >> 1) * 16 + swz / 64; C = (st & 1) * 32 + (swz % 64) / 2; }
__host__ __device__ __forceinline__ int perm32(int rho) { const int n = rho >> 4, i = rho & 15; return 8 * (i >> 2) + 4 * n + (i & 3); }

struct Unit { int pm, pn, pb; };
struct Gemm { const bf16_t* A; const bf16_t* Bt; int K; const PG8_LAS int* ut; };

__device__ __forceinline__ void tile_of(int L, int nM, int nN, int& pm, int& pn) {
    const int nwg = nM * nN;
    int wgid = L; { const int q = nwg / NXCD, r = nwg % NXCD, xcd = wgid % NXCD, off = wgid / NXCD; wgid = (xcd < r ? xcd * (q + 1) : r * (q + 1) + (xcd - r) * q) + off; }
    const int nig = WGM * nN, gid = wgid / nig, fm = gid * WGM, gsz = (nM - fm) < WGM ? (nM - fm) : WGM;
    pm = fm + ((wgid % nig) % gsz); pn = (wgid % nig) / gsz;
}
struct StaticOrder {
    int nM, nN, G, c;
    __device__ __forceinline__ bool next(int i, Unit& u) const { const long L = (long)i * G + c; if (L >= (long)nM * nN) return false; tile_of((int)L, nM, nN, u.pm, u.pn); u.pb = u.pn; return true; }
    __device__ __forceinline__ void a_ready(const Unit&) const {}
    __device__ __forceinline__ void done(const Unit&) const {}
};
struct P1Order {
    int G, c, lo, hi;
    __device__ __forceinline__ bool next(int i, Unit& u) const { const long L = (long)lo + (long)i * G + c; if (L >= hi) return false;
        if (L < 2560) tile_of((int)L, 128, 20, u.pm, u.pn); else { const int k = (int)L - 2560; u.pm = 128 + (k >> 2); u.pn = 20 + (k & 3); }
        u.pb = u.pn; return true; }
    __device__ __forceinline__ void a_ready(const Unit&) const {}
    __device__ __forceinline__ void done(const Unit&) const {}
};
struct MoeOrder {
    int nM, G, c; const LAS int* te;
    __device__ __forceinline__ bool next(int i, Unit& u) const { const long L = (long)i * G + c; if (L >= (long)nM * 8) return false; tile_of((int)L, nM, 8, u.pm, u.pn); u.pb = te[u.pm] * 8 + u.pn; return true; }
    __device__ __forceinline__ void a_ready(const Unit&) const {}
    __device__ __forceinline__ void done(const Unit&) const {}
};

struct EpiProj {
    static constexpr bool PERM = true, AFTER_DRAIN = false;
    bf16_t* O; bf16_t* O2;
    __device__ __forceinline__ void operator()(const f32x4 (&acc)[2][2][4][2], const Unit& u, int wr, int wc, int fr, int fq) const {
        int row0 = u.pm * BM + wr * 64 + fr, col0 = u.pn * BM + wc * 32 + 8 * fq, ldc = PROJ; bf16_t* base = O;
        if (u.pm >= 128) { row0 -= 128 * BM; col0 -= 20 * BM; ldc = 1024; base = O2; }
#pragma unroll
        for (int ai = 0; ai < 2; ++ai)
#pragma unroll
            for (int m = 0; m < 4; ++m) { bf16_t* rowp = base + (size_t)(row0 + ai * HALF + m * 16) * ldc + col0;
#pragma unroll
                for (int bj = 0; bj < 2; ++bj) { const f32x4 v0 = acc[ai][bj][m][0], v1 = acc[ai][bj][m][1];
                    u32x4 w; w.x = cvtpk(v0[0], v0[1]); w.y = cvtpk(v0[2], v0[3]); w.z = cvtpk(v1[0], v1[1]); w.w = cvtpk(v1[2], v1[3]);
                    *(u32x4*)(rowp + bj * HALF) = w; } }
    }
};
struct EpiResid {
    static constexpr bool PERM = true, AFTER_DRAIN = false;
    const float* X; float* X1; bf16_t* X1B;
    __device__ __forceinline__ void operator()(const f32x4 (&acc)[2][2][4][2], const Unit& u, int wr, int wc, int fr, int fq) const {
        const int row0 = u.pm * BM + wr * 64 + fr, col0 = u.pn * BM + wc * 32 + 8 * fq;
#pragma unroll
        for (int ai = 0; ai < 2; ++ai)
#pragma unroll
            for (int m = 0; m < 4; ++m) { const size_t off = (size_t)(row0 + ai * HALF + m * 16) * D + col0;
#pragma unroll
                for (int bj = 0; bj < 2; ++bj) { const f32x4 xa = __builtin_nontemporal_load((const f32x4*)(X + off + bj * HALF)), xb = __builtin_nontemporal_load((const f32x4*)(X + off + bj * HALF + 4));
                    const f32x4 v0 = acc[ai][bj][m][0] + xa, v1 = acc[ai][bj][m][1] + xb;
                    *(f32x4*)(X1 + off + bj * HALF) = v0; *(f32x4*)(X1 + off + bj * HALF + 4) = v1;
                    v2u w; w.x = pk_fp8x4(v0[0], v0[1], v0[2], v0[3]); w.y = pk_fp8x4(v1[0], v1[1], v1[2], v1[3]);
                    *(v2u*)((unsigned char*)X1B + off + bj * HALF) = w; }
                asm volatile("" ::: "memory"); }
    }
};
struct EpiSwiGLU {
    static constexpr bool PERM = true, AFTER_DRAIN = false;
    bf16_t* ACT; const float* RS; const PG8_LAS int* tb;
    __device__ __forceinline__ void operator()(const f32x4 (&acc)[2][2][4][2], const Unit& u, int wr, int wc, int fr, int fq) const {
        const int row0 = u.pm * BM + wr * 64 + fr, col0 = u.pn * HALF + wc * 32 + 8 * fq, lb = tb[u.pm] - u.pm * BM;
#pragma unroll
        for (int ai = 0; ai < 2; ++ai)
#pragma unroll
            for (int m = 0; m < 4; ++m) { const int row = row0 + ai * HALF + m * 16; const float rs = RS[lb + row] * (1.0f / SC_WGU); float o[8];
#pragma unroll
                for (int n = 0; n < 2; ++n)
#pragma unroll
                    for (int j = 0; j < 4; ++j) { const float g = acc[ai][0][m][n][j] * rs, uu = acc[ai][1][m][n][j] * rs;
                        o[n * 4 + j] = g * __builtin_amdgcn_rcpf(1.0f + __builtin_amdgcn_exp2f(-g * LOG2E)) * uu * SC_ACT; }
                v2u w; w.x = pk_fp8x4(o[0], o[1], o[2], o[3]); w.y = pk_fp8x4(o[4], o[5], o[6], o[7]);
                *(v2u*)((unsigned char*)ACT + (size_t)row * DEXP + col0) = w; }
    }
};
struct EpiDown {
    static constexpr bool PERM = true, AFTER_DRAIN = false;
    bf16_t* Y; const float* GT; const PG8_LAS int* tb;
    __device__ __forceinline__ void operator()(const f32x4 (&acc)[2][2][4][2], const Unit& u, int wr, int wc, int fr, int fq) const {
        const int row0 = u.pm * BM + wr * 64 + fr, col0 = u.pn * BM + wc * 32 + 8 * fq, lb = tb[u.pm] - u.pm * BM;
#pragma unroll
        for (int ai = 0; ai < 2; ++ai)
#pragma unroll
            for (int m = 0; m < 4; ++m) { const int row = row0 + ai * HALF + m * 16; const float gt = GT[lb + row] * (1.0f / (SC_ACT * SC_WD)); bf16_t* rowp = Y + (size_t)row * D + col0;
#pragma unroll
                for (int bj = 0; bj < 2; ++bj) { const f32x4 v0 = acc[ai][bj][m][0] * gt, v1 = acc[ai][bj][m][1] * gt;
                    u32x4 w; w.x = cvtpk(v0[0], v0[1]); w.y = cvtpk(v0[2], v0[3]); w.z = cvtpk(v1[0], v1[1]); w.w = cvtpk(v1[2], v1[3]);
                    *(u32x4*)(rowp + bj * HALF) = w; } }
    }
};

template <class Epi, class Sched, bool ALIGN_EPI = true, bool GATHER = false, bool BKN = false, bool FP8 = false>
__device__ __forceinline__ void gemm_phase(PG8_LAS unsigned char* lds, const Gemm g, const Sched& S, const Epi& E) {
    static_assert(!(FP8 && BKN), "the fp8 path takes N-major B");
    const int tid = threadIdx.x, wid = __builtin_amdgcn_readfirstlane(tid >> 6), lane = tid & 63, wr = wid >> 2, wc = wid & 3, fr = lane & 15, fq = lane >> 4;
    const int K = FP8 ? g.K / 2 : g.K, nt = K / BK;
    unsigned voffA[2], voffB[2]; int gR[2], gC[2];
#pragma unroll
    for (int i = 0; i < 2; ++i) { int R, C; stage_rc(tid * 16 + i * 8192, R, C); const int Rb = Epi::PERM ? ((R & ~31) + perm32(R & 31)) : R; gR[i] = R; gC[i] = C;
        voffA[i] = (unsigned)(R * K + C) * 2u; voffB[i] = (unsigned)(Rb * K + C) * 2u; }
    unsigned vA0[2], vA1[2], vN0[2], vN1[2];
#define PG8_GOFF(dst0, dst1, ui_) do { _Pragma("unroll") for (int _i = 0; _i < 2; ++_i) { \
        dst0[_i] = ((unsigned)g.ut[(ui_) * 256 + gR[_i]] * (unsigned)K + (unsigned)gC[_i]) * 2u; dst1[_i] = ((unsigned)g.ut[(ui_) * 256 + 128 + gR[_i]] * (unsigned)K + (unsigned)gC[_i]) * 2u; } } while (0)
    const size_t kstep = (size_t)(BK * 2);
    const size_t hstep = (size_t)HALF * K * 2;
    const size_t tstep = 2 * hstep;
    const size_t kstepB = BKN ? (size_t)BK * 4096 : kstep, hstepB = BKN ? (size_t)256 : hstep;
    if constexpr (BKN) {
#pragma unroll
        for (int i = 0; i < 2; ++i) { const int p = tid * 16 + i * 8192, kk = p >> 8, c16p = (p & 255) >> 4, sw = (kk & 3) | (((kk >> 3) & 1) << 2);
            voffB[i] = (unsigned)(kk * 4096 + ((c16p ^ (sw << 1)) << 4)); } }
    int bbase[2];
    { const int q = fr >> 2, p = fr & 3, sw = q | ((fq & 1) << 2);
#pragma unroll
      for (int n = 0; n < 2; ++n) bbase[n] = (int)(uintptr_t)lds + (8 * fq + q) * 256 + (((4 * wc + 2 * n + (p >> 1)) ^ (sw << 1)) << 4) + 8 * (p & 1); }
    const unsigned ldsw = (unsigned)wid * 1024u;
    const int aoff = lds_byte(wr * 64 + fr, fq * 8), boff = lds_byte(wc * 32 + fr, fq * 8);
    const int aoq0 = lds_byte(wr * 64 + fr, fq * 16), aoq1 = lds_byte(wr * 64 + fr, fq * 16 + 8), boq0 = lds_byte(wc * 32 + fr, fq * 16), boq1 = lds_byte(wc * 32 + fr, fq * 16 + 8);
#define PG8_SA(b, h) (((b) * 2 + (h)) * HTB)
#define PG8_SB(b, h) ((4 + (b) * 2 + (h)) * HTB)
#define PG8_STAGE(bufoff, gbase, voff) do { _Pragma("unroll") for (int _i = 0; _i < 2; ++_i) \
        __builtin_amdgcn_global_load_lds((const unsigned*)((const char*)(gbase) + (voff)[_i]), (PG8_LAS unsigned*)(lds + (bufoff) + ldsw + _i * 8192), 16, 0, 0); } while (0)
#define PG8_Q_At Aq
#define PG8_Q_B0 Bq0
#define PG8_Q_B1 Bq1
#define PG8_LD8(p0_, p1_) __builtin_shufflevector(*(const PG8_LAS i32x4*)(p0_), *(const PG8_LAS i32x4*)(p1_), 0, 1, 2, 3, 4, 5, 6, 7)
#define PG8_LDA(dst, b, h) do { if constexpr (FP8) { _Pragma("unroll") for (int m = 0; m < 4; ++m) PG8_Q_##dst[m] = PG8_LD8(lds + PG8_SA(b, h) + aoq0 + m * 2048, lds + PG8_SA(b, h) + aoq1 + m * 2048); } \
        else { _Pragma("unroll") for (int m = 0; m < 4; ++m) _Pragma("unroll") for (int k = 0; k < 2; ++k) dst[m][k] = *(const PG8_LAS bf16x8*)(lds + PG8_SA(b, h) + aoff + m * 2048 + k * 1024); } } while (0)
#define PG8_TR(dst, addr, OFF) asm volatile("ds_read_b64_tr_b16 %0, %1 offset:%2" : "=&v"(dst) : "v"(addr), "i"(OFF) : "memory")
#define PG8_LDB(dst, b, h) do { if constexpr (BKN) { _Pragma("unroll") for (int n = 0; n < 2; ++n) { const int ad_ = bbase[n] + PG8_SB(b, h); s16x4 l0_, h0_, l1_, h1_; \
            PG8_TR(l0_, ad_, 0); PG8_TR(h0_, ad_, 1024); PG8_TR(l1_, ad_, 8192); PG8_TR(h1_, ad_, 9216); \
            dst[n][0] = (bf16x8){l0_[0], l0_[1], l0_[2], l0_[3], h0_[0], h0_[1], h0_[2], h0_[3]}; dst[n][1] = (bf16x8){l1_[0], l1_[1], l1_[2], l1_[3], h1_[0], h1_[1], h1_[2], h1_[3]}; } } \
        else if constexpr (FP8) { _Pragma("unroll") for (int n = 0; n < 2; ++n) PG8_Q_##dst[n] = PG8_LD8(lds + PG8_SB(b, h) + boq0 + n * 2048, lds + PG8_SB(b, h) + boq1 + n * 2048); } \
        else { _Pragma("unroll") for (int n = 0; n < 2; ++n) _Pragma("unroll") for (int k = 0; k < 2; ++k) dst[n][k] = *(const PG8_LAS bf16x8*)(lds + PG8_SB(b, h) + boff + n * 2048 + k * 1024); } } while (0)
#define PG8_MMA(ai, bj, At, Bt) do { __builtin_amdgcn_s_setprio(1); if constexpr (FP8) { _Pragma("unroll") for (int m = 0; m < 4; ++m) _Pragma("unroll") for (int n = 0; n < 2; ++n) \
            asm volatile("v_mfma_scale_f32_16x16x128_f8f6f4 %0, %1, %2, %0, %3, %3 op_sel_hi:[0,0,0]" : "+v"(acc[ai][bj][m][n]) : "v"(PG8_Q_##Bt[n]), "v"(PG8_Q_##At[m]), "v"(sc1_)); } \
        else { _Pragma("unroll") for (int m = 0; m < 4; ++m) _Pragma("unroll") for (int n = 0; n < 2; ++n) _Pragma("unroll") for (int k = 0; k < 2; ++k) \
            acc[ai][bj][m][n] = __builtin_amdgcn_mfma_f32_16x16x32_bf16(Bt[n][k], At[m][k], acc[ai][bj][m][n], 0, 0, 0); } __builtin_amdgcn_s_setprio(0); } while (0)
#define PG8_WAIT_V(n) asm volatile("s_waitcnt vmcnt(" #n ")" ::: "memory")
#define PG8_WAIT_L(n) asm volatile("s_waitcnt lgkmcnt(" #n ")" ::: "memory")
#define PG8_BAR __builtin_amdgcn_s_barrier()
#define PG8_SCHED __builtin_amdgcn_sched_barrier(0)
    Unit cur, nxt; int ui = 0;
    if (!S.next(0, cur)) return;
    f32x4 acc[2][2][4][2];
#pragma unroll
    for (int a = 0; a < 2; ++a)
#pragma unroll
        for (int b = 0; b < 2; ++b)
#pragma unroll
            for (int m = 0; m < 4; ++m)
#pragma unroll
                for (int n = 0; n < 2; ++n) acc[a][b][m][n] = (f32x4){0.f, 0.f, 0.f, 0.f};
    bf16x8 At[4][2], B0[2][2], B1[2][2];
    i32x8 Aq[4], Bq0[2], Bq1[2]; const int sc1_ = 0x7F7F7F7F;
    const char* cA = GATHER ? (const char*)g.A : (const char*)g.A + (size_t)cur.pm * tstep; const char* cB = BKN ? (const char*)g.Bt + (size_t)(cur.pb >> 3) * ((size_t)K * 4096) + (size_t)(cur.pb & 7) * 512 : (const char*)g.Bt + (size_t)cur.pb * tstep;
    const size_t hA = GATHER ? 0 : hstep;
    if constexpr (GATHER) { PG8_GOFF(vA0, vA1, 0); } else {
#pragma unroll
        for (int i = 0; i < 2; ++i) { vA0[i] = voffA[i]; vA1[i] = voffA[i]; vN0[i] = voffA[i]; vN1[i] = voffA[i]; } }
    S.a_ready(cur);
    PG8_STAGE(PG8_SB(0, 0), cB, voffB); PG8_STAGE(PG8_SB(0, 1), cB + hstepB, voffB); PG8_STAGE(PG8_SA(0, 0), cA, vA0); PG8_STAGE(PG8_SA(0, 1), cA + hA, vA1);
    if (wr == 1) PG8_BAR;
    PG8_WAIT_V(2); PG8_BAR;
    PG8_STAGE(PG8_SB(1, 0), cB + kstepB, voffB); PG8_STAGE(PG8_SA(1, 0), cA + kstep, vA0); PG8_STAGE(PG8_SB(1, 1), cB + hstepB + kstepB, voffB);
    PG8_WAIT_V(6); PG8_BAR;
    for (;;) {
        const bool has_next = S.next(ui + 1, nxt);
        const char* nA = GATHER ? cA : (has_next ? (const char*)g.A + (size_t)nxt.pm * tstep : cA); const char* nB = has_next ? (BKN ? (const char*)g.Bt + (size_t)(nxt.pb >> 3) * ((size_t)K * 4096) + (size_t)(nxt.pb & 7) * 512 : (const char*)g.Bt + (size_t)nxt.pb * tstep) : cB;
        if constexpr (GATHER) { if (has_next) { PG8_GOFF(vN0, vN1, ui + 1); } else {
#pragma unroll
            for (int i = 0; i < 2; ++i) { vN0[i] = vA0[i]; vN1[i] = vA1[i]; } } }
#pragma unroll 1
        for (int t = 0; t < nt; t += 2) {
            const bool last = (t == nt - 2);
            unsigned s0[2], s1[2];
#pragma unroll
            for (int i = 0; i < 2; ++i) { s0[i] = (GATHER && last) ? vN0[i] : vA0[i]; s1[i] = (GATHER && last) ? vN1[i] : vA1[i]; }
            const char* a1 = cA + (size_t)(t + 1) * kstep;
            const char* a2 = last ? nA : cA + (size_t)(t + 2) * kstep; const char* b2 = last ? nB : cB + (size_t)(t + 2) * kstepB;
            const char* a3 = a2 + kstep; const char* b3 = b2 + kstepB;
            if (last && has_next) S.a_ready(nxt);
            PG8_LDB(B0, 0, 0); PG8_LDB(B1, 0, 1); PG8_SCHED; PG8_LDA(At, 0, 0); PG8_STAGE(PG8_SA(1, 1), a1 + hA, vA1);
            PG8_WAIT_V(8); PG8_WAIT_L(0); PG8_BAR; PG8_SCHED; PG8_MMA(0, 0, At, B0); PG8_MMA(0, 1, At, B1); PG8_BAR; PG8_SCHED;
            PG8_LDA(At, 0, 1); PG8_STAGE(PG8_SB(0, 0), b2, voffB); PG8_STAGE(PG8_SB(0, 1), b2 + hstepB, voffB); PG8_STAGE(PG8_SA(0, 0), a2, s0);
            PG8_WAIT_V(8); PG8_WAIT_L(0); PG8_BAR; PG8_SCHED; PG8_MMA(1, 0, At, B0); PG8_MMA(1, 1, At, B1); PG8_BAR; PG8_SCHED;
            PG8_LDB(B0, 1, 0); PG8_LDB(B1, 1, 1); PG8_SCHED; PG8_LDA(At, 1, 0); PG8_STAGE(PG8_SA(0, 1), a2 + hA, s1);
            PG8_WAIT_V(8); PG8_WAIT_L(0); PG8_BAR; PG8_SCHED; PG8_MMA(0, 0, At, B0); PG8_MMA(0, 1, At, B1); PG8_BAR; PG8_SCHED;
            PG8_LDA(At, 1, 1); PG8_STAGE(PG8_SB(1, 0), b3, voffB); PG8_STAGE(PG8_SB(1, 1), b3 + hstepB, voffB); PG8_STAGE(PG8_SA(1, 0), a3, s0);
            PG8_WAIT_V(8); PG8_WAIT_L(0); PG8_BAR; PG8_SCHED; PG8_MMA(1, 0, At, B0); PG8_MMA(1, 1, At, B1); PG8_BAR; PG8_SCHED;
        }
        if constexpr (ALIGN_EPI) { if (wr == 0) PG8_BAR; }
        if constexpr (FP8) asm volatile("s_nop 15\n\ts_nop 15" ::: "memory");
        { int ln_ = lane; asm volatile("" : "+v"(ln_)); E(acc, cur, wr, wc, ln_ & 15, ln_ >> 4); } S.done(cur);
        if (!has_next) break;
#pragma unroll
        for (int a = 0; a < 2; ++a)
#pragma unroll
            for (int b = 0; b < 2; ++b)
#pragma unroll
                for (int m = 0; m < 4; ++m)
#pragma unroll
                    for (int n = 0; n < 2; ++n) acc[a][b][m][n] = (f32x4){0.f, 0.f, 0.f, 0.f};
        cur = nxt; cA = nA; cB = nB; ++ui;
#pragma unroll
        for (int i = 0; i < 2; ++i) { vA0[i] = vN0[i]; vA1[i] = vN1[i]; }
        if constexpr (ALIGN_EPI) { if (wr == 1) PG8_BAR; }
    }
    PG8_WAIT_V(0);
    if constexpr (!ALIGN_EPI) { if (wr == 0) PG8_BAR; }
    PG8_BAR;
#undef PG8_GOFF
#undef PG8_Q_At
#undef PG8_Q_B0
#undef PG8_Q_B1
#undef PG8_LD8
#undef PG8_TR
#undef PG8_SA
#undef PG8_SB
#undef PG8_STAGE
#undef PG8_LDA
#undef PG8_LDB
#undef PG8_MMA
#undef PG8_WAIT_V
#undef PG8_WAIT_L
#undef PG8_BAR
#undef PG8_SCHED
}
}

#define XB_TMO      128
#define XB_XCNT(j)  (256  + 64 * (j))
#define XB_XSUB(j)  (1280 + 64 * (j))
#define XB_XGEN(j)  (2304 + 64 * (j))
#define XB_TOP      3328
#define XB_TOPGEN   3392
#define XCD_BAR_WORDS 3456
#define XB_SPIN_CAP (1u << 18)
__device__ __forceinline__ unsigned xb_ld(unsigned* p)              { return __hip_atomic_load(p, __ATOMIC_RELAXED, __HIP_MEMORY_SCOPE_AGENT); }
__device__ __forceinline__ unsigned xb_add(unsigned* p, unsigned v) { return __hip_atomic_fetch_add(p, v, __ATOMIC_RELAXED, __HIP_MEMORY_SCOPE_AGENT); }
__device__ __forceinline__ unsigned xb_xcc_id() { return (unsigned)__builtin_amdgcn_s_getreg((3 << 11) | 20) & 0xFu; }
#define XB_SPIN(cond, bar) do { unsigned _sp = 0; while (cond) { __builtin_amdgcn_s_sleep(1); \
    if ((++_sp & 255u) == 0u) { if (xb_ld(&(bar)[XB_TMO])) break; if (_sp > XB_SPIN_CAP) { atomicAdd(&(bar)[XB_TMO], 1u); break; } } } } while (0)
struct XcdBarrier { unsigned* bar; unsigned x; volatile LAS unsigned* st; };
__device__ __forceinline__ XcdBarrier xcd_barrier_post(unsigned* bar, volatile LAS unsigned* st) {
    XcdBarrier b; b.bar = bar; b.x = xb_xcc_id(); b.st = st;
    if (threadIdx.x == 0) (void)xb_add(&bar[XB_XCNT(b.x)], 1u);
    return b;
}
__device__ __forceinline__ void xcd_barrier_complete(unsigned* bar, unsigned x, unsigned& nloc, unsigned& nx) {
    const unsigned G = gridDim.x * gridDim.y * gridDim.z;
    unsigned sum, cnt, mine, sp = 0u;
    for (;;) {
        sum = 0u; cnt = 0u; mine = 0u;
#pragma unroll
        for (unsigned j = 0; j < 16; ++j) { const unsigned c = xb_ld(&bar[XB_XCNT(j)]); sum += c; cnt += (c > 0u) ? 1u : 0u; mine = (j == x) ? c : mine; }
        if (sum == G) break;
        __builtin_amdgcn_s_sleep(1);
        if ((++sp & 255u) == 0u) { if (xb_ld(&bar[XB_TMO])) break; if (sp > XB_SPIN_CAP) { atomicAdd(&bar[XB_TMO], 1u); break; } }
    }
    nloc = mine > 0u ? mine : 1u; nx = cnt > 0u ? cnt : 1u;
}
__device__ __forceinline__ void xcd_barrier(const XcdBarrier& b) {
    asm volatile("s_waitcnt vmcnt(0)" ::: "memory");
    __syncthreads();
    if (threadIdx.x == 0) {
        unsigned* bar = b.bar;
        __builtin_amdgcn_s_waitcnt(0);
        unsigned nloc = b.st[0], nx = b.st[1];
        if (nloc == 0u) { xcd_barrier_complete(bar, b.x, nloc, nx); b.st[0] = nloc; b.st[1] = nx; }
        const unsigned old = xb_add(&bar[XB_XSUB(b.x)], 1u);
        const unsigned gen = old / nloc;
        if (old + 1u == (gen + 1u) * nloc) {
            __builtin_amdgcn_fence(__ATOMIC_RELEASE, "agent");
            asm volatile("s_waitcnt vmcnt(0)" ::: "memory");
            const unsigned og = xb_add(&bar[XB_TOP], 1u);
            const unsigned tg = og / nx;
            if (og + 1u == (tg + 1u) * nx) xb_add(&bar[XB_TOPGEN], 1u);
            else XB_SPIN(xb_ld(&bar[XB_TOPGEN]) == tg, bar);
            __builtin_amdgcn_fence(__ATOMIC_ACQUIRE, "agent");
            xb_add(&bar[XB_XGEN(b.x)], 1u);
            asm volatile("s_waitcnt vmcnt(0)" ::: "memory");
        } else {
            XB_SPIN(xb_ld(&bar[XB_XGEN(b.x)]) == gen, bar);
            __builtin_amdgcn_fence(__ATOMIC_ACQUIRE, "agent");
            asm volatile("s_waitcnt vmcnt(0)" ::: "memory");
        }
    }
    __syncthreads();
}

constexpr int NWAVES = 8;
struct Frame {
    LAS unsigned char* lds;
    unsigned* ctl;
    int tid, lane, wave, vcu, G;
    const float *x, *mem, *norm1_g, *w_in, *q_norm_g, *k_norm_g, *conv_w, *mem_norm_g, *w_mem_kv, *mem_q_norm_g, *mem_k_norm_g, *out_norm_g, *w_out, *norm2_g,
                *w_rg, *b_rg, *w_re, *b_re, *w_gate, *w_up, *w_down;
    float* out; unsigned char* ws;
};

__device__ __forceinline__ void p0_transpose_item(const float* W, int N, int k0, int n0, const float* ks, bf16* dst, int pitch, LAS float* scr, int lane) {
#pragma unroll 8
    for (int i = 0; i < 32; ++i) { const int kk = 2 * i + (lane >> 5); scr[kk * 33 + (lane & 31)] = __builtin_nontemporal_load(W + (size_t)(k0 + kk) * N + n0 + (lane & 31)); }
    const int c = lane & 7;
    float g[8];
#pragma unroll
    for (int j = 0; j < 8; ++j) g[j] = ks ? ks[k0 + 8 * c + j] : 1.0f;
    LDS_WAIT(); asm volatile("" ::: "memory");
#pragma unroll
    for (int j = 0; j < 4; ++j) { const int n = (lane >> 3) + 8 * j; const LAS float* s = scr + (8 * c) * 33 + n;
        v4u o; o.x = pk2(s[0 * 33] * g[0], s[1 * 33] * g[1]); o.y = pk2(s[2 * 33] * g[2], s[3 * 33] * g[3]); o.z = pk2(s[4 * 33] * g[4], s[5 * 33] * g[5]); o.w = pk2(s[6 * 33] * g[6], s[7 * 33] * g[7]);
        *(GAS v4u*)(dst + (size_t)n * pitch + k0 + 8 * c) = o; }
    LDS_WAIT(); asm volatile("" ::: "memory");
}
__device__ __forceinline__ void rms_row_to_bf16(const float* xrow, const float* gain, bf16* orow, int lane) {
    const GAS f32x4* xr = (const GAS f32x4*)xrow + lane; const GAS f32x4* gr = (const GAS f32x4*)gain + lane;
    f32x4 v[8]; float s = 0.f;
#pragma unroll
    for (int j = 0; j < 8; ++j) { v[j] = __builtin_nontemporal_load(xr + 64 * j); s += (v[j].x * v[j].x + v[j].y * v[j].y) + (v[j].z * v[j].z + v[j].w * v[j].w); }
    const float rstd = 1.0f / sqrtf(wave_sum(s) * (1.f / D) + EPS);
    GAS v2u* o8 = (GAS v2u*)orow + lane;
#pragma unroll
    for (int j = 0; j < 8; ++j) { const f32x4 gg = gr[64 * j]; v2u o; o.x = pk2(v[j].x * rstd * gg.x, v[j].y * rstd * gg.y); o.y = pk2(v[j].z * rstd * gg.z, v[j].w * rstd * gg.w); o8[64 * j] = o; }
}
__device__ __forceinline__ void p0_transpose_item_q(const float* W, int N, int k0, int n0, const float* ks, float sc, unsigned char* dst, int pitch, LAS float* scr, int lane) {
#pragma unroll 8
    for (int i = 0; i < 64; ++i) { const int kk = 2 * i + (lane >> 5); scr[kk * 33 + (lane & 31)] = __builtin_nontemporal_load(W + (size_t)(k0 + kk) * N + n0 + (lane & 31)); }
    const int c = lane & 15;
    float g[8];
#pragma unroll
    for (int j = 0; j < 8; ++j) g[j] = ks ? ks[k0 + 8 * c + j] * sc : sc;
    LDS_WAIT(); asm volatile("" ::: "memory");
#pragma unroll
    for (int j = 0; j < 8; ++j) { const int n = (lane >> 4) + 4 * j; const LAS float* s = scr + (8 * c) * 33 + n;
        v2u o; o.x = pk_fp8x4(s[0 * 33] * g[0], s[1 * 33] * g[1], s[2 * 33] * g[2], s[3 * 33] * g[3]); o.y = pk_fp8x4(s[4 * 33] * g[4], s[5 * 33] * g[5], s[6 * 33] * g[6], s[7 * 33] * g[7]);
        __builtin_nontemporal_store(o, (GAS v2u*)(dst + (size_t)n * pitch + k0 + 8 * c)); }
    LDS_WAIT(); asm volatile("" ::: "memory");
}
__device__ __forceinline__ void p0_item_q64(const float* W, int N, int k0, int n0, const float* ks, float sc, unsigned char* dst, int pitch, LAS unsigned char* scr, int lane) {
    const GAS float* src = (const GAS float*)(W + (size_t)k0 * N + n0 + lane);
    float g0 = sc, g1 = sc;
    if (ks) { g0 = ks[k0 + lane] * sc; g1 = ks[k0 + 64 + lane] * sc; }
#pragma unroll
    for (int h = 0; h < 2; ++h) {
        float v[64];
#pragma unroll
        for (int i = 0; i < 64; ++i) v[i] = __builtin_nontemporal_load(src + (size_t)(64 * h + i) * N);
        const float gh = h ? g1 : g0;
#pragma unroll
        for (int q = 0; q < 4; ++q) { v4u o;
#pragma unroll
            for (int d = 0; d < 4; ++d) { const int i = 16 * q + 4 * d;
                const float s0 = __builtin_bit_cast(float, __builtin_amdgcn_readlane(__builtin_bit_cast(int, gh), i)), s1 = __builtin_bit_cast(float, __builtin_amdgcn_readlane(__builtin_bit_cast(int, gh), i + 1));
                const float s2 = __builtin_bit_cast(float, __builtin_amdgcn_readlane(__builtin_bit_cast(int, gh), i + 2)), s3 = __builtin_bit_cast(float, __builtin_amdgcn_readlane(__builtin_bit_cast(int, gh), i + 3));
                o[d] = pk_fp8x4(v[i] * s0, v[i + 1] * s1, v[i + 2] * s2, v[i + 3] * s3); }
            *(LAS v4u*)(scr + lane * 144 + (4 * h + q) * 16) = o; }
    }
    LDS_WAIT(); asm volatile("" ::: "memory");
#pragma unroll
    for (int i = 0; i < 8; ++i) { const int row = 8 * i + (lane >> 3), ch = lane & 7;
        const v4u w = *(const LAS v4u*)(scr + row * 144 + ch * 16);
        __builtin_nontemporal_store(w, (GAS v4u*)(dst + (size_t)row * pitch + k0 + ch * 16)); }
    LDS_WAIT(); asm volatile("" ::: "memory");
}
__device__ __forceinline__ void p0_prologue(Frame& F) {
    LAS float* scr = (LAS float*)(F.lds + F.wave * 16896);
    const int gw = F.vcu * NWAVES + F.wave, NGW = F.G * NWAVES;
    bf16* Win_t = (bf16*)(F.ws + WS_WIN); bf16* Wmkv_t = (bf16*)(F.ws + WS_WMKV); bf16* Wout_t = (bf16*)(F.ws + WS_WOUT);
    constexpr int I_IN = 32 * 160, I_MKV = 32 * 32, I_OUT = 32 * 64;
    constexpr int NITEMS = I_IN + I_MKV + I_OUT;
    for (int it = gw; it < NITEMS; it += NGW) {
        int r = it;
        if (r < I_IN) { const int kb = r / 160, nb = r % 160; p0_transpose_item(F.w_in, PROJ, 64 * kb, 32 * nb, nullptr, Win_t + (size_t)(32 * nb) * D, D, scr, F.lane); continue; } r -= I_IN;
        if (r < I_MKV) { const int kb = r / 32, nb = r % 32; p0_transpose_item(F.w_mem_kv, 1024, 64 * kb, 32 * nb, nullptr, Wmkv_t + (size_t)(32 * nb) * D, D, scr, F.lane); continue; } r -= I_MKV;
        { const int kb = r / 64, nb = r % 64; p0_transpose_item(F.w_out, D, 64 * kb, 32 * nb, nullptr, Wout_t + (size_t)(32 * nb) * D, D, scr, F.lane); }
    }
    { unsigned char* Wgu_q = (unsigned char*)(F.ws + WS_WGU); unsigned char* Wd_q = (unsigned char*)(F.ws + WS_WD); LAS unsigned char* scq = F.lds + F.wave * 16896;
      constexpr int IPE = 256 + 256 + 256;
#pragma unroll 1
      for (int it = gw; it < 64 * IPE; it += NGW) { const int e = it / IPE; int r = it - e * IPE;
          if (r < 512) { const int up = r >> 8, q = r & 255, kb = q >> 4, nb = q & 15, n0 = 64 * nb;
              const float* W = (up ? F.w_up : F.w_gate) + (size_t)e * D * DEXP; const int drow = 256 * (n0 >> 7) + 128 * up + (n0 & 127);
              p0_item_q64(W, DEXP, 128 * kb, n0, F.norm2_g, SC_WGU, Wgu_q + ((size_t)e * 2048 + drow) * D, D, scq, F.lane); }
          else { const int q = r - 512, kb = q >> 5, nb = q & 31;
              p0_item_q64(F.w_down + (size_t)e * DEXP * D, D, 128 * kb, 64 * nb, nullptr, SC_WD, Wd_q + ((size_t)e * 2048 + 64 * nb) * DEXP, DEXP, scq, F.lane); } } }
    { bf16* WT = (bf16*)(F.ws + WS_WR); const int gt = (F.vcu * NWAVES + F.wave) * 64 + F.lane, NT = F.G * NWAVES * 64;
      for (int i = gt; i < 96 * 2048; i += NT) { const int n = i >> 11, k = i & 2047;
          float w = n < 64 ? F.w_re[k * 64 + n] : (n < 72 ? F.w_rg[k * 8 + (n - 64)] : 0.f); w *= F.norm2_g[k];
          const unsigned h = f2bf(w); const float hf = __builtin_bit_cast(float, h << 16);
          WT[i] = (bf16)h; WT[96 * 2048 + i] = (bf16)f2bf(w - hf); } }
    bf16* H = (bf16*)(F.ws + WS_H);
    for (int m = gw; m < T + 512; m += NGW) {
        if (m < T) rms_row_to_bf16(F.x + (size_t)m * D, F.norm1_g, H + (size_t)m * D, F.lane);
        else rms_row_to_bf16(F.mem + (size_t)(m - T) * D, F.mem_norm_g, H + (size_t)m * D, F.lane);
    }
}

namespace att {
constexpr int LDS_K = 0, LDS_V = 65536, LDS_STG = 131072, LDS_LI = LDS_STG + 16384, LDS_GT = LDS_LI + 8 * 256;
constexpr float CS = 0.08838834764831845f * LOG2E;
#define KSWZ(row, colB) ((row) * 256 + ((colB) ^ (((row) & 7) << 4)))
__device__ __forceinline__ int crow(int r, int hi) { return (r & 3) + 8 * (r >> 2) + 4 * hi; }
__device__ __forceinline__ int v_rd_base(int lane) { return ((lane & 3) << 3) | (((lane >> 2) & 3) << 6) | (((lane >> 4) & 1) << 5) | (((lane >> 5) & 1) << 8); }
template <int OFF> __device__ __forceinline__ s16x4 tr_read(int vb) { s16x4 r; asm volatile("ds_read_b64_tr_b16 %0, %1 offset:%2" : "=&v"(r) : "v"(vb), "i"(OFF) : "memory"); return r; }

struct RowMap { const char* base; long stride; int win0; bool wrap; };
__device__ __forceinline__ const char* rowptr(const RowMap& m, int p) { int sp = m.wrap ? m.win0 + ((p - m.win0) & 255) : p; sp = sp < 0 ? 0 : sp; return m.base + (long)sp * m.stride; }

__device__ __forceinline__ void dma_k(LAS unsigned char* Kl, int p0, int nrows, const RowMap& m, int wave, int lane) {
    asm volatile("" : "+v"(lane));
#pragma unroll 1
    for (int i = 0; i < nrows / 32; ++i) {
        const int prow0 = p0 + 32 * i + 4 * wave, prow = prow0 + (lane >> 4);
        const char* src = rowptr(m, prow) + (((lane & 15) ^ (prow & 7)) << 4);
        __builtin_amdgcn_global_load_lds((const unsigned*)src, (LAS unsigned*)(Kl + prow0 * 256), 16, 0, 0);
    }
}
__device__ __forceinline__ void dma_v(LAS unsigned char* Vl, int p0, int nrows, const RowMap& m, int wave, int lane) {
    asm volatile("" : "+v"(lane));
#pragma unroll 1
    for (int i = 0; i < nrows / 32; ++i) {
        const int ii = wave + 8 * i, g = (p0 >> 4) + (ii >> 2), q = ii & 3;
        const int kk = ((q >> 1) << 3) + ((lane & 31) >> 2), k = (kk & ~0xC) | ((kk & 4) << 1) | ((kk & 8) >> 1);
        const int c = 32 * (2 * (q & 1) + (lane >> 5)) + 8 * (lane & 3);
        const char* src = rowptr(m, 16 * g + k) + c * 2;
        __builtin_amdgcn_global_load_lds((const unsigned*)src, (LAS unsigned*)(Vl + g * 4096 + q * 1024), 16, 0, 0);
    }
}
__device__ __forceinline__ void dma_v2(LAS unsigned char* Vl, int p0, int nrows, const RowMap& m, int wave, int lane) {
    asm volatile("" : "+v"(lane));
#pragma unroll 1
    for (int i = 0; i < nrows / 32; ++i) {
        const int prow0 = p0 + 32 * i + 4 * wave, prow = prow0 + (lane >> 4);
        const char* src = rowptr(m, prow) + (((lane & 15) ^ ((prow & 7) << 1)) << 4);
        __builtin_amdgcn_global_load_lds((const unsigned*)src, (LAS unsigned*)(Vl + prow0 * 256), 16, 0, 0);
    }
}
__device__ __forceinline__ void load_q16(v4u (&raw)[4], const char* qrow, int kg) {
#pragma unroll
    for (int s = 0; s < 4; ++s) raw[s] = *(const GAS v4u*)(qrow + (32 * s + 8 * kg) * 2);
}
__device__ __forceinline__ void norm_q16(const v4u (&raw)[4], bf16x8 (&qr)[4], const LAS float* gt, int kg) {
    float ss = 0.f;
#pragma unroll
    for (int s = 0; s < 4; ++s)
#pragma unroll
        for (int j = 0; j < 4; ++j) { const float a = bflo(raw[s][j]), b = bfhi(raw[s][j]); ss += a * a + b * b; }
    ss += __shfl_xor(ss, 16); ss += __shfl_xor(ss, 32);
    const float rstd = 1.0f / sqrtf(ss * (1.f / HD) + EPS);
#pragma unroll
    for (int s = 0; s < 4; ++s) { const LAS f32x4* gp = (const LAS f32x4*)(gt + 32 * s + 8 * kg); const f32x4 g0 = gp[0], g1 = gp[1]; v4u o;
        o.x = cvtpk(bflo(raw[s].x) * rstd * g0.x, bfhi(raw[s].x) * rstd * g0.y); o.y = cvtpk(bflo(raw[s].y) * rstd * g0.z, bfhi(raw[s].y) * rstd * g0.w);
        o.z = cvtpk(bflo(raw[s].z) * rstd * g1.x, bfhi(raw[s].z) * rstd * g1.y); o.w = cvtpk(bflo(raw[s].w) * rstd * g1.z, bfhi(raw[s].w) * rstd * g1.w);
        qr[s] = __builtin_bit_cast(bf16x8, o); }
}
__device__ __forceinline__ void norm_k(LAS unsigned char* Kl, int p0, int nrows, const LAS float* gt, int tid) {
    asm volatile("" : "+v"(tid));
#pragma unroll 1
    for (int idx = tid; idx < nrows * 4; idx += 512) {
        const int row = p0 + (idx >> 2), qd = idx & 3;
        v4u w[4]; float ss = 0.f;
#pragma unroll
        for (int i = 0; i < 4; ++i) { w[i] = *(const LAS v4u*)(Kl + KSWZ(row, (4 * qd + i) * 16));
#pragma unroll
            for (int j = 0; j < 4; ++j) { const float a = bflo(w[i][j]), b = bfhi(w[i][j]); ss += a * a + b * b; } }
        ss += __shfl_xor(ss, 1); ss += __shfl_xor(ss, 2);
        const float rstd = 1.0f / sqrtf(ss * (1.f / HD) + EPS);
#pragma unroll
        for (int i = 0; i < 4; ++i) { const LAS f32x4* gp = (const LAS f32x4*)(gt + (4 * qd + i) * 8); const f32x4 g0 = gp[0], g1 = gp[1]; v4u o;
            o.x = cvtpk(bflo(w[i].x) * rstd * g0.x, bfhi(w[i].x) * rstd * g0.y); o.y = cvtpk(bflo(w[i].y) * rstd * g0.z, bfhi(w[i].y) * rstd * g0.w);
            o.z = cvtpk(bflo(w[i].z) * rstd * g1.x, bfhi(w[i].z) * rstd * g1.y); o.w = cvtpk(bflo(w[i].w) * rstd * g1.z, bfhi(w[i].w) * rstd * g1.w);
            *(LAS v4u*)(Kl + KSWZ(row, (4 * qd + i) * 16)) = o; }
    }
}
__device__ __forceinline__ float xsum32(float v) { unsigned a = __builtin_bit_cast(unsigned, v), b = a; asm volatile("s_nop 1\n\tv_permlane32_swap_b32 %0, %1" : "+v"(a), "+v"(b)); return __builtin_bit_cast(float, a) + __builtin_bit_cast(float, b); }
__device__ __forceinline__ void load_q(v4u (&raw)[8], const char* qrow, int hi) {
#pragma unroll
    for (int d0 = 0; d0 < 8; ++d0) raw[d0] = *(const GAS v4u*)(qrow + (d0 * 16 + hi * 8) * 2);
}
__device__ __forceinline__ void norm_q(const v4u (&raw)[8], bf16x8 (&qr)[8], const LAS float* gt, int hi) {
    float ss = 0.f;
#pragma unroll
    for (int d0 = 0; d0 < 8; ++d0)
#pragma unroll
        for (int j = 0; j < 4; ++j) { const float a = bflo(raw[d0][j]), b = bfhi(raw[d0][j]); ss += a * a + b * b; }
    ss = xsum32(ss);
    const float rstd = 1.0f / sqrtf(ss * (1.f / HD) + EPS);
#pragma unroll
    for (int d0 = 0; d0 < 8; ++d0) { const LAS f32x4* gp = (const LAS f32x4*)(gt + d0 * 16 + hi * 8); const f32x4 g0 = gp[0], g1 = gp[1]; v4u o;
        o.x = cvtpk(bflo(raw[d0].x) * rstd * g0.x, bfhi(raw[d0].x) * rstd * g0.y); o.y = cvtpk(bflo(raw[d0].y) * rstd * g0.z, bfhi(raw[d0].y) * rstd * g0.w);
        o.z = cvtpk(bflo(raw[d0].z) * rstd * g1.x, bfhi(raw[d0].z) * rstd * g1.y); o.w = cvtpk(bflo(raw[d0].w) * rstd * g1.z, bfhi(raw[d0].w) * rstd * g1.w);
        qr[d0] = __builtin_bit_cast(bf16x8, o); }
}
__device__ __forceinline__ f32x16 qk_tile(const LAS unsigned char* Kl, int pb, const bf16x8 (&qr)[8], int r32, int hi) {
    f32x16 p = {};
#pragma unroll
    for (int d0 = 0; d0 < 8; ++d0) { const bf16x8 kf = *(const LAS bf16x8*)(Kl + KSWZ(pb + r32, (d0 * 16 + hi * 8) * 2));
        p = __builtin_amdgcn_mfma_f32_32x32x16_bf16(kf, qr[d0], p, 0, 0, 0); }
    return p;
}
#define PK4(P, BASE, OUT) do { unsigned a0 = cvtpk(P[BASE + 0], P[BASE + 1]), a1 = cvtpk(P[BASE + 2], P[BASE + 3]);   \
    unsigned b0 = cvtpk(P[BASE + 4], P[BASE + 5]), b1 = cvtpk(P[BASE + 6], P[BASE + 7]);                              \
    auto r0 = __builtin_amdgcn_permlane32_swap(a0, b0, false, false); auto r1 = __builtin_amdgcn_permlane32_swap(a1, b1, false, false); \
    v4u w_ = {r0[0], r1[0], r0[1], r1[1]}; OUT = __builtin_bit_cast(bf16x8, w_); } while (0)
template <int OFF> __device__ __forceinline__ void pv_step(f32x16& o, int vb, bf16x8 pa) {
    const s16x4 l = tr_read<OFF>(vb), h = tr_read<OFF + 2048>(vb);
    asm volatile("s_waitcnt lgkmcnt(0)" ::: "memory"); __builtin_amdgcn_sched_barrier(0);
    o = __builtin_amdgcn_mfma_f32_32x32x16_bf16(pa, (bf16x8){l[0], l[1], l[2], l[3], h[0], h[1], h[2], h[3]}, o, 0, 0, 0);
}
__device__ __forceinline__ void store_block(const f32x16& o, const LAS float* il, LAS unsigned short* stg, char* dst0, long rstride, int lane) {
    asm volatile("" : "+v"(lane));
    const int r32 = lane & 31, hi = lane >> 5;
#pragma unroll
    for (int r = 0; r < 16; ++r) { const int row = crow(r, hi); stg[row * 32 + r32] = (unsigned short)f2bf(o[r] * il[row]); }
    LDS_WAIT(); asm volatile("" ::: "memory");
#pragma unroll
    for (int p = 0; p < 2; ++p) { const int row = 16 * p + (lane >> 2), ch = lane & 3;
        const v4u w = *(const LAS v4u*)((const LAS unsigned char*)stg + row * 64 + ch * 16);
        *(GAS v4u*)(dst0 + (long)row * rstride + ch * 16) = w; }
    LDS_WAIT(); asm volatile("" ::: "memory");
}
}

#define RAW_BAR() do { asm volatile("s_waitcnt lgkmcnt(0)" ::: "memory"); __builtin_amdgcn_s_barrier(); asm volatile("" ::: "memory"); } while (0)
__device__ __forceinline__ void p2_attention(Frame& F) {
    using namespace att;
    LAS unsigned char* Kl = F.lds + LDS_K; LAS unsigned char* Vl = F.lds + LDS_V;
    LAS unsigned short* stg = (LAS unsigned short*)(F.lds + LDS_STG + F.wave * 2048);
    LAS float* li = (LAS float*)(F.lds + LDS_LI + F.wave * 256);
    LAS float* gtab = (LAS float*)(F.lds + LDS_GT);
    LAS float* rk = (LAS float*)(F.lds + LDS_GT + 2048);
    volatile LAS int* QN = (volatile LAS int*)(F.lds + LDS_GT + 2048 + 1024);
    const int tid = F.tid, wave = F.wave;
    if (blockIdx.x < 8) {
        pg8::Gemm g{(const bf16*)(F.ws + WS_H), (const bf16*)(F.ws + WS_WIN), D, nullptr}; pg8::P1Order S{F.G, (int)blockIdx.x, 2560, 2568};
        pg8::EpiProj E{(bf16*)(F.ws + WS_R1), (bf16*)(F.ws + WS_MEMKV)};
        pg8::gemm_phase<pg8::EpiProj, pg8::P1Order>(F.lds, g, S, E);
        VM_WAIT(); __syncthreads();
        if (tid == 0) { __builtin_amdgcn_fence(__ATOMIC_RELEASE, "agent"); asm volatile("s_waitcnt vmcnt(0)" ::: "memory"); __hip_atomic_fetch_add(F.ctl + CW_KVREADY, 1u, RLX_AGENT); }
    }
    if (tid < 128) { gtab[tid] = F.q_norm_g[tid] * F.k_norm_g[tid]; gtab[128 + tid] = F.mem_q_norm_g[tid] * F.mem_k_norm_g[tid]; gtab[256 + tid] = F.mem_q_norm_g[tid]; gtab[384 + tid] = F.mem_k_norm_g[tid]; }
    if (tid == 0) QN[0] = 1 << 30;
    __syncthreads();
    float MD, MM;
    { float a = 0.f, c = 0.f;
#pragma unroll 1
      for (int i = 0; i < 128; ++i) { a = fmaxf(a, fabsf(gtab[i])); c = fmaxf(c, fabsf(gtab[128 + i])); }
      MD = a * (128.0f * 1.03f) * CS; MM = c * (128.0f * 1.03f) * CS; }
    const char* proj = (const char*)(F.ws + WS_R1);

    {
    const int j = wave & 3, dh = wave >> 2, w0 = 32 * j + 16 * dh;
    constexpr int NCHUNK = 6144 / 4;
    v4u qraw[4];
#define DECODE(u, br, b, h, r, nb, dil) const int br = (u) >> 11, _rem = (u) & 2047, b = _rem >> 10, h = (_rem >> 7) & 7, _w = _rem & 127, dil = 1 << (2 * br), _nps = 128 >> (2 * br), r = _w / _nps, nb = _w % _nps
    int u = 4 * F.vcu;
    bool have = F.vcu < NCHUNK;
    bool full = true;
    if (have) {
        DECODE(u, br, b, h, r, nb, dil);
        const long rs = (long)dil * PROJ * 2; const char* tb = proj + (size_t)(b * SEQ + r) * (PROJ * 2);
        RowMap mk{tb + (COL_K + h * HD) * 2, rs, 128 * nb - 128, true};
        dma_k(Kl, 0, 256, mk, wave, F.lane);
        load_q16(qraw, tb + (long)(128 * nb + w0 + (F.lane & 15)) * rs + (COL_Q + h * HD) * 2, F.lane >> 4);
    }
    while (have) {
        DECODE(u, br, b, h, r, nb, dil);
        int lane = F.lane; asm volatile("" : "+v"(lane));
        const int q16 = lane & 15, kg = lane >> 4;
        const int off = 128 * ((nb + 1) & 1);
        const long rs_ = (long)dil * PROJ * 2; const char* tb_ = proj + (size_t)(b * SEQ + r) * (PROJ * 2);
        asm volatile("s_waitcnt vmcnt(0)" ::: "memory"); RAW_BAR();
        { RowMap mv{tb_ + (COL_V + h * HD) * 2, rs_, 128 * nb - 128, true};
          if (full) dma_v2(Vl, 0, 256, mv, wave, lane); else dma_v2(Vl, 128 * (nb & 1), 128, mv, wave, lane); }
        if ((u & 3) == 0 && tid == 0) QN[0] = F.G + (int)__hip_atomic_fetch_add(F.ctl + CW_ATTQ, 1u, RLX_AGENT);
        { const int p0 = full ? 0 : 128 * (nb & 1), n4 = full ? 1024 : 512;
#pragma unroll 1
          for (int idx = tid; idx < n4; idx += 512) { const int row = p0 + (idx >> 2), qd = idx & 3; float ss = 0.f;
#pragma unroll
              for (int i = 0; i < 4; ++i) { const v4u w = *(const LAS v4u*)(Kl + KSWZ(row, (4 * qd + i) * 16));
#pragma unroll
                  for (int jj = 0; jj < 4; ++jj) { const float a = bflo(w[jj]), c = bfhi(w[jj]); ss += a * a + c * c; } }
              ss += __shfl_xor(ss, 1); ss += __shfl_xor(ss, 2);
              if (qd == 0) rk[row] = 1.0f / sqrtf(ss * (1.f / HD) + EPS); } }
        bf16x8 qr[4];
        norm_q16(qraw, qr, gtab, kg);
        f32x4 s[9];
#pragma unroll
        for (int t = 0; t < 9; ++t) { const int pb = (w0 + 16 * t + off) & 255; f32x4 a = {0.f, 0.f, 0.f, 0.f};
#pragma unroll
            for (int d = 0; d < 4; ++d) { const bf16x8 kf = *(const LAS bf16x8*)(Kl + KSWZ(pb + q16, 64 * d + 16 * kg));
                a = __builtin_amdgcn_mfma_f32_16x16x32_bf16(kf, qr[d], a, 0, 0, 0); }
            s[t] = a; }
        RAW_BAR();
        int un = u + 1; bool has_next = true;
        if ((un & 3) == 0) { const int nc = QN[0]; has_next = nc < NCHUNK; un = 4 * nc; }
        bool n_full = false;
        if (has_next) {
            DECODE(un, br2, b2, h2, r2, nb2, dil2);
            n_full = (un != u + 1) || (nb2 == 0);
            const long rs = (long)dil2 * PROJ * 2; const char* tb = proj + (size_t)(b2 * SEQ + r2) * (PROJ * 2);
            RowMap nmk{tb + (COL_K + h2 * HD) * 2, rs, 128 * nb2 - 128, true};
            if (n_full) dma_k(Kl, 0, 256, nmk, wave, lane); else dma_k(Kl, 128 * (nb2 & 1), 128, nmk, wave, lane);
            load_q16(qraw, tb + (long)(128 * nb2 + w0 + q16) * rs + (COL_Q + h2 * HD) * 2, kg);
        }
        const float bias2 = __builtin_amdgcn_exp2f(-(float)(h + 1)) * (float)dil * LOG2E;
        const float rowoff = bias2 * (float)(4 * kg - q16 - 128) - MD;
        float l = 0.f;
#pragma unroll
        for (int t = 0; t < 9; ++t) {
            const int pb = (w0 + 16 * t + off) & 255;
            const f32x4 rkv = *(const LAS f32x4*)(rk + pb + 4 * kg);
            const bool dead = (nb == 0) && (w0 + 16 * t < 128);
#pragma unroll
            for (int r_ = 0; r_ < 4; ++r_) {
                float v = fmaf(s[t][r_] * rkv[r_], CS, fmaf(bias2, (float)(16 * t + r_), rowoff));
                if (t == 0) v = (4 * kg + r_ >= q16) ? v : -1.0e30f;
                if (t == 8) v = (4 * kg + r_ <= q16) ? v : -1.0e30f;
                v = dead ? 0.f : __builtin_amdgcn_exp2f(v); s[t][r_] = v; l += v; }
        }
        l += __shfl_xor(l, 16); l += __shfl_xor(l, 32);
        bf16x8 pa[5];
#pragma unroll
        for (int sp = 0; sp < 5; ++sp) { v4u w; w.x = cvtpk(s[2 * sp][0], s[2 * sp][1]); w.y = cvtpk(s[2 * sp][2], s[2 * sp][3]);
            if (sp < 4) { w.z = cvtpk(s[2 * sp + 1][0], s[2 * sp + 1][1]); w.w = cvtpk(s[2 * sp + 1][2], s[2 * sp + 1][3]); } else { w.z = 0u; w.w = 0u; }
            pa[sp] = __builtin_bit_cast(bf16x8, w); }
        if (has_next) asm volatile("s_waitcnt vmcnt(8)" ::: "memory"); else asm volatile("s_waitcnt vmcnt(0)" ::: "memory");
        RAW_BAR();
        f32x4 o[8];
#pragma unroll
        for (int db = 0; db < 8; ++db) o[db] = (f32x4){0.f, 0.f, 0.f, 0.f};
        { const int qq = q16 >> 2, pp = q16 & 3;
#pragma unroll
          for (int sp = 0; sp < 5; ++sp) {
              const int ra = (w0 + 32 * sp + off + 4 * kg + qq) & 255, rb = (w0 + 32 * sp + 16 + off + 4 * kg + qq) & 255;
              const int va = (int)(uintptr_t)Vl + ra * 256 + 8 * pp, vb = (int)(uintptr_t)Vl + rb * 256 + 8 * pp, xa = (ra & 7) << 5, xb = (rb & 7) << 5;
#pragma unroll
              for (int dq = 0; dq < 2; ++dq) {
                  s16x4 la[4], lb[4];
#pragma unroll
                  for (int i = 0; i < 4; ++i) { const int db = 4 * dq + i;
                      asm volatile("ds_read_b64_tr_b16 %0, %1" : "=&v"(la[i]) : "v"(va + ((32 * db) ^ xa)) : "memory");
                      asm volatile("ds_read_b64_tr_b16 %0, %1" : "=&v"(lb[i]) : "v"(vb + ((32 * db) ^ xb)) : "memory"); }
                  asm volatile("s_waitcnt lgkmcnt(0)" ::: "memory"); __builtin_amdgcn_sched_barrier(0);
#pragma unroll
                  for (int i = 0; i < 4; ++i) { const int db = 4 * dq + i;
                      o[db] = __builtin_amdgcn_mfma_f32_16x16x32_bf16(pa[sp], (bf16x8){la[i][0], la[i][1], la[i][2], la[i][3], lb[i][0], lb[i][1], lb[i][2], lb[i][3]}, o[db], 0, 0, 0); }
              } } }
        const float il = 1.0f / l;
        if (kg == 0) li[q16] = il;
        LDS_WAIT(); asm volatile("" ::: "memory");
        const f32x4 ilr = *(const LAS f32x4*)(li + 4 * kg);
        const int tok0 = b * SEQ + r + dil * (128 * nb + w0);
        char* dst = (char*)(F.ws + WS_OPART) + ((size_t)br * T + tok0) * (ATTN_W * 2) + (h * HD) * 2;
#pragma unroll
        for (int hf = 0; hf < 2; ++hf) {
#pragma unroll
            for (int i = 0; i < 4; ++i)
#pragma unroll
                for (int r_ = 0; r_ < 4; ++r_) stg[(4 * kg + r_) * 64 + 16 * i + q16] = (unsigned short)f2bf(o[4 * hf + i][r_] * ilr[r_]);
            LDS_WAIT(); asm volatile("" ::: "memory");
#pragma unroll
            for (int p = 0; p < 2; ++p) { const int row = lane >> 2, ch = (lane & 3) + 4 * p;
                const v4u w = *(const LAS v4u*)((const LAS unsigned char*)stg + row * 128 + ch * 16);
                *(GAS v4u*)(dst + (long)row * ((long)dil * ATTN_W * 2) + hf * 128 + ch * 16) = w; }
            LDS_WAIT(); asm volatile("" ::: "memory");
        }
        if (kg == 0) ((float*)(F.ws + WS_LSE))[((size_t)br * T + tok0 + dil * q16) * 8 + h] = MD + __builtin_amdgcn_logf(l);
        have = has_next; u = un; full = n_full;
    }
#undef DECODE
    }

    VM_WAIT(); __syncthreads();
    if (wave == 0) { unsigned sp = 0;
        while (__builtin_amdgcn_readfirstlane(__hip_atomic_load(F.ctl + CW_KVREADY, RLX_AGENT)) < 8u) { __builtin_amdgcn_s_sleep(2); if (++sp > (1u << 22)) { if (F.lane == 0) __hip_atomic_store(F.ctl + CW_TMO, 1u, RLX_AGENT); break; } }
        __builtin_amdgcn_fence(__ATOMIC_ACQUIRE, "agent"); asm volatile("s_waitcnt vmcnt(0)" ::: "memory"); }
    __syncthreads();
    for (int it = F.vcu; it < 256; it += F.G) {
        const int combo = it >> 5, part = it & 31, b = combo >> 2, hm = combo & 3;
        const char* mkv = (const char*)(F.ws + WS_MEMKV) + (size_t)(b * NMEM) * 2048 + hm * 256;
        RowMap mk{mkv, 2048, 0, false}, mv{mkv + 1024, 2048, 0, false};
        __syncthreads();
        dma_k(Kl, 0, 256, mk, wave, F.lane); dma_v(Vl, 0, 256, mv, wave, F.lane);
        VM_WAIT(); __syncthreads();
        norm_k(Kl, 0, 256, gtab + 384, tid);
        __syncthreads();
        for (int qb = 0; qb < 2; ++qb) {
            int lane = F.lane; asm volatile("" : "+v"(lane));
            const int r32 = lane & 31, hi = lane >> 5, vbase = (int)(uintptr_t)Vl + v_rd_base(lane);
            const int tok = b * SEQ + part * 512 + qb * 256 + wave * 32 + r32;
            v4u raw[8]; bf16x8 qr[8];
            load_q(raw, proj + (size_t)tok * (PROJ * 2) + (COL_MQ + hm * HD) * 2, hi);
            norm_q(raw, qr, gtab + 256, hi);
            const float mc = -MM; float l = 0.f;
            f32x16 o[4] = {};
#pragma unroll 1
            for (int hk = 0; hk < 2; ++hk) {
                bf16x8 pa[8];
#pragma unroll
                for (int kt = 0; kt < 4; ++kt) { f32x16 s = qk_tile(Kl, 128 * hk + 32 * kt, qr, r32, hi);
#pragma unroll
                    for (int r = 0; r < 16; ++r) { s[r] = __builtin_amdgcn_exp2f(fmaf(s[r], CS, mc)); l += s[r]; }
                    PK4(s, 0, pa[2 * kt]); PK4(s, 8, pa[2 * kt + 1]); }
#pragma unroll
                for (int f = 0; f < 8; ++f) { const int vb = vbase + (8 * hk + f) * 4096;
                    pv_step<0>(o[0], vb, pa[f]); pv_step<512>(o[1], vb, pa[f]); pv_step<1024>(o[2], vb, pa[f]); pv_step<1536>(o[3], vb, pa[f]); }
            }
            l = xsum32(l);
            if (hi == 0) li[r32] = 1.0f / l;
            LDS_WAIT(); asm volatile("" ::: "memory");
            char* dst = (char*)(F.ws + WS_MEMO) + (size_t)(tok - r32) * (MEM_W * 2) + hm * 256;
#pragma unroll
            for (int d0 = 0; d0 < 4; ++d0) store_block(o[d0], li, stg, dst + d0 * 64, MEM_W * 2, lane);
        }
    }
}

__device__ __forceinline__ void unpack8(const v4u w, float (&f)[8]) { f[0] = bflo(w.x); f[1] = bfhi(w.x); f[2] = bflo(w.y); f[3] = bfhi(w.y); f[4] = bflo(w.z); f[5] = bfhi(w.z); f[6] = bflo(w.w); f[7] = bfhi(w.w); }
__device__ __forceinline__ void p3_combine(Frame& F) {
    const int gw = F.vcu * NWAVES + F.wave, NGW = F.G * NWAVES, lane = F.lane;
    const bf16* proj = (const bf16*)(F.ws + WS_R1); const bf16* opart = (const bf16*)(F.ws + WS_OPART); const float* lse = (const float*)(F.ws + WS_LSE);
    const bf16* memo = (const bf16*)(F.ws + WS_MEMO); bf16* Y = (bf16*)(F.ws + WS_Y);
    for (int t = gw; t < T; t += NGW) {
        float a[16]; float ssa = 0.f;
#pragma unroll
        for (int cc = 0; cc < 2; ++cc) { const int head = 4 * cc + (lane >> 4);
            const float l0 = lse[((size_t)0 * T + t) * 8 + head], l1 = lse[((size_t)1 * T + t) * 8 + head], l2 = lse[((size_t)2 * T + t) * 8 + head];
            const float mx = fmaxf(l0, fmaxf(l1, l2)); float w0 = __builtin_amdgcn_exp2f(l0 - mx), w1 = __builtin_amdgcn_exp2f(l1 - mx), w2 = __builtin_amdgcn_exp2f(l2 - mx);
            const float inv = 1.0f / (w0 + w1 + w2); w0 *= inv; w1 *= inv; w2 *= inv;
            float f0[8], f1[8], f2[8];
            unpack8(__builtin_nontemporal_load((const GAS v4u*)(opart + ((size_t)0 * T + t) * ATTN_W + cc * 512 + 8 * lane)), f0);
            unpack8(__builtin_nontemporal_load((const GAS v4u*)(opart + ((size_t)1 * T + t) * ATTN_W + cc * 512 + 8 * lane)), f1);
            unpack8(__builtin_nontemporal_load((const GAS v4u*)(opart + ((size_t)2 * T + t) * ATTN_W + cc * 512 + 8 * lane)), f2);
#pragma unroll
            for (int jj = 0; jj < 8; ++jj) { const float v = w0 * f0[jj] + w1 * f1[jj] + w2 * f2[jj]; a[8 * cc + jj] = v; ssa += v * v; } }
        float co[8]; float ssc = 0.f;
        { const int s = t & (SEQ - 1); float bg[8], c0[8], uu0[8], c1[8], uu1[8], c2[8], uu2[8];
          const bf16* p0 = proj + (size_t)t * PROJ + 8 * lane;
          unpack8(*(const GAS v4u*)(p0 + COL_B), bg); unpack8(*(const GAS v4u*)(p0 + COL_C), c0); unpack8(*(const GAS v4u*)(p0 + COL_U), uu0);
          if (s >= 1) { unpack8(*(const GAS v4u*)(p0 - PROJ + COL_C), c1); unpack8(*(const GAS v4u*)(p0 - PROJ + COL_U), uu1); }
          if (s >= 2) { unpack8(*(const GAS v4u*)(p0 - 2 * PROJ + COL_C), c2); unpack8(*(const GAS v4u*)(p0 - 2 * PROJ + COL_U), uu2); }
#pragma unroll
          for (int jj = 0; jj < 8; ++jj) { const int c = 8 * lane + jj;
              const float z0 = c0[jj] * uu0[jj], z1 = (s >= 1) ? c1[jj] * uu1[jj] : 0.f, z2 = (s >= 2) ? c2[jj] * uu2[jj] : 0.f;
              const float v = bg[jj] * (F.conv_w[c] * z2 + F.conv_w[CONV_W + c] * z1 + F.conv_w[2 * CONV_W + c] * z0); co[jj] = v; ssc += v * v; } }
        float mo[8]; float ssm = 0.f;
        unpack8(__builtin_nontemporal_load((const GAS v4u*)(memo + (size_t)t * MEM_W + 8 * lane)), mo);
#pragma unroll
        for (int jj = 0; jj < 8; ++jj) ssm += mo[jj] * mo[jj];
#pragma unroll
        for (int o = 1; o < 64; o <<= 1) { ssa += __shfl_xor(ssa, o); ssc += __shfl_xor(ssc, o); ssm += __shfl_xor(ssm, o); }
        const float ra = 1.0f / sqrtf(ssa * (1.f / ATTN_W) + EPS), rc = 1.0f / sqrtf(ssc * (1.f / CONV_W) + EPS), rm = 1.0f / sqrtf(ssm * (1.f / MEM_W) + EPS);
        bf16* yr = Y + (size_t)t * D;
#pragma unroll
        for (int cc = 0; cc < 2; ++cc) { const float* g = F.out_norm_g + cc * 512 + 8 * lane; v4u w;
            w.x = pk2(a[8 * cc + 0] * ra * g[0], a[8 * cc + 1] * ra * g[1]); w.y = pk2(a[8 * cc + 2] * ra * g[2], a[8 * cc + 3] * ra * g[3]);
            w.z = pk2(a[8 * cc + 4] * ra * g[4], a[8 * cc + 5] * ra * g[5]); w.w = pk2(a[8 * cc + 6] * ra * g[6], a[8 * cc + 7] * ra * g[7]);
            *(GAS v4u*)(yr + cc * 512 + 8 * lane) = w; }
        { const float* g = F.out_norm_g + ATTN_W + 8 * lane; v4u w;
          w.x = pk2(co[0] * rc * g[0], co[1] * rc * g[1]); w.y = pk2(co[2] * rc * g[2], co[3] * rc * g[3]); w.z = pk2(co[4] * rc * g[4], co[5] * rc * g[5]); w.w = pk2(co[6] * rc * g[6], co[7] * rc * g[7]);
          *(GAS v4u*)(yr + ATTN_W + 8 * lane) = w; }
        { const float* g = F.out_norm_g + ATTN_W + CONV_W + 8 * lane; v4u w;
          w.x = pk2(mo[0] * rm * g[0], mo[1] * rm * g[1]); w.y = pk2(mo[2] * rm * g[2], mo[3] * rm * g[3]); w.z = pk2(mo[4] * rm * g[4], mo[5] * rm * g[5]); w.w = pk2(mo[6] * rm * g[6], mo[7] * rm * g[7]);
          *(GAS v4u*)(yr + ATTN_W + CONV_W + 8 * lane) = w; }
    }
}

__device__ __forceinline__ float max8(float v) { v = fmaxf(v, __shfl_xor(v, 1)); v = fmaxf(v, __shfl_xor(v, 2)); v = fmaxf(v, __shfl_xor(v, 4)); return v; }
namespace rt {
constexpr int KC = 128, NCH = D / KC, BP = KC * 2 + 16, BUFB = 2 * 96 * BP;
__device__ __forceinline__ void issue_b(v4u (&bst)[6], const bf16* WT, int c, int tid) {
#pragma unroll
    for (int i = 0; i < 6; ++i) { const int p = tid + 512 * i, arr = p / 1536, rem = p - arr * 1536, n = rem >> 4, ch = rem & 15;
        bst[i] = *(const GAS v4u*)(WT + ((size_t)arr * 96 + n) * 2048 + c * KC + ch * 8); }
}
__device__ __forceinline__ void write_b(const v4u (&bst)[6], LAS unsigned char* buf, int tid) {
#pragma unroll
    for (int i = 0; i < 6; ++i) { const int p = tid + 512 * i, arr = p / 1536, rem = p - arr * 1536, n = rem >> 4, ch = rem & 15;
        *(LAS v4u*)(buf + arr * (96 * BP) + n * BP + ch * 16) = bst[i]; }
}
__device__ __forceinline__ void issue_a(f32x4 (&a)[4][2], const float* xrow, int c) {
#pragma unroll
    for (int ks = 0; ks < 4; ++ks) { a[ks][0] = *(const GAS f32x4*)(xrow + c * KC + ks * 32); a[ks][1] = *(const GAS f32x4*)(xrow + c * KC + ks * 32 + 4); }
}
__device__ __forceinline__ void compute(f32x4 (&acc)[6], float& ss, const f32x4 (&a)[4][2], const LAS unsigned char* buf, int fr, int kg) {
#pragma unroll
    for (int ks = 0; ks < 4; ++ks) {
        const f32x4 f0 = a[ks][0], f1 = a[ks][1];
        ss += (f0.x * f0.x + f0.y * f0.y) + (f0.z * f0.z + f0.w * f0.w) + (f1.x * f1.x + f1.y * f1.y) + (f1.z * f1.z + f1.w * f1.w);
        asm volatile("" : "+v"(ss));
        v4u h; h.x = cvtpk(f0.x, f0.y); h.y = cvtpk(f0.z, f0.w); h.z = cvtpk(f1.x, f1.y); h.w = cvtpk(f1.z, f1.w);
        v4u l; l.x = cvtpk(f0.x - bflo(h.x), f0.y - bfhi(h.x)); l.y = cvtpk(f0.z - bflo(h.y), f0.w - bfhi(h.y)); l.z = cvtpk(f1.x - bflo(h.z), f1.y - bfhi(h.z)); l.w = cvtpk(f1.z - bflo(h.w), f1.w - bfhi(h.w));
        const bf16x8 ah = __builtin_bit_cast(bf16x8, h), al = __builtin_bit_cast(bf16x8, l);
#pragma unroll
        for (int nb = 0; nb < 6; ++nb) { const LAS unsigned char* bp = buf + (nb * 16 + fr) * BP + (ks * 32 + 8 * kg) * 2;
            const bf16x8 bh = *(const LAS bf16x8*)bp, bl = *(const LAS bf16x8*)(bp + 96 * BP);
            acc[nb] = __builtin_amdgcn_mfma_f32_16x16x32_bf16(ah, bh, acc[nb], 0, 0, 0);
            acc[nb] = __builtin_amdgcn_mfma_f32_16x16x32_bf16(al, bh, acc[nb], 0, 0, 0);
            acc[nb] = __builtin_amdgcn_mfma_f32_16x16x32_bf16(ah, bl, acc[nb], 0, 0, 0); }
    }
}
}
__device__ __forceinline__ void p5_router(Frame& F) {
    using namespace rt;
    const int tid = F.tid, wave = F.wave;
    const float* X1 = F.out; const bf16* WT = (const bf16*)(F.ws + WS_WR);
    LAS unsigned char* Bl = F.lds;
    LAS float* Lg = (LAS float*)(F.lds + 2 * BUFB + wave * (16 * 97 * 4));
    unsigned* cnt = F.ctl + CW_CNT;
    int* tok_e = (int*)(F.ws + WS_TOK + TOK_E); int* tok_rank = (int*)(F.ws + WS_TOK + TOK_RANK);
    for (int mt = F.vcu; mt < T / 128; mt += F.G) {
        int lane = F.lane; asm volatile("" : "+v"(lane));
        const int fr = lane & 15, kg = lane >> 4;
        const int t0 = mt * 128 + wave * 16;
        const float* xrow = X1 + (size_t)(t0 + fr) * D + 8 * kg;
        f32x4 acc[6];
#pragma unroll
        for (int i = 0; i < 6; ++i) acc[i] = (f32x4){0.f, 0.f, 0.f, 0.f};
        float ss = 0.f;
        v4u bst[6]; f32x4 a0[4][2], a1[4][2];
        __syncthreads();
        issue_b(bst, WT, 0, tid); issue_a(a0, xrow, 0);
#pragma unroll 1
        for (int c = 0; c < NCH; c += 2) {
            write_b(bst, Bl, tid); __syncthreads();
            issue_b(bst, WT, c + 1, tid); issue_a(a1, xrow, c + 1);
            compute(acc, ss, a0, Bl, fr, kg);
            write_b(bst, Bl + BUFB, tid); __syncthreads();
            if (c + 2 < NCH) { issue_b(bst, WT, c + 2, tid); issue_a(a0, xrow, c + 2); }
            compute(acc, ss, a1, Bl + BUFB, fr, kg);
        }
        ss += __shfl_xor(ss, 16); ss += __shfl_xor(ss, 32);
        const float rs_row = 1.0f / sqrtf(ss * (1.f / D) + EPS);
#pragma unroll
        for (int r = 0; r < 4; ++r) { const float rr = __shfl(rs_row, 4 * kg + r);
#pragma unroll
            for (int nb = 0; nb < 6; ++nb) Lg[(4 * kg + r) * 97 + nb * 16 + fr] = acc[nb][r] * rr; }
        LDS_WAIT(); asm volatile("" ::: "memory");
        const float be = F.b_re[lane], bg = F.b_rg[lane & 7];
        int my_e1 = 0, my_e2 = 0; float my_g1 = 0.f, my_g2 = 0.f;
#pragma unroll 4
        for (int tk = 0; tk < 16; ++tk) {
            const float gl = Lg[tk * 97 + 64 + (lane & 7)] + bg;
            const float el = Lg[tk * 97 + lane] + be;
            const float gmax = max8(gl);
            const int gi = __builtin_ctzll(__ballot(gl == gmax) & 0xFFull);
            float gs = __builtin_amdgcn_exp2f((gl - gmax) * LOG2E); gs += __shfl_xor(gs, 1); gs += __shfl_xor(gs, 2); gs += __shfl_xor(gs, 4);
            const float gwt = 1.0f / gs;
            const float v1 = __shfl(max8(el), 8 * gi);
            const int i1 = __builtin_ctzll((__ballot(el == v1) >> (8 * gi)) & 0xFFull);
            const float el2 = (lane == 8 * gi + i1) ? -3.0e38f : el;
            const float v2 = __shfl(max8(el2), 8 * gi);
            const int i2 = __builtin_ctzll((__ballot(el2 == v2) >> (8 * gi)) & 0xFFull);
            const float pr = __builtin_amdgcn_exp2f((v2 - v1) * LOG2E), den = 1.0f / (1.0f + pr);
            if (lane == tk) { my_e1 = 8 * gi + i1; my_e2 = 8 * gi + i2; my_g1 = gwt * den; my_g2 = gwt * pr * den; }
        }
        LAS unsigned* hist = (LAS unsigned*)(F.lds + MISC_OFF + 256);
        if (tid < 64) hist[tid] = 0u;
        __syncthreads();
        unsigned lr1 = 0u, lr2 = 0u;
        if (lane < 16) { lr1 = __hip_atomic_fetch_add(hist + my_e1, 1u, __ATOMIC_RELAXED, __HIP_MEMORY_SCOPE_WORKGROUP); lr2 = __hip_atomic_fetch_add(hist + my_e2, 1u, __ATOMIC_RELAXED, __HIP_MEMORY_SCOPE_WORKGROUP); }
        __syncthreads();
        if (tid < 64) { const unsigned c = hist[tid]; hist[64 + tid] = c ? __hip_atomic_fetch_add(cnt + 64 * tid, c, RLX_AGENT) : 0u; }
        __syncthreads();
        if (lane < 16) {
            const int t = t0 + lane;
            const int k1 = (int)(hist[64 + my_e1] + lr1), k2 = (int)(hist[64 + my_e2] + lr2);
            tok_e[2 * t] = my_e1; tok_e[2 * t + 1] = my_e2; tok_rank[2 * t] = k1; tok_rank[2 * t + 1] = k2;
            int* ltok = (int*)(F.ws + WS_LIST + LIST_TOK); float* lrs = (float*)(F.ws + WS_LIST + LIST_RSTD); float* lgt = (float*)(F.ws + WS_LIST + LIST_GATE);
            ltok[my_e1 * CAP + k1] = t; ltok[my_e2 * CAP + k2] = t; lrs[my_e1 * CAP + k1] = rs_row; lrs[my_e2 * CAP + k2] = rs_row; lgt[my_e1 * CAP + k1] = my_g1; lgt[my_e2 * CAP + k2] = my_g2;
        }
    }
}

constexpr int MOE_MT = MISC_OFF + 48, MOE_PST = MISC_OFF + 64, MOE_TE = MOE_PST + 256;
constexpr int MOE_TB = LDS_EXTRA, MOE_VR = MOE_TB + MAXTILES * 4, MOE_UT = MOE_VR + MAXTILES * 4;
constexpr int MOE_MAXU = 12;
static_assert(MOE_UT + MOE_MAXU * 256 * 4 <= MISC_OFF && MOE_TE + MAXTILES * 4 <= LDS_BYTES, "LDS map");
__device__ __forceinline__ int moe_tables(Frame& F) {
    LAS int* PST = (LAS int*)(F.lds + MOE_PST); LAS int* TE = (LAS int*)(F.lds + MOE_TE); LAS int* MTp = (LAS int*)(F.lds + MOE_MT); LAS int* TB = (LAS int*)(F.lds + MOE_TB); LAS int* VR = (LAS int*)(F.lds + MOE_VR);
    __syncthreads();
    if (F.tid < 64) {
        const int c = (int)__hip_atomic_load(F.ctl + CW_CNT + 64 * F.tid, RLX_AGENT); const int nt = (c + 255) >> 8;
        int x = nt;
#pragma unroll
        for (int o = 1; o < 64; o <<= 1) { const int y = __shfl_up(x, o); if (F.lane >= o) x += y; }
        const int ex = x - nt; PST[F.tid] = ex; if (F.tid == 63) MTp[0] = x;
        for (int i = 0; i < nt; ++i) { TE[ex + i] = F.tid; TB[ex + i] = F.tid * CAP + 256 * i; VR[ex + i] = (c - 256 * i) < 256 ? (c - 256 * i) : 256; }
    }
    __syncthreads();
    return MTp[0];
}

__device__ __forceinline__ void p9_final(Frame& F) {
    (void)moe_tables(F);
    const LAS int* PST = (const LAS int*)(F.lds + MOE_PST);
    const int gw = F.vcu * NWAVES + F.wave, NGW = F.G * NWAVES, lane = F.lane;
    const int* tok_e = (const int*)(F.ws + WS_TOK + TOK_E); const int* tok_rank = (const int*)(F.ws + WS_TOK + TOK_RANK); const bf16* YB = (const bf16*)(F.ws + WS_R1);
    typedef int i32x2 __attribute__((ext_vector_type(2)));
    i32x2 ce = {0, 0}, cr = {0, 0};
    if (gw < T) { ce = *(const GAS i32x2*)(tok_e + 2 * gw); cr = *(const GAS i32x2*)(tok_rank + 2 * gw); }
    for (int t = gw; t < T; t += NGW) {
        const int s1 = PST[ce.x] * 256 + cr.x, s2 = PST[ce.y] * 256 + cr.y;
        if (t + NGW < T) { ce = *(const GAS i32x2*)(tok_e + 2 * (t + NGW)); cr = *(const GAS i32x2*)(tok_rank + 2 * (t + NGW)); }
        const GAS v4u* y1 = (const GAS v4u*)(YB + (size_t)s1 * D) + lane; const GAS v4u* y2 = (const GAS v4u*)(YB + (size_t)s2 * D) + lane;
        GAS f32x4* o = (GAS f32x4*)(F.out + (size_t)t * D) + 2 * lane;
#pragma unroll
        for (int i = 0; i < 4; ++i) { float a[8], b[8]; unpack8(__builtin_nontemporal_load(y1 + 64 * i), a); unpack8(__builtin_nontemporal_load(y2 + 64 * i), b);
            f32x4 v0 = __builtin_nontemporal_load(o + 128 * i), v1 = __builtin_nontemporal_load(o + 128 * i + 1);
            v0.x += a[0] + b[0]; v0.y += a[1] + b[1]; v0.z += a[2] + b[2]; v0.w += a[3] + b[3]; v1.x += a[4] + b[4]; v1.y += a[5] + b[5]; v1.z += a[6] + b[6]; v1.w += a[7] + b[7];
            __builtin_nontemporal_store(v0, o + 128 * i); __builtin_nontemporal_store(v1, o + 128 * i + 1); }
    }
}

constexpr int PER_PHASE = 10;
constexpr int N_LAUNCHES = MK_N_LAUNCHES;
struct Args { const float* in[21]; float* out; unsigned char* ws; int ph_lo, ph_hi, li, pad; };
__global__ void __launch_bounds__(NWAVES * 64, 2) hymba_fwd(Args args) {
    extern __shared__ __attribute__((aligned(16))) unsigned char lds[];
    Frame F;
    F.lds = (LAS unsigned char*)lds;
    F.tid = threadIdx.x; F.lane = F.tid & 63; F.wave = __builtin_amdgcn_readfirstlane(F.tid >> 6);
    F.G = gridDim.x; { const int bx = blockIdx.x; F.vcu = (F.G % 8 == 0) ? (bx % 8) * (F.G / 8) + bx / 8 : bx; }
    F.ws = args.ws; F.ctl = (unsigned*)(args.ws + WS_CTL); F.out = args.out;
    F.x = args.in[0]; F.mem = args.in[1]; F.norm1_g = args.in[2]; F.w_in = args.in[3]; F.q_norm_g = args.in[4]; F.k_norm_g = args.in[5]; F.conv_w = args.in[6];
    F.mem_norm_g = args.in[7]; F.w_mem_kv = args.in[8]; F.mem_q_norm_g = args.in[9]; F.mem_k_norm_g = args.in[10]; F.out_norm_g = args.in[11]; F.w_out = args.in[12];
    F.norm2_g = args.in[13]; F.w_rg = args.in[14]; F.b_rg = args.in[15]; F.w_re = args.in[16]; F.b_re = args.in[17]; F.w_gate = args.in[18]; F.w_up = args.in[19]; F.w_down = args.in[20];
    volatile LAS unsigned* MISC = (volatile LAS unsigned*)(F.lds + MISC_OFF);
    if (F.tid < 16) MISC[F.tid] = 0u;
    __syncthreads();
    const int lo = args.ph_lo, hi = args.ph_hi;
    const bool multi = (hi - lo) > 1;
    XcdBarrier bar; bar.bar = F.ctl + CW_BAR + args.li * XCD_BAR_WORDS; bar.x = 0; bar.st = nullptr;
    if (multi) bar = xcd_barrier_post(F.ctl + CW_BAR + args.li * XCD_BAR_WORDS, MISC + 8);
#define GRID_BAR() do { if (multi) xcd_barrier(bar); } while (0)
#define IN(k) (lo <= (k) && (k) < hi)
#define BOTH(k) (IN(k) && IN((k) + 1))
    if (IN(0)) { p0_prologue(F); if (BOTH(0)) GRID_BAR(); }
    if (IN(1)) {
        pg8::Gemm g{(const bf16*)(F.ws + WS_H), (const bf16*)(F.ws + WS_WIN), D, nullptr}; pg8::P1Order S{F.G, (int)blockIdx.x, 0, 2560};
        pg8::EpiProj E{(bf16*)(F.ws + WS_R1), (bf16*)(F.ws + WS_MEMKV)};
        pg8::gemm_phase<pg8::EpiProj, pg8::P1Order>(F.lds, g, S, E);
        if (BOTH(1)) GRID_BAR();
    }
    if (IN(2)) { p2_attention(F); if (BOTH(2)) GRID_BAR(); }
    if (IN(3)) { p3_combine(F); if (BOTH(3)) GRID_BAR(); }
    if (IN(4)) {
        pg8::Gemm g{(const bf16*)(F.ws + WS_Y), (const bf16*)(F.ws + WS_WOUT), D, nullptr}; pg8::StaticOrder S{T / 256, D / 256, F.G, (int)blockIdx.x};
        pg8::EpiResid E{F.x, F.out, (bf16*)(F.ws + WS_H)};
        pg8::gemm_phase<pg8::EpiResid, pg8::StaticOrder, false>(F.lds, g, S, E);
        if (BOTH(4)) GRID_BAR();
    }
    if (IN(5)) { p5_router(F); if (BOTH(5)) GRID_BAR(); }
    if (IN(7)) {
        const int MT = moe_tables(F);
        pg8::MoeOrder S{MT, F.G, (int)blockIdx.x, (const LAS int*)(F.lds + MOE_TE)};
        { const LAS int* TB = (const LAS int*)(F.lds + MOE_TB); const LAS int* VR = (const LAS int*)(F.lds + MOE_VR); LAS int* UT = (LAS int*)(F.lds + MOE_UT);
          const int* ltok = (const int*)(F.ws + WS_LIST + LIST_TOK);
          for (int i = 0; i < MOE_MAXU; ++i) { pg8::Unit u; if (!S.next(i, u)) break;
              if (F.tid < 256) UT[i * 256 + F.tid] = (F.tid < VR[u.pm]) ? ltok[TB[u.pm] + F.tid] : 0; }
          __syncthreads(); }
        pg8::Gemm g{(const bf16*)(F.ws + WS_H), (const bf16*)(F.ws + WS_WGU), D, (const LAS int*)(F.lds + MOE_UT)};
        pg8::EpiSwiGLU E{(bf16*)(F.ws + WS_OPART), (const float*)(F.ws + WS_LIST + LIST_RSTD), (const LAS int*)(F.lds + MOE_TB)};
        pg8::gemm_phase<pg8::EpiSwiGLU, pg8::MoeOrder, true, true, false, true>(F.lds, g, S, E);
        if (BOTH(7)) GRID_BAR();
    }
    if (IN(8)) {
        const int MT = moe_tables(F);
        pg8::Gemm g{(const bf16*)(F.ws + WS_OPART), (const bf16*)(F.ws + WS_WD), DEXP, nullptr}; pg8::MoeOrder S{MT, F.G, (int)blockIdx.x, (const LAS int*)(F.lds + MOE_TE)};
        pg8::EpiDown E{(bf16*)(F.ws + WS_R1), (const float*)(F.ws + WS_LIST + LIST_GATE), (const LAS int*)(F.lds + MOE_TB)};
        pg8::gemm_phase<pg8::EpiDown, pg8::MoeOrder, true, false, false, true>(F.lds, g, S, E);
        if (BOTH(8)) GRID_BAR();
    }
    if (IN(9)) { p9_final(F); }
#undef IN
#undef BOTH
#undef GRID_BAR
}

extern "C" void kernel_launch(void* const* d_in, const int* in_sizes, int n_in, void* d_out, int out_size, void* d_ws, size_t ws_size, hipStream_t stream) {
    static int grid = 0;
    if (grid == 0) {
        if (n_in != 21 || in_sizes[0] != T * D || out_size != T * D || ws_size < WS_END) { fprintf(stderr, "kernel_launch: shape/workspace mismatch (n_in %d, ws %zu < %zu); nothing launched\n", n_in, ws_size, (size_t)WS_END); grid = -1; return; }
        int dev = 0, cus = 0, per_cu = 0;
        if (hipGetDevice(&dev) != hipSuccess || hipDeviceGetAttribute(&cus, hipDeviceAttributeMultiprocessorCount, dev) != hipSuccess) { grid = -1; return; }
        if (hipFuncSetAttribute((const void*)hymba_fwd, hipFuncAttributeMaxDynamicSharedMemorySize, LDS_BYTES) != hipSuccess) { fprintf(stderr, "kernel_launch: hipFuncSetAttribute failed\n"); grid = -1; return; }
        if (hipOccupancyMaxActiveBlocksPerMultiprocessor(&per_cu, (const void*)hymba_fwd, NWAVES * 64, LDS_BYTES) != hipSuccess || per_cu < 1) { fprintf(stderr, "kernel_launch: occupancy query reports %d\n", per_cu); }
        (void)hipGetLastError();
        grid = cus;
    }
    if (grid < 0) return;
    if (hipMemsetAsync((char*)d_ws + WS_CTL, 0, CTL_ZERO_BYTES, stream) != hipSuccess) { fprintf(stderr, "kernel_launch: memset failed\n"); return; }
    Args a{};
    for (int i = 0; i < 21; ++i) a.in[i] = (const float*)d_in[i];
    a.out = (float*)d_out; a.ws = (unsigned char*)d_ws;
    int los[4], his[4], nl = 0;
#if defined(PROBE_REPEAT)
    los[nl] = 0; his[nl] = PROBE_REPEAT + 1; ++nl; los[nl] = PROBE_REPEAT; his[nl] = PROBE_REPEAT + 1; ++nl; if (PROBE_REPEAT + 1 < PER_PHASE) { los[nl] = PROBE_REPEAT + 1; his[nl] = PER_PHASE; ++nl; }
#else
    los[nl] = 0; his[nl] = PER_PHASE; ++nl;
#endif
    for (int li = 0; li < nl; ++li) {
        a.ph_lo = los[li]; a.ph_hi = his[li]; a.li = li;
#if defined(PROBE_REPEAT)
        if (li == 1) { (void)hipMemsetAsync((char*)d_ws + WS_CTL + CW_ATTQ * 4, 0, 64, stream); if (PROBE_REPEAT == 5) (void)hipMemsetAsync((char*)d_ws + WS_CTL + CW_CNT * 4, 0, 64 * 256, stream); }
#endif
        hipLaunchKernelGGL(hymba_fwd, dim3(grid), dim3(NWAVES * 64), LDS_BYTES, stream, a);
        const hipError_t le = hipPeekAtLastError();
        if (le != hipSuccess) { fprintf(stderr, "kernel_launch: launch %d failed: %s\n", li, hipGetErrorName(le)); break; }
    }
}
```

```cpp
#include <hip/hip_runtime.h>
#include <cstdio>
#include <cstdint>

#ifndef MK_N_LAUNCHES
#define MK_N_LAUNCHES 1
#endif

#define GAS __attribute__((address_space(1)))
#define LAS __attribute__((address_space(3)))
typedef unsigned short bf16;
typedef unsigned v4u __attribute__((ext_vector_type(4)));
typedef unsigned v2u __attribute__((ext_vector_type(2)));
typedef float f32x4 __attribute__((ext_vector_type(4)));
typedef float f32x16 __attribute__((ext_vector_type(16)));
typedef short bf16x8 __attribute__((ext_vector_type(8)));
typedef short s16x4 __attribute__((ext_vector_type(4)));
#define LDS_WAIT() asm volatile("s_waitcnt lgkmcnt(0)" ::: "memory")
#define VM_WAIT() asm volatile("s_waitcnt vmcnt(0)" ::: "memory")
#define RLX_AGENT __ATOMIC_RELAXED, __HIP_MEMORY_SCOPE_AGENT

constexpr int BATCH = 2, SEQ = 16384, T = BATCH * SEQ, D = 2048, PROJ = 5120;
constexpr int NH = 8, HD = 128, ATTN_W = 1024, CONV_W = 512, MEM_W = 512, NMEM = 256, NMH = 4;
constexpr int COL_Q = 0, COL_K = 1024, COL_V = 2048, COL_B = 3072, COL_C = 3584, COL_U = 4096, COL_MQ = 4608;
constexpr int NEXP = 64, DEXP = 1024;
constexpr int RMAX = 81920;
constexpr int MAXTILES = RMAX / 256;
constexpr float EPS = 1e-6f;
constexpr float LOG2E = 1.4426950408889634f;

constexpr size_t MiB = 1u << 20;
constexpr size_t WS_CTL = 0, CTL_ZERO_BYTES = 1 * MiB;
constexpr size_t WS_WIN = 1 * MiB;
constexpr size_t WS_WMKV = WS_WIN + (size_t)PROJ * D * 2;
constexpr size_t WS_WOUT = 25 * MiB;
constexpr size_t WS_WR = 33 * MiB;
constexpr size_t WS_WGU = 34 * MiB;
constexpr size_t WS_WD = WS_WGU + 512 * MiB;
constexpr size_t WS_H = WS_WD + 256 * MiB;
constexpr size_t WS_MEMKV = WS_H + 130 * MiB;
constexpr size_t WS_R1 = WS_MEMKV + 1 * MiB;
constexpr size_t WS_OPART = WS_R1 + 320 * MiB;
constexpr size_t WS_LSE = WS_OPART + 192 * MiB;
constexpr size_t WS_MEMO = WS_LSE + 3 * MiB;
constexpr size_t WS_Y = WS_MEMO + 32 * MiB;
constexpr size_t WS_TOK = WS_Y + 128 * MiB;
constexpr size_t WS_LIST = WS_TOK + 4 * MiB;
constexpr size_t WS_END = WS_LIST + 24 * MiB;
constexpr int CAP = T;
constexpr size_t LIST_TOK = 0, LIST_RSTD = 8 * MiB, LIST_GATE = 16 * MiB;
constexpr size_t TOK_E = 0, TOK_RANK = 256 * 1024, TOK_GATE = 512 * 1024, TOK_RSTD = 768 * 1024, TOK_SLOT = 1024 * 1024, SLOT_RSTD = 1536 * 1024, SLOT_GATE = 2048 * 1024;
static_assert(WS_WMKV + 1024 * (size_t)D * 2 <= WS_WOUT && WS_WOUT + 8 * MiB <= WS_WR && WS_WR + 2048 * 72 * 4 <= WS_WGU, "ws map");
static_assert((size_t)(T + 512) * D * 2 <= 130 * MiB && (size_t)RMAX * D * 2 <= 320 * MiB && (size_t)RMAX * DEXP * 2 <= 192 * MiB && SLOT_GATE + RMAX * 4 <= 4 * MiB, "ws map");

constexpr int CW_TMO = 0, CW_CODE = 1;
constexpr int CW_CNT = 8192;
constexpr int CW_BAR = 16384;
constexpr int CW_KVREADY = 512, CW_ATTQ = 576;

constexpr int RING_BYTES = 131072;
constexpr int LDS_EXTRA = RING_BYTES;
constexpr int MISC_OFF = 163840 - 2048;
constexpr int LDS_BYTES = 163840;

__device__ __forceinline__ unsigned f2bf(float f) { unsigned u = __builtin_bit_cast(unsigned, f); return (u + 0x7fffu + ((u >> 16) & 1u)) >> 16; }
__device__ __forceinline__ unsigned pk2(float lo, float hi) { return f2bf(lo) | (f2bf(hi) << 16); }
__device__ __forceinline__ unsigned cvtpk(float lo, float hi) { unsigned r; asm volatile("v_cvt_pk_bf16_f32 %0, %1, %2" : "=v"(r) : "v"(lo), "v"(hi)); return r; }
__device__ __forceinline__ unsigned pk_fp8x4(float a, float b, float c, float d) { unsigned w = 0u; w = __builtin_amdgcn_cvt_pk_fp8_f32(a, b, w, false); w = __builtin_amdgcn_cvt_pk_fp8_f32(c, d, w, true); return w; }
constexpr float SC_WGU = 128.0f, SC_ACT = 4.0f, SC_WD = 64.0f;
__device__ __forceinline__ float bflo(unsigned w) { return __builtin_bit_cast(float, w << 16); }
__device__ __forceinline__ float bfhi(unsigned w) { return __builtin_bit_cast(float, w & 0xffff0000u); }
__device__ __forceinline__ float wave_sum(float v) {
#pragma unroll
    for (int o = 1; o < 64; o <<= 1) v += __shfl_xor(v, o);
    return v;
}

namespace pg8 {
#define PG8_LAS __attribute__((address_space(3)))
typedef unsigned short bf16_t;
typedef unsigned u32x4 __attribute__((ext_vector_type(4)));
typedef int i32x4 __attribute__((ext_vector_type(4)));
typedef int i32x8 __attribute__((ext_vector_type(8)));
constexpr int BM = 256, BK = 64, HALF = 128, HTB = HALF * BK * 2, STAGE_BYTES = 8 * HTB, NXCD = 8, WGM = 8;
__host__ __device__ __forceinline__ int lds_byte(int r, int c) { const int st = (r >> 4) * 2 + (c >> 5), rr = r & 15, cc = c & 31, ob = rr * 64 + cc * 2; return st * 1024 + (ob ^ (((ob >> 9) & 1) << 5)); }
__host__ __device__ __forceinline__ void stage_rc(int b, int& R, int& C) { const int st = b / 1024, sb = b % 1024, swz = sb ^ (((sb >> 9) & 1) << 5); R = (st >> 1) * 16 + swz / 64; C = (st & 1) * 32 + (swz % 64) / 2; }
__host__ __device__ __forceinline__ int perm32(int rho) { const int n = rho >> 4, i = rho & 15; return 8 * (i >> 2) + 4 * n + (i & 3); }

struct Unit { int pm, pn, pb; };
struct Gemm { const bf16_t* A; const bf16_t* Bt; int K; const PG8_LAS int* ut; };

__device__ __forceinline__ void tile_of(int L, int nM, int nN, int& pm, int& pn) {
    const int nwg = nM * nN;
    int wgid = L; { const int q = nwg / NXCD, r = nwg % NXCD, xcd = wgid % NXCD, off = wgid / NXCD; wgid = (xcd < r ? xcd * (q + 1) : r * (q + 1) + (xcd - r) * q) + off; }
    const int nig = WGM * nN, gid = wgid / nig, fm = gid * WGM, gsz = (nM - fm) < WGM ? (nM - fm) : WGM;
    pm = fm + ((wgid % nig) % gsz); pn = (wgid % nig) / gsz;
}
struct StaticOrder {
    int nM, nN, G, c;
    __device__ __forceinline__ bool next(int i, Unit& u) const { const long L = (long)i * G + c; if (L >= (long)nM * nN) return false; tile_of((int)L, nM, nN, u.pm, u.pn); u.pb = u.pn; return true; }
    __device__ __forceinline__ void a_ready(const Unit&) const {}
    __device__ __forceinline__ void done(const Unit&) const {}
};
struct P1Order {
    int G, c, lo, hi;
    __device__ __forceinline__ bool next(int i, Unit& u) const { const long L = (long)lo + (long)i * G + c; if (L >= hi) return false;
        if (L < 2560) tile_of((int)L, 128, 20, u.pm, u.pn); else { const int k = (int)L - 2560; u.pm = 128 + (k >> 2); u.pn = 20 + (k & 3); }
        u.pb = u.pn; return true; }
    __device__ __forceinline__ void a_ready(const Unit&) const {}
    __device__ __forceinline__ void done(const Unit&) const {}
};
struct MoeOrder {
    int nM, G, c; const LAS int* te;
    __device__ __forceinline__ bool next(int i, Unit& u) const { const long L = (long)i * G + c; if (L >= (long)nM * 8) return false; tile_of((int)L, nM, 8, u.pm, u.pn); u.pb = te[u.pm] * 8 + u.pn; return true; }
    __device__ __forceinline__ void a_ready(const Unit&) const {}
    __device__ __forceinline__ void done(const Unit&) const {}
};

struct EpiProj {
    static constexpr bool PERM = true, AFTER_DRAIN = false;
    bf16_t* O; bf16_t* O2;
    static constexpr int NPRE = 0;
    __device__ __forceinline__ void pre(const Unit&, int, int, float (&)[8]) const {}
    __device__ __forceinline__ void operator()(const f32x4 (&acc)[2][2][4][2], const Unit& u, int wr, int wc, int fr, int fq, const float (&)[8]) const {
        int row0 = u.pm * BM + wr * 64 + fr, col0 = u.pn * BM + wc * 32 + 8 * fq, ldc = PROJ; bf16_t* base = O;
        if (u.pm >= 128) { row0 -= 128 * BM; col0 -= 20 * BM; ldc = 1024; base = O2; }
#pragma unroll
        for (int ai = 0; ai < 2; ++ai)
#pragma unroll
            for (int m = 0; m < 4; ++m) { bf16_t* rowp = base + (size_t)(row0 + ai * HALF + m * 16) * ldc + col0;
#pragma unroll
                for (int bj = 0; bj < 2; ++bj) { const f32x4 v0 = acc[ai][bj][m][0], v1 = acc[ai][bj][m][1];
                    u32x4 w; w.x = cvtpk(v0[0], v0[1]); w.y = cvtpk(v0[2], v0[3]); w.z = cvtpk(v1[0], v1[1]); w.w = cvtpk(v1[2], v1[3]);
                    *(u32x4*)(rowp + bj * HALF) = w; } }
    }
};
struct EpiResid {
    static constexpr bool PERM = true, AFTER_DRAIN = false;
    const float* X; float* X1; bf16_t* X1B;
    static constexpr int NPRE = 0;
    __device__ __forceinline__ void pre(const Unit&, int, int, float (&)[8]) const {}
    __device__ __forceinline__ void operator()(const f32x4 (&acc)[2][2][4][2], const Unit& u, int wr, int wc, int fr, int fq, const float (&)[8]) const {
        const int row0 = u.pm * BM + wr * 64 + fr, col0 = u.pn * BM + wc * 32 + 8 * fq;
#pragma unroll
        for (int ai = 0; ai < 2; ++ai)
#pragma unroll
            for (int m = 0; m < 4; ++m) { const size_t off = (size_t)(row0 + ai * HALF + m * 16) * D + col0;
#pragma unroll
                for (int bj = 0; bj < 2; ++bj) { const f32x4 xa = __builtin_nontemporal_load((const f32x4*)(X + off + bj * HALF)), xb = __builtin_nontemporal_load((const f32x4*)(X + off + bj * HALF + 4));
                    const f32x4 v0 = acc[ai][bj][m][0] + xa, v1 = acc[ai][bj][m][1] + xb;
                    *(f32x4*)(X1 + off + bj * HALF) = v0; *(f32x4*)(X1 + off + bj * HALF + 4) = v1;
                    v2u w; w.x = pk_fp8x4(v0[0], v0[1], v0[2], v0[3]); w.y = pk_fp8x4(v1[0], v1[1], v1[2], v1[3]);
                    *(v2u*)((unsigned char*)X1B + off + bj * HALF) = w; }
                asm volatile("" ::: "memory"); }
    }
};
struct EpiSwiGLU {
    static constexpr bool PERM = true, AFTER_DRAIN = false;
    bf16_t* ACT; const float* RS; const PG8_LAS int* tb;
    static constexpr int NPRE = 8;
    __device__ __forceinline__ void pre(const Unit& u, int wr, int fr, float (&p)[8]) const {
        const int lb = tb[u.pm] + wr * 64 + fr;
#pragma unroll
        for (int ai = 0; ai < 2; ++ai)
#pragma unroll
            for (int m = 0; m < 4; ++m) p[ai * 4 + m] = RS[lb + ai * HALF + m * 16];
    }
    __device__ __forceinline__ void operator()(const f32x4 (&acc)[2][2][4][2], const Unit& u, int wr, int wc, int fr, int fq, const float (&p)[8]) const {
        const int row0 = u.pm * BM + wr * 64 + fr, col0 = u.pn * HALF + wc * 32 + 8 * fq;
#pragma unroll
        for (int ai = 0; ai < 2; ++ai)
#pragma unroll
            for (int m = 0; m < 4; ++m) { const int row = row0 + ai * HALF + m * 16; const float rs = p[ai * 4 + m] * (1.0f / SC_WGU); float o[8];
#pragma unroll
                for (int n = 0; n < 2; ++n)
#pragma unroll
                    for (int j = 0; j < 4; ++j) { const float g = acc[ai][0][m][n][j] * rs, uu = acc[ai][1][m][n][j] * rs;
                        o[n * 4 + j] = g * __builtin_amdgcn_rcpf(1.0f + __builtin_amdgcn_exp2f(-g * LOG2E)) * uu * SC_ACT; }
                v2u w; w.x = pk_fp8x4(o[0], o[1], o[2], o[3]); w.y = pk_fp8x4(o[4], o[5], o[6], o[7]);
                *(v2u*)((unsigned char*)ACT + (size_t)row * DEXP + col0) = w; }
    }
};
struct EpiDown {
    static constexpr bool PERM = true, AFTER_DRAIN = false;
    bf16_t* Y; const float* GT; const PG8_LAS int* tb;
    static constexpr int NPRE = 8;
    __device__ __forceinline__ void pre(const Unit& u, int wr, int fr, float (&p)[8]) const {
        const int lb = tb[u.pm] + wr * 64 + fr;
#pragma unroll
        for (int ai = 0; ai < 2; ++ai)
#pragma unroll
            for (int m = 0; m < 4; ++m) p[ai * 4 + m] = GT[lb + ai * HALF + m * 16];
    }
    __device__ __forceinline__ void operator()(const f32x4 (&acc)[2][2][4][2], const Unit& u, int wr, int wc, int fr, int fq, const float (&p)[8]) const {
        const int row0 = u.pm * BM + wr * 64 + fr, col0 = u.pn * BM + wc * 32 + 8 * fq;
#pragma unroll
        for (int ai = 0; ai < 2; ++ai)
#pragma unroll
            for (int m = 0; m < 4; ++m) { const int row = row0 + ai * HALF + m * 16; const float gt = p[ai * 4 + m] * (1.0f / (SC_ACT * SC_WD)); bf16_t* rowp = Y + (size_t)row * D + col0;
#pragma unroll
                for (int bj = 0; bj < 2; ++bj) { const f32x4 v0 = acc[ai][bj][m][0] * gt, v1 = acc[ai][bj][m][1] * gt;
                    u32x4 w; w.x = cvtpk(v0[0], v0[1]); w.y = cvtpk(v0[2], v0[3]); w.z = cvtpk(v1[0], v1[1]); w.w = cvtpk(v1[2], v1[3]);
                    *(u32x4*)(rowp + bj * HALF) = w; } }
    }
};

template <class Epi, class Sched, bool ALIGN_EPI = true, bool GATHER = false, bool BKN = false, bool FP8 = false>
__device__ __forceinline__ void gemm_phase(PG8_LAS unsigned char* lds, const Gemm g, const Sched& S, const Epi& E) {
    static_assert(!(FP8 && BKN), "the fp8 path takes N-major B");
    const int tid = threadIdx.x, wid = __builtin_amdgcn_readfirstlane(tid >> 6), lane = tid & 63, wr = wid >> 2, wc = wid & 3, fr = lane & 15, fq = lane >> 4;
    const int K = FP8 ? g.K / 2 : g.K, nt = K / BK;
    unsigned voffA[2], voffB[2]; int gR[2], gC[2];
#pragma unroll
    for (int i = 0; i < 2; ++i) { int R, C; stage_rc(tid * 16 + i * 8192, R, C); const int Rb = Epi::PERM ? ((R & ~31) + perm32(R & 31)) : R; gR[i] = R; gC[i] = C;
        voffA[i] = (unsigned)(R * K + C) * 2u; voffB[i] = (unsigned)(Rb * K + C) * 2u; }
    unsigned vA0[2], vA1[2], vN0[2], vN1[2];
#define PG8_GOFF(dst0, dst1, ui_) do { _Pragma("unroll") for (int _i = 0; _i < 2; ++_i) { \
        dst0[_i] = ((unsigned)g.ut[(ui_) * 256 + gR[_i]] * (unsigned)K + (unsigned)gC[_i]) * 2u; dst1[_i] = ((unsigned)g.ut[(ui_) * 256 + 128 + gR[_i]] * (unsigned)K + (unsigned)gC[_i]) * 2u; } } while (0)
    const size_t kstep = (size_t)(BK * 2);
    const size_t hstep = (size_t)HALF * K * 2;
    const size_t tstep = 2 * hstep;
    const size_t kstepB = BKN ? (size_t)BK * 4096 : kstep, hstepB = BKN ? (size_t)256 : hstep;
    if constexpr (BKN) {
#pragma unroll
        for (int i = 0; i < 2; ++i) { const int p = tid * 16 + i * 8192, kk = p >> 8, c16p = (p & 255) >> 4, sw = (kk & 3) | (((kk >> 3) & 1) << 2);
            voffB[i] = (unsigned)(kk * 4096 + ((c16p ^ (sw << 1)) << 4)); } }
    int bbase[2];
    { const int q = fr >> 2, p = fr & 3, sw = q | ((fq & 1) << 2);
#pragma unroll
      for (int n = 0; n < 2; ++n) bbase[n] = (int)(uintptr_t)lds + (8 * fq + q) * 256 + (((4 * wc + 2 * n + (p >> 1)) ^ (sw << 1)) << 4) + 8 * (p & 1); }
    const unsigned ldsw = (unsigned)wid * 1024u;
    const int aoff = lds_byte(wr * 64 + fr, fq * 8), boff = lds_byte(wc * 32 + fr, fq * 8);
    const int aoq0 = lds_byte(wr * 64 + fr, fq * 16), aoq1 = lds_byte(wr * 64 + fr, fq * 16 + 8), boq0 = lds_byte(wc * 32 + fr, fq * 16), boq1 = lds_byte(wc * 32 + fr, fq * 16 + 8);
#define PG8_SA(b, h) (((b) * 2 + (h)) * HTB)
#define PG8_SB(b, h) ((4 + (b) * 2 + (h)) * HTB)
#define PG8_STAGE(bufoff, gbase, voff) do { _Pragma("unroll") for (int _i = 0; _i < 2; ++_i) \
        __builtin_amdgcn_global_load_lds((const unsigned*)((const char*)(gbase) + (voff)[_i]), (PG8_LAS unsigned*)(lds + (bufoff) + ldsw + _i * 8192), 16, 0, 0); } while (0)
#define PG8_Q_At Aq
#define PG8_Q_B0 Bq0
#define PG8_Q_B1 Bq1
#define PG8_LD8(p0_, p1_) __builtin_shufflevector(*(const PG8_LAS i32x4*)(p0_), *(const PG8_LAS i32x4*)(p1_), 0, 1, 2, 3, 4, 5, 6, 7)
#define PG8_LDA(dst, b, h) do { if constexpr (FP8) { _Pragma("unroll") for (int m = 0; m < 4; ++m) PG8_Q_##dst[m] = PG8_LD8(lds + PG8_SA(b, h) + aoq0 + m * 2048, lds + PG8_SA(b, h) + aoq1 + m * 2048); } \
        else { _Pragma("unroll") for (int m = 0; m < 4; ++m) _Pragma("unroll") for (int k = 0; k < 2; ++k) dst[m][k] = *(const PG8_LAS bf16x8*)(lds + PG8_SA(b, h) + aoff + m * 2048 + k * 1024); } } while (0)
#define PG8_TR(dst, addr, OFF) asm volatile("ds_read_b64_tr_b16 %0, %1 offset:%2" : "=&v"(dst) : "v"(addr), "i"(OFF) : "memory")
#define PG8_LDB(dst, b, h) do { if constexpr (BKN) { _Pragma("unroll") for (int n = 0; n < 2; ++n) { const int ad_ = bbase[n] + PG8_SB(b, h); s16x4 l0_, h0_, l1_, h1_; \
            PG8_TR(l0_, ad_, 0); PG8_TR(h0_, ad_, 1024); PG8_TR(l1_, ad_, 8192); PG8_TR(h1_, ad_, 9216); \
            dst[n][0] = (bf16x8){l0_[0], l0_[1], l0_[2], l0_[3], h0_[0], h0_[1], h0_[2], h0_[3]}; dst[n][1] = (bf16x8){l1_[0], l1_[1], l1_[2], l1_[3], h1_[0], h1_[1], h1_[2], h1_[3]}; } } \
        else if constexpr (FP8) { _Pragma("unroll") for (int n = 0; n < 2; ++n) PG8_Q_##dst[n] = PG8_LD8(lds + PG8_SB(b, h) + boq0 + n * 2048, lds + PG8_SB(b, h) + boq1 + n * 2048); } \
        else { _Pragma("unroll") for (int n = 0; n < 2; ++n) _Pragma("unroll") for (int k = 0; k < 2; ++k) dst[n][k] = *(const PG8_LAS bf16x8*)(lds + PG8_SB(b, h) + boff + n * 2048 + k * 1024); } } while (0)
#define PG8_MMA(ai, bj, At, Bt) do { __builtin_amdgcn_s_setprio(1); if constexpr (FP8) { _Pragma("unroll") for (int m = 0; m < 4; ++m) _Pragma("unroll") for (int n = 0; n < 2; ++n) \
            asm volatile("v_mfma_scale_f32_16x16x128_f8f6f4 %0, %1, %2, %0, %3, %3 op_sel_hi:[0,0,0]" : "+v"(acc[ai][bj][m][n]) : "v"(PG8_Q_##Bt[n]), "v"(PG8_Q_##At[m]), "v"(sc1_)); } \
        else { _Pragma("unroll") for (int m = 0; m < 4; ++m) _Pragma("unroll") for (int n = 0; n < 2; ++n) _Pragma("unroll") for (int k = 0; k < 2; ++k) \
            acc[ai][bj][m][n] = __builtin_amdgcn_mfma_f32_16x16x32_bf16(Bt[n][k], At[m][k], acc[ai][bj][m][n], 0, 0, 0); } __builtin_amdgcn_s_setprio(0); } while (0)
#define PG8_WAIT_V(n) asm volatile("s_waitcnt vmcnt(" #n ")" ::: "memory")
#define PG8_WAIT_L(n) asm volatile("s_waitcnt lgkmcnt(" #n ")" ::: "memory")
#define PG8_BAR __builtin_amdgcn_s_barrier()
#define PG8_SCHED __builtin_amdgcn_sched_barrier(0)
    Unit cur, nxt; int ui = 0;
    if (!S.next(0, cur)) return;
    float preC[8], preN[8];
#pragma unroll
    for (int i = 0; i < 8; ++i) { preC[i] = 0.f; preN[i] = 0.f; }
    if constexpr (Epi::NPRE > 0) { int ln_ = lane; asm volatile("" : "+v"(ln_)); E.pre(cur, wr, ln_ & 15, preC); }
    f32x4 acc[2][2][4][2];
#pragma unroll
    for (int a = 0; a < 2; ++a)
#pragma unroll
        for (int b = 0; b < 2; ++b)
#pragma unroll
            for (int m = 0; m < 4; ++m)
#pragma unroll
                for (int n = 0; n < 2; ++n) acc[a][b][m][n] = (f32x4){0.f, 0.f, 0.f, 0.f};
    bf16x8 At[4][2], B0[2][2], B1[2][2];
    i32x8 Aq[4], Bq0[2], Bq1[2]; const int sc1_ = 0x7F7F7F7F;
    const char* cA = GATHER ? (const char*)g.A : (const char*)g.A + (size_t)cur.pm * tstep; const char* cB = BKN ? (const char*)g.Bt + (size_t)(cur.pb >> 3) * ((size_t)K * 4096) + (size_t)(cur.pb & 7) * 512 : (const char*)g.Bt + (size_t)cur.pb * tstep;
    const size_t hA = GATHER ? 0 : hstep;
    if constexpr (GATHER) { PG8_GOFF(vA0, vA1, 0); } else {
#pragma unroll
        for (int i = 0; i < 2; ++i) { vA0[i] = voffA[i]; vA1[i] = voffA[i]; vN0[i] = voffA[i]; vN1[i] = voffA[i]; } }
    S.a_ready(cur);
    PG8_STAGE(PG8_SB(0, 0), cB, voffB); PG8_STAGE(PG8_SB(0, 1), cB + hstepB, voffB); PG8_STAGE(PG8_SA(0, 0), cA, vA0); PG8_STAGE(PG8_SA(0, 1), cA + hA, vA1);
    if (wr == 1) PG8_BAR;
    PG8_WAIT_V(2); PG8_BAR;
    PG8_STAGE(PG8_SB(1, 0), cB + kstepB, voffB); PG8_STAGE(PG8_SA(1, 0), cA + kstep, vA0); PG8_STAGE(PG8_SB(1, 1), cB + hstepB + kstepB, voffB);
    PG8_WAIT_V(6); PG8_BAR;
    for (;;) {
        const bool has_next = S.next(ui + 1, nxt);
        if constexpr (Epi::NPRE > 0) { if (has_next) { int ln_ = lane; asm volatile("" : "+v"(ln_)); E.pre(nxt, wr, ln_ & 15, preN); } }
        const char* nA = GATHER ? cA : (has_next ? (const char*)g.A + (size_t)nxt.pm * tstep : cA); const char* nB = has_next ? (BKN ? (const char*)g.Bt + (size_t)(nxt.pb >> 3) * ((size_t)K * 4096) + (size_t)(nxt.pb & 7) * 512 : (const char*)g.Bt + (size_t)nxt.pb * tstep) : cB;
        if constexpr (GATHER) { if (has_next) { PG8_GOFF(vN0, vN1, ui + 1); } else {
#pragma unroll
            for (int i = 0; i < 2; ++i) { vN0[i] = vA0[i]; vN1[i] = vA1[i]; } } }
#pragma unroll 1
        for (int t = 0; t < nt; t += 2) {
            const bool last = (t == nt - 2);
            unsigned s0[2], s1[2];
#pragma unroll
            for (int i = 0; i < 2; ++i) { s0[i] = (GATHER && last) ? vN0[i] : vA0[i]; s1[i] = (GATHER && last) ? vN1[i] : vA1[i]; }
            const char* a1 = cA + (size_t)(t + 1) * kstep;
            const char* a2 = last ? nA : cA + (size_t)(t + 2) * kstep; const char* b2 = last ? nB : cB + (size_t)(t + 2) * kstepB;
            const char* a3 = a2 + kstep; const char* b3 = b2 + kstepB;
            if (last && has_next) S.a_ready(nxt);
            PG8_LDB(B0, 0, 0); PG8_LDB(B1, 0, 1); PG8_SCHED; PG8_LDA(At, 0, 0); PG8_STAGE(PG8_SA(1, 1), a1 + hA, vA1);
            PG8_WAIT_V(8); PG8_WAIT_L(0); PG8_BAR; PG8_SCHED; PG8_MMA(0, 0, At, B0); PG8_MMA(0, 1, At, B1); PG8_BAR; PG8_SCHED;
            PG8_LDA(At, 0, 1); PG8_STAGE(PG8_SB(0, 0), b2, voffB); PG8_STAGE(PG8_SB(0, 1), b2 + hstepB, voffB); PG8_STAGE(PG8_SA(0, 0), a2, s0);
            PG8_WAIT_V(8); PG8_WAIT_L(0); PG8_BAR; PG8_SCHED; PG8_MMA(1, 0, At, B0); PG8_MMA(1, 1, At, B1); PG8_BAR; PG8_SCHED;
            PG8_LDB(B0, 1, 0); PG8_LDB(B1, 1, 1); PG8_SCHED; PG8_LDA(At, 1, 0); PG8_STAGE(PG8_SA(0, 1), a2 + hA, s1);
            PG8_WAIT_V(8); PG8_WAIT_L(0); PG8_BAR; PG8_SCHED; PG8_MMA(0, 0, At, B0); PG8_MMA(0, 1, At, B1); PG8_BAR; PG8_SCHED;
            PG8_LDA(At, 1, 1); PG8_STAGE(PG8_SB(1, 0), b3, voffB); PG8_STAGE(PG8_SB(1, 1), b3 + hstepB, voffB); PG8_STAGE(PG8_SA(1, 0), a3, s0);
            PG8_WAIT_V(8); PG8_WAIT_L(0); PG8_BAR; PG8_SCHED; PG8_MMA(1, 0, At, B0); PG8_MMA(1, 1, At, B1); PG8_BAR; PG8_SCHED;
        }
        if constexpr (ALIGN_EPI) { if (wr == 0) PG8_BAR; }
        if constexpr (FP8) { __builtin_amdgcn_sched_barrier(0); asm volatile("s_nop 15\n\ts_nop 15" ::: "memory"); __builtin_amdgcn_sched_barrier(0); }
        { int ln_ = lane; asm volatile("" : "+v"(ln_)); E(acc, cur, wr, wc, ln_ & 15, ln_ >> 4, preC); } S.done(cur);
        if (!has_next) break;
#pragma unroll
        for (int a = 0; a < 2; ++a)
#pragma unroll
            for (int b = 0; b < 2; ++b)
#pragma unroll
                for (int m = 0; m < 4; ++m)
#pragma unroll
                    for (int n = 0; n < 2; ++n) acc[a][b][m][n] = (f32x4){0.f, 0.f, 0.f, 0.f};
        cur = nxt; cA = nA; cB = nB; ++ui;
        if constexpr (Epi::NPRE > 0) {
#pragma unroll
            for (int i = 0; i < 8; ++i) preC[i] = preN[i]; }
#pragma unroll
        for (int i = 0; i < 2; ++i) { vA0[i] = vN0[i]; vA1[i] = vN1[i]; }
        if constexpr (ALIGN_EPI) { if (wr == 1) PG8_BAR; }
    }
    PG8_WAIT_V(0);
    if constexpr (!ALIGN_EPI) { if (wr == 0) PG8_BAR; }
    PG8_BAR;
#undef PG8_GOFF
#undef PG8_Q_At
#undef PG8_Q_B0
#undef PG8_Q_B1
#undef PG8_LD8
#undef PG8_TR
#undef PG8_SA
#undef PG8_SB
#undef PG8_STAGE
#undef PG8_LDA
#undef PG8_LDB
#undef PG8_MMA
#undef PG8_WAIT_V
#undef PG8_WAIT_L
#undef PG8_BAR
#undef PG8_SCHED
}
}

#define XB_TMO      128
#define XB_XCNT(j)  (256  + 64 * (j))
#define XB_XSUB(j)  (1280 + 64 * (j))
#define XB_XGEN(j)  (2304 + 64 * (j))
#define XB_TOP      3328
#define XB_TOPGEN   3392
#define XCD_BAR_WORDS 3456
#define XB_SPIN_CAP (1u << 18)
__device__ __forceinline__ unsigned xb_ld(unsigned* p)              { return __hip_atomic_load(p, __ATOMIC_RELAXED, __HIP_MEMORY_SCOPE_AGENT); }
__device__ __forceinline__ unsigned xb_add(unsigned* p, unsigned v) { return __hip_atomic_fetch_add(p, v, __ATOMIC_RELAXED, __HIP_MEMORY_SCOPE_AGENT); }
__device__ __forceinline__ unsigned xb_xcc_id() { return (unsigned)__builtin_amdgcn_s_getreg((3 << 11) | 20) & 0xFu; }
#define XB_SPIN(cond, bar) do { unsigned _sp = 0; while (cond) { __builtin_amdgcn_s_sleep(1); \
    if ((++_sp & 255u) == 0u) { if (xb_ld(&(bar)[XB_TMO])) break; if (_sp > XB_SPIN_CAP) { atomicAdd(&(bar)[XB_TMO], 1u); break; } } } } while (0)
struct XcdBarrier { unsigned* bar; unsigned x; volatile LAS unsigned* st; };
__device__ __forceinline__ XcdBarrier xcd_barrier_post(unsigned* bar, volatile LAS unsigned* st) {
    XcdBarrier b; b.bar = bar; b.x = xb_xcc_id(); b.st = st;
    if (threadIdx.x == 0) (void)xb_add(&bar[XB_XCNT(b.x)], 1u);
    return b;
}
__device__ __forceinline__ void xcd_barrier_complete(unsigned* bar, unsigned x, unsigned& nloc, unsigned& nx) {
    const unsigned G = gridDim.x * gridDim.y * gridDim.z;
    unsigned sum, cnt, mine, sp = 0u;
    for (;;) {
        sum = 0u; cnt = 0u; mine = 0u;
#pragma unroll
        for (unsigned j = 0; j < 16; ++j) { const unsigned c = xb_ld(&bar[XB_XCNT(j)]); sum += c; cnt += (c > 0u) ? 1u : 0u; mine = (j == x) ? c : mine; }
        if (sum == G) break;
        __builtin_amdgcn_s_sleep(1);
        if ((++sp & 255u) == 0u) { if (xb_ld(&bar[XB_TMO])) break; if (sp > XB_SPIN_CAP) { atomicAdd(&bar[XB_TMO], 1u); break; } }
    }
    nloc = mine > 0u ? mine : 1u; nx = cnt > 0u ? cnt : 1u;
}
__device__ __forceinline__ void xcd_barrier(const XcdBarrier& b) {
    asm volatile("s_waitcnt vmcnt(0)" ::: "memory");
    __syncthreads();
    if (threadIdx.x == 0) {
        unsigned* bar = b.bar;
        __builtin_amdgcn_s_waitcnt(0);
        unsigned nloc = b.st[0], nx = b.st[1];
        if (nloc == 0u) { xcd_barrier_complete(bar, b.x, nloc, nx); b.st[0] = nloc; b.st[1] = nx; }
        const unsigned old = xb_add(&bar[XB_XSUB(b.x)], 1u);
        const unsigned gen = old / nloc;
        if (old + 1u == (gen + 1u) * nloc) {
            __builtin_amdgcn_fence(__ATOMIC_RELEASE, "agent");
            asm volatile("s_waitcnt vmcnt(0)" ::: "memory");
            const unsigned og = xb_add(&bar[XB_TOP], 1u);
            const unsigned tg = og / nx;
            if (og + 1u == (tg + 1u) * nx) xb_add(&bar[XB_TOPGEN], 1u);
            else XB_SPIN(xb_ld(&bar[XB_TOPGEN]) == tg, bar);
            __builtin_amdgcn_fence(__ATOMIC_ACQUIRE, "agent");
            xb_add(&bar[XB_XGEN(b.x)], 1u);
            asm volatile("s_waitcnt vmcnt(0)" ::: "memory");
        } else {
            XB_SPIN(xb_ld(&bar[XB_XGEN(b.x)]) == gen, bar);
            __builtin_amdgcn_fence(__ATOMIC_ACQUIRE, "agent");
            asm volatile("s_waitcnt vmcnt(0)" ::: "memory");
        }
    }
    __syncthreads();
}

constexpr int NWAVES = 8;
struct Frame {
    LAS unsigned char* lds;
    unsigned* ctl;
    int tid, lane, wave, vcu, G;
    const float *x, *mem, *norm1_g, *w_in, *q_norm_g, *k_norm_g, *conv_w, *mem_norm_g, *w_mem_kv, *mem_q_norm_g, *mem_k_norm_g, *out_norm_g, *w_out, *norm2_g,
                *w_rg, *b_rg, *w_re, *b_re, *w_gate, *w_up, *w_down;
    float* out; unsigned char* ws;
};

__device__ __forceinline__ void p0_transpose_item(const float* W, int N, int k0, int n0, const float* ks, bf16* dst, int pitch, LAS float* scr, int lane) {
#pragma unroll 8
    for (int i = 0; i < 32; ++i) { const int kk = 2 * i + (lane >> 5); scr[kk * 33 + (lane & 31)] = __builtin_nontemporal_load(W + (size_t)(k0 + kk) * N + n0 + (lane & 31)); }
    const int c = lane & 7;
    float g[8];
#pragma unroll
    for (int j = 0; j < 8; ++j) g[j] = ks ? ks[k0 + 8 * c + j] : 1.0f;
    LDS_WAIT(); asm volatile("" ::: "memory");
#pragma unroll
    for (int j = 0; j < 4; ++j) { const int n = (lane >> 3) + 8 * j; const LAS float* s = scr + (8 * c) * 33 + n;
        v4u o; o.x = pk2(s[0 * 33] * g[0], s[1 * 33] * g[1]); o.y = pk2(s[2 * 33] * g[2], s[3 * 33] * g[3]); o.z = pk2(s[4 * 33] * g[4], s[5 * 33] * g[5]); o.w = pk2(s[6 * 33] * g[6], s[7 * 33] * g[7]);
        *(GAS v4u*)(dst + (size_t)n * pitch + k0 + 8 * c) = o; }
    LDS_WAIT(); asm volatile("" ::: "memory");
}
__device__ __forceinline__ void rms_row_to_bf16(const float* xrow, const float* gain, bf16* orow, int lane) {
    const GAS f32x4* xr = (const GAS f32x4*)xrow + lane; const GAS f32x4* gr = (const GAS f32x4*)gain + lane;
    f32x4 v[8]; float s = 0.f;
#pragma unroll
    for (int j = 0; j < 8; ++j) { v[j] = __builtin_nontemporal_load(xr + 64 * j); s += (v[j].x * v[j].x + v[j].y * v[j].y) + (v[j].z * v[j].z + v[j].w * v[j].w); }
    const float rstd = 1.0f / sqrtf(wave_sum(s) * (1.f / D) + EPS);
    GAS v2u* o8 = (GAS v2u*)orow + lane;
#pragma unroll
    for (int j = 0; j < 8; ++j) { const f32x4 gg = gr[64 * j]; v2u o; o.x = pk2(v[j].x * rstd * gg.x, v[j].y * rstd * gg.y); o.y = pk2(v[j].z * rstd * gg.z, v[j].w * rstd * gg.w); o8[64 * j] = o; }
}
__device__ __forceinline__ void p0_transpose_item_q(const float* W, int N, int k0, int n0, const float* ks, float sc, unsigned char* dst, int pitch, LAS float* scr, int lane) {
#pragma unroll 8
    for (int i = 0; i < 64; ++i) { const int kk = 2 * i + (lane >> 5); scr[kk * 33 + (lane & 31)] = __builtin_nontemporal_load(W + (size_t)(k0 + kk) * N + n0 + (lane & 31)); }
    const int c = lane & 15;
    float g[8];
#pragma unroll
    for (int j = 0; j < 8; ++j) g[j] = ks ? ks[k0 + 8 * c + j] * sc : sc;
    LDS_WAIT(); asm volatile("" ::: "memory");
#pragma unroll
    for (int j = 0; j < 8; ++j) { const int n = (lane >> 4) + 4 * j; const LAS float* s = scr + (8 * c) * 33 + n;
        v2u o; o.x = pk_fp8x4(s[0 * 33] * g[0], s[1 * 33] * g[1], s[2 * 33] * g[2], s[3 * 33] * g[3]); o.y = pk_fp8x4(s[4 * 33] * g[4], s[5 * 33] * g[5], s[6 * 33] * g[6], s[7 * 33] * g[7]);
        __builtin_nontemporal_store(o, (GAS v2u*)(dst + (size_t)n * pitch + k0 + 8 * c)); }
    LDS_WAIT(); asm volatile("" ::: "memory");
}
__device__ __forceinline__ void p0_item_q64(const float* W, int N, int k0, int n0, const float* ks, float sc, unsigned char* dst, int pitch, LAS unsigned char* scr, int lane) {
    const GAS float* src = (const GAS float*)(W + (size_t)k0 * N + n0 + lane);
    float g0 = sc, g1 = sc;
    if (ks) { g0 = ks[k0 + lane] * sc; g1 = ks[k0 + 64 + lane] * sc; }
#pragma unroll
    for (int h = 0; h < 2; ++h) {
        float v[64];
#pragma unroll
        for (int i = 0; i < 64; ++i) v[i] = __builtin_nontemporal_load(src + (size_t)(64 * h + i) * N);
        const float gh = h ? g1 : g0;
#pragma unroll
        for (int q = 0; q < 4; ++q) { v4u o;
#pragma unroll
            for (int d = 0; d < 4; ++d) { const int i = 16 * q + 4 * d;
                const float s0 = __builtin_bit_cast(float, __builtin_amdgcn_readlane(__builtin_bit_cast(int, gh), i)), s1 = __builtin_bit_cast(float, __builtin_amdgcn_readlane(__builtin_bit_cast(int, gh), i + 1));
                const float s2 = __builtin_bit_cast(float, __builtin_amdgcn_readlane(__builtin_bit_cast(int, gh), i + 2)), s3 = __builtin_bit_cast(float, __builtin_amdgcn_readlane(__builtin_bit_cast(int, gh), i + 3));
                o[d] = pk_fp8x4(v[i] * s0, v[i + 1] * s1, v[i + 2] * s2, v[i + 3] * s3); }
            *(LAS v4u*)(scr + lane * 144 + (4 * h + q) * 16) = o; }
    }
    LDS_WAIT(); asm volatile("" ::: "memory");
#pragma unroll
    for (int i = 0; i < 8; ++i) { const int row = 8 * i + (lane >> 3), ch = lane & 7;
        const v4u w = *(const LAS v4u*)(scr + row * 144 + ch * 16);
        __builtin_nontemporal_store(w, (GAS v4u*)(dst + (size_t)row * pitch + k0 + ch * 16)); }
    LDS_WAIT(); asm volatile("" ::: "memory");
}
__device__ __forceinline__ void p0_prologue(Frame& F) {
    LAS float* scr = (LAS float*)(F.lds + F.wave * 16896);
    const int gw = F.vcu * NWAVES + F.wave, NGW = F.G * NWAVES;
    bf16* Win_t = (bf16*)(F.ws + WS_WIN); bf16* Wmkv_t = (bf16*)(F.ws + WS_WMKV); bf16* Wout_t = (bf16*)(F.ws + WS_WOUT);
    constexpr int I_IN = 32 * 160, I_MKV = 32 * 32, I_OUT = 32 * 64;
    constexpr int NITEMS = I_IN + I_MKV + I_OUT;
    for (int it = gw; it < NITEMS; it += NGW) {
        int r = it;
        if (r < I_IN) { const int kb = r / 160, nb = r % 160; p0_transpose_item(F.w_in, PROJ, 64 * kb, 32 * nb, nullptr, Win_t + (size_t)(32 * nb) * D, D, scr, F.lane); continue; } r -= I_IN;
        if (r < I_MKV) { const int kb = r / 32, nb = r % 32; p0_transpose_item(F.w_mem_kv, 1024, 64 * kb, 32 * nb, nullptr, Wmkv_t + (size_t)(32 * nb) * D, D, scr, F.lane); continue; } r -= I_MKV;
        { const int kb = r / 64, nb = r % 64; p0_transpose_item(F.w_out, D, 64 * kb, 32 * nb, nullptr, Wout_t + (size_t)(32 * nb) * D, D, scr, F.lane); }
    }
    { unsigned char* Wgu_q = (unsigned char*)(F.ws + WS_WGU); unsigned char* Wd_q = (unsigned char*)(F.ws + WS_WD); LAS unsigned char* scq = F.lds + F.wave * 16896;
      constexpr int IPE = 256 + 256 + 256;
#pragma unroll 1
      for (int it = gw; it < 64 * IPE; it += NGW) { const int e = it / IPE; int r = it - e * IPE;
          if (r < 512) { const int up = r >> 8, q = r & 255, kb = q >> 4, nb = q & 15, n0 = 64 * nb;
              const float* W = (up ? F.w_up : F.w_gate) + (size_t)e * D * DEXP; const int drow = 256 * (n0 >> 7) + 128 * up + (n0 & 127);
              p0_item_q64(W, DEXP, 128 * kb, n0, F.norm2_g, SC_WGU, Wgu_q + ((size_t)e * 2048 + drow) * D, D, scq, F.lane); }
          else { const int q = r - 512, kb = q >> 5, nb = q & 31;
              p0_item_q64(F.w_down + (size_t)e * DEXP * D, D, 128 * kb, 64 * nb, nullptr, SC_WD, Wd_q + ((size_t)e * 2048 + 64 * nb) * DEXP, DEXP, scq, F.lane); } } }
    { bf16* WT = (bf16*)(F.ws + WS_WR); const int gt = (F.vcu * NWAVES + F.wave) * 64 + F.lane, NT = F.G * NWAVES * 64;
      for (int i = gt; i < 96 * 2048; i += NT) { const int n = i >> 11, k = i & 2047;
          float w = n < 64 ? F.w_re[k * 64 + n] : (n < 72 ? F.w_rg[k * 8 + (n - 64)] : 0.f); w *= F.norm2_g[k];
          const unsigned h = f2bf(w); const float hf = __builtin_bit_cast(float, h << 16);
          WT[i] = (bf16)h; WT[96 * 2048 + i] = (bf16)f2bf(w - hf); } }
    bf16* H = (bf16*)(F.ws + WS_H);
    for (int m = gw; m < T + 512; m += NGW) {
        if (m < T) rms_row_to_bf16(F.x + (size_t)m * D, F.norm1_g, H + (size_t)m * D, F.lane);
        else rms_row_to_bf16(F.mem + (size_t)(m - T) * D, F.mem_norm_g, H + (size_t)m * D, F.lane);
    }
}

namespace att {
constexpr int LDS_K = 0, LDS_V = 65536, LDS_STG = 131072, LDS_LI = LDS_STG + 16384, LDS_GT = LDS_LI + 8 * 256;
constexpr float CS = 0.08838834764831845f * LOG2E;
#define KSWZ(row, colB) ((row) * 256 + ((colB) ^ (((row) & 7) << 4)))
__device__ __forceinline__ int crow(int r, int hi) { return (r & 3) + 8 * (r >> 2) + 4 * hi; }
__device__ __forceinline__ int v_rd_base(int lane) { return ((lane & 3) << 3) | (((lane >> 2) & 3) << 6) | (((lane >> 4) & 1) << 5) | (((lane >> 5) & 1) << 8); }
template <int OFF> __device__ __forceinline__ s16x4 tr_read(int vb) { s16x4 r; asm volatile("ds_read_b64_tr_b16 %0, %1 offset:%2" : "=&v"(r) : "v"(vb), "i"(OFF) : "memory"); return r; }

struct RowMap { const char* base; long stride; int win0; bool wrap; };
__device__ __forceinline__ const char* rowptr(const RowMap& m, int p) { int sp = m.wrap ? m.win0 + ((p - m.win0) & 255) : p; sp = sp < 0 ? 0 : sp; return m.base + (long)sp * m.stride; }

__device__ __forceinline__ void dma_k(LAS unsigned char* Kl, int p0, int nrows, const RowMap& m, int wave, int lane) {
    asm volatile("" : "+v"(lane));
#pragma unroll 1
    for (int i = 0; i < nrows / 32; ++i) {
        const int prow0 = p0 + 32 * i + 4 * wave, prow = prow0 + (lane >> 4);
        const char* src = rowptr(m, prow) + (((lane & 15) ^ (prow & 7)) << 4);
        __builtin_amdgcn_global_load_lds((const unsigned*)src, (LAS unsigned*)(Kl + prow0 * 256), 16, 0, 0);
    }
}
__device__ __forceinline__ void dma_v(LAS unsigned char* Vl, int p0, int nrows, const RowMap& m, int wave, int lane) {
    asm volatile("" : "+v"(lane));
#pragma unroll 1
    for (int i = 0; i < nrows / 32; ++i) {
        const int ii = wave + 8 * i, g = (p0 >> 4) + (ii >> 2), q = ii & 3;
        const int kk = ((q >> 1) << 3) + ((lane & 31) >> 2), k = (kk & ~0xC) | ((kk & 4) << 1) | ((kk & 8) >> 1);
        const int c = 32 * (2 * (q & 1) + (lane >> 5)) + 8 * (lane & 3);
        const char* src = rowptr(m, 16 * g + k) + c * 2;
        __builtin_amdgcn_global_load_lds((const unsigned*)src, (LAS unsigned*)(Vl + g * 4096 + q * 1024), 16, 0, 0);
    }
}
__device__ __forceinline__ void dma_v2(LAS unsigned char* Vl, int p0, int nrows, const RowMap& m, int wave, int lane) {
    asm volatile("" : "+v"(lane));
#pragma unroll 1
    for (int i = 0; i < nrows / 32; ++i) {
        const int prow0 = p0 + 32 * i + 4 * wave, prow = prow0 + (lane >> 4);
        const char* src = rowptr(m, prow) + (((lane & 15) ^ ((prow & 7) << 1)) << 4);
        __builtin_amdgcn_global_load_lds((const unsigned*)src, (LAS unsigned*)(Vl + prow0 * 256), 16, 0, 0);
    }
}
__device__ __forceinline__ void load_q16(v4u (&raw)[4], const char* qrow, int kg) {
#pragma unroll
    for (int s = 0; s < 4; ++s) raw[s] = *(const GAS v4u*)(qrow + (32 * s + 8 * kg) * 2);
}
__device__ __forceinline__ void norm_q16(const v4u (&raw)[4], bf16x8 (&qr)[4], const LAS float* gt, int kg) {
    float ss = 0.f;
#pragma unroll
    for (int s = 0; s < 4; ++s)
#pragma unroll
        for (int j = 0; j < 4; ++j) { const float a = bflo(raw[s][j]), b = bfhi(raw[s][j]); ss += a * a + b * b; }
    ss += __shfl_xor(ss, 16); ss += __shfl_xor(ss, 32);
    const float rstd = 1.0f / sqrtf(ss * (1.f / HD) + EPS);
#pragma unroll
    for (int s = 0; s < 4; ++s) { const LAS f32x4* gp = (const LAS f32x4*)(gt + 32 * s + 8 * kg); const f32x4 g0 = gp[0], g1 = gp[1]; v4u o;
        o.x = cvtpk(bflo(raw[s].x) * rstd * g0.x, bfhi(raw[s].x) * rstd * g0.y); o.y = cvtpk(bflo(raw[s].y) * rstd * g0.z, bfhi(raw[s].y) * rstd * g0.w);
        o.z = cvtpk(bflo(raw[s].z) * rstd * g1.x, bfhi(raw[s].z) * rstd * g1.y); o.w = cvtpk(bflo(raw[s].w) * rstd * g1.z, bfhi(raw[s].w) * rstd * g1.w);
        qr[s] = __builtin_bit_cast(bf16x8, o); }
}
__device__ __forceinline__ void norm_k(LAS unsigned char* Kl, int p0, int nrows, const LAS float* gt, int tid) {
    asm volatile("" : "+v"(tid));
#pragma unroll 1
    for (int idx = tid; idx < nrows * 4; idx += 512) {
        const int row = p0 + (idx >> 2), qd = idx & 3;
        v4u w[4]; float ss = 0.f;
#pragma unroll
        for (int i = 0; i < 4; ++i) { w[i] = *(const LAS v4u*)(Kl + KSWZ(row, (4 * qd + i) * 16));
#pragma unroll
            for (int j = 0; j < 4; ++j) { const float a = bflo(w[i][j]), b = bfhi(w[i][j]); ss += a * a + b * b; } }
        ss += __shfl_xor(ss, 1); ss += __shfl_xor(ss, 2);
        const float rstd = 1.0f / sqrtf(ss * (1.f / HD) + EPS);
#pragma unroll
        for (int i = 0; i < 4; ++i) { const LAS f32x4* gp = (const LAS f32x4*)(gt + (4 * qd + i) * 8); const f32x4 g0 = gp[0], g1 = gp[1]; v4u o;
            o.x = cvtpk(bflo(w[i].x) * rstd * g0.x, bfhi(w[i].x) * rstd * g0.y); o.y = cvtpk(bflo(w[i].y) * rstd * g0.z, bfhi(w[i].y) * rstd * g0.w);
            o.z = cvtpk(bflo(w[i].z) * rstd * g1.x, bfhi(w[i].z) * rstd * g1.y); o.w = cvtpk(bflo(w[i].w) * rstd * g1.z, bfhi(w[i].w) * rstd * g1.w);
            *(LAS v4u*)(Kl + KSWZ(row, (4 * qd + i) * 16)) = o; }
    }
}
__device__ __forceinline__ float xsum32(float v) { unsigned a = __builtin_bit_cast(unsigned, v), b = a; asm volatile("s_nop 1\n\tv_permlane32_swap_b32 %0, %1" : "+v"(a), "+v"(b)); return __builtin_bit_cast(float, a) + __builtin_bit_cast(float, b); }
__device__ __forceinline__ void load_q(v4u (&raw)[8], const char* qrow, int hi) {
#pragma unroll
    for (int d0 = 0; d0 < 8; ++d0) raw[d0] = *(const GAS v4u*)(qrow + (d0 * 16 + hi * 8) * 2);
}
__device__ __forceinline__ void norm_q(const v4u (&raw)[8], bf16x8 (&qr)[8], const LAS float* gt, int hi) {
    float ss = 0.f;
#pragma unroll
    for (int d0 = 0; d0 < 8; ++d0)
#pragma unroll
        for (int j = 0; j < 4; ++j) { const float a = bflo(raw[d0][j]), b = bfhi(raw[d0][j]); ss += a * a + b * b; }
    ss = xsum32(ss);
    const float rstd = 1.0f / sqrtf(ss * (1.f / HD) + EPS);
#pragma unroll
    for (int d0 = 0; d0 < 8; ++d0) { const LAS f32x4* gp = (const LAS f32x4*)(gt + d0 * 16 + hi * 8); const f32x4 g0 = gp[0], g1 = gp[1]; v4u o;
        o.x = cvtpk(bflo(raw[d0].x) * rstd * g0.x, bfhi(raw[d0].x) * rstd * g0.y); o.y = cvtpk(bflo(raw[d0].y) * rstd * g0.z, bfhi(raw[d0].y) * rstd * g0.w);
        o.z = cvtpk(bflo(raw[d0].z) * rstd * g1.x, bfhi(raw[d0].z) * rstd * g1.y); o.w = cvtpk(bflo(raw[d0].w) * rstd * g1.z, bfhi(raw[d0].w) * rstd * g1.w);
        qr[d0] = __builtin_bit_cast(bf16x8, o); }
}
__device__ __forceinline__ f32x16 qk_tile(const LAS unsigned char* Kl, int pb, const bf16x8 (&qr)[8], int r32, int hi) {
    f32x16 p = {};
#pragma unroll
    for (int d0 = 0; d0 < 8; ++d0) { const bf16x8 kf = *(const LAS bf16x8*)(Kl + KSWZ(pb + r32, (d0 * 16 + hi * 8) * 2));
        p = __builtin_amdgcn_mfma_f32_32x32x16_bf16(kf, qr[d0], p, 0, 0, 0); }
    return p;
}
#define PK4(P, BASE, OUT) do { unsigned a0 = cvtpk(P[BASE + 0], P[BASE + 1]), a1 = cvtpk(P[BASE + 2], P[BASE + 3]);   \
    unsigned b0 = cvtpk(P[BASE + 4], P[BASE + 5]), b1 = cvtpk(P[BASE + 6], P[BASE + 7]);                              \
    auto r0 = __builtin_amdgcn_permlane32_swap(a0, b0, false, false); auto r1 = __builtin_amdgcn_permlane32_swap(a1, b1, false, false); \
    v4u w_ = {r0[0], r1[0], r0[1], r1[1]}; OUT = __builtin_bit_cast(bf16x8, w_); } while (0)
template <int OFF> __device__ __forceinline__ void pv_step(f32x16& o, int vb, bf16x8 pa) {
    const s16x4 l = tr_read<OFF>(vb), h = tr_read<OFF + 2048>(vb);
    asm volatile("s_waitcnt lgkmcnt(0)" ::: "memory"); __builtin_amdgcn_sched_barrier(0);
    o = __builtin_amdgcn_mfma_f32_32x32x16_bf16(pa, (bf16x8){l[0], l[1], l[2], l[3], h[0], h[1], h[2], h[3]}, o, 0, 0, 0);
}
__device__ __forceinline__ void store_block(const f32x16& o, const LAS float* il, LAS unsigned short* stg, char* dst0, long rstride, int lane) {
    asm volatile("" : "+v"(lane));
    const int r32 = lane & 31, hi = lane >> 5;
#pragma unroll
    for (int r = 0; r < 16; ++r) { const int row = crow(r, hi); stg[row * 32 + r32] = (unsigned short)f2bf(o[r] * il[row]); }
    LDS_WAIT(); asm volatile("" ::: "memory");
#pragma unroll
    for (int p = 0; p < 2; ++p) { const int row = 16 * p + (lane >> 2), ch = lane & 3;
        const v4u w = *(const LAS v4u*)((const LAS unsigned char*)stg + row * 64 + ch * 16);
        *(GAS v4u*)(dst0 + (long)row * rstride + ch * 16) = w; }
    LDS_WAIT(); asm volatile("" ::: "memory");
}
}

#define RAW_BAR() do { asm volatile("s_waitcnt lgkmcnt(0)" ::: "memory"); __builtin_amdgcn_s_barrier(); asm volatile("" ::: "memory"); } while (0)
__device__ __forceinline__ void p2_attention(Frame& F) {
    using namespace att;
    LAS unsigned char* Kl = F.lds + LDS_K; LAS unsigned char* Vl = F.lds + LDS_V;
    LAS unsigned short* stg = (LAS unsigned short*)(F.lds + LDS_STG + F.wave * 2048);
    LAS float* li = (LAS float*)(F.lds + LDS_LI + F.wave * 256);
    LAS float* gtab = (LAS float*)(F.lds + LDS_GT);
    LAS float* rk = (LAS float*)(F.lds + LDS_GT + 2048);
    volatile LAS int* QN = (volatile LAS int*)(F.lds + LDS_GT + 2048 + 1024);
    const int tid = F.tid, wave = F.wave;
    if (blockIdx.x < 8) {
        pg8::Gemm g{(const bf16*)(F.ws + WS_H), (const bf16*)(F.ws + WS_WIN), D, nullptr}; pg8::P1Order S{F.G, (int)blockIdx.x, 2560, 2568};
        pg8::EpiProj E{(bf16*)(F.ws + WS_R1), (bf16*)(F.ws + WS_MEMKV)};
        pg8::gemm_phase<pg8::EpiProj, pg8::P1Order>(F.lds, g, S, E);
        VM_WAIT(); __syncthreads();
        if (tid == 0) { __builtin_amdgcn_fence(__ATOMIC_RELEASE, "agent"); asm volatile("s_waitcnt vmcnt(0)" ::: "memory"); __hip_atomic_fetch_add(F.ctl + CW_KVREADY, 1u, RLX_AGENT); }
    }
    if (tid < 128) { gtab[tid] = F.q_norm_g[tid] * F.k_norm_g[tid]; gtab[128 + tid] = F.mem_q_norm_g[tid] * F.mem_k_norm_g[tid]; gtab[256 + tid] = F.mem_q_norm_g[tid]; gtab[384 + tid] = F.mem_k_norm_g[tid]; }
    if (tid == 0) QN[0] = 1 << 30;
    __syncthreads();
    float MD, MM;
    { float a = 0.f, c = 0.f;
#pragma unroll 1
      for (int i = 0; i < 128; ++i) { a = fmaxf(a, fabsf(gtab[i])); c = fmaxf(c, fabsf(gtab[128 + i])); }
      MD = a * (128.0f * 1.03f) * CS; MM = c * (128.0f * 1.03f) * CS; }
    const char* proj = (const char*)(F.ws + WS_R1);

    {
    const int j = wave & 3, dh = wave >> 2, w0 = 32 * j + 16 * dh;
    constexpr int NCHUNK = 6144 / 4;
    v4u qraw[4];
#define DECODE(u, br, b, h, r, nb, dil) const int br = (u) >> 11, _rem = (u) & 2047, b = _rem >> 10, h = (_rem >> 7) & 7, _w = _rem & 127, dil = 1 << (2 * br), _nps = 128 >> (2 * br), r = _w / _nps, nb = _w % _nps
    int u = 4 * F.vcu;
    bool have = F.vcu < NCHUNK;
    bool full = true;
    if (have) {
        DECODE(u, br, b, h, r, nb, dil);
        const long rs = (long)dil * PROJ * 2; const char* tb = proj + (size_t)(b * SEQ + r) * (PROJ * 2);
        RowMap mk{tb + (COL_K + h * HD) * 2, rs, 128 * nb - 128, true};
        dma_k(Kl, 0, 256, mk, wave, F.lane);
        load_q16(qraw, tb + (long)(128 * nb + w0 + (F.lane & 15)) * rs + (COL_Q + h * HD) * 2, F.lane >> 4);
    }
    while (have) {
        DECODE(u, br, b, h, r, nb, dil);
        int lane = F.lane; asm volatile("" : "+v"(lane));
        const int q16 = lane & 15, kg = lane >> 4;
        const int off = 128 * ((nb + 1) & 1);
        const long rs_ = (long)dil * PROJ * 2; const char* tb_ = proj + (size_t)(b * SEQ + r) * (PROJ * 2);
        asm volatile("s_waitcnt vmcnt(0)" ::: "memory"); RAW_BAR();
        { RowMap mv{tb_ + (COL_V + h * HD) * 2, rs_, 128 * nb - 128, true};
          if (full) dma_v2(Vl, 0, 256, mv, wave, lane); else dma_v2(Vl, 128 * (nb & 1), 128, mv, wave, lane); }
        if ((u & 3) == 0 && tid == 0) QN[0] = F.G + (int)__hip_atomic_fetch_add(F.ctl + CW_ATTQ, 1u, RLX_AGENT);
        { const int p0 = full ? 0 : 128 * (nb & 1), n4 = full ? 1024 : 512;
#pragma unroll 1
          for (int idx = tid; idx < n4; idx += 512) { const int row = p0 + (idx >> 2), qd = idx & 3; float ss = 0.f;
#pragma unroll
              for (int i = 0; i < 4; ++i) { const v4u w = *(const LAS v4u*)(Kl + KSWZ(row, (4 * qd + i) * 16));
#pragma unroll
                  for (int jj = 0; jj < 4; ++jj) { const float a = bflo(w[jj]), c = bfhi(w[jj]); ss += a * a + c * c; } }
              ss += __shfl_xor(ss, 1); ss += __shfl_xor(ss, 2);
              if (qd == 0) rk[row] = 1.0f / sqrtf(ss * (1.f / HD) + EPS); } }
        bf16x8 qr[4];
        norm_q16(qraw, qr, gtab, kg);
        f32x4 s[9];
#pragma unroll
        for (int t = 0; t < 9; ++t) { const int pb = (w0 + 16 * t + off) & 255; f32x4 a = {0.f, 0.f, 0.f, 0.f};
#pragma unroll
            for (int d = 0; d < 4; ++d) { const bf16x8 kf = *(const LAS bf16x8*)(Kl + KSWZ(pb + q16, 64 * d + 16 * kg));
                a = __builtin_amdgcn_mfma_f32_16x16x32_bf16(kf, qr[d], a, 0, 0, 0); }
            s[t] = a; }
        RAW_BAR();
        int un = u + 1; bool has_next = true;
        if ((un & 3) == 0) { const int nc = QN[0]; has_next = nc < NCHUNK; un = 4 * nc; }
        bool n_full = false;
        if (has_next) {
            DECODE(un, br2, b2, h2, r2, nb2, dil2);
            n_full = (un != u + 1) || (nb2 == 0);
            const long rs = (long)dil2 * PROJ * 2; const char* tb = proj + (size_t)(b2 * SEQ + r2) * (PROJ * 2);
            RowMap nmk{tb + (COL_K + h2 * HD) * 2, rs, 128 * nb2 - 128, true};
            if (n_full) dma_k(Kl, 0, 256, nmk, wave, lane); else dma_k(Kl, 128 * (nb2 & 1), 128, nmk, wave, lane);
            load_q16(qraw, tb + (long)(128 * nb2 + w0 + q16) * rs + (COL_Q + h2 * HD) * 2, kg);
        }
        const float bias2 = __builtin_amdgcn_exp2f(-(float)(h + 1)) * (float)dil * LOG2E;
        const float rowoff = bias2 * (float)(4 * kg - q16 - 128) - MD;
        float l = 0.f;
#pragma unroll
        for (int t = 0; t < 9; ++t) {
            const int pb = (w0 + 16 * t + off) & 255;
            const f32x4 rkv = *(const LAS f32x4*)(rk + pb + 4 * kg);
            const bool dead = (nb == 0) && (w0 + 16 * t < 128);
#pragma unroll
            for (int r_ = 0; r_ < 4; ++r_) {
                float v = fmaf(s[t][r_] * rkv[r_], CS, fmaf(bias2, (float)(16 * t + r_), rowoff));
                if (t == 0) v = (4 * kg + r_ >= q16) ? v : -1.0e30f;
                if (t == 8) v = (4 * kg + r_ <= q16) ? v : -1.0e30f;
                v = dead ? 0.f : __builtin_amdgcn_exp2f(v); s[t][r_] = v; l += v; }
        }
        l += __shfl_xor(l, 16); l += __shfl_xor(l, 32);
        bf16x8 pa[5];
#pragma unroll
        for (int sp = 0; sp < 5; ++sp) { v4u w; w.x = cvtpk(s[2 * sp][0], s[2 * sp][1]); w.y = cvtpk(s[2 * sp][2], s[2 * sp][3]);
            if (sp < 4) { w.z = cvtpk(s[2 * sp + 1][0], s[2 * sp + 1][1]); w.w = cvtpk(s[2 * sp + 1][2], s[2 * sp + 1][3]); } else { w.z = 0u; w.w = 0u; }
            pa[sp] = __builtin_bit_cast(bf16x8, w); }
        if (has_next) asm volatile("s_waitcnt vmcnt(8)" ::: "memory"); else asm volatile("s_waitcnt vmcnt(0)" ::: "memory");
        RAW_BAR();
        f32x4 o[8];
#pragma unroll
        for (int db = 0; db < 8; ++db) o[db] = (f32x4){0.f, 0.f, 0.f, 0.f};
        { const int qq = q16 >> 2, pp = q16 & 3;
#pragma unroll
          for (int sp = 0; sp < 5; ++sp) {
              const int ra = (w0 + 32 * sp + off + 4 * kg + qq) & 255, rb = (w0 + 32 * sp + 16 + off + 4 * kg + qq) & 255;
              const int va = (int)(uintptr_t)Vl + ra * 256 + 8 * pp, vb = (int)(uintptr_t)Vl + rb * 256 + 8 * pp, xa = (ra & 7) << 5, xb = (rb & 7) << 5;
#pragma unroll
              for (int dq = 0; dq < 2; ++dq) {
                  s16x4 la[4], lb[4];
#pragma unroll
                  for (int i = 0; i < 4; ++i) { const int db = 4 * dq + i;
                      asm volatile("ds_read_b64_tr_b16 %0, %1" : "=&v"(la[i]) : "v"(va + ((32 * db) ^ xa)) : "memory");
                      asm volatile("ds_read_b64_tr_b16 %0, %1" : "=&v"(lb[i]) : "v"(vb + ((32 * db) ^ xb)) : "memory"); }
                  asm volatile("s_waitcnt lgkmcnt(0)" ::: "memory"); __builtin_amdgcn_sched_barrier(0);
#pragma unroll
                  for (int i = 0; i < 4; ++i) { const int db = 4 * dq + i;
                      o[db] = __builtin_amdgcn_mfma_f32_16x16x32_bf16(pa[sp], (bf16x8){la[i][0], la[i][1], la[i][2], la[i][3], lb[i][0], lb[i][1], lb[i][2], lb[i][3]}, o[db], 0, 0, 0); }
              } } }
        const float il = 1.0f / l;
        if (kg == 0) li[q16] = il;
        LDS_WAIT(); asm volatile("" ::: "memory");
        const f32x4 ilr = *(const LAS f32x4*)(li + 4 * kg);
        const int tok0 = b * SEQ + r + dil * (128 * nb + w0);
        char* dst = (char*)(F.ws + WS_OPART) + ((size_t)br * T + tok0) * (ATTN_W * 2) + (h * HD) * 2;
#pragma unroll
        for (int hf = 0; hf < 2; ++hf) {
#pragma unroll
            for (int i = 0; i < 4; ++i)
#pragma unroll
                for (int r_ = 0; r_ < 4; ++r_) stg[(4 * kg + r_) * 64 + 16 * i + q16] = (unsigned short)f2bf(o[4 * hf + i][r_] * ilr[r_]);
            LDS_WAIT(); asm volatile("" ::: "memory");
#pragma unroll
            for (int p = 0; p < 2; ++p) { const int row = lane >> 2, ch = (lane & 3) + 4 * p;
                const v4u w = *(const LAS v4u*)((const LAS unsigned char*)stg + row * 128 + ch * 16);
                *(GAS v4u*)(dst + (long)row * ((long)dil * ATTN_W * 2) + hf * 128 + ch * 16) = w; }
            LDS_WAIT(); asm volatile("" ::: "memory");
        }
        if (kg == 0) ((float*)(F.ws + WS_LSE))[((size_t)br * T + tok0 + dil * q16) * 8 + h] = MD + __builtin_amdgcn_logf(l);
        have = has_next; u = un; full = n_full;
    }
#undef DECODE
    }

    VM_WAIT(); __syncthreads();
    if (wave == 0) { unsigned sp = 0;
        while (__builtin_amdgcn_readfirstlane(__hip_atomic_load(F.ctl + CW_KVREADY, RLX_AGENT)) < 8u) { __builtin_amdgcn_s_sleep(2); if (++sp > (1u << 22)) { if (F.lane == 0) __hip_atomic_store(F.ctl + CW_TMO, 1u, RLX_AGENT); break; } }
        __builtin_amdgcn_fence(__ATOMIC_ACQUIRE, "agent"); asm volatile("s_waitcnt vmcnt(0)" ::: "memory"); }
    __syncthreads();
    for (int it = F.vcu; it < 256; it += F.G) {
        const int combo = it >> 5, part = it & 31, b = combo >> 2, hm = combo & 3;
        const char* mkv = (const char*)(F.ws + WS_MEMKV) + (size_t)(b * NMEM) * 2048 + hm * 256;
        RowMap mk{mkv, 2048, 0, false}, mv{mkv + 1024, 2048, 0, false};
        __syncthreads();
        dma_k(Kl, 0, 256, mk, wave, F.lane); dma_v(Vl, 0, 256, mv, wave, F.lane);
        VM_WAIT(); __syncthreads();
        norm_k(Kl, 0, 256, gtab + 384, tid);
        __syncthreads();
        for (int qb = 0; qb < 2; ++qb) {
            int lane = F.lane; asm volatile("" : "+v"(lane));
            const int r32 = lane & 31, hi = lane >> 5, vbase = (int)(uintptr_t)Vl + v_rd_base(lane);
            const int tok = b * SEQ + part * 512 + qb * 256 + wave * 32 + r32;
            v4u raw[8]; bf16x8 qr[8];
            load_q(raw, proj + (size_t)tok * (PROJ * 2) + (COL_MQ + hm * HD) * 2, hi);
            norm_q(raw, qr, gtab + 256, hi);
            const float mc = -MM; float l = 0.f;
            f32x16 o[4] = {};
#pragma unroll 1
            for (int hk = 0; hk < 2; ++hk) {
                bf16x8 pa[8];
#pragma unroll
                for (int kt = 0; kt < 4; ++kt) { f32x16 s = qk_tile(Kl, 128 * hk + 32 * kt, qr, r32, hi);
#pragma unroll
                    for (int r = 0; r < 16; ++r) { s[r] = __builtin_amdgcn_exp2f(fmaf(s[r], CS, mc)); l += s[r]; }
                    PK4(s, 0, pa[2 * kt]); PK4(s, 8, pa[2 * kt + 1]); }
#pragma unroll
                for (int f = 0; f < 8; ++f) { const int vb = vbase + (8 * hk + f) * 4096;
                    pv_step<0>(o[0], vb, pa[f]); pv_step<512>(o[1], vb, pa[f]); pv_step<1024>(o[2], vb, pa[f]); pv_step<1536>(o[3], vb, pa[f]); }
            }
            l = xsum32(l);
            if (hi == 0) li[r32] = 1.0f / l;
            LDS_WAIT(); asm volatile("" ::: "memory");
            char* dst = (char*)(F.ws + WS_MEMO) + (size_t)(tok - r32) * (MEM_W * 2) + hm * 256;
#pragma unroll
            for (int d0 = 0; d0 < 4; ++d0) store_block(o[d0], li, stg, dst + d0 * 64, MEM_W * 2, lane);
        }
    }
}

__device__ __forceinline__ void unpack8(const v4u w, float (&f)[8]) { f[0] = bflo(w.x); f[1] = bfhi(w.x); f[2] = bflo(w.y); f[3] = bfhi(w.y); f[4] = bflo(w.z); f[5] = bfhi(w.z); f[6] = bflo(w.w); f[7] = bfhi(w.w); }
__device__ __forceinline__ void p3_combine(Frame& F) {
    const int gw = F.vcu * NWAVES + F.wave, NGW = F.G * NWAVES, lane = F.lane;
    const bf16* proj = (const bf16*)(F.ws + WS_R1); const bf16* opart = (const bf16*)(F.ws + WS_OPART); const float* lse = (const float*)(F.ws + WS_LSE);
    const bf16* memo = (const bf16*)(F.ws + WS_MEMO); bf16* Y = (bf16*)(F.ws + WS_Y);
    for (int t = gw; t < T; t += NGW) {
        float a[16]; float ssa = 0.f;
#pragma unroll
        for (int cc = 0; cc < 2; ++cc) { const int head = 4 * cc + (lane >> 4);
            const float l0 = lse[((size_t)0 * T + t) * 8 + head], l1 = lse[((size_t)1 * T + t) * 8 + head], l2 = lse[((size_t)2 * T + t) * 8 + head];
            const float mx = fmaxf(l0, fmaxf(l1, l2)); float w0 = __builtin_amdgcn_exp2f(l0 - mx), w1 = __builtin_amdgcn_exp2f(l1 - mx), w2 = __builtin_amdgcn_exp2f(l2 - mx);
            const float inv = 1.0f / (w0 + w1 + w2); w0 *= inv; w1 *= inv; w2 *= inv;
            float f0[8], f1[8], f2[8];
            unpack8(__builtin_nontemporal_load((const GAS v4u*)(opart + ((size_t)0 * T + t) * ATTN_W + cc * 512 + 8 * lane)), f0);
            unpack8(__builtin_nontemporal_load((const GAS v4u*)(opart + ((size_t)1 * T + t) * ATTN_W + cc * 512 + 8 * lane)), f1);
            unpack8(__builtin_nontemporal_load((const GAS v4u*)(opart + ((size_t)2 * T + t) * ATTN_W + cc * 512 + 8 * lane)), f2);
#pragma unroll
            for (int jj = 0; jj < 8; ++jj) { const float v = w0 * f0[jj] + w1 * f1[jj] + w2 * f2[jj]; a[8 * cc + jj] = v; ssa += v * v; } }
        float co[8]; float ssc = 0.f;
        { const int s = t & (SEQ - 1); float bg[8], c0[8], uu0[8], c1[8], uu1[8], c2[8], uu2[8];
          const bf16* p0 = proj + (size_t)t * PROJ + 8 * lane;
          unpack8(*(const GAS v4u*)(p0 + COL_B), bg); unpack8(*(const GAS v4u*)(p0 + COL_C), c0); unpack8(*(const GAS v4u*)(p0 + COL_U), uu0);
          if (s >= 1) { unpack8(*(const GAS v4u*)(p0 - PROJ + COL_C), c1); unpack8(*(const GAS v4u*)(p0 - PROJ + COL_U), uu1); }
          if (s >= 2) { unpack8(*(const GAS v4u*)(p0 - 2 * PROJ + COL_C), c2); unpack8(*(const GAS v4u*)(p0 - 2 * PROJ + COL_U), uu2); }
#pragma unroll
          for (int jj = 0; jj < 8; ++jj) { const int c = 8 * lane + jj;
              const float z0 = c0[jj] * uu0[jj], z1 = (s >= 1) ? c1[jj] * uu1[jj] : 0.f, z2 = (s >= 2) ? c2[jj] * uu2[jj] : 0.f;
              const float v = bg[jj] * (F.conv_w[c] * z2 + F.conv_w[CONV_W + c] * z1 + F.conv_w[2 * CONV_W + c] * z0); co[jj] = v; ssc += v * v; } }
        float mo[8]; float ssm = 0.f;
        unpack8(__builtin_nontemporal_load((const GAS v4u*)(memo + (size_t)t * MEM_W + 8 * lane)), mo);
#pragma unroll
        for (int jj = 0; jj < 8; ++jj) ssm += mo[jj] * mo[jj];
#pragma unroll
        for (int o = 1; o < 64; o <<= 1) { ssa += __shfl_xor(ssa, o); ssc += __shfl_xor(ssc, o); ssm += __shfl_xor(ssm, o); }
        const float ra = 1.0f / sqrtf(ssa * (1.f / ATTN_W) + EPS), rc = 1.0f / sqrtf(ssc * (1.f / CONV_W) + EPS), rm = 1.0f / sqrtf(ssm * (1.f / MEM_W) + EPS);
        bf16* yr = Y + (size_t)t * D;
#pragma unroll
        for (int cc = 0; cc < 2; ++cc) { const float* g = F.out_norm_g + cc * 512 + 8 * lane; v4u w;
            w.x = pk2(a[8 * cc + 0] * ra * g[0], a[8 * cc + 1] * ra * g[1]); w.y = pk2(a[8 * cc + 2] * ra * g[2], a[8 * cc + 3] * ra * g[3]);
            w.z = pk2(a[8 * cc + 4] * ra * g[4], a[8 * cc + 5] * ra * g[5]); w.w = pk2(a[8 * cc + 6] * ra * g[6], a[8 * cc + 7] * ra * g[7]);
            *(GAS v4u*)(yr + cc * 512 + 8 * lane) = w; }
        { const float* g = F.out_norm_g + ATTN_W + 8 * lane; v4u w;
          w.x = pk2(co[0] * rc * g[0], co[1] * rc * g[1]); w.y = pk2(co[2] * rc * g[2], co[3] * rc * g[3]); w.z = pk2(co[4] * rc * g[4], co[5] * rc * g[5]); w.w = pk2(co[6] * rc * g[6], co[7] * rc * g[7]);
          *(GAS v4u*)(yr + ATTN_W + 8 * lane) = w; }
        { const float* g = F.out_norm_g + ATTN_W + CONV_W + 8 * lane; v4u w;
          w.x = pk2(mo[0] * rm * g[0], mo[1] * rm * g[1]); w.y = pk2(mo[2] * rm * g[2], mo[3] * rm * g[3]); w.z = pk2(mo[4] * rm * g[4], mo[5] * rm * g[5]); w.w = pk2(mo[6] * rm * g[6], mo[7] * rm * g[7]);
          *(GAS v4u*)(yr + ATTN_W + CONV_W + 8 * lane) = w; }
    }
}

__device__ __forceinline__ float max8(float v) { v = fmaxf(v, __shfl_xor(v, 1)); v = fmaxf(v, __shfl_xor(v, 2)); v = fmaxf(v, __shfl_xor(v, 4)); return v; }
namespace rt {
constexpr int KC = 128, NCH = D / KC, BP = KC * 2 + 16, BUFB = 2 * 96 * BP;
__device__ __forceinline__ void issue_b(v4u (&bst)[6], const bf16* WT, int c, int tid) {
#pragma unroll
    for (int i = 0; i < 6; ++i) { const int p = tid + 512 * i, arr = p / 1536, rem = p - arr * 1536, n = rem >> 4, ch = rem & 15;
        bst[i] = *(const GAS v4u*)(WT + ((size_t)arr * 96 + n) * 2048 + c * KC + ch * 8); }
}
__device__ __forceinline__ void write_b(const v4u (&bst)[6], LAS unsigned char* buf, int tid) {
#pragma unroll
    for (int i = 0; i < 6; ++i) { const int p = tid + 512 * i, arr = p / 1536, rem = p - arr * 1536, n = rem >> 4, ch = rem & 15;
        *(LAS v4u*)(buf + arr * (96 * BP) + n * BP + ch * 16) = bst[i]; }
}
__device__ __forceinline__ void issue_a(f32x4 (&a)[4][2], const float* xrow, int c) {
#pragma unroll
    for (int ks = 0; ks < 4; ++ks) { a[ks][0] = *(const GAS f32x4*)(xrow + c * KC + ks * 32); a[ks][1] = *(const GAS f32x4*)(xrow + c * KC + ks * 32 + 4); }
}
__device__ __forceinline__ void compute(f32x4 (&acc)[6], float& ss, const f32x4 (&a)[4][2], const LAS unsigned char* buf, int fr, int kg) {
#pragma unroll
    for (int ks = 0; ks < 4; ++ks) {
        const f32x4 f0 = a[ks][0], f1 = a[ks][1];
        ss += (f0.x * f0.x + f0.y * f0.y) + (f0.z * f0.z + f0.w * f0.w) + (f1.x * f1.x + f1.y * f1.y) + (f1.z * f1.z + f1.w * f1.w);
        asm volatile("" : "+v"(ss));
        v4u h; h.x = cvtpk(f0.x, f0.y); h.y = cvtpk(f0.z, f0.w); h.z = cvtpk(f1.x, f1.y); h.w = cvtpk(f1.z, f1.w);
        v4u l; l.x = cvtpk(f0.x - bflo(h.x), f0.y - bfhi(h.x)); l.y = cvtpk(f0.z - bflo(h.y), f0.w - bfhi(h.y)); l.z = cvtpk(f1.x - bflo(h.z), f1.y - bfhi(h.z)); l.w = cvtpk(f1.z - bflo(h.w), f1.w - bfhi(h.w));
        const bf16x8 ah = __builtin_bit_cast(bf16x8, h), al = __builtin_bit_cast(bf16x8, l);
#pragma unroll
        for (int nb = 0; nb < 6; ++nb) { const LAS unsigned char* bp = buf + (nb * 16 + fr) * BP + (ks * 32 + 8 * kg) * 2;
            const bf16x8 bh = *(const LAS bf16x8*)bp, bl = *(const LAS bf16x8*)(bp + 96 * BP);
            acc[nb] = __builtin_amdgcn_mfma_f32_16x16x32_bf16(ah, bh, acc[nb], 0, 0, 0);
            acc[nb] = __builtin_amdgcn_mfma_f32_16x16x32_bf16(al, bh, acc[nb], 0, 0, 0);
            acc[nb] = __builtin_amdgcn_mfma_f32_16x16x32_bf16(ah, bl, acc[nb], 0, 0, 0); }
    }
}
}
__device__ __forceinline__ void p5_router(Frame& F) {
    using namespace rt;
    const int tid = F.tid, wave = F.wave;
    const float* X1 = F.out; const bf16* WT = (const bf16*)(F.ws + WS_WR);
    LAS unsigned char* Bl = F.lds;
    LAS float* Lg = (LAS float*)(F.lds + 2 * BUFB + wave * (16 * 97 * 4));
    unsigned* cnt = F.ctl + CW_CNT;
    int* tok_e = (int*)(F.ws + WS_TOK + TOK_E); int* tok_rank = (int*)(F.ws + WS_TOK + TOK_RANK);
    for (int mt = F.vcu; mt < T / 128; mt += F.G) {
        int lane = F.lane; asm volatile("" : "+v"(lane));
        const int fr = lane & 15, kg = lane >> 4;
        const int t0 = mt * 128 + wave * 16;
        const float* xrow = X1 + (size_t)(t0 + fr) * D + 8 * kg;
        f32x4 acc[6];
#pragma unroll
        for (int i = 0; i < 6; ++i) acc[i] = (f32x4){0.f, 0.f, 0.f, 0.f};
        float ss = 0.f;
        v4u bst[6]; f32x4 a0[4][2], a1[4][2];
        __syncthreads();
        issue_b(bst, WT, 0, tid); issue_a(a0, xrow, 0);
#pragma unroll 1
        for (int c = 0; c < NCH; c += 2) {
            write_b(bst, Bl, tid); __syncthreads();
            issue_b(bst, WT, c + 1, tid); issue_a(a1, xrow, c + 1);
            compute(acc, ss, a0, Bl, fr, kg);
            write_b(bst, Bl + BUFB, tid); __syncthreads();
            if (c + 2 < NCH) { issue_b(bst, WT, c + 2, tid); issue_a(a0, xrow, c + 2); }
            compute(acc, ss, a1, Bl + BUFB, fr, kg);
        }
        ss += __shfl_xor(ss, 16); ss += __shfl_xor(ss, 32);
        const float rs_row = 1.0f / sqrtf(ss * (1.f / D) + EPS);
#pragma unroll
        for (int r = 0; r < 4; ++r) { const float rr = __shfl(rs_row, 4 * kg + r);
#pragma unroll
            for (int nb = 0; nb < 6; ++nb) Lg[(4 * kg + r) * 97 + nb * 16 + fr] = acc[nb][r] * rr; }
        LDS_WAIT(); asm volatile("" ::: "memory");
        const float be = F.b_re[lane], bg = F.b_rg[lane & 7];
        int my_e1 = 0, my_e2 = 0; float my_g1 = 0.f, my_g2 = 0.f;
#pragma unroll 4
        for (int tk = 0; tk < 16; ++tk) {
            const float gl = Lg[tk * 97 + 64 + (lane & 7)] + bg;
            const float el = Lg[tk * 97 + lane] + be;
            const float gmax = max8(gl);
            const int gi = __builtin_ctzll(__ballot(gl == gmax) & 0xFFull);
            float gs = __builtin_amdgcn_exp2f((gl - gmax) * LOG2E); gs += __shfl_xor(gs, 1); gs += __shfl_xor(gs, 2); gs += __shfl_xor(gs, 4);
            const float gwt = 1.0f / gs;
            const float v1 = __shfl(max8(el), 8 * gi);
            const int i1 = __builtin_ctzll((__ballot(el == v1) >> (8 * gi)) & 0xFFull);
            const float el2 = (lane == 8 * gi + i1) ? -3.0e38f : el;
            const float v2 = __shfl(max8(el2), 8 * gi);
            const int i2 = __builtin_ctzll((__ballot(el2 == v2) >> (8 * gi)) & 0xFFull);
            const float pr = __builtin_amdgcn_exp2f((v2 - v1) * LOG2E), den = 1.0f / (1.0f + pr);
            if (lane == tk) { my_e1 = 8 * gi + i1; my_e2 = 8 * gi + i2; my_g1 = gwt * den; my_g2 = gwt * pr * den; }
        }
        LAS unsigned* hist = (LAS unsigned*)(F.lds + MISC_OFF + 256);
        if (tid < 64) hist[tid] = 0u;
        __syncthreads();
        unsigned lr1 = 0u, lr2 = 0u;
        if (lane < 16) { lr1 = __hip_atomic_fetch_add(hist + my_e1, 1u, __ATOMIC_RELAXED, __HIP_MEMORY_SCOPE_WORKGROUP); lr2 = __hip_atomic_fetch_add(hist + my_e2, 1u, __ATOMIC_RELAXED, __HIP_MEMORY_SCOPE_WORKGROUP); }
        __syncthreads();
        if (tid < 64) { const unsigned c = hist[tid]; hist[64 + tid] = c ? __hip_atomic_fetch_add(cnt + 64 * tid, c, RLX_AGENT) : 0u; }
        __syncthreads();
        if (lane < 16) {
            const int t = t0 + lane;
            const int k1 = (int)(hist[64 + my_e1] + lr1), k2 = (int)(hist[64 + my_e2] + lr2);
            tok_e[2 * t] = my_e1; tok_e[2 * t + 1] = my_e2; tok_rank[2 * t] = k1; tok_rank[2 * t + 1] = k2;
            int* ltok = (int*)(F.ws + WS_LIST + LIST_TOK); float* lrs = (float*)(F.ws + WS_LIST + LIST_RSTD); float* lgt = (float*)(F.ws + WS_LIST + LIST_GATE);
            ltok[my_e1 * CAP + k1] = t; ltok[my_e2 * CAP + k2] = t; lrs[my_e1 * CAP + k1] = rs_row; lrs[my_e2 * CAP + k2] = rs_row; lgt[my_e1 * CAP + k1] = my_g1; lgt[my_e2 * CAP + k2] = my_g2;
        }
    }
}

constexpr int MOE_MT = MISC_OFF + 48, MOE_PST = MISC_OFF + 64, MOE_TE = MOE_PST + 256;
constexpr int MOE_TB = LDS_EXTRA, MOE_VR = MOE_TB + MAXTILES * 4, MOE_UT = MOE_VR + MAXTILES * 4;
constexpr int MOE_MAXU = 12;
static_assert(MOE_UT + MOE_MAXU * 256 * 4 <= MISC_OFF && MOE_TE + MAXTILES * 4 <= LDS_BYTES, "LDS map");
__device__ __forceinline__ int moe_tables(Frame& F) {
    LAS int* PST = (LAS int*)(F.lds + MOE_PST); LAS int* TE = (LAS int*)(F.lds + MOE_TE); LAS int* MTp = (LAS int*)(F.lds + MOE_MT); LAS int* TB = (LAS int*)(F.lds + MOE_TB); LAS int* VR = (LAS int*)(F.lds + MOE_VR);
    __syncthreads();
    if (F.tid < 64) {
        const int c = (int)__hip_atomic_load(F.ctl + CW_CNT + 64 * F.tid, RLX_AGENT); const int nt = (c + 255) >> 8;
        int x = nt;
#pragma unroll
        for (int o = 1; o < 64; o <<= 1) { const int y = __shfl_up(x, o); if (F.lane >= o) x += y; }
        const int ex = x - nt; PST[F.tid] = ex; if (F.tid == 63) MTp[0] = x;
        for (int i = 0; i < nt; ++i) { TE[ex + i] = F.tid; TB[ex + i] = F.tid * CAP + 256 * i; VR[ex + i] = (c - 256 * i) < 256 ? (c - 256 * i) : 256; }
    }
    __syncthreads();
    return MTp[0];
}

__device__ __forceinline__ void p9_final(Frame& F) {
    (void)moe_tables(F);
    const LAS int* PST = (const LAS int*)(F.lds + MOE_PST);
    const int gw = F.vcu * NWAVES + F.wave, NGW = F.G * NWAVES, lane = F.lane;
    const int* tok_e = (const int*)(F.ws + WS_TOK + TOK_E); const int* tok_rank = (const int*)(F.ws + WS_TOK + TOK_RANK); const bf16* YB = (const bf16*)(F.ws + WS_R1);
    typedef int i32x2 __attribute__((ext_vector_type(2)));
    i32x2 ce = {0, 0}, cr = {0, 0};
    if (gw < T) { ce = *(const GAS i32x2*)(tok_e + 2 * gw); cr = *(const GAS i32x2*)(tok_rank + 2 * gw); }
    for (int t = gw; t < T; t += NGW) {
        const int s1 = PST[ce.x] * 256 + cr.x, s2 = PST[ce.y] * 256 + cr.y;
        if (t + NGW < T) { ce = *(const GAS i32x2*)(tok_e + 2 * (t + NGW)); cr = *(const GAS i32x2*)(tok_rank + 2 * (t + NGW)); }
        const GAS v4u* y1 = (const GAS v4u*)(YB + (size_t)s1 * D) + lane; const GAS v4u* y2 = (const GAS v4u*)(YB + (size_t)s2 * D) + lane;
        GAS f32x4* o = (GAS f32x4*)(F.out + (size_t)t * D) + 2 * lane;
#pragma unroll
        for (int i = 0; i < 4; ++i) { float a[8], b[8]; unpack8(__builtin_nontemporal_load(y1 + 64 * i), a); unpack8(__builtin_nontemporal_load(y2 + 64 * i), b);
            f32x4 v0 = __builtin_nontemporal_load(o + 128 * i), v1 = __builtin_nontemporal_load(o + 128 * i + 1);
            v0.x += a[0] + b[0]; v0.y += a[1] + b[1]; v0.z += a[2] + b[2]; v0.w += a[3] + b[3]; v1.x += a[4] + b[4]; v1.y += a[5] + b[5]; v1.z += a[6] + b[6]; v1.w += a[7] + b[7];
            __builtin_nontemporal_store(v0, o + 128 * i); __builtin_nontemporal_store(v1, o + 128 * i + 1); }
    }
}

constexpr int PER_PHASE = 10;
constexpr int N_LAUNCHES = MK_N_LAUNCHES;
struct Args { const float* in[21]; float* out; unsigned char* ws; int ph_lo, ph_hi, li, pad; };
__global__ void __launch_bounds__(NWAVES * 64, 2) hymba_fwd(Args args) {
    extern __shared__ __attribute__((aligned(16))) unsigned char lds[];
    Frame F;
    F.lds = (LAS unsigned char*)lds;
    F.tid = threadIdx.x; F.lane = F.tid & 63; F.wave = __builtin_amdgcn_readfirstlane(F.tid >> 6);
    F.G = gridDim.x; { const int bx = blockIdx.x; F.vcu = (F.G % 8 == 0) ? (bx % 8) * (F.G / 8) + bx / 8 : bx; }
    F.ws = args.ws; F.ctl = (unsigned*)(args.ws + WS_CTL); F.out = args.out;
    F.x = args.in[0]; F.mem = args.in[1]; F.norm1_g = args.in[2]; F.w_in = args.in[3]; F.q_norm_g = args.in[4]; F.k_norm_g = args.in[5]; F.conv_w = args.in[6];
    F.mem_norm_g = args.in[7]; F.w_mem_kv = args.in[8]; F.mem_q_norm_g = args.in[9]; F.mem_k_norm_g = args.in[10]; F.out_norm_g = args.in[11]; F.w_out = args.in[12];
    F.norm2_g = args.in[13]; F.w_rg = args.in[14]; F.b_rg = args.in[15]; F.w_re = args.in[16]; F.b_re = args.in[17]; F.w_gate = args.in[18]; F.w_up = args.in[19]; F.w_down = args.in[20];
    volatile LAS unsigned* MISC = (volatile LAS unsigned*)(F.lds + MISC_OFF);
    if (F.tid < 16) MISC[F.tid] = 0u;
    __syncthreads();
    const int lo = args.ph_lo, hi = args.ph_hi;
    const bool multi = (hi - lo) > 1;
    XcdBarrier bar; bar.bar = F.ctl + CW_BAR + args.li * XCD_BAR_WORDS; bar.x = 0; bar.st = nullptr;
    if (multi) bar = xcd_barrier_post(F.ctl + CW_BAR + args.li * XCD_BAR_WORDS, MISC + 8);
#define GRID_BAR() do { if (multi) xcd_barrier(bar); } while (0)
#define IN(k) (lo <= (k) && (k) < hi)
#define BOTH(k) (IN(k) && IN((k) + 1))
    if (IN(0)) { p0_prologue(F); if (BOTH(0)) GRID_BAR(); }
    if (IN(1)) {
        pg8::Gemm g{(const bf16*)(F.ws + WS_H), (const bf16*)(F.ws + WS_WIN), D, nullptr}; pg8::P1Order S{F.G, (int)blockIdx.x, 0, 2560};
        pg8::EpiProj E{(bf16*)(F.ws + WS_R1), (bf16*)(F.ws + WS_MEMKV)};
        pg8::gemm_phase<pg8::EpiProj, pg8::P1Order>(F.lds, g, S, E);
        if (BOTH(1)) GRID_BAR();
    }
    if (IN(2)) { p2_attention(F); if (BOTH(2)) GRID_BAR(); }
    if (IN(3)) { p3_combine(F); if (BOTH(3)) GRID_BAR(); }
    if (IN(4)) {
        pg8::Gemm g{(const bf16*)(F.ws + WS_Y), (const bf16*)(F.ws + WS_WOUT), D, nullptr}; pg8::StaticOrder S{T / 256, D / 256, F.G, (int)blockIdx.x};
        pg8::EpiResid E{F.x, F.out, (bf16*)(F.ws + WS_H)};
        pg8::gemm_phase<pg8::EpiResid, pg8::StaticOrder, false>(F.lds, g, S, E);
        if (BOTH(4)) GRID_BAR();
    }
    if (IN(5)) { p5_router(F); if (BOTH(5)) GRID_BAR(); }
    if (IN(7)) {
        const int MT = moe_tables(F);
        pg8::MoeOrder S{MT, F.G, (int)blockIdx.x, (const LAS int*)(F.lds + MOE_TE)};
        { const LAS int* TB = (const LAS int*)(F.lds + MOE_TB); const LAS int* VR = (const LAS int*)(F.lds + MOE_VR); LAS int* UT = (LAS int*)(F.lds + MOE_UT);
          const int* ltok = (const int*)(F.ws + WS_LIST + LIST_TOK);
          for (int i = 0; i < MOE_MAXU; ++i) { pg8::Unit u; if (!S.next(i, u)) break;
              if (F.tid < 256) UT[i * 256 + F.tid] = (F.tid < VR[u.pm]) ? ltok[TB[u.pm] + F.tid] : 0; }
          __syncthreads(); }
        pg8::Gemm g{(const bf16*)(F.ws + WS_H), (const bf16*)(F.ws + WS_WGU), D, (const LAS int*)(F.lds + MOE_UT)};
        pg8::EpiSwiGLU E{(bf16*)(F.ws + WS_OPART), (const float*)(F.ws + WS_LIST + LIST_RSTD), (const LAS int*)(F.lds + MOE_TB)};
        pg8::gemm_phase<pg8::EpiSwiGLU, pg8::MoeOrder, true, true, false, true>(F.lds, g, S, E);
        if (BOTH(7)) GRID_BAR();
    }
    if (IN(8)) {
        const int MT = moe_tables(F);
        pg8::Gemm g{(const bf16*)(F.ws + WS_OPART), (const bf16*)(F.ws + WS_WD), DEXP, nullptr}; pg8::MoeOrder S{MT, F.G, (int)blockIdx.x, (const LAS int*)(F.lds + MOE_TE)};
        pg8::EpiDown E{(bf16*)(F.ws + WS_R1), (const float*)(F.ws + WS_LIST + LIST_GATE), (const LAS int*)(F.lds + MOE_TB)};
        pg8::gemm_phase<pg8::EpiDown, pg8::MoeOrder, true, false, false, true>(F.lds, g, S, E);
        if (BOTH(8)) GRID_BAR();
    }
    if (IN(9)) { p9_final(F); }
#undef IN
#undef BOTH
#undef GRID_BAR
}

extern "C" void kernel_launch(void* const* d_in, const int* in_sizes, int n_in, void* d_out, int out_size, void* d_ws, size_t ws_size, hipStream_t stream) {
    static int grid = 0;
    if (grid == 0) {
        if (n_in != 21 || in_sizes[0] != T * D || out_size != T * D || ws_size < WS_END) { fprintf(stderr, "kernel_launch: shape/workspace mismatch (n_in %d, ws %zu < %zu); nothing launched\n", n_in, ws_size, (size_t)WS_END); grid = -1; return; }
        int dev = 0, cus = 0, per_cu = 0;
        if (hipGetDevice(&dev) != hipSuccess || hipDeviceGetAttribute(&cus, hipDeviceAttributeMultiprocessorCount, dev) != hipSuccess) { grid = -1; return; }
        if (hipFuncSetAttribute((const void*)hymba_fwd, hipFuncAttributeMaxDynamicSharedMemorySize, LDS_BYTES) != hipSuccess) { fprintf(stderr, "kernel_launch: hipFuncSetAttribute failed\n"); grid = -1; return; }
        if (hipOccupancyMaxActiveBlocksPerMultiprocessor(&per_cu, (const void*)hymba_fwd, NWAVES * 64, LDS_BYTES) != hipSuccess || per_cu < 1) { fprintf(stderr, "kernel_launch: occupancy query reports %d\n", per_cu); }
        (void)hipGetLastError();
        grid = cus;
    }
    if (grid < 0) return;
    if (hipMemsetAsync((char*)d_ws + WS_CTL, 0, CTL_ZERO_BYTES, stream) != hipSuccess) { fprintf(stderr, "kernel_launch: memset failed\n"); return; }
    Args a{};
    for (int i = 0; i < 21; ++i) a.in[i] = (const float*)d_in[i];
    a.out = (float*)d_out; a.ws = (unsigned char*)d_ws;
    int los[4], his[4], nl = 0;
#if defined(PROBE_REPEAT)
    los[nl] = 0; his[nl] = PROBE_REPEAT + 1; ++nl; los[nl] = PROBE_REPEAT; his[nl] = PROBE_REPEAT + 1; ++nl; if (PROBE_REPEAT + 1 < PER_PHASE) { los[nl] = PROBE_REPEAT + 1; his[nl] = PER_PHASE; ++nl; }
#else
    los[nl] = 0; his[nl] = PER_PHASE; ++nl;
#endif
    for (int li = 0; li < nl; ++li) {
        a.ph_lo = los[li]; a.ph_hi = his[li]; a.li = li;
#if defined(PROBE_REPEAT)
        if (li == 1) { (void)hipMemsetAsync((char*)d_ws + WS_CTL + CW_ATTQ * 4, 0, 64, stream); if (PROBE_REPEAT == 5) (void)hipMemsetAsync((char*)d_ws + WS_CTL + CW_CNT * 4, 0, 64 * 256, stream); }
#endif
        hipLaunchKernelGGL(hymba_fwd, dim3(grid), dim3(NWAVES * 64), LDS_BYTES, stream, a);
        const hipError_t le = hipPeekAtLastError();
        if (le != hipSuccess) { fprintf(stderr, "kernel_launch: launch %d failed: %s\n", li, hipGetErrorName(le)); break; }
    }
}
```

```cpp
#include <hip/hip_runtime.h>
#include <cstdio>
#include <cstdint>

#ifndef MK_N_LAUNCHES
#define MK_N_LAUNCHES 1
#endif

#define GAS __attribute__((address_space(1)))
#define LAS __attribute__((address_space(3)))
typedef unsigned short bf16;
typedef unsigned v4u __attribute__((ext_vector_type(4)));
typedef unsigned v2u __attribute__((ext_vector_type(2)));
typedef float f32x4 __attribute__((ext_vector_type(4)));
typedef float f32x16 __attribute__((ext_vector_type(16)));
typedef short bf16x8 __attribute__((ext_vector_type(8)));
typedef short s16x4 __attribute__((ext_vector_type(4)));
#define LDS_WAIT() asm volatile("s_waitcnt lgkmcnt(0)" ::: "memory")
#define VM_WAIT() asm volatile("s_waitcnt vmcnt(0)" ::: "memory")
#define RLX_AGENT __ATOMIC_RELAXED, __HIP_MEMORY_SCOPE_AGENT

constexpr int BATCH = 2, SEQ = 16384, T = BATCH * SEQ, D = 2048, PROJ = 5120;
constexpr int NH = 8, HD = 128, ATTN_W = 1024, CONV_W = 512, MEM_W = 512, NMEM = 256, NMH = 4;
constexpr int COL_Q = 0, COL_K = 1024, COL_V = 2048, COL_B = 3072, COL_C = 3584, COL_U = 4096, COL_MQ = 4608;
constexpr int NEXP = 64, DEXP = 1024;
constexpr int RMAX = 81920;
constexpr int MAXTILES = RMAX / 256;
constexpr float EPS = 1e-6f;
constexpr float LOG2E = 1.4426950408889634f;

constexpr size_t MiB = 1u << 20;
constexpr size_t WS_CTL = 0, CTL_ZERO_BYTES = 1 * MiB;
constexpr size_t WS_WIN = 1 * MiB;
constexpr size_t WS_WMKV = WS_WIN + (size_t)PROJ * D * 2;
constexpr size_t WS_WOUT = 25 * MiB;
constexpr size_t WS_WR = 33 * MiB;
constexpr size_t WS_WGU = 34 * MiB;
constexpr size_t WS_WD = WS_WGU + 512 * MiB;
constexpr size_t WS_H = WS_WD + 256 * MiB;
constexpr size_t WS_MEMKV = WS_H + 130 * MiB;
constexpr size_t WS_R1 = WS_MEMKV + 1 * MiB;
constexpr size_t WS_OPART = WS_R1 + 320 * MiB;
constexpr size_t WS_LSE = WS_OPART + 192 * MiB;
constexpr size_t WS_MEMO = WS_LSE + 3 * MiB;
constexpr size_t WS_Y = WS_MEMO + 32 * MiB;
constexpr size_t WS_TOK = WS_Y + 128 * MiB;
constexpr size_t WS_LIST = WS_TOK + 4 * MiB;
constexpr size_t WS_END = WS_LIST + 24 * MiB;
constexpr int CAP = T;
constexpr size_t LIST_TOK = 0, LIST_RSTD = 8 * MiB, LIST_GATE = 16 * MiB;
constexpr size_t TOK_E = 0, TOK_RANK = 256 * 1024, TOK_GATE = 512 * 1024, TOK_RSTD = 768 * 1024, TOK_SLOT = 1024 * 1024, SLOT_RSTD = 1536 * 1024, SLOT_GATE = 2048 * 1024;
static_assert(WS_WMKV + 1024 * (size_t)D * 2 <= WS_WOUT && WS_WOUT + 8 * MiB <= WS_WR && WS_WR + 2048 * 72 * 4 <= WS_WGU, "ws map");
static_assert((size_t)(T + 512) * D * 2 <= 130 * MiB && (size_t)RMAX * D * 2 <= 320 * MiB && (size_t)RMAX * DEXP * 2 <= 192 * MiB && SLOT_GATE + RMAX * 4 <= 4 * MiB, "ws map");

constexpr int CW_TMO = 0, CW_CODE = 1;
constexpr int CW_CNT = 8192;
constexpr int CW_BAR = 16384;
constexpr int CW_KVREADY = 512, CW_ATTQ = 576;

constexpr int RING_BYTES = 131072;
constexpr int LDS_EXTRA = RING_BYTES;
constexpr int MISC_OFF = 163840 - 2048;
constexpr int LDS_BYTES = 163840;

__device__ __forceinline__ unsigned f2bf(float f) { unsigned u = __builtin_bit_cast(unsigned, f); return (u + 0x7fffu + ((u >> 16) & 1u)) >> 16; }
__device__ __forceinline__ unsigned pk2(float lo, float hi) { return f2bf(lo) | (f2bf(hi) << 16); }
__device__ __forceinline__ unsigned cvtpk(float lo, float hi) { unsigned r; asm volatile("v_cvt_pk_bf16_f32 %0, %1, %2" : "=v"(r) : "v"(lo), "v"(hi)); return r; }
__device__ __forceinline__ unsigned pk_fp8x4(float a, float b, float c, float d) { unsigned w = 0u; w = __builtin_amdgcn_cvt_pk_fp8_f32(a, b, w, false); w = __builtin_amdgcn_cvt_pk_fp8_f32(c, d, w, true); return w; }
constexpr float SC_WGU = 128.0f, SC_ACT = 4.0f, SC_WD = 64.0f;
__device__ __forceinline__ float bflo(unsigned w) { return __builtin_bit_cast(float, w << 16); }
__device__ __forceinline__ float bfhi(unsigned w) { return __builtin_bit_cast(float, w & 0xffff0000u); }
__device__ __forceinline__ float wave_sum(float v) {
#pragma unroll
    for (int o = 1; o < 64; o <<= 1) v += __shfl_xor(v, o);
    return v;
}

namespace pg8 {
#define PG8_LAS __attribute__((address_space(3)))
typedef unsigned short bf16_t;
typedef unsigned u32x4 __attribute__((ext_vector_type(4)));
typedef int i32x4 __attribute__((ext_vector_type(4)));
typedef int i32x8 __attribute__((ext_vector_type(8)));
constexpr int BM = 256, BK = 64, HALF = 128, HTB = HALF * BK * 2, STAGE_BYTES = 8 * HTB, NXCD = 8, WGM = 8;
__host__ __device__ __forceinline__ int lds_byte(int r, int c) { const int st = (r >> 4) * 2 + (c >> 5), rr = r & 15, cc = c & 31, ob = rr * 64 + cc * 2; return st * 1024 + (ob ^ (((ob >> 9) & 1) << 5)); }
__host__ __device__ __forceinline__ void stage_rc(int b, int& R, int& C) { const int st = b / 1024, sb = b % 1024, swz = sb ^ (((sb >> 9) & 1) << 5); R = (st >> 1) * 16 + swz / 64; C = (st & 1) * 32 + (swz % 64) / 2; }
__host__ __device__ __forceinline__ int perm32(int rho) { const int n = rho >> 4, i = rho & 15; return 8 * (i >> 2) + 4 * n + (i & 3); }

struct Unit { int pm, pn, pb, ui; };
struct Gemm { const bf16_t* A; const bf16_t* Bt; int K; const PG8_LAS int* ut; };

__device__ __forceinline__ void tile_of(int L, int nM, int nN, int& pm, int& pn) {
    const int nwg = nM * nN;
    int wgid = L; { const int q = nwg / NXCD, r = nwg % NXCD, xcd = wgid % NXCD, off = wgid / NXCD; wgid = (xcd < r ? xcd * (q + 1) : r * (q + 1) + (xcd - r) * q) + off; }
    const int nig = WGM * nN, gid = wgid / nig, fm = gid * WGM, gsz = (nM - fm) < WGM ? (nM - fm) : WGM;
    pm = fm + ((wgid % nig) % gsz); pn = (wgid % nig) / gsz;
}
struct StaticOrder {
    int nM, nN, G, c;
    __device__ __forceinline__ bool next(int i, Unit& u) const { const long L = (long)i * G + c; if (L >= (long)nM * nN) return false; tile_of((int)L, nM, nN, u.pm, u.pn); u.pb = u.pn; return true; }
    __device__ __forceinline__ void a_ready(const Unit&) const {}
    __device__ __forceinline__ void done(const Unit&) const {}
};
struct P1Order {
    int G, c, lo, hi;
    __device__ __forceinline__ bool next(int i, Unit& u) const { const long L = (long)lo + (long)i * G + c; if (L >= hi) return false;
        if (L < 2560) tile_of((int)L, 128, 20, u.pm, u.pn); else { const int k = (int)L - 2560; u.pm = 128 + (k >> 2); u.pn = 20 + (k & 3); }
        u.pb = u.pn; return true; }
    __device__ __forceinline__ void a_ready(const Unit&) const {}
    __device__ __forceinline__ void done(const Unit&) const {}
};
struct MoeOrder {
    int nM, G, c; const LAS int* te;
    __device__ __forceinline__ bool next(int i, Unit& u) const { const long L = (long)i * G + c; if (L >= (long)nM * 8) return false; tile_of((int)L, nM, 8, u.pm, u.pn); u.pb = te[u.pm] * 8 + u.pn; u.ui = i; return true; }
    __device__ __forceinline__ void a_ready(const Unit&) const {}
    __device__ __forceinline__ void done(const Unit&) const {}
};

struct EpiProj {
    static constexpr bool PERM = true, AFTER_DRAIN = false;
    bf16_t* O; bf16_t* O2;
    __device__ __forceinline__ void operator()(const f32x4 (&acc)[2][2][4][2], const Unit& u, int wr, int wc, int fr, int fq) const {
        int row0 = u.pm * BM + wr * 64 + fr, col0 = u.pn * BM + wc * 32 + 8 * fq, ldc = PROJ; bf16_t* base = O;
        if (u.pm >= 128) { row0 -= 128 * BM; col0 -= 20 * BM; ldc = 1024; base = O2; }
#pragma unroll
        for (int ai = 0; ai < 2; ++ai)
#pragma unroll
            for (int m = 0; m < 4; ++m) { bf16_t* rowp = base + (size_t)(row0 + ai * HALF + m * 16) * ldc + col0;
#pragma unroll
                for (int bj = 0; bj < 2; ++bj) { const f32x4 v0 = acc[ai][bj][m][0], v1 = acc[ai][bj][m][1];
                    u32x4 w; w.x = cvtpk(v0[0], v0[1]); w.y = cvtpk(v0[2], v0[3]); w.z = cvtpk(v1[0], v1[1]); w.w = cvtpk(v1[2], v1[3]);
                    *(u32x4*)(rowp + bj * HALF) = w; } }
    }
};
struct EpiResid {
    static constexpr bool PERM = true, AFTER_DRAIN = false;
    const float* X; float* X1; bf16_t* X1B;
    __device__ __forceinline__ void operator()(const f32x4 (&acc)[2][2][4][2], const Unit& u, int wr, int wc, int fr, int fq) const {
        const int row0 = u.pm * BM + wr * 64 + fr, col0 = u.pn * BM + wc * 32 + 8 * fq;
#pragma unroll
        for (int ai = 0; ai < 2; ++ai)
#pragma unroll
            for (int m = 0; m < 4; ++m) { const size_t off = (size_t)(row0 + ai * HALF + m * 16) * D + col0;
#pragma unroll
                for (int bj = 0; bj < 2; ++bj) { const f32x4 xa = __builtin_nontemporal_load((const f32x4*)(X + off + bj * HALF)), xb = __builtin_nontemporal_load((const f32x4*)(X + off + bj * HALF + 4));
                    const f32x4 v0 = acc[ai][bj][m][0] + xa, v1 = acc[ai][bj][m][1] + xb;
                    *(f32x4*)(X1 + off + bj * HALF) = v0; *(f32x4*)(X1 + off + bj * HALF + 4) = v1;
                    v2u w; w.x = pk_fp8x4(v0[0], v0[1], v0[2], v0[3]); w.y = pk_fp8x4(v1[0], v1[1], v1[2], v1[3]);
                    *(v2u*)((unsigned char*)X1B + off + bj * HALF) = w; }
                asm volatile("" ::: "memory"); }
    }
};
struct EpiSwiGLU {
    static constexpr bool PERM = true, AFTER_DRAIN = false;
    bf16_t* ACT; const PG8_LAS float* RSU;
    __device__ __forceinline__ void operator()(const f32x4 (&acc)[2][2][4][2], const Unit& u, int wr, int wc, int fr, int fq) const {
        const int row0 = u.pm * BM + wr * 64 + fr, col0 = u.pn * HALF + wc * 32 + 8 * fq; const PG8_LAS float* rsu = RSU + u.ui * 256 + wr * 64 + fr;
#pragma unroll
        for (int ai = 0; ai < 2; ++ai)
#pragma unroll
            for (int m = 0; m < 4; ++m) { const int row = row0 + ai * HALF + m * 16; const float rs = rsu[ai * HALF + m * 16] * (1.0f / SC_WGU); float o[8];
#pragma unroll
                for (int n = 0; n < 2; ++n)
#pragma unroll
                    for (int j = 0; j < 4; ++j) { const float g = acc[ai][0][m][n][j] * rs, uu = acc[ai][1][m][n][j] * rs;
                        o[n * 4 + j] = g * __builtin_amdgcn_rcpf(1.0f + __builtin_amdgcn_exp2f(-g * LOG2E)) * uu * SC_ACT; }
                v2u w; w.x = pk_fp8x4(o[0], o[1], o[2], o[3]); w.y = pk_fp8x4(o[4], o[5], o[6], o[7]);
                *(v2u*)((unsigned char*)ACT + (size_t)row * DEXP + col0) = w; }
    }
};
struct EpiDown {
    static constexpr bool PERM = true, AFTER_DRAIN = false;
    bf16_t* Y; const PG8_LAS float* GTU;
    __device__ __forceinline__ void operator()(const f32x4 (&acc)[2][2][4][2], const Unit& u, int wr, int wc, int fr, int fq) const {
        const int row0 = u.pm * BM + wr * 64 + fr, col0 = u.pn * BM + wc * 32 + 8 * fq; const PG8_LAS float* gtu = GTU + u.ui * 256 + wr * 64 + fr;
#pragma unroll
        for (int ai = 0; ai < 2; ++ai)
#pragma unroll
            for (int m = 0; m < 4; ++m) { const int row = row0 + ai * HALF + m * 16; const float gt = gtu[ai * HALF + m * 16] * (1.0f / (SC_ACT * SC_WD)); bf16_t* rowp = Y + (size_t)row * D + col0;
#pragma unroll
                for (int bj = 0; bj < 2; ++bj) { const f32x4 v0 = acc[ai][bj][m][0] * gt, v1 = acc[ai][bj][m][1] * gt;
                    u32x4 w; w.x = cvtpk(v0[0], v0[1]); w.y = cvtpk(v0[2], v0[3]); w.z = cvtpk(v1[0], v1[1]); w.w = cvtpk(v1[2], v1[3]);
                    *(u32x4*)(rowp + bj * HALF) = w; } }
    }
};

template <class Epi, class Sched, bool ALIGN_EPI = true, bool GATHER = false, bool BKN = false, bool FP8 = false>
__device__ __forceinline__ void gemm_phase(PG8_LAS unsigned char* lds, const Gemm g, const Sched& S, const Epi& E) {
    static_assert(!(FP8 && BKN), "the fp8 path takes N-major B");
    const int tid = threadIdx.x, wid = __builtin_amdgcn_readfirstlane(tid >> 6), lane = tid & 63, wr = wid >> 2, wc = wid & 3, fr = lane & 15, fq = lane >> 4;
    const int K = FP8 ? g.K / 2 : g.K, nt = K / BK;
    unsigned voffA[2], voffB[2]; int gR[2], gC[2];
#pragma unroll
    for (int i = 0; i < 2; ++i) { int R, C; stage_rc(tid * 16 + i * 8192, R, C); const int Rb = Epi::PERM ? ((R & ~31) + perm32(R & 31)) : R; gR[i] = R; gC[i] = C;
        voffA[i] = (unsigned)(R * K + C) * 2u; voffB[i] = (unsigned)(Rb * K + C) * 2u; }
    unsigned vA0[2], vA1[2], vN0[2], vN1[2];
#define PG8_GOFF(dst0, dst1, ui_) do { _Pragma("unroll") for (int _i = 0; _i < 2; ++_i) { \
        dst0[_i] = ((unsigned)g.ut[(ui_) * 256 + gR[_i]] * (unsigned)K + (unsigned)gC[_i]) * 2u; dst1[_i] = ((unsigned)g.ut[(ui_) * 256 + 128 + gR[_i]] * (unsigned)K + (unsigned)gC[_i]) * 2u; } } while (0)
    const size_t kstep = (size_t)(BK * 2);
    const size_t hstep = (size_t)HALF * K * 2;
    const size_t tstep = 2 * hstep;
    const size_t kstepB = BKN ? (size_t)BK * 4096 : kstep, hstepB = BKN ? (size_t)256 : hstep;
    if constexpr (BKN) {
#pragma unroll
        for (int i = 0; i < 2; ++i) { const int p = tid * 16 + i * 8192, kk = p >> 8, c16p = (p & 255) >> 4, sw = (kk & 3) | (((kk >> 3) & 1) << 2);
            voffB[i] = (unsigned)(kk * 4096 + ((c16p ^ (sw << 1)) << 4)); } }
    int bbase[2];
    { const int q = fr >> 2, p = fr & 3, sw = q | ((fq & 1) << 2);
#pragma unroll
      for (int n = 0; n < 2; ++n) bbase[n] = (int)(uintptr_t)lds + (8 * fq + q) * 256 + (((4 * wc + 2 * n + (p >> 1)) ^ (sw << 1)) << 4) + 8 * (p & 1); }
    const unsigned ldsw = (unsigned)wid * 1024u;
    const int aoff = lds_byte(wr * 64 + fr, fq * 8), boff = lds_byte(wc * 32 + fr, fq * 8);
    const int aoq0 = lds_byte(wr * 64 + fr, fq * 16), aoq1 = lds_byte(wr * 64 + fr, fq * 16 + 8), boq0 = lds_byte(wc * 32 + fr, fq * 16), boq1 = lds_byte(wc * 32 + fr, fq * 16 + 8);
#define PG8_SA(b, h) (((b) * 2 + (h)) * HTB)
#define PG8_SB(b, h) ((4 + (b) * 2 + (h)) * HTB)
#define PG8_STAGE(bufoff, gbase, voff) do { _Pragma("unroll") for (int _i = 0; _i < 2; ++_i) \
        __builtin_amdgcn_global_load_lds((const unsigned*)((const char*)(gbase) + (voff)[_i]), (PG8_LAS unsigned*)(lds + (bufoff) + ldsw + _i * 8192), 16, 0, 0); } while (0)
#define PG8_Q_At Aq
#define PG8_Q_B0 Bq0
#define PG8_Q_B1 Bq1
#define PG8_LD8(p0_, p1_) __builtin_shufflevector(*(const PG8_LAS i32x4*)(p0_), *(const PG8_LAS i32x4*)(p1_), 0, 1, 2, 3, 4, 5, 6, 7)
#define PG8_LDA(dst, b, h) do { if constexpr (FP8) { _Pragma("unroll") for (int m = 0; m < 4; ++m) PG8_Q_##dst[m] = PG8_LD8(lds + PG8_SA(b, h) + aoq0 + m * 2048, lds + PG8_SA(b, h) + aoq1 + m * 2048); } \
        else { _Pragma("unroll") for (int m = 0; m < 4; ++m) _Pragma("unroll") for (int k = 0; k < 2; ++k) dst[m][k] = *(const PG8_LAS bf16x8*)(lds + PG8_SA(b, h) + aoff + m * 2048 + k * 1024); } } while (0)
#define PG8_TR(dst, addr, OFF) asm volatile("ds_read_b64_tr_b16 %0, %1 offset:%2" : "=&v"(dst) : "v"(addr), "i"(OFF) : "memory")
#define PG8_LDB(dst, b, h) do { if constexpr (BKN) { _Pragma("unroll") for (int n = 0; n < 2; ++n) { const int ad_ = bbase[n] + PG8_SB(b, h); s16x4 l0_, h0_, l1_, h1_; \
            PG8_TR(l0_, ad_, 0); PG8_TR(h0_, ad_, 1024); PG8_TR(l1_, ad_, 8192); PG8_TR(h1_, ad_, 9216); \
            dst[n][0] = (bf16x8){l0_[0], l0_[1], l0_[2], l0_[3], h0_[0], h0_[1], h0_[2], h0_[3]}; dst[n][1] = (bf16x8){l1_[0], l1_[1], l1_[2], l1_[3], h1_[0], h1_[1], h1_[2], h1_[3]}; } } \
        else if constexpr (FP8) { _Pragma("unroll") for (int n = 0; n < 2; ++n) PG8_Q_##dst[n] = PG8_LD8(lds + PG8_SB(b, h) + boq0 + n * 2048, lds + PG8_SB(b, h) + boq1 + n * 2048); } \
        else { _Pragma("unroll") for (int n = 0; n < 2; ++n) _Pragma("unroll") for (int k = 0; k < 2; ++k) dst[n][k] = *(const PG8_LAS bf16x8*)(lds + PG8_SB(b, h) + boff + n * 2048 + k * 1024); } } while (0)
#define PG8_MMA(ai, bj, At, Bt) do { __builtin_amdgcn_s_setprio(1); if constexpr (FP8) { _Pragma("unroll") for (int m = 0; m < 4; ++m) _Pragma("unroll") for (int n = 0; n < 2; ++n) \
            asm volatile("v_mfma_scale_f32_16x16x128_f8f6f4 %0, %1, %2, %0, %3, %3 op_sel_hi:[0,0,0]" : "+v"(acc[ai][bj][m][n]) : "v"(PG8_Q_##Bt[n]), "v"(PG8_Q_##At[m]), "v"(sc1_)); } \
        else { _Pragma("unroll") for (int m = 0; m < 4; ++m) _Pragma("unroll") for (int n = 0; n < 2; ++n) _Pragma("unroll") for (int k = 0; k < 2; ++k) \
            acc[ai][bj][m][n] = __builtin_amdgcn_mfma_f32_16x16x32_bf16(Bt[n][k], At[m][k], acc[ai][bj][m][n], 0, 0, 0); } __builtin_amdgcn_s_setprio(0); } while (0)
#define PG8_WAIT_V(n) asm volatile("s_waitcnt vmcnt(" #n ")" ::: "memory")
#define PG8_WAIT_L(n) asm volatile("s_waitcnt lgkmcnt(" #n ")" ::: "memory")
#define PG8_BAR __builtin_amdgcn_s_barrier()
#define PG8_SCHED __builtin_amdgcn_sched_barrier(0)
    Unit cur, nxt; int ui = 0;
    if (!S.next(0, cur)) return;
    f32x4 acc[2][2][4][2];
#pragma unroll
    for (int a = 0; a < 2; ++a)
#pragma unroll
        for (int b = 0; b < 2; ++b)
#pragma unroll
            for (int m = 0; m < 4; ++m)
#pragma unroll
                for (int n = 0; n < 2; ++n) acc[a][b][m][n] = (f32x4){0.f, 0.f, 0.f, 0.f};
    bf16x8 At[4][2], B0[2][2], B1[2][2];
    i32x8 Aq[4], Bq0[2], Bq1[2]; const int sc1_ = 0x7F7F7F7F;
    const char* cA = GATHER ? (const char*)g.A : (const char*)g.A + (size_t)cur.pm * tstep; const char* cB = BKN ? (const char*)g.Bt + (size_t)(cur.pb >> 3) * ((size_t)K * 4096) + (size_t)(cur.pb & 7) * 512 : (const char*)g.Bt + (size_t)cur.pb * tstep;
    const size_t hA = GATHER ? 0 : hstep;
    if constexpr (GATHER) { PG8_GOFF(vA0, vA1, 0); } else {
#pragma unroll
        for (int i = 0; i < 2; ++i) { vA0[i] = voffA[i]; vA1[i] = voffA[i]; vN0[i] = voffA[i]; vN1[i] = voffA[i]; } }
    S.a_ready(cur);
    PG8_STAGE(PG8_SB(0, 0), cB, voffB); PG8_STAGE(PG8_SB(0, 1), cB + hstepB, voffB); PG8_STAGE(PG8_SA(0, 0), cA, vA0); PG8_STAGE(PG8_SA(0, 1), cA + hA, vA1);
    if (wr == 1) PG8_BAR;
    PG8_WAIT_V(2); PG8_BAR;
    PG8_STAGE(PG8_SB(1, 0), cB + kstepB, voffB); PG8_STAGE(PG8_SA(1, 0), cA + kstep, vA0); PG8_STAGE(PG8_SB(1, 1), cB + hstepB + kstepB, voffB);
    PG8_WAIT_V(6); PG8_BAR;
    for (;;) {
        const bool has_next = S.next(ui + 1, nxt);
        const char* nA = GATHER ? cA : (has_next ? (const char*)g.A + (size_t)nxt.pm * tstep : cA); const char* nB = has_next ? (BKN ? (const char*)g.Bt + (size_t)(nxt.pb >> 3) * ((size_t)K * 4096) + (size_t)(nxt.pb & 7) * 512 : (const char*)g.Bt + (size_t)nxt.pb * tstep) : cB;
        if constexpr (GATHER) { if (has_next) { PG8_GOFF(vN0, vN1, ui + 1); } else {
#pragma unroll
            for (int i = 0; i < 2; ++i) { vN0[i] = vA0[i]; vN1[i] = vA1[i]; } } }
#pragma unroll 1
        for (int t = 0; t < nt; t += 2) {
            const bool last = (t == nt - 2);
            unsigned s0[2], s1[2];
#pragma unroll
            for (int i = 0; i < 2; ++i) { s0[i] = (GATHER && last) ? vN0[i] : vA0[i]; s1[i] = (GATHER && last) ? vN1[i] : vA1[i]; }
            const char* a1 = cA + (size_t)(t + 1) * kstep;
            const char* a2 = last ? nA : cA + (size_t)(t + 2) * kstep; const char* b2 = last ? nB : cB + (size_t)(t + 2) * kstepB;
            const char* a3 = a2 + kstep; const char* b3 = b2 + kstepB;
            if (last && has_next) S.a_ready(nxt);
            PG8_LDB(B0, 0, 0); PG8_LDB(B1, 0, 1); PG8_SCHED; PG8_LDA(At, 0, 0); PG8_STAGE(PG8_SA(1, 1), a1 + hA, vA1);
            PG8_WAIT_V(8); PG8_WAIT_L(0); PG8_BAR; PG8_SCHED; PG8_MMA(0, 0, At, B0); PG8_MMA(0, 1, At, B1); PG8_BAR; PG8_SCHED;
            PG8_LDA(At, 0, 1); PG8_STAGE(PG8_SB(0, 0), b2, voffB); PG8_STAGE(PG8_SB(0, 1), b2 + hstepB, voffB); PG8_STAGE(PG8_SA(0, 0), a2, s0);
            PG8_WAIT_V(8); PG8_WAIT_L(0); PG8_BAR; PG8_SCHED; PG8_MMA(1, 0, At, B0); PG8_MMA(1, 1, At, B1); PG8_BAR; PG8_SCHED;
            PG8_LDB(B0, 1, 0); PG8_LDB(B1, 1, 1); PG8_SCHED; PG8_LDA(At, 1, 0); PG8_STAGE(PG8_SA(0, 1), a2 + hA, s1);
            PG8_WAIT_V(8); PG8_WAIT_L(0); PG8_BAR; PG8_SCHED; PG8_MMA(0, 0, At, B0); PG8_MMA(0, 1, At, B1); PG8_BAR; PG8_SCHED;
            PG8_LDA(At, 1, 1); PG8_STAGE(PG8_SB(1, 0), b3, voffB); PG8_STAGE(PG8_SB(1, 1), b3 + hstepB, voffB); PG8_STAGE(PG8_SA(1, 0), a3, s0);
            PG8_WAIT_V(8); PG8_WAIT_L(0); PG8_BAR; PG8_SCHED; PG8_MMA(1, 0, At, B0); PG8_MMA(1, 1, At, B1); PG8_BAR; PG8_SCHED;
        }
        if constexpr (ALIGN_EPI) { if (wr == 0) PG8_BAR; }
        if constexpr (FP8) { __builtin_amdgcn_sched_barrier(0); asm volatile("s_nop 15\n\ts_nop 15" ::: "memory"); __builtin_amdgcn_sched_barrier(0); }
        { int ln_ = lane; asm volatile("" : "+v"(ln_)); E(acc, cur, wr, wc, ln_ & 15, ln_ >> 4); } S.done(cur);
        if (!has_next) break;
#pragma unroll
        for (int a = 0; a < 2; ++a)
#pragma unroll
            for (int b = 0; b < 2; ++b)
#pragma unroll
                for (int m = 0; m < 4; ++m)
#pragma unroll
                    for (int n = 0; n < 2; ++n) acc[a][b][m][n] = (f32x4){0.f, 0.f, 0.f, 0.f};
        cur = nxt; cA = nA; cB = nB; ++ui;
#pragma unroll
        for (int i = 0; i < 2; ++i) { vA0[i] = vN0[i]; vA1[i] = vN1[i]; }
        if constexpr (ALIGN_EPI) { if (wr == 1) PG8_BAR; }
    }
    PG8_WAIT_V(0);
    if constexpr (!ALIGN_EPI) { if (wr == 0) PG8_BAR; }
    PG8_BAR;
#undef PG8_GOFF
#undef PG8_Q_At
#undef PG8_Q_B0
#undef PG8_Q_B1
#undef PG8_LD8
#undef PG8_TR
#undef PG8_SA
#undef PG8_SB
#undef PG8_STAGE
#undef PG8_LDA
#undef PG8_LDB
#undef PG8_MMA
#undef PG8_WAIT_V
#undef PG8_WAIT_L
#undef PG8_BAR
#undef PG8_SCHED
}
}

#define XB_TMO      128
#define XB_XCNT(j)  (256  + 64 * (j))
#define XB_XSUB(j)  (1280 + 64 * (j))
#define XB_XGEN(j)  (2304 + 64 * (j))
#define XB_TOP      3328
#define XB_TOPGEN   3392
#define XCD_BAR_WORDS 3456
#define XB_SPIN_CAP (1u << 18)
__device__ __forceinline__ unsigned xb_ld(unsigned* p)              { return __hip_atomic_load(p, __ATOMIC_RELAXED, __HIP_MEMORY_SCOPE_AGENT); }
__device__ __forceinline__ unsigned xb_add(unsigned* p, unsigned v) { return __hip_atomic_fetch_add(p, v, __ATOMIC_RELAXED, __HIP_MEMORY_SCOPE_AGENT); }
__device__ __forceinline__ unsigned xb_xcc_id() { return (unsigned)__builtin_amdgcn_s_getreg((3 << 11) | 20) & 0xFu; }
#define XB_SPIN(cond, bar) do { unsigned _sp = 0; while (cond) { __builtin_amdgcn_s_sleep(1); \
    if ((++_sp & 255u) == 0u) { if (xb_ld(&(bar)[XB_TMO])) break; if (_sp > XB_SPIN_CAP) { atomicAdd(&(bar)[XB_TMO], 1u); break; } } } } while (0)
struct XcdBarrier { unsigned* bar; unsigned x; volatile LAS unsigned* st; };
__device__ __forceinline__ XcdBarrier xcd_barrier_post(unsigned* bar, volatile LAS unsigned* st) {
    XcdBarrier b; b.bar = bar; b.x = xb_xcc_id(); b.st = st;
    if (threadIdx.x == 0) (void)xb_add(&bar[XB_XCNT(b.x)], 1u);
    return b;
}
__device__ __forceinline__ void xcd_barrier_complete(unsigned* bar, unsigned x, unsigned& nloc, unsigned& nx) {
    const unsigned G = gridDim.x * gridDim.y * gridDim.z;
    unsigned sum, cnt, mine, sp = 0u;
    for (;;) {
        sum = 0u; cnt = 0u; mine = 0u;
#pragma unroll
        for (unsigned j = 0; j < 16; ++j) { const unsigned c = xb_ld(&bar[XB_XCNT(j)]); sum += c; cnt += (c > 0u) ? 1u : 0u; mine = (j == x) ? c : mine; }
        if (sum == G) break;
        __builtin_amdgcn_s_sleep(1);
        if ((++sp & 255u) == 0u) { if (xb_ld(&bar[XB_TMO])) break; if (sp > XB_SPIN_CAP) { atomicAdd(&bar[XB_TMO], 1u); break; } }
    }
    nloc = mine > 0u ? mine : 1u; nx = cnt > 0u ? cnt : 1u;
}
__device__ __forceinline__ void xcd_barrier(const XcdBarrier& b) {
    asm volatile("s_waitcnt vmcnt(0)" ::: "memory");
    __syncthreads();
    if (threadIdx.x == 0) {
        unsigned* bar = b.bar;
        __builtin_amdgcn_s_waitcnt(0);
        unsigned nloc = b.st[0], nx = b.st[1];
        if (nloc == 0u) { xcd_barrier_complete(bar, b.x, nloc, nx); b.st[0] = nloc; b.st[1] = nx; }
        const unsigned old = xb_add(&bar[XB_XSUB(b.x)], 1u);
        const unsigned gen = old / nloc;
        if (old + 1u == (gen + 1u) * nloc) {
            __builtin_amdgcn_fence(__ATOMIC_RELEASE, "agent");
            asm volatile("s_waitcnt vmcnt(0)" ::: "memory");
            const unsigned og = xb_add(&bar[XB_TOP], 1u);
            const unsigned tg = og / nx;
            if (og + 1u == (tg + 1u) * nx) xb_add(&bar[XB_TOPGEN], 1u);
            else XB_SPIN(xb_ld(&bar[XB_TOPGEN]) == tg, bar);
            __builtin_amdgcn_fence(__ATOMIC_ACQUIRE, "agent");
            xb_add(&bar[XB_XGEN(b.x)], 1u);
            asm volatile("s_waitcnt vmcnt(0)" ::: "memory");
        } else {
            XB_SPIN(xb_ld(&bar[XB_XGEN(b.x)]) == gen, bar);
            __builtin_amdgcn_fence(__ATOMIC_ACQUIRE, "agent");
            asm volatile("s_waitcnt vmcnt(0)" ::: "memory");
        }
    }
    __syncthreads();
}

constexpr int NWAVES = 8;
struct Frame {
    LAS unsigned char* lds;
    unsigned* ctl;
    int tid, lane, wave, vcu, G;
    const float *x, *mem, *norm1_g, *w_in, *q_norm_g, *k_norm_g, *conv_w, *mem_norm_g, *w_mem_kv, *mem_q_norm_g, *mem_k_norm_g, *out_norm_g, *w_out, *norm2_g,
                *w_rg, *b_rg, *w_re, *b_re, *w_gate, *w_up, *w_down;
    float* out; unsigned char* ws;
};

__device__ __forceinline__ void p0_transpose_item(const float* W, int N, int k0, int n0, const float* ks, bf16* dst, int pitch, LAS float* scr, int lane) {
#pragma unroll 8
    for (int i = 0; i < 32; ++i) { const int kk = 2 * i + (lane >> 5); scr[kk * 33 + (lane & 31)] = __builtin_nontemporal_load(W + (size_t)(k0 + kk) * N + n0 + (lane & 31)); }
    const int c = lane & 7;
    float g[8];
#pragma unroll
    for (int j = 0; j < 8; ++j) g[j] = ks ? ks[k0 + 8 * c + j] : 1.0f;
    LDS_WAIT(); asm volatile("" ::: "memory");
#pragma unroll
    for (int j = 0; j < 4; ++j) { const int n = (lane >> 3) + 8 * j; const LAS float* s = scr + (8 * c) * 33 + n;
        v4u o; o.x = pk2(s[0 * 33] * g[0], s[1 * 33] * g[1]); o.y = pk2(s[2 * 33] * g[2], s[3 * 33] * g[3]); o.z = pk2(s[4 * 33] * g[4], s[5 * 33] * g[5]); o.w = pk2(s[6 * 33] * g[6], s[7 * 33] * g[7]);
        *(GAS v4u*)(dst + (size_t)n * pitch + k0 + 8 * c) = o; }
    LDS_WAIT(); asm volatile("" ::: "memory");
}
__device__ __forceinline__ void rms_row_to_bf16(const float* xrow, const float* gain, bf16* orow, int lane) {
    const GAS f32x4* xr = (const GAS f32x4*)xrow + lane; const GAS f32x4* gr = (const GAS f32x4*)gain + lane;
    f32x4 v[8]; float s = 0.f;
#pragma unroll
    for (int j = 0; j < 8; ++j) { v[j] = __builtin_nontemporal_load(xr + 64 * j); s += (v[j].x * v[j].x + v[j].y * v[j].y) + (v[j].z * v[j].z + v[j].w * v[j].w); }
    const float rstd = 1.0f / sqrtf(wave_sum(s) * (1.f / D) + EPS);
    GAS v2u* o8 = (GAS v2u*)orow + lane;
#pragma unroll
    for (int j = 0; j < 8; ++j) { const f32x4 gg = gr[64 * j]; v2u o; o.x = pk2(v[j].x * rstd * gg.x, v[j].y * rstd * gg.y); o.y = pk2(v[j].z * rstd * gg.z, v[j].w * rstd * gg.w); o8[64 * j] = o; }
}
__device__ __forceinline__ void p0_transpose_item_q(const float* W, int N, int k0, int n0, const float* ks, float sc, unsigned char* dst, int pitch, LAS float* scr, int lane) {
#pragma unroll 8
    for (int i = 0; i < 64; ++i) { const int kk = 2 * i + (lane >> 5); scr[kk * 33 + (lane & 31)] = __builtin_nontemporal_load(W + (size_t)(k0 + kk) * N + n0 + (lane & 31)); }
    const int c = lane & 15;
    float g[8];
#pragma unroll
    for (int j = 0; j < 8; ++j) g[j] = ks ? ks[k0 + 8 * c + j] * sc : sc;
    LDS_WAIT(); asm volatile("" ::: "memory");
#pragma unroll
    for (int j = 0; j < 8; ++j) { const int n = (lane >> 4) + 4 * j; const LAS float* s = scr + (8 * c) * 33 + n;
        v2u o; o.x = pk_fp8x4(s[0 * 33] * g[0], s[1 * 33] * g[1], s[2 * 33] * g[2], s[3 * 33] * g[3]); o.y = pk_fp8x4(s[4 * 33] * g[4], s[5 * 33] * g[5], s[6 * 33] * g[6], s[7 * 33] * g[7]);
        __builtin_nontemporal_store(o, (GAS v2u*)(dst + (size_t)n * pitch + k0 + 8 * c)); }
    LDS_WAIT(); asm volatile("" ::: "memory");
}
__device__ __forceinline__ void p0_item_q64(const float* W, int N, int k0, int n0, const float* ks, float sc, unsigned char* dst, int pitch, LAS unsigned char* scr, int lane) {
    const GAS float* src = (const GAS float*)(W + (size_t)k0 * N + n0 + lane);
    float g0 = sc, g1 = sc;
    if (ks) { g0 = ks[k0 + lane] * sc; g1 = ks[k0 + 64 + lane] * sc; }
#pragma unroll
    for (int h = 0; h < 2; ++h) {
        float v[64];
#pragma unroll
        for (int i = 0; i < 64; ++i) v[i] = __builtin_nontemporal_load(src + (size_t)(64 * h + i) * N);
        const float gh = h ? g1 : g0;
#pragma unroll
        for (int q = 0; q < 4; ++q) { v4u o;
#pragma unroll
            for (int d = 0; d < 4; ++d) { const int i = 16 * q + 4 * d;
                const float s0 = __builtin_bit_cast(float, __builtin_amdgcn_readlane(__builtin_bit_cast(int, gh), i)), s1 = __builtin_bit_cast(float, __builtin_amdgcn_readlane(__builtin_bit_cast(int, gh), i + 1));
                const float s2 = __builtin_bit_cast(float, __builtin_amdgcn_readlane(__builtin_bit_cast(int, gh), i + 2)), s3 = __builtin_bit_cast(float, __builtin_amdgcn_readlane(__builtin_bit_cast(int, gh), i + 3));
                o[d] = pk_fp8x4(v[i] * s0, v[i + 1] * s1, v[i + 2] * s2, v[i + 3] * s3); }
            *(LAS v4u*)(scr + lane * 144 + (4 * h + q) * 16) = o; }
    }
    LDS_WAIT(); asm volatile("" ::: "memory");
#pragma unroll
    for (int i = 0; i < 8; ++i) { const int row = 8 * i + (lane >> 3), ch = lane & 7;
        const v4u w = *(const LAS v4u*)(scr + row * 144 + ch * 16);
        __builtin_nontemporal_store(w, (GAS v4u*)(dst + (size_t)row * pitch + k0 + ch * 16)); }
    LDS_WAIT(); asm volatile("" ::: "memory");
}
__device__ __forceinline__ void p0_prologue(Frame& F) {
    LAS float* scr = (LAS float*)(F.lds + F.wave * 16896);
    const int gw = F.vcu * NWAVES + F.wave, NGW = F.G * NWAVES;
    bf16* Win_t = (bf16*)(F.ws + WS_WIN); bf16* Wmkv_t = (bf16*)(F.ws + WS_WMKV); bf16* Wout_t = (bf16*)(F.ws + WS_WOUT);
    constexpr int I_IN = 32 * 160, I_MKV = 32 * 32, I_OUT = 32 * 64;
    constexpr int NITEMS = I_IN + I_MKV + I_OUT;
    for (int it = gw; it < NITEMS; it += NGW) {
        int r = it;
        if (r < I_IN) { const int kb = r / 160, nb = r % 160; p0_transpose_item(F.w_in, PROJ, 64 * kb, 32 * nb, nullptr, Win_t + (size_t)(32 * nb) * D, D, scr, F.lane); continue; } r -= I_IN;
        if (r < I_MKV) { const int kb = r / 32, nb = r % 32; p0_transpose_item(F.w_mem_kv, 1024, 64 * kb, 32 * nb, nullptr, Wmkv_t + (size_t)(32 * nb) * D, D, scr, F.lane); continue; } r -= I_MKV;
        { const int kb = r / 64, nb = r % 64; p0_transpose_item(F.w_out, D, 64 * kb, 32 * nb, nullptr, Wout_t + (size_t)(32 * nb) * D, D, scr, F.lane); }
    }
    { unsigned char* Wgu_q = (unsigned char*)(F.ws + WS_WGU); unsigned char* Wd_q = (unsigned char*)(F.ws + WS_WD); LAS unsigned char* scq = F.lds + F.wave * 16896;
      constexpr int IPE = 256 + 256 + 256;
#pragma unroll 1
      for (int it = gw; it < 64 * IPE; it += NGW) { const int e = it / IPE; int r = it - e * IPE;
          if (r < 512) { const int up = r >> 8, q = r & 255, kb = q >> 4, nb = q & 15, n0 = 64 * nb;
              const float* W = (up ? F.w_up : F.w_gate) + (size_t)e * D * DEXP; const int drow = 256 * (n0 >> 7) + 128 * up + (n0 & 127);
              p0_item_q64(W, DEXP, 128 * kb, n0, F.norm2_g, SC_WGU, Wgu_q + ((size_t)e * 2048 + drow) * D, D, scq, F.lane); }
          else { const int q = r - 512, kb = q >> 5, nb = q & 31;
              p0_item_q64(F.w_down + (size_t)e * DEXP * D, D, 128 * kb, 64 * nb, nullptr, SC_WD, Wd_q + ((size_t)e * 2048 + 64 * nb) * DEXP, DEXP, scq, F.lane); } } }
    { bf16* WT = (bf16*)(F.ws + WS_WR); const int gt = (F.vcu * NWAVES + F.wave) * 64 + F.lane, NT = F.G * NWAVES * 64;
      for (int i = gt; i < 96 * 2048; i += NT) { const int n = i >> 11, k = i & 2047;
          float w = n < 64 ? F.w_re[k * 64 + n] : (n < 72 ? F.w_rg[k * 8 + (n - 64)] : 0.f); w *= F.norm2_g[k];
          const unsigned h = f2bf(w); const float hf = __builtin_bit_cast(float, h << 16);
          WT[i] = (bf16)h; WT[96 * 2048 + i] = (bf16)f2bf(w - hf); } }
    bf16* H = (bf16*)(F.ws + WS_H);
    for (int m = gw; m < T + 512; m += NGW) {
        if (m < T) rms_row_to_bf16(F.x + (size_t)m * D, F.norm1_g, H + (size_t)m * D, F.lane);
        else rms_row_to_bf16(F.mem + (size_t)(m - T) * D, F.mem_norm_g, H + (size_t)m * D, F.lane);
    }
}

namespace att {
constexpr int LDS_K = 0, LDS_V = 65536, LDS_STG = 131072, LDS_LI = LDS_STG + 16384, LDS_GT = LDS_LI + 8 * 256;
constexpr float CS = 0.08838834764831845f * LOG2E;
#define KSWZ(row, colB) ((row) * 256 + ((colB) ^ (((row) & 7) << 4)))
__device__ __forceinline__ int crow(int r, int hi) { return (r & 3) + 8 * (r >> 2) + 4 * hi; }
__device__ __forceinline__ int v_rd_base(int lane) { return ((lane & 3) << 3) | (((lane >> 2) & 3) << 6) | (((lane >> 4) & 1) << 5) | (((lane >> 5) & 1) << 8); }
template <int OFF> __device__ __forceinline__ s16x4 tr_read(int vb) { s16x4 r; asm volatile("ds_read_b64_tr_b16 %0, %1 offset:%2" : "=&v"(r) : "v"(vb), "i"(OFF) : "memory"); return r; }

struct RowMap { const char* base; long stride; int win0; bool wrap; };
__device__ __forceinline__ const char* rowptr(const RowMap& m, int p) { int sp = m.wrap ? m.win0 + ((p - m.win0) & 255) : p; sp = sp < 0 ? 0 : sp; return m.base + (long)sp * m.stride; }

__device__ __forceinline__ void dma_k(LAS unsigned char* Kl, int p0, int nrows, const RowMap& m, int wave, int lane) {
    asm volatile("" : "+v"(lane));
#pragma unroll 1
    for (int i = 0; i < nrows / 32; ++i) {
        const int prow0 = p0 + 32 * i + 4 * wave, prow = prow0 + (lane >> 4);
        const char* src = rowptr(m, prow) + (((lane & 15) ^ (prow & 7)) << 4);
        __builtin_amdgcn_global_load_lds((const unsigned*)src, (LAS unsigned*)(Kl + prow0 * 256), 16, 0, 0);
    }
}
__device__ __forceinline__ void dma_v(LAS unsigned char* Vl, int p0, int nrows, const RowMap& m, int wave, int lane) {
    asm volatile("" : "+v"(lane));
#pragma unroll 1
    for (int i = 0; i < nrows / 32; ++i) {
        const int ii = wave + 8 * i, g = (p0 >> 4) + (ii >> 2), q = ii & 3;
        const int kk = ((q >> 1) << 3) + ((lane & 31) >> 2), k = (kk & ~0xC) | ((kk & 4) << 1) | ((kk & 8) >> 1);
        const int c = 32 * (2 * (q & 1) + (lane >> 5)) + 8 * (lane & 3);
        const char* src = rowptr(m, 16 * g + k) + c * 2;
        __builtin_amdgcn_global_load_lds((const unsigned*)src, (LAS unsigned*)(Vl + g * 4096 + q * 1024), 16, 0, 0);
    }
}
__device__ __forceinline__ void dma_v2(LAS unsigned char* Vl, int p0, int nrows, const RowMap& m, int wave, int lane) {
    asm volatile("" : "+v"(lane));
#pragma unroll 1
    for (int i = 0; i < nrows / 32; ++i) {
        const int prow0 = p0 + 32 * i + 4 * wave, prow = prow0 + (lane >> 4);
        const char* src = rowptr(m, prow) + (((lane & 15) ^ ((prow & 7) << 1)) << 4);
        __builtin_amdgcn_global_load_lds((const unsigned*)src, (LAS unsigned*)(Vl + prow0 * 256), 16, 0, 0);
    }
}
__device__ __forceinline__ void load_q16(v4u (&raw)[4], const char* qrow, int kg) {
#pragma unroll
    for (int s = 0; s < 4; ++s) raw[s] = *(const GAS v4u*)(qrow + (32 * s + 8 * kg) * 2);
}
__device__ __forceinline__ void norm_q16(const v4u (&raw)[4], bf16x8 (&qr)[4], const LAS float* gt, int kg) {
    float ss = 0.f;
#pragma unroll
    for (int s = 0; s < 4; ++s)
#pragma unroll
        for (int j = 0; j < 4; ++j) { const float a = bflo(raw[s][j]), b = bfhi(raw[s][j]); ss += a * a + b * b; }
    ss += __shfl_xor(ss, 16); ss += __shfl_xor(ss, 32);
    const float rstd = 1.0f / sqrtf(ss * (1.f / HD) + EPS);
#pragma unroll
    for (int s = 0; s < 4; ++s) { const LAS f32x4* gp = (const LAS f32x4*)(gt + 32 * s + 8 * kg); const f32x4 g0 = gp[0], g1 = gp[1]; v4u o;
        o.x = cvtpk(bflo(raw[s].x) * rstd * g0.x, bfhi(raw[s].x) * rstd * g0.y); o.y = cvtpk(bflo(raw[s].y) * rstd * g0.z, bfhi(raw[s].y) * rstd * g0.w);
        o.z = cvtpk(bflo(raw[s].z) * rstd * g1.x, bfhi(raw[s].z) * rstd * g1.y); o.w = cvtpk(bflo(raw[s].w) * rstd * g1.z, bfhi(raw[s].w) * rstd * g1.w);
        qr[s] = __builtin_bit_cast(bf16x8, o); }
}
__device__ __forceinline__ void norm_k(LAS unsigned char* Kl, int p0, int nrows, const LAS float* gt, int tid) {
    asm volatile("" : "+v"(tid));
#pragma unroll 1
    for (int idx = tid; idx < nrows * 4; idx += 512) {
        const int row = p0 + (idx >> 2), qd = idx & 3;
        v4u w[4]; float ss = 0.f;
#pragma unroll
        for (int i = 0; i < 4; ++i) { w[i] = *(const LAS v4u*)(Kl + KSWZ(row, (4 * qd + i) * 16));
#pragma unroll
            for (int j = 0; j < 4; ++j) { const float a = bflo(w[i][j]), b = bfhi(w[i][j]); ss += a * a + b * b; } }
        ss += __shfl_xor(ss, 1); ss += __shfl_xor(ss, 2);
        const float rstd = 1.0f / sqrtf(ss * (1.f / HD) + EPS);
#pragma unroll
        for (int i = 0; i < 4; ++i) { const LAS f32x4* gp = (const LAS f32x4*)(gt + (4 * qd + i) * 8); const f32x4 g0 = gp[0], g1 = gp[1]; v4u o;
            o.x = cvtpk(bflo(w[i].x) * rstd * g0.x, bfhi(w[i].x) * rstd * g0.y); o.y = cvtpk(bflo(w[i].y) * rstd * g0.z, bfhi(w[i].y) * rstd * g0.w);
            o.z = cvtpk(bflo(w[i].z) * rstd * g1.x, bfhi(w[i].z) * rstd * g1.y); o.w = cvtpk(bflo(w[i].w) * rstd * g1.z, bfhi(w[i].w) * rstd * g1.w);
            *(LAS v4u*)(Kl + KSWZ(row, (4 * qd + i) * 16)) = o; }
    }
}
__device__ __forceinline__ float xsum32(float v) { unsigned a = __builtin_bit_cast(unsigned, v), b = a; asm volatile("s_nop 1\n\tv_permlane32_swap_b32 %0, %1" : "+v"(a), "+v"(b)); return __builtin_bit_cast(float, a) + __builtin_bit_cast(float, b); }
__device__ __forceinline__ void load_q(v4u (&raw)[8], const char* qrow, int hi) {
#pragma unroll
    for (int d0 = 0; d0 < 8; ++d0) raw[d0] = *(const GAS v4u*)(qrow + (d0 * 16 + hi * 8) * 2);
}
__device__ __forceinline__ void norm_q(const v4u (&raw)[8], bf16x8 (&qr)[8], const LAS float* gt, int hi) {
    float ss = 0.f;
#pragma unroll
    for (int d0 = 0; d0 < 8; ++d0)
#pragma unroll
        for (int j = 0; j < 4; ++j) { const float a = bflo(raw[d0][j]), b = bfhi(raw[d0][j]); ss += a * a + b * b; }
    ss = xsum32(ss);
    const float rstd = 1.0f / sqrtf(ss * (1.f / HD) + EPS);
#pragma unroll
    for (int d0 = 0; d0 < 8; ++d0) { const LAS f32x4* gp = (const LAS f32x4*)(gt + d0 * 16 + hi * 8); const f32x4 g0 = gp[0], g1 = gp[1]; v4u o;
        o.x = cvtpk(bflo(raw[d0].x) * rstd * g0.x, bfhi(raw[d0].x) * rstd * g0.y); o.y = cvtpk(bflo(raw[d0].y) * rstd * g0.z, bfhi(raw[d0].y) * rstd * g0.w);
        o.z = cvtpk(bflo(raw[d0].z) * rstd * g1.x, bfhi(raw[d0].z) * rstd * g1.y); o.w = cvtpk(bflo(raw[d0].w) * rstd * g1.z, bfhi(raw[d0].w) * rstd * g1.w);
        qr[d0] = __builtin_bit_cast(bf16x8, o); }
}
__device__ __forceinline__ f32x16 qk_tile(const LAS unsigned char* Kl, int pb, const bf16x8 (&qr)[8], int r32, int hi) {
    f32x16 p = {};
#pragma unroll
    for (int d0 = 0; d0 < 8; ++d0) { const bf16x8 kf = *(const LAS bf16x8*)(Kl + KSWZ(pb + r32, (d0 * 16 + hi * 8) * 2));
        p = __builtin_amdgcn_mfma_f32_32x32x16_bf16(kf, qr[d0], p, 0, 0, 0); }
    return p;
}
#define PK4(P, BASE, OUT) do { unsigned a0 = cvtpk(P[BASE + 0], P[BASE + 1]), a1 = cvtpk(P[BASE + 2], P[BASE + 3]);   \
    unsigned b0 = cvtpk(P[BASE + 4], P[BASE + 5]), b1 = cvtpk(P[BASE + 6], P[BASE + 7]);                              \
    auto r0 = __builtin_amdgcn_permlane32_swap(a0, b0, false, false); auto r1 = __builtin_amdgcn_permlane32_swap(a1, b1, false, false); \
    v4u w_ = {r0[0], r1[0], r0[1], r1[1]}; OUT = __builtin_bit_cast(bf16x8, w_); } while (0)
template <int OFF> __device__ __forceinline__ void pv_step(f32x16& o, int vb, bf16x8 pa) {
    const s16x4 l = tr_read<OFF>(vb), h = tr_read<OFF + 2048>(vb);
    asm volatile("s_waitcnt lgkmcnt(0)" ::: "memory"); __builtin_amdgcn_sched_barrier(0);
    o = __builtin_amdgcn_mfma_f32_32x32x16_bf16(pa, (bf16x8){l[0], l[1], l[2], l[3], h[0], h[1], h[2], h[3]}, o, 0, 0, 0);
}
__device__ __forceinline__ void store_block(const f32x16& o, const LAS float* il, LAS unsigned short* stg, char* dst0, long rstride, int lane) {
    asm volatile("" : "+v"(lane));
    const int r32 = lane & 31, hi = lane >> 5;
#pragma unroll
    for (int r = 0; r < 16; ++r) { const int row = crow(r, hi); stg[row * 32 + r32] = (unsigned short)f2bf(o[r] * il[row]); }
    LDS_WAIT(); asm volatile("" ::: "memory");
#pragma unroll
    for (int p = 0; p < 2; ++p) { const int row = 16 * p + (lane >> 2), ch = lane & 3;
        const v4u w = *(const LAS v4u*)((const LAS unsigned char*)stg + row * 64 + ch * 16);
        *(GAS v4u*)(dst0 + (long)row * rstride + ch * 16) = w; }
    LDS_WAIT(); asm volatile("" ::: "memory");
}
}

#define RAW_BAR() do { asm volatile("s_waitcnt lgkmcnt(0)" ::: "memory"); __builtin_amdgcn_s_barrier(); asm volatile("" ::: "memory"); } while (0)
__device__ __forceinline__ void p2_attention(Frame& F) {
    using namespace att;
    LAS unsigned char* Kl = F.lds + LDS_K; LAS unsigned char* Vl = F.lds + LDS_V;
    LAS unsigned short* stg = (LAS unsigned short*)(F.lds + LDS_STG + F.wave * 2048);
    LAS float* li = (LAS float*)(F.lds + LDS_LI + F.wave * 256);
    LAS float* gtab = (LAS float*)(F.lds + LDS_GT);
    LAS float* rk = (LAS float*)(F.lds + LDS_GT + 2048);
    volatile LAS int* QN = (volatile LAS int*)(F.lds + LDS_GT + 2048 + 1024);
    const int tid = F.tid, wave = F.wave;
    if (blockIdx.x < 8) {
        pg8::Gemm g{(const bf16*)(F.ws + WS_H), (const bf16*)(F.ws + WS_WIN), D, nullptr}; pg8::P1Order S{F.G, (int)blockIdx.x, 2560, 2568};
        pg8::EpiProj E{(bf16*)(F.ws + WS_R1), (bf16*)(F.ws + WS_MEMKV)};
        pg8::gemm_phase<pg8::EpiProj, pg8::P1Order>(F.lds, g, S, E);
        VM_WAIT(); __syncthreads();
        if (tid == 0) { __builtin_amdgcn_fence(__ATOMIC_RELEASE, "agent"); asm volatile("s_waitcnt vmcnt(0)" ::: "memory"); __hip_atomic_fetch_add(F.ctl + CW_KVREADY, 1u, RLX_AGENT); }
    }
    if (tid < 128) { gtab[tid] = F.q_norm_g[tid] * F.k_norm_g[tid]; gtab[128 + tid] = F.mem_q_norm_g[tid] * F.mem_k_norm_g[tid]; gtab[256 + tid] = F.mem_q_norm_g[tid]; gtab[384 + tid] = F.mem_k_norm_g[tid]; }
    if (tid == 0) QN[0] = 1 << 30;
    __syncthreads();
    float MD, MM;
    { float a = 0.f, c = 0.f;
#pragma unroll 1
      for (int i = 0; i < 128; ++i) { a = fmaxf(a, fabsf(gtab[i])); c = fmaxf(c, fabsf(gtab[128 + i])); }
      MD = a * (128.0f * 1.03f) * CS; MM = c * (128.0f * 1.03f) * CS; }
    const char* proj = (const char*)(F.ws + WS_R1);

    {
    const int j = wave & 3, dh = wave >> 2, w0 = 32 * j + 16 * dh;
    constexpr int NCHUNK = 6144 / 4;
    v4u qraw[4];
#define DECODE(u, br, b, h, r, nb, dil) const int br = (u) >> 11, _rem = (u) & 2047, b = _rem >> 10, h = (_rem >> 7) & 7, _w = _rem & 127, dil = 1 << (2 * br), _nps = 128 >> (2 * br), r = _w / _nps, nb = _w % _nps
    int u = 4 * F.vcu;
    bool have = F.vcu < NCHUNK;
    bool full = true;
    if (have) {
        DECODE(u, br, b, h, r, nb, dil);
        const long rs = (long)dil * PROJ * 2; const char* tb = proj + (size_t)(b * SEQ + r) * (PROJ * 2);
        RowMap mk{tb + (COL_K + h * HD) * 2, rs, 128 * nb - 128, true};
        dma_k(Kl, 0, 256, mk, wave, F.lane);
        load_q16(qraw, tb + (long)(128 * nb + w0 + (F.lane & 15)) * rs + (COL_Q + h * HD) * 2, F.lane >> 4);
    }
    while (have) {
        DECODE(u, br, b, h, r, nb, dil);
        int lane = F.lane; asm volatile("" : "+v"(lane));
        const int q16 = lane & 15, kg = lane >> 4;
        const int off = 128 * ((nb + 1) & 1);
        const long rs_ = (long)dil * PROJ * 2; const char* tb_ = proj + (size_t)(b * SEQ + r) * (PROJ * 2);
        asm volatile("s_waitcnt vmcnt(0)" ::: "memory"); RAW_BAR();
        { RowMap mv{tb_ + (COL_V + h * HD) * 2, rs_, 128 * nb - 128, true};
          if (full) dma_v2(Vl, 0, 256, mv, wave, lane); else dma_v2(Vl, 128 * (nb & 1), 128, mv, wave, lane); }
        if ((u & 3) == 0 && tid == 0) QN[0] = F.G + (int)__hip_atomic_fetch_add(F.ctl + CW_ATTQ, 1u, RLX_AGENT);
        { const int p0 = full ? 0 : 128 * (nb & 1), n4 = full ? 1024 : 512;
#pragma unroll 1
          for (int idx = tid; idx < n4; idx += 512) { const int row = p0 + (idx >> 2), qd = idx & 3; float ss = 0.f;
#pragma unroll
              for (int i = 0; i < 4; ++i) { const v4u w = *(const LAS v4u*)(Kl + KSWZ(row, (4 * qd + i) * 16));
#pragma unroll
                  for (int jj = 0; jj < 4; ++jj) { const float a = bflo(w[jj]), c = bfhi(w[jj]); ss += a * a + c * c; } }
              ss += __shfl_xor(ss, 1); ss += __shfl_xor(ss, 2);
              if (qd == 0) rk[row] = 1.0f / sqrtf(ss * (1.f / HD) + EPS); } }
        bf16x8 qr[4];
        norm_q16(qraw, qr, gtab, kg);
        f32x4 s[9];
#pragma unroll
        for (int t = 0; t < 9; ++t) { const int pb = (w0 + 16 * t + off) & 255; f32x4 a = {0.f, 0.f, 0.f, 0.f};
#pragma unroll
            for (int d = 0; d < 4; ++d) { const bf16x8 kf = *(const LAS bf16x8*)(Kl + KSWZ(pb + q16, 64 * d + 16 * kg));
                a = __builtin_amdgcn_mfma_f32_16x16x32_bf16(kf, qr[d], a, 0, 0, 0); }
            s[t] = a; }
        RAW_BAR();
        int un = u + 1; bool has_next = true;
        if ((un & 3) == 0) { const int nc = QN[0]; has_next = nc < NCHUNK; un = 4 * nc; }
        bool n_full = false;
        if (has_next) {
            DECODE(un, br2, b2, h2, r2, nb2, dil2);
            n_full = (un != u + 1) || (nb2 == 0);
            const long rs = (long)dil2 * PROJ * 2; const char* tb = proj + (size_t)(b2 * SEQ + r2) * (PROJ * 2);
            RowMap nmk{tb + (COL_K + h2 * HD) * 2, rs, 128 * nb2 - 128, true};
            if (n_full) dma_k(Kl, 0, 256, nmk, wave, lane); else dma_k(Kl, 128 * (nb2 & 1), 128, nmk, wave, lane);
            load_q16(qraw, tb + (long)(128 * nb2 + w0 + q16) * rs + (COL_Q + h2 * HD) * 2, kg);
        }
        const float bias2 = __builtin_amdgcn_exp2f(-(float)(h + 1)) * (float)dil * LOG2E;
        const float rowoff = bias2 * (float)(4 * kg - q16 - 128) - MD;
        float l = 0.f;
#pragma unroll
        for (int t = 0; t < 9; ++t) {
            const int pb = (w0 + 16 * t + off) & 255;
            const f32x4 rkv = *(const LAS f32x4*)(rk + pb + 4 * kg);
            const bool dead = (nb == 0) && (w0 + 16 * t < 128);
#pragma unroll
            for (int r_ = 0; r_ < 4; ++r_) {
                float v = fmaf(s[t][r_] * rkv[r_], CS, fmaf(bias2, (float)(16 * t + r_), rowoff));
                if (t == 0) v = (4 * kg + r_ >= q16) ? v : -1.0e30f;
                if (t == 8) v = (4 * kg + r_ <= q16) ? v : -1.0e30f;
                v = dead ? 0.f : __builtin_amdgcn_exp2f(v); s[t][r_] = v; l += v; }
        }
        l += __shfl_xor(l, 16); l += __shfl_xor(l, 32);
        bf16x8 pa[5];
#pragma unroll
        for (int sp = 0; sp < 5; ++sp) { v4u w; w.x = cvtpk(s[2 * sp][0], s[2 * sp][1]); w.y = cvtpk(s[2 * sp][2], s[2 * sp][3]);
            if (sp < 4) { w.z = cvtpk(s[2 * sp + 1][0], s[2 * sp + 1][1]); w.w = cvtpk(s[2 * sp + 1][2], s[2 * sp + 1][3]); } else { w.z = 0u; w.w = 0u; }
            pa[sp] = __builtin_bit_cast(bf16x8, w); }
        if (has_next) asm volatile("s_waitcnt vmcnt(8)" ::: "memory"); else asm volatile("s_waitcnt vmcnt(0)" ::: "memory");
        RAW_BAR();
        f32x4 o[8];
#pragma unroll
        for (int db = 0; db < 8; ++db) o[db] = (f32x4){0.f, 0.f, 0.f, 0.f};
        { const int qq = q16 >> 2, pp = q16 & 3;
#pragma unroll
          for (int sp = 0; sp < 5; ++sp) {
              const int ra = (w0 + 32 * sp + off + 4 * kg + qq) & 255, rb = (w0 + 32 * sp + 16 + off + 4 * kg + qq) & 255;
              const int va = (int)(uintptr_t)Vl + ra * 256 + 8 * pp, vb = (int)(uintptr_t)Vl + rb * 256 + 8 * pp, xa = (ra & 7) << 5, xb = (rb & 7) << 5;
#pragma unroll
              for (int dq = 0; dq < 2; ++dq) {
                  s16x4 la[4], lb[4];
#pragma unroll
                  for (int i = 0; i < 4; ++i) { const int db = 4 * dq + i;
                      asm volatile("ds_read_b64_tr_b16 %0, %1" : "=&v"(la[i]) : "v"(va + ((32 * db) ^ xa)) : "memory");
                      asm volatile("ds_read_b64_tr_b16 %0, %1" : "=&v"(lb[i]) : "v"(vb + ((32 * db) ^ xb)) : "memory"); }
                  asm volatile("s_waitcnt lgkmcnt(0)" ::: "memory"); __builtin_amdgcn_sched_barrier(0);
#pragma unroll
                  for (int i = 0; i < 4; ++i) { const int db = 4 * dq + i;
                      o[db] = __builtin_amdgcn_mfma_f32_16x16x32_bf16(pa[sp], (bf16x8){la[i][0], la[i][1], la[i][2], la[i][3], lb[i][0], lb[i][1], lb[i][2], lb[i][3]}, o[db], 0, 0, 0); }
              } } }
        const float il = 1.0f / l;
        if (kg == 0) li[q16] = il;
        LDS_WAIT(); asm volatile("" ::: "memory");
        const f32x4 ilr = *(const LAS f32x4*)(li + 4 * kg);
        const int tok0 = b * SEQ + r + dil * (128 * nb + w0);
        char* dst = (char*)(F.ws + WS_OPART) + ((size_t)br * T + tok0) * (ATTN_W * 2) + (h * HD) * 2;
#pragma unroll
        for (int hf = 0; hf < 2; ++hf) {
#pragma unroll
            for (int i = 0; i < 4; ++i)
#pragma unroll
                for (int r_ = 0; r_ < 4; ++r_) stg[(4 * kg + r_) * 64 + 16 * i + q16] = (unsigned short)f2bf(o[4 * hf + i][r_] * ilr[r_]);
            LDS_WAIT(); asm volatile("" ::: "memory");
#pragma unroll
            for (int p = 0; p < 2; ++p) { const int row = lane >> 2, ch = (lane & 3) + 4 * p;
                const v4u w = *(const LAS v4u*)((const LAS unsigned char*)stg + row * 128 + ch * 16);
                *(GAS v4u*)(dst + (long)row * ((long)dil * ATTN_W * 2) + hf * 128 + ch * 16) = w; }
            LDS_WAIT(); asm volatile("" ::: "memory");
        }
        if (kg == 0) ((float*)(F.ws + WS_LSE))[((size_t)br * T + tok0 + dil * q16) * 8 + h] = MD + __builtin_amdgcn_logf(l);
        have = has_next; u = un; full = n_full;
    }
#undef DECODE
    }

    VM_WAIT(); __syncthreads();
    if (wave == 0) { unsigned sp = 0;
        while (__builtin_amdgcn_readfirstlane(__hip_atomic_load(F.ctl + CW_KVREADY, RLX_AGENT)) < 8u) { __builtin_amdgcn_s_sleep(2); if (++sp > (1u << 22)) { if (F.lane == 0) __hip_atomic_store(F.ctl + CW_TMO, 1u, RLX_AGENT); break; } }
        __builtin_amdgcn_fence(__ATOMIC_ACQUIRE, "agent"); asm volatile("s_waitcnt vmcnt(0)" ::: "memory"); }
    __syncthreads();
    for (int it = F.vcu; it < 256; it += F.G) {
        const int combo = it >> 5, part = it & 31, b = combo >> 2, hm = combo & 3;
        const char* mkv = (const char*)(F.ws + WS_MEMKV) + (size_t)(b * NMEM) * 2048 + hm * 256;
        RowMap mk{mkv, 2048, 0, false}, mv{mkv + 1024, 2048, 0, false};
        __syncthreads();
        dma_k(Kl, 0, 256, mk, wave, F.lane); dma_v(Vl, 0, 256, mv, wave, F.lane);
        VM_WAIT(); __syncthreads();
        norm_k(Kl, 0, 256, gtab + 384, tid);
        __syncthreads();
        for (int qb = 0; qb < 2; ++qb) {
            int lane = F.lane; asm volatile("" : "+v"(lane));
            const int r32 = lane & 31, hi = lane >> 5, vbase = (int)(uintptr_t)Vl + v_rd_base(lane);
            const int tok = b * SEQ + part * 512 + qb * 256 + wave * 32 + r32;
            v4u raw[8]; bf16x8 qr[8];
            load_q(raw, proj + (size_t)tok * (PROJ * 2) + (COL_MQ + hm * HD) * 2, hi);
            norm_q(raw, qr, gtab + 256, hi);
            const float mc = -MM; float l = 0.f;
            f32x16 o[4] = {};
#pragma unroll 1
            for (int hk = 0; hk < 2; ++hk) {
                bf16x8 pa[8];
#pragma unroll
                for (int kt = 0; kt < 4; ++kt) { f32x16 s = qk_tile(Kl, 128 * hk + 32 * kt, qr, r32, hi);
#pragma unroll
                    for (int r = 0; r < 16; ++r) { s[r] = __builtin_amdgcn_exp2f(fmaf(s[r], CS, mc)); l += s[r]; }
                    PK4(s, 0, pa[2 * kt]); PK4(s, 8, pa[2 * kt + 1]); }
#pragma unroll
                for (int f = 0; f < 8; ++f) { const int vb = vbase + (8 * hk + f) * 4096;
                    pv_step<0>(o[0], vb, pa[f]); pv_step<512>(o[1], vb, pa[f]); pv_step<1024>(o[2], vb, pa[f]); pv_step<1536>(o[3], vb, pa[f]); }
            }
            l = xsum32(l);
            if (hi == 0) li[r32] = 1.0f / l;
            LDS_WAIT(); asm volatile("" ::: "memory");
            char* dst = (char*)(F.ws + WS_MEMO) + (size_t)(tok - r32) * (MEM_W * 2) + hm * 256;
#pragma unroll
            for (int d0 = 0; d0 < 4; ++d0) store_block(o[d0], li, stg, dst + d0 * 64, MEM_W * 2, lane);
        }
    }
}

__device__ __forceinline__ void unpack8(const v4u w, float (&f)[8]) { f[0] = bflo(w.x); f[1] = bfhi(w.x); f[2] = bflo(w.y); f[3] = bfhi(w.y); f[4] = bflo(w.z); f[5] = bfhi(w.z); f[6] = bflo(w.w); f[7] = bfhi(w.w); }
__device__ __forceinline__ void p3_combine(Frame& F) {
    const int gw = F.vcu * NWAVES + F.wave, NGW = F.G * NWAVES, lane = F.lane;
    const bf16* proj = (const bf16*)(F.ws + WS_R1); const bf16* opart = (const bf16*)(F.ws + WS_OPART); const float* lse = (const float*)(F.ws + WS_LSE);
    const bf16* memo = (const bf16*)(F.ws + WS_MEMO); bf16* Y = (bf16*)(F.ws + WS_Y);
    for (int t = gw; t < T; t += NGW) {
        float a[16]; float ssa = 0.f;
#pragma unroll
        for (int cc = 0; cc < 2; ++cc) { const int head = 4 * cc + (lane >> 4);
            const float l0 = lse[((size_t)0 * T + t) * 8 + head], l1 = lse[((size_t)1 * T + t) * 8 + head], l2 = lse[((size_t)2 * T + t) * 8 + head];
            const float mx = fmaxf(l0, fmaxf(l1, l2)); float w0 = __builtin_amdgcn_exp2f(l0 - mx), w1 = __builtin_amdgcn_exp2f(l1 - mx), w2 = __builtin_amdgcn_exp2f(l2 - mx);
            const float inv = 1.0f / (w0 + w1 + w2); w0 *= inv; w1 *= inv; w2 *= inv;
            float f0[8], f1[8], f2[8];
            unpack8(__builtin_nontemporal_load((const GAS v4u*)(opart + ((size_t)0 * T + t) * ATTN_W + cc * 512 + 8 * lane)), f0);
            unpack8(__builtin_nontemporal_load((const GAS v4u*)(opart + ((size_t)1 * T + t) * ATTN_W + cc * 512 + 8 * lane)), f1);
            unpack8(__builtin_nontemporal_load((const GAS v4u*)(opart + ((size_t)2 * T + t) * ATTN_W + cc * 512 + 8 * lane)), f2);
#pragma unroll
            for (int jj = 0; jj < 8; ++jj) { const float v = w0 * f0[jj] + w1 * f1[jj] + w2 * f2[jj]; a[8 * cc + jj] = v; ssa += v * v; } }
        float co[8]; float ssc = 0.f;
        { const int s = t & (SEQ - 1); float bg[8], c0[8], uu0[8], c1[8], uu1[8], c2[8], uu2[8];
          const bf16* p0 = proj + (size_t)t * PROJ + 8 * lane;
          unpack8(*(const GAS v4u*)(p0 + COL_B), bg); unpack8(*(const GAS v4u*)(p0 + COL_C), c0); unpack8(*(const GAS v4u*)(p0 + COL_U), uu0);
          if (s >= 1) { unpack8(*(const GAS v4u*)(p0 - PROJ + COL_C), c1); unpack8(*(const GAS v4u*)(p0 - PROJ + COL_U), uu1); }
          if (s >= 2) { unpack8(*(const GAS v4u*)(p0 - 2 * PROJ + COL_C), c2); unpack8(*(const GAS v4u*)(p0 - 2 * PROJ + COL_U), uu2); }
#pragma unroll
          for (int jj = 0; jj < 8; ++jj) { const int c = 8 * lane + jj;
              const float z0 = c0[jj] * uu0[jj], z1 = (s >= 1) ? c1[jj] * uu1[jj] : 0.f, z2 = (s >= 2) ? c2[jj] * uu2[jj] : 0.f;
              const float v = bg[jj] * (F.conv_w[c] * z2 + F.conv_w[CONV_W + c] * z1 + F.conv_w[2 * CONV_W + c] * z0); co[jj] = v; ssc += v * v; } }
        float mo[8]; float ssm = 0.f;
        unpack8(__builtin_nontemporal_load((const GAS v4u*)(memo + (size_t)t * MEM_W + 8 * lane)), mo);
#pragma unroll
        for (int jj = 0; jj < 8; ++jj) ssm += mo[jj] * mo[jj];
#pragma unroll
        for (int o = 1; o < 64; o <<= 1) { ssa += __shfl_xor(ssa, o); ssc += __shfl_xor(ssc, o); ssm += __shfl_xor(ssm, o); }
        const float ra = 1.0f / sqrtf(ssa * (1.f / ATTN_W) + EPS), rc = 1.0f / sqrtf(ssc * (1.f / CONV_W) + EPS), rm = 1.0f / sqrtf(ssm * (1.f / MEM_W) + EPS);
        bf16* yr = Y + (size_t)t * D;
#pragma unroll
        for (int cc = 0; cc < 2; ++cc) { const float* g = F.out_norm_g + cc * 512 + 8 * lane; v4u w;
            w.x = pk2(a[8 * cc + 0] * ra * g[0], a[8 * cc + 1] * ra * g[1]); w.y = pk2(a[8 * cc + 2] * ra * g[2], a[8 * cc + 3] * ra * g[3]);
            w.z = pk2(a[8 * cc + 4] * ra * g[4], a[8 * cc + 5] * ra * g[5]); w.w = pk2(a[8 * cc + 6] * ra * g[6], a[8 * cc + 7] * ra * g[7]);
            *(GAS v4u*)(yr + cc * 512 + 8 * lane) = w; }
        { const float* g = F.out_norm_g + ATTN_W + 8 * lane; v4u w;
          w.x = pk2(co[0] * rc * g[0], co[1] * rc * g[1]); w.y = pk2(co[2] * rc * g[2], co[3] * rc * g[3]); w.z = pk2(co[4] * rc * g[4], co[5] * rc * g[5]); w.w = pk2(co[6] * rc * g[6], co[7] * rc * g[7]);
          *(GAS v4u*)(yr + ATTN_W + 8 * lane) = w; }
        { const float* g = F.out_norm_g + ATTN_W + CONV_W + 8 * lane; v4u w;
          w.x = pk2(mo[0] * rm * g[0], mo[1] * rm * g[1]); w.y = pk2(mo[2] * rm * g[2], mo[3] * rm * g[3]); w.z = pk2(mo[4] * rm * g[4], mo[5] * rm * g[5]); w.w = pk2(mo[6] * rm * g[6], mo[7] * rm * g[7]);
          *(GAS v4u*)(yr + ATTN_W + CONV_W + 8 * lane) = w; }
    }
}

__device__ __forceinline__ float max8(float v) { v = fmaxf(v, __shfl_xor(v, 1)); v = fmaxf(v, __shfl_xor(v, 2)); v = fmaxf(v, __shfl_xor(v, 4)); return v; }
namespace rt {
constexpr int KC = 128, NCH = D / KC, BP = KC * 2 + 16, BUFB = 2 * 96 * BP;
__device__ __forceinline__ void issue_b(v4u (&bst)[6], const bf16* WT, int c, int tid) {
#pragma unroll
    for (int i = 0; i < 6; ++i) { const int p = tid + 512 * i, arr = p / 1536, rem = p - arr * 1536, n = rem >> 4, ch = rem & 15;
        bst[i] = *(const GAS v4u*)(WT + ((size_t)arr * 96 + n) * 2048 + c * KC + ch * 8); }
}
__device__ __forceinline__ void write_b(const v4u (&bst)[6], LAS unsigned char* buf, int tid) {
#pragma unroll
    for (int i = 0; i < 6; ++i) { const int p = tid + 512 * i, arr = p / 1536, rem = p - arr * 1536, n = rem >> 4, ch = rem & 15;
        *(LAS v4u*)(buf + arr * (96 * BP) + n * BP + ch * 16) = bst[i]; }
}
__device__ __forceinline__ void issue_a(f32x4 (&a)[4][2], const float* xrow, int c) {
#pragma unroll
    for (int ks = 0; ks < 4; ++ks) { a[ks][0] = *(const GAS f32x4*)(xrow + c * KC + ks * 32); a[ks][1] = *(const GAS f32x4*)(xrow + c * KC + ks * 32 + 4); }
}
__device__ __forceinline__ void compute(f32x4 (&acc)[6], float& ss, const f32x4 (&a)[4][2], const LAS unsigned char* buf, int fr, int kg) {
#pragma unroll
    for (int ks = 0; ks < 4; ++ks) {
        const f32x4 f0 = a[ks][0], f1 = a[ks][1];
        ss += (f0.x * f0.x + f0.y * f0.y) + (f0.z * f0.z + f0.w * f0.w) + (f1.x * f1.x + f1.y * f1.y) + (f1.z * f1.z + f1.w * f1.w);
        asm volatile("" : "+v"(ss));
        v4u h; h.x = cvtpk(f0.x, f0.y); h.y = cvtpk(f0.z, f0.w); h.z = cvtpk(f1.x, f1.y); h.w = cvtpk(f1.z, f1.w);
        v4u l; l.x = cvtpk(f0.x - bflo(h.x), f0.y - bfhi(h.x)); l.y = cvtpk(f0.z - bflo(h.y), f0.w - bfhi(h.y)); l.z = cvtpk(f1.x - bflo(h.z), f1.y - bfhi(h.z)); l.w = cvtpk(f1.z - bflo(h.w), f1.w - bfhi(h.w));
        const bf16x8 ah = __builtin_bit_cast(bf16x8, h), al = __builtin_bit_cast(bf16x8, l);
#pragma unroll
        for (int nb = 0; nb < 6; ++nb) { const LAS unsigned char* bp = buf + (nb * 16 + fr) * BP + (ks * 32 + 8 * kg) * 2;
            const bf16x8 bh = *(const LAS bf16x8*)bp, bl = *(const LAS bf16x8*)(bp + 96 * BP);
            acc[nb] = __builtin_amdgcn_mfma_f32_16x16x32_bf16(ah, bh, acc[nb], 0, 0, 0);
            acc[nb] = __builtin_amdgcn_mfma_f32_16x16x32_bf16(al, bh, acc[nb], 0, 0, 0);
            acc[nb] = __builtin_amdgcn_mfma_f32_16x16x32_bf16(ah, bl, acc[nb], 0, 0, 0); }
    }
}
}
__device__ __forceinline__ void p5_router(Frame& F) {
    using namespace rt;
    const int tid = F.tid, wave = F.wave;
    const float* X1 = F.out; const bf16* WT = (const bf16*)(F.ws + WS_WR);
    LAS unsigned char* Bl = F.lds;
    LAS float* Lg = (LAS float*)(F.lds + 2 * BUFB + wave * (16 * 97 * 4));
    unsigned* cnt = F.ctl + CW_CNT;
    int* tok_e = (int*)(F.ws + WS_TOK + TOK_E); int* tok_rank = (int*)(F.ws + WS_TOK + TOK_RANK);
    for (int mt = F.vcu; mt < T / 128; mt += F.G) {
        int lane = F.lane; asm volatile("" : "+v"(lane));
        const int fr = lane & 15, kg = lane >> 4;
        const int t0 = mt * 128 + wave * 16;
        const float* xrow = X1 + (size_t)(t0 + fr) * D + 8 * kg;
        f32x4 acc[6];
#pragma unroll
        for (int i = 0; i < 6; ++i) acc[i] = (f32x4){0.f, 0.f, 0.f, 0.f};
        float ss = 0.f;
        v4u bst[6]; f32x4 a0[4][2], a1[4][2];
        __syncthreads();
        issue_b(bst, WT, 0, tid); issue_a(a0, xrow, 0);
#pragma unroll 1
        for (int c = 0; c < NCH; c += 2) {
            write_b(bst, Bl, tid); __syncthreads();
            issue_b(bst, WT, c + 1, tid); issue_a(a1, xrow, c + 1);
            compute(acc, ss, a0, Bl, fr, kg);
            write_b(bst, Bl + BUFB, tid); __syncthreads();
            if (c + 2 < NCH) { issue_b(bst, WT, c + 2, tid); issue_a(a0, xrow, c + 2); }
            compute(acc, ss, a1, Bl + BUFB, fr, kg);
        }
        ss += __shfl_xor(ss, 16); ss += __shfl_xor(ss, 32);
        const float rs_row = 1.0f / sqrtf(ss * (1.f / D) + EPS);
#pragma unroll
        for (int r = 0; r < 4; ++r) { const float rr = __shfl(rs_row, 4 * kg + r);
#pragma unroll
            for (int nb = 0; nb < 6; ++nb) Lg[(4 * kg + r) * 97 + nb * 16 + fr] = acc[nb][r] * rr; }
        LDS_WAIT(); asm volatile("" ::: "memory");
        const float be = F.b_re[lane], bg = F.b_rg[lane & 7];
        int my_e1 = 0, my_e2 = 0; float my_g1 = 0.f, my_g2 = 0.f;
#pragma unroll 4
        for (int tk = 0; tk < 16; ++tk) {
            const float gl = Lg[tk * 97 + 64 + (lane & 7)] + bg;
            const float el = Lg[tk * 97 + lane] + be;
            const float gmax = max8(gl);
            const int gi = __builtin_ctzll(__ballot(gl == gmax) & 0xFFull);
            float gs = __builtin_amdgcn_exp2f((gl - gmax) * LOG2E); gs += __shfl_xor(gs, 1); gs += __shfl_xor(gs, 2); gs += __shfl_xor(gs, 4);
            const float gwt = 1.0f / gs;
            const float v1 = __shfl(max8(el), 8 * gi);
            const int i1 = __builtin_ctzll((__ballot(el == v1) >> (8 * gi)) & 0xFFull);
            const float el2 = (lane == 8 * gi + i1) ? -3.0e38f : el;
            const float v2 = __shfl(max8(el2), 8 * gi);
            const int i2 = __builtin_ctzll((__ballot(el2 == v2) >> (8 * gi)) & 0xFFull);
            const float pr = __builtin_amdgcn_exp2f((v2 - v1) * LOG2E), den = 1.0f / (1.0f + pr);
            if (lane == tk) { my_e1 = 8 * gi + i1; my_e2 = 8 * gi + i2; my_g1 = gwt * den; my_g2 = gwt * pr * den; }
        }
        LAS unsigned* hist = (LAS unsigned*)(F.lds + MISC_OFF + 256);
        if (tid < 64) hist[tid] = 0u;
        __syncthreads();
        unsigned lr1 = 0u, lr2 = 0u;
        if (lane < 16) { lr1 = __hip_atomic_fetch_add(hist + my_e1, 1u, __ATOMIC_RELAXED, __HIP_MEMORY_SCOPE_WORKGROUP); lr2 = __hip_atomic_fetch_add(hist + my_e2, 1u, __ATOMIC_RELAXED, __HIP_MEMORY_SCOPE_WORKGROUP); }
        __syncthreads();
        if (tid < 64) { const unsigned c = hist[tid]; hist[64 + tid] = c ? __hip_atomic_fetch_add(cnt + 64 * tid, c, RLX_AGENT) : 0u; }
        __syncthreads();
        if (lane < 16) {
            const int t = t0 + lane;
            const int k1 = (int)(hist[64 + my_e1] + lr1), k2 = (int)(hist[64 + my_e2] + lr2);
            tok_e[2 * t] = my_e1; tok_e[2 * t + 1] = my_e2; tok_rank[2 * t] = k1; tok_rank[2 * t + 1] = k2;
            int* ltok = (int*)(F.ws + WS_LIST + LIST_TOK); float* lrs = (float*)(F.ws + WS_LIST + LIST_RSTD); float* lgt = (float*)(F.ws + WS_LIST + LIST_GATE);
            ltok[my_e1 * CAP + k1] = t; ltok[my_e2 * CAP + k2] = t; lrs[my_e1 * CAP + k1] = rs_row; lrs[my_e2 * CAP + k2] = rs_row; lgt[my_e1 * CAP + k1] = my_g1; lgt[my_e2 * CAP + k2] = my_g2;
        }
    }
}

constexpr int MOE_MT = MISC_OFF + 48, MOE_PST = MISC_OFF + 64, MOE_TE = MOE_PST + 256;
constexpr int MOE_TB = LDS_EXTRA, MOE_VR = MOE_TB + MAXTILES * 4, MOE_UT = MOE_VR + MAXTILES * 4, MOE_SCU = MOE_UT + 12 * 256 * 4;
constexpr int MOE_MAXU = 12;
static_assert(MOE_SCU + MOE_MAXU * 256 * 4 <= MISC_OFF && MOE_TE + MAXTILES * 4 <= LDS_BYTES, "LDS map");
__device__ __forceinline__ int moe_tables(Frame& F) {
    LAS int* PST = (LAS int*)(F.lds + MOE_PST); LAS int* TE = (LAS int*)(F.lds + MOE_TE); LAS int* MTp = (LAS int*)(F.lds + MOE_MT); LAS int* TB = (LAS int*)(F.lds + MOE_TB); LAS int* VR = (LAS int*)(F.lds + MOE_VR);
    __syncthreads();
    if (F.tid < 64) {
        const int c = (int)__hip_atomic_load(F.ctl + CW_CNT + 64 * F.tid, RLX_AGENT); const int nt = (c + 255) >> 8;
        int x = nt;
#pragma unroll
        for (int o = 1; o < 64; o <<= 1) { const int y = __shfl_up(x, o); if (F.lane >= o) x += y; }
        const int ex = x - nt; PST[F.tid] = ex; if (F.tid == 63) MTp[0] = x;
        for (int i = 0; i < nt; ++i) { TE[ex + i] = F.tid; TB[ex + i] = F.tid * CAP + 256 * i; VR[ex + i] = (c - 256 * i) < 256 ? (c - 256 * i) : 256; }
    }
    __syncthreads();
    return MTp[0];
}

__device__ __forceinline__ void p9_final(Frame& F) {
    (void)moe_tables(F);
    const LAS int* PST = (const LAS int*)(F.lds + MOE_PST);
    const int gw = F.vcu * NWAVES + F.wave, NGW = F.G * NWAVES, lane = F.lane;
    const int* tok_e = (const int*)(F.ws + WS_TOK + TOK_E); const int* tok_rank = (const int*)(F.ws + WS_TOK + TOK_RANK); const bf16* YB = (const bf16*)(F.ws + WS_R1);
    typedef int i32x2 __attribute__((ext_vector_type(2)));
    i32x2 ce = {0, 0}, cr = {0, 0};
    if (gw < T) { ce = *(const GAS i32x2*)(tok_e + 2 * gw); cr = *(const GAS i32x2*)(tok_rank + 2 * gw); }
    for (int t = gw; t < T; t += NGW) {
        const int s1 = PST[ce.x] * 256 + cr.x, s2 = PST[ce.y] * 256 + cr.y;
        if (t + NGW < T) { ce = *(const GAS i32x2*)(tok_e + 2 * (t + NGW)); cr = *(const GAS i32x2*)(tok_rank + 2 * (t + NGW)); }
        const GAS v4u* y1 = (const GAS v4u*)(YB + (size_t)s1 * D) + lane; const GAS v4u* y2 = (const GAS v4u*)(YB + (size_t)s2 * D) + lane;
        GAS f32x4* o = (GAS f32x4*)(F.out + (size_t)t * D) + 2 * lane;
#pragma unroll
        for (int i = 0; i < 4; ++i) { float a[8], b[8]; unpack8(__builtin_nontemporal_load(y1 + 64 * i), a); unpack8(__builtin_nontemporal_load(y2 + 64 * i), b);
            f32x4 v0 = __builtin_nontemporal_load(o + 128 * i), v1 = __builtin_nontemporal_load(o + 128 * i + 1);
            v0.x += a[0] + b[0]; v0.y += a[1] + b[1]; v0.z += a[2] + b[2]; v0.w += a[3] + b[3]; v1.x += a[4] + b[4]; v1.y += a[5] + b[5]; v1.z += a[6] + b[6]; v1.w += a[7] + b[7];
            __builtin_nontemporal_store(v0, o + 128 * i); __builtin_nontemporal_store(v1, o + 128 * i + 1); }
    }
}

constexpr int PER_PHASE = 10;
constexpr int N_LAUNCHES = MK_N_LAUNCHES;
struct Args { const float* in[21]; float* out; unsigned char* ws; int ph_lo, ph_hi, li, pad; };
__global__ void __launch_bounds__(NWAVES * 64, 2) hymba_fwd(Args args) {
    extern __shared__ __attribute__((aligned(16))) unsigned char lds[];
    Frame F;
    F.lds = (LAS unsigned char*)lds;
    F.tid = threadIdx.x; F.lane = F.tid & 63; F.wave = __builtin_amdgcn_readfirstlane(F.tid >> 6);
    F.G = gridDim.x; { const int bx = blockIdx.x; F.vcu = (F.G % 8 == 0) ? (bx % 8) * (F.G / 8) + bx / 8 : bx; }
    F.ws = args.ws; F.ctl = (unsigned*)(args.ws + WS_CTL); F.out = args.out;
    F.x = args.in[0]; F.mem = args.in[1]; F.norm1_g = args.in[2]; F.w_in = args.in[3]; F.q_norm_g = args.in[4]; F.k_norm_g = args.in[5]; F.conv_w = args.in[6];
    F.mem_norm_g = args.in[7]; F.w_mem_kv = args.in[8]; F.mem_q_norm_g = args.in[9]; F.mem_k_norm_g = args.in[10]; F.out_norm_g = args.in[11]; F.w_out = args.in[12];
    F.norm2_g = args.in[13]; F.w_rg = args.in[14]; F.b_rg = args.in[15]; F.w_re = args.in[16]; F.b_re = args.in[17]; F.w_gate = args.in[18]; F.w_up = args.in[19]; F.w_down = args.in[20];
    volatile LAS unsigned* MISC = (volatile LAS unsigned*)(F.lds + MISC_OFF);
    if (F.tid < 16) MISC[F.tid] = 0u;
    __syncthreads();
    const int lo = args.ph_lo, hi = args.ph_hi;
    const bool multi = (hi - lo) > 1;
    XcdBarrier bar; bar.bar = F.ctl + CW_BAR + args.li * XCD_BAR_WORDS; bar.x = 0; bar.st = nullptr;
    if (multi) bar = xcd_barrier_post(F.ctl + CW_BAR + args.li * XCD_BAR_WORDS, MISC + 8);
#define GRID_BAR() do { if (multi) xcd_barrier(bar); } while (0)
#define IN(k) (lo <= (k) && (k) < hi)
#define BOTH(k) (IN(k) && IN((k) + 1))
    if (IN(0)) { p0_prologue(F); if (BOTH(0)) GRID_BAR(); }
    if (IN(1)) {
        pg8::Gemm g{(const bf16*)(F.ws + WS_H), (const bf16*)(F.ws + WS_WIN), D, nullptr}; pg8::P1Order S{F.G, (int)blockIdx.x, 0, 2560};
        pg8::EpiProj E{(bf16*)(F.ws + WS_R1), (bf16*)(F.ws + WS_MEMKV)};
        pg8::gemm_phase<pg8::EpiProj, pg8::P1Order>(F.lds, g, S, E);
        if (BOTH(1)) GRID_BAR();
    }
    if (IN(2)) { p2_attention(F); if (BOTH(2)) GRID_BAR(); }
    if (IN(3)) { p3_combine(F); if (BOTH(3)) GRID_BAR(); }
    if (IN(4)) {
        pg8::Gemm g{(const bf16*)(F.ws + WS_Y), (const bf16*)(F.ws + WS_WOUT), D, nullptr}; pg8::StaticOrder S{T / 256, D / 256, F.G, (int)blockIdx.x};
        pg8::EpiResid E{F.x, F.out, (bf16*)(F.ws + WS_H)};
        pg8::gemm_phase<pg8::EpiResid, pg8::StaticOrder, false>(F.lds, g, S, E);
        if (BOTH(4)) GRID_BAR();
    }
    if (IN(5)) { p5_router(F); if (BOTH(5)) GRID_BAR(); }
    if (IN(7)) {
        const int MT = moe_tables(F);
        pg8::MoeOrder S{MT, F.G, (int)blockIdx.x, (const LAS int*)(F.lds + MOE_TE)};
        { const LAS int* TB = (const LAS int*)(F.lds + MOE_TB); const LAS int* VR = (const LAS int*)(F.lds + MOE_VR); LAS int* UT = (LAS int*)(F.lds + MOE_UT);
          const int* ltok = (const int*)(F.ws + WS_LIST + LIST_TOK); const float* lrs = (const float*)(F.ws + WS_LIST + LIST_RSTD); LAS float* SCU = (LAS float*)(F.lds + MOE_SCU);
          for (int i = 0; i < MOE_MAXU; ++i) { pg8::Unit u; if (!S.next(i, u)) break;
              if (F.tid < 256) { const bool ok = F.tid < VR[u.pm]; UT[i * 256 + F.tid] = ok ? ltok[TB[u.pm] + F.tid] : 0; SCU[i * 256 + F.tid] = ok ? lrs[TB[u.pm] + F.tid] : 0.f; } }
          __syncthreads(); }
        pg8::Gemm g{(const bf16*)(F.ws + WS_H), (const bf16*)(F.ws + WS_WGU), D, (const LAS int*)(F.lds + MOE_UT)};
        pg8::EpiSwiGLU E{(bf16*)(F.ws + WS_OPART), (const LAS float*)(F.lds + MOE_SCU)};
        pg8::gemm_phase<pg8::EpiSwiGLU, pg8::MoeOrder, true, true, false, true>(F.lds, g, S, E);
        if (BOTH(7)) GRID_BAR();
    }
    if (IN(8)) {
        const int MT = moe_tables(F);
        pg8::Gemm g{(const bf16*)(F.ws + WS_OPART), (const bf16*)(F.ws + WS_WD), DEXP, nullptr}; pg8::MoeOrder S{MT, F.G, (int)blockIdx.x, (const LAS int*)(F.lds + MOE_TE)};
        { const LAS int* TB = (const LAS int*)(F.lds + MOE_TB); const LAS int* VR = (const LAS int*)(F.lds + MOE_VR); LAS float* SCU = (LAS float*)(F.lds + MOE_SCU);
          const float* lgt = (const float*)(F.ws + WS_LIST + LIST_GATE);
          for (int i = 0; i < MOE_MAXU; ++i) { pg8::Unit u; if (!S.next(i, u)) break;
              if (F.tid < 256) SCU[i * 256 + F.tid] = (F.tid < VR[u.pm]) ? lgt[TB[u.pm] + F.tid] : 0.f; }
          __syncthreads(); }
        pg8::EpiDown E{(bf16*)(F.ws + WS_R1), (const LAS float*)(F.lds + MOE_SCU)};
        pg8::gemm_phase<pg8::EpiDown, pg8::MoeOrder, true, false, false, true>(F.lds, g, S, E);
        if (BOTH(8)) GRID_BAR();
    }
    if (IN(9)) { p9_final(F); }
#undef IN
#undef BOTH
#undef GRID_BAR
}

extern "C" void kernel_launch(void* const* d_in, const int* in_sizes, int n_in, void* d_out, int out_size, void* d_ws, size_t ws_size, hipStream_t stream) {
    static int grid = 0;
    if (grid == 0) {
        if (n_in != 21 || in_sizes[0] != T * D || out_size != T * D || ws_size < WS_END) { fprintf(stderr, "kernel_launch: shape/workspace mismatch (n_in %d, ws %zu < %zu); nothing launched\n", n_in, ws_size, (size_t)WS_END); grid = -1; return; }
        int dev = 0, cus = 0, per_cu = 0;
        if (hipGetDevice(&dev) != hipSuccess || hipDeviceGetAttribute(&cus, hipDeviceAttributeMultiprocessorCount, dev) != hipSuccess) { grid = -1; return; }
        if (hipFuncSetAttribute((const void*)hymba_fwd, hipFuncAttributeMaxDynamicSharedMemorySize, LDS_BYTES) != hipSuccess) { fprintf(stderr, "kernel_launch: hipFuncSetAttribute failed\n"); grid = -1; return; }
        if (hipOccupancyMaxActiveBlocksPerMultiprocessor(&per_cu, (const void*)hymba_fwd, NWAVES * 64, LDS_BYTES) != hipSuccess || per_cu < 1) { fprintf(stderr, "kernel_launch: occupancy query reports %d\n", per_cu); }
        (void)hipGetLastError();
        grid = cus;
    }
    if (grid < 0) return;
    if (hipMemsetAsync((char*)d_ws + WS_CTL, 0, CTL_ZERO_BYTES, stream) != hipSuccess) { fprintf(stderr, "kernel_launch: memset failed\n"); return; }
    Args a{};
    for (int i = 0; i < 21; ++i) a.in[i] = (const float*)d_in[i];
    a.out = (float*)d_out; a.ws = (unsigned char*)d_ws;
    int los[4], his[4], nl = 0;
#if defined(PROBE_REPEAT)
    los[nl] = 0; his[nl] = PROBE_REPEAT + 1; ++nl; los[nl] = PROBE_REPEAT; his[nl] = PROBE_REPEAT + 1; ++nl; if (PROBE_REPEAT + 1 < PER_PHASE) { los[nl] = PROBE_REPEAT + 1; his[nl] = PER_PHASE; ++nl; }
#else
    los[nl] = 0; his[nl] = PER_PHASE; ++nl;
#endif
    for (int li = 0; li < nl; ++li) {
        a.ph_lo = los[li]; a.ph_hi = his[li]; a.li = li;
#if defined(PROBE_REPEAT)
        if (li == 1) { (void)hipMemsetAsync((char*)d_ws + WS_CTL + CW_ATTQ * 4, 0, 64, stream); if (PROBE_REPEAT == 5) (void)hipMemsetAsync((char*)d_ws + WS_CTL + CW_CNT * 4, 0, 64 * 256, stream); }
#endif
        hipLaunchKernelGGL(hymba_fwd, dim3(grid), dim3(NWAVES * 64), LDS_BYTES, stream, a);
        const hipError_t le = hipPeekAtLastError();
        if (le != hipSuccess) { fprintf(stderr, "kernel_launch: launch %d failed: %s\n", li, hipGetErrorName(le)); break; }
    }
}
```

```cpp
#include <hip/hip_runtime.h>
#include <cstdio>
#include <cstdint>

#ifndef MK_N_LAUNCHES
#define MK_N_LAUNCHES 1
#endif

#define GAS __attribute__((address_space(1)))
#define LAS __attribute__((address_space(3)))
typedef unsigned short bf16;
typedef unsigned v4u __attribute__((ext_vector_type(4)));
typedef unsigned v2u __attribute__((ext_vector_type(2)));
typedef float f32x4 __attribute__((ext_vector_type(4)));
typedef float f32x16 __attribute__((ext_vector_type(16)));
typedef short bf16x8 __attribute__((ext_vector_type(8)));
typedef short s16x4 __attribute__((ext_vector_type(4)));
#define LDS_WAIT() asm volatile("s_waitcnt lgkmcnt(0)" ::: "memory")
#define VM_WAIT() asm volatile("s_waitcnt vmcnt(0)" ::: "memory")
#define RLX_AGENT __ATOMIC_RELAXED, __HIP_MEMORY_SCOPE_AGENT

constexpr int BATCH = 2, SEQ = 16384, T = BATCH * SEQ, D = 2048, PROJ = 5120;
constexpr int NH = 8, HD = 128, ATTN_W = 1024, CONV_W = 512, MEM_W = 512, NMEM = 256, NMH = 4;
constexpr int COL_Q = 0, COL_K = 1024, COL_V = 2048, COL_B = 3072, COL_C = 3584, COL_U = 4096, COL_MQ = 4608;
constexpr int NEXP = 64, DEXP = 1024;
constexpr int RMAX = 81920;
constexpr int MAXTILES = RMAX / 256;
constexpr float EPS = 1e-6f;
constexpr float LOG2E = 1.4426950408889634f;

constexpr size_t MiB = 1u << 20;
constexpr size_t WS_CTL = 0, CTL_ZERO_BYTES = 1 * MiB;
constexpr size_t WS_WIN = 1 * MiB;
constexpr size_t WS_WMKV = WS_WIN + (size_t)PROJ * D * 2;
constexpr size_t WS_WOUT = 25 * MiB;
constexpr size_t WS_WR = 33 * MiB;
constexpr size_t WS_WGU = 34 * MiB;
constexpr size_t WS_WD = WS_WGU + 512 * MiB;
constexpr size_t WS_H = WS_WD + 256 * MiB;
constexpr size_t WS_MEMKV = WS_H + 130 * MiB;
constexpr size_t WS_R1 = WS_MEMKV + 1 * MiB;
constexpr size_t WS_OPART = WS_R1 + 320 * MiB;
constexpr size_t WS_LSE = WS_OPART + 192 * MiB;
constexpr size_t WS_MEMO = WS_LSE + 3 * MiB;
constexpr size_t WS_Y = WS_MEMO + 32 * MiB;
constexpr size_t WS_TOK = WS_Y + 128 * MiB;
constexpr size_t WS_LIST = WS_TOK + 4 * MiB;
constexpr size_t WS_END = WS_LIST + 24 * MiB;
constexpr int CAP = T;
constexpr size_t LIST_TOK = 0, LIST_RSTD = 8 * MiB, LIST_GATE = 16 * MiB;
constexpr size_t TOK_E = 0, TOK_RANK = 256 * 1024, TOK_GATE = 512 * 1024, TOK_RSTD = 768 * 1024, TOK_SLOT = 1024 * 1024, SLOT_RSTD = 1536 * 1024, SLOT_GATE = 2048 * 1024;
static_assert(WS_WMKV + 1024 * (size_t)D * 2 <= WS_WOUT && WS_WOUT + 8 * MiB <= WS_WR && WS_WR + 2048 * 72 * 4 <= WS_WGU, "ws map");
static_assert((size_t)(T + 512) * D * 2 <= 130 * MiB && (size_t)RMAX * D * 2 <= 320 * MiB && (size_t)RMAX * DEXP * 2 <= 192 * MiB && SLOT_GATE + RMAX * 4 <= 4 * MiB, "ws map");

constexpr int CW_TMO = 0, CW_CODE = 1;
constexpr int CW_CNT = 8192;
constexpr int CW_BAR = 16384;
constexpr int CW_KVREADY = 512, CW_ATTQ = 576;

constexpr int RING_BYTES = 131072;
constexpr int LDS_EXTRA = RING_BYTES;
constexpr int MISC_OFF = 163840 - 2048;
constexpr int LDS_BYTES = 163840;

__device__ __forceinline__ unsigned f2bf(float f) { unsigned u = __builtin_bit_cast(unsigned, f); return (u + 0x7fffu + ((u >> 16) & 1u)) >> 16; }
__device__ __forceinline__ unsigned pk2(float lo, float hi) { return f2bf(lo) | (f2bf(hi) << 16); }
__device__ __forceinline__ unsigned cvtpk(float lo, float hi) { unsigned r; asm volatile("v_cvt_pk_bf16_f32 %0, %1, %2" : "=v"(r) : "v"(lo), "v"(hi)); return r; }
__device__ __forceinline__ unsigned pk_fp8x4(float a, float b, float c, float d) { unsigned w = 0u; w = __builtin_amdgcn_cvt_pk_fp8_f32(a, b, w, false); w = __builtin_amdgcn_cvt_pk_fp8_f32(c, d, w, true); return w; }
constexpr float SC_WGU = 128.0f, SC_ACT = 4.0f, SC_WD = 64.0f;
__device__ __forceinline__ float bflo(unsigned w) { return __builtin_bit_cast(float, w << 16); }
__device__ __forceinline__ float bfhi(unsigned w) { return __builtin_bit_cast(float, w & 0xffff0000u); }
__device__ __forceinline__ float wave_sum(float v) {
#pragma unroll
    for (int o = 1; o < 64; o <<= 1) v += __shfl_xor(v, o);
    return v;
}

namespace pg8 {
#define PG8_LAS __attribute__((address_space(3)))
typedef unsigned short bf16_t;
typedef unsigned u32x4 __attribute__((ext_vector_type(4)));
typedef int i32x4 __attribute__((ext_vector_type(4)));
typedef int i32x8 __attribute__((ext_vector_type(8)));
constexpr int BM = 256, BK = 64, HALF = 128, HTB = HALF * BK * 2, STAGE_BYTES = 8 * HTB, NXCD = 8, WGM = 8;
__host__ __device__ __forceinline__ int lds_byte(int r, int c) { const int st = (r >> 4) * 2 + (c >> 5), rr = r & 15, cc = c & 31, ob = rr * 64 + cc * 2; return st * 1024 + (ob ^ (((ob >> 9) & 1) << 5)); }
__host__ __device__ __forceinline__ void stage_rc(int b, int& R, int& C) { const int st = b / 1024, sb = b % 1024, swz = sb ^ (((sb >> 9) & 1) << 5); R = (st >> 1) * 16 + swz / 64; C = (st & 1) * 32 + (swz % 64) / 2; }
__host__ __device__ __forceinline__ int perm32(int rho) { const int n = rho >> 4, i = rho & 15; return 8 * (i >> 2) + 4 * n + (i & 3); }

struct Unit { int pm, pn, pb, ui; };
struct Gemm { const bf16_t* A; const bf16_t* Bt; int K; const PG8_LAS int* ut; };

__device__ __forceinline__ void tile_of(int L, int nM, int nN, int& pm, int& pn) {
    const int nwg = nM * nN;
    int wgid = L; { const int q = nwg / NXCD, r = nwg % NXCD, xcd = wgid % NXCD, off = wgid / NXCD; wgid = (xcd < r ? xcd * (q + 1) : r * (q + 1) + (xcd - r) * q) + off; }
    const int nig = WGM * nN, gid = wgid / nig, fm = gid * WGM, gsz = (nM - fm) < WGM ? (nM - fm) : WGM;
    pm = fm + ((wgid % nig) % gsz); pn = (wgid % nig) / gsz;
}
struct StaticOrder {
    int nM, nN, G, c;
    __device__ __forceinline__ bool next(int i, Unit& u) const { const long L = (long)i * G + c; if (L >= (long)nM * nN) return false; tile_of((int)L, nM, nN, u.pm, u.pn); u.pb = u.pn; return true; }
    __device__ __forceinline__ void a_ready(const Unit&) const {}
    __device__ __forceinline__ void done(const Unit&) const {}
};
struct P1Order {
    int G, c, lo, hi;
    __device__ __forceinline__ bool next(int i, Unit& u) const { const long L = (long)lo + (long)i * G + c; if (L >= hi) return false;
        if (L < 2560) tile_of((int)L, 128, 20, u.pm, u.pn); else { const int k = (int)L - 2560; u.pm = 128 + (k >> 2); u.pn = 20 + (k & 3); }
        u.pb = u.pn; return true; }
    __device__ __forceinline__ void a_ready(const Unit&) const {}
    __device__ __forceinline__ void done(const Unit&) const {}
};
struct MoeOrder {
    int nM, G, c; const LAS int* te;
    __device__ __forceinline__ bool next(int i, Unit& u) const { const long L = (long)i * G + c; if (L >= (long)nM * 8) return false; tile_of((int)L, nM, 8, u.pm, u.pn); u.pb = te[u.pm] * 8 + u.pn; u.ui = i; return true; }
    __device__ __forceinline__ void a_ready(const Unit&) const {}
    __device__ __forceinline__ void done(const Unit&) const {}
};

struct EpiProj {
    static constexpr bool PERM = true, AFTER_DRAIN = false;
    bf16_t* O; bf16_t* O2;
    __device__ __forceinline__ void operator()(const f32x4 (&acc)[2][2][4][2], const Unit& u, int wr, int wc, int fr, int fq) const {
        int row0 = u.pm * BM + wr * 64 + fr, col0 = u.pn * BM + wc * 32 + 8 * fq, ldc = PROJ; bf16_t* base = O;
        if (u.pm >= 128) { row0 -= 128 * BM; col0 -= 20 * BM; ldc = 1024; base = O2; }
#pragma unroll
        for (int ai = 0; ai < 2; ++ai)
#pragma unroll
            for (int m = 0; m < 4; ++m) { bf16_t* rowp = base + (size_t)(row0 + ai * HALF + m * 16) * ldc + col0;
#pragma unroll
                for (int bj = 0; bj < 2; ++bj) { const f32x4 v0 = acc[ai][bj][m][0], v1 = acc[ai][bj][m][1];
                    u32x4 w; w.x = cvtpk(v0[0], v0[1]); w.y = cvtpk(v0[2], v0[3]); w.z = cvtpk(v1[0], v1[1]); w.w = cvtpk(v1[2], v1[3]);
                    *(u32x4*)(rowp + bj * HALF) = w; } }
    }
};
struct EpiResid {
    static constexpr bool PERM = true, AFTER_DRAIN = false;
    const float* X; float* X1; bf16_t* X1B;
    __device__ __forceinline__ void operator()(const f32x4 (&acc)[2][2][4][2], const Unit& u, int wr, int wc, int fr, int fq) const {
        const int row0 = u.pm * BM + wr * 64 + fr, col0 = u.pn * BM + wc * 32 + 8 * fq;
#pragma unroll
        for (int ai = 0; ai < 2; ++ai)
#pragma unroll
            for (int m = 0; m < 4; ++m) { const size_t off = (size_t)(row0 + ai * HALF + m * 16) * D + col0;
#pragma unroll
                for (int bj = 0; bj < 2; ++bj) { const f32x4 xa = __builtin_nontemporal_load((const f32x4*)(X + off + bj * HALF)), xb = __builtin_nontemporal_load((const f32x4*)(X + off + bj * HALF + 4));
                    const f32x4 v0 = acc[ai][bj][m][0] + xa, v1 = acc[ai][bj][m][1] + xb;
                    *(f32x4*)(X1 + off + bj * HALF) = v0; *(f32x4*)(X1 + off + bj * HALF + 4) = v1;
                    v2u w; w.x = pk_fp8x4(v0[0], v0[1], v0[2], v0[3]); w.y = pk_fp8x4(v1[0], v1[1], v1[2], v1[3]);
                    *(v2u*)((unsigned char*)X1B + off + bj * HALF) = w; }
                asm volatile("" ::: "memory"); }
    }
};
struct EpiSwiGLU {
    static constexpr bool PERM = true, AFTER_DRAIN = false;
    bf16_t* ACT; const PG8_LAS float* RSU;
    __device__ __forceinline__ void operator()(const f32x4 (&acc)[2][2][4][2], const Unit& u, int wr, int wc, int fr, int fq) const {
        const int row0 = u.pm * BM + wr * 64 + fr, col0 = u.pn * HALF + wc * 32 + 8 * fq; const PG8_LAS float* rsu = RSU + u.ui * 256 + wr * 64 + fr;
#pragma unroll
        for (int ai = 0; ai < 2; ++ai)
#pragma unroll
            for (int m = 0; m < 4; ++m) { const int row = row0 + ai * HALF + m * 16; const float rs = rsu[ai * HALF + m * 16] * (1.0f / SC_WGU); float o[8];
#pragma unroll
                for (int n = 0; n < 2; ++n)
#pragma unroll
                    for (int j = 0; j < 4; ++j) { const float g = acc[ai][0][m][n][j] * rs, uu = acc[ai][1][m][n][j] * rs;
                        o[n * 4 + j] = g * __builtin_amdgcn_rcpf(1.0f + __builtin_amdgcn_exp2f(-g * LOG2E)) * uu * SC_ACT; }
                v2u w; w.x = pk_fp8x4(o[0], o[1], o[2], o[3]); w.y = pk_fp8x4(o[4], o[5], o[6], o[7]);
                *(v2u*)((unsigned char*)ACT + (size_t)row * DEXP + col0) = w; }
    }
};
struct EpiDown {
    static constexpr bool PERM = true, AFTER_DRAIN = false;
    bf16_t* Y; const PG8_LAS float* GTU;
    __device__ __forceinline__ void operator()(const f32x4 (&acc)[2][2][4][2], const Unit& u, int wr, int wc, int fr, int fq) const {
        const int row0 = u.pm * BM + wr * 64 + fr, col0 = u.pn * BM + wc * 32 + 8 * fq; const PG8_LAS float* gtu = GTU + u.ui * 256 + wr * 64 + fr;
#pragma unroll
        for (int ai = 0; ai < 2; ++ai)
#pragma unroll
            for (int m = 0; m < 4; ++m) { const int row = row0 + ai * HALF + m * 16; const float gt = gtu[ai * HALF + m * 16] * (1.0f / (SC_ACT * SC_WD)); bf16_t* rowp = Y + (size_t)row * D + col0;
#pragma unroll
                for (int bj = 0; bj < 2; ++bj) { const f32x4 v0 = acc[ai][bj][m][0] * gt, v1 = acc[ai][bj][m][1] * gt;
                    u32x4 w; w.x = cvtpk(v0[0], v0[1]); w.y = cvtpk(v0[2], v0[3]); w.z = cvtpk(v1[0], v1[1]); w.w = cvtpk(v1[2], v1[3]);
                    *(u32x4*)(rowp + bj * HALF) = w; } }
    }
};

template <class Epi, class Sched, bool ALIGN_EPI = true, bool GATHER = false, bool BKN = false, bool FP8 = false>
__device__ __forceinline__ void gemm_phase(PG8_LAS unsigned char* lds, const Gemm g, const Sched& S, const Epi& E) {
    static_assert(!(FP8 && BKN), "the fp8 path takes N-major B");
    const int tid = threadIdx.x, wid = __builtin_amdgcn_readfirstlane(tid >> 6), lane = tid & 63, wr = wid >> 2, wc = wid & 3, fr = lane & 15, fq = lane >> 4;
    const int K = FP8 ? g.K / 2 : g.K, nt = K / BK;
    unsigned voffA[2], voffB[2]; int gR[2], gC[2];
#pragma unroll
    for (int i = 0; i < 2; ++i) { int R, C; stage_rc(tid * 16 + i * 8192, R, C); const int Rb = Epi::PERM ? ((R & ~31) + perm32(R & 31)) : R; gR[i] = R; gC[i] = C;
        voffA[i] = (unsigned)(R * K + C) * 2u; voffB[i] = (unsigned)(Rb * K + C) * 2u; }
    unsigned vA0[2], vA1[2], vN0[2], vN1[2];
#define PG8_GOFF(dst0, dst1, ui_) do { _Pragma("unroll") for (int _i = 0; _i < 2; ++_i) { \
        dst0[_i] = ((unsigned)g.ut[(ui_) * 256 + gR[_i]] * (unsigned)K + (unsigned)gC[_i]) * 2u; dst1[_i] = ((unsigned)g.ut[(ui_) * 256 + 128 + gR[_i]] * (unsigned)K + (unsigned)gC[_i]) * 2u; } } while (0)
    const size_t kstep = (size_t)(BK * 2);
    const size_t hstep = (size_t)HALF * K * 2;
    const size_t tstep = 2 * hstep;
    const size_t kstepB = BKN ? (size_t)BK * 4096 : kstep, hstepB = BKN ? (size_t)256 : hstep;
    if constexpr (BKN) {
#pragma unroll
        for (int i = 0; i < 2; ++i) { const int p = tid * 16 + i * 8192, kk = p >> 8, c16p = (p & 255) >> 4, sw = (kk & 3) | (((kk >> 3) & 1) << 2);
            voffB[i] = (unsigned)(kk * 4096 + ((c16p ^ (sw << 1)) << 4)); } }
    int bbase[2];
    { const int q = fr >> 2, p = fr & 3, sw = q | ((fq & 1) << 2);
#pragma unroll
      for (int n = 0; n < 2; ++n) bbase[n] = (int)(uintptr_t)lds + (8 * fq + q) * 256 + (((4 * wc + 2 * n + (p >> 1)) ^ (sw << 1)) << 4) + 8 * (p & 1); }
    const unsigned ldsw = (unsigned)wid * 1024u;
    const int aoff = lds_byte(wr * 64 + fr, fq * 8), boff = lds_byte(wc * 32 + fr, fq * 8);
    const int aoq0 = lds_byte(wr * 64 + fr, fq * 16), aoq1 = lds_byte(wr * 64 + fr, fq * 16 + 8), boq0 = lds_byte(wc * 32 + fr, fq * 16), boq1 = lds_byte(wc * 32 + fr, fq * 16 + 8);
#define PG8_SA(b, h) (((b) * 2 + (h)) * HTB)
#define PG8_SB(b, h) ((4 + (b) * 2 + (h)) * HTB)
#define PG8_STAGE(bufoff, gbase, voff) do { _Pragma("unroll") for (int _i = 0; _i < 2; ++_i) \
        __builtin_amdgcn_global_load_lds((const unsigned*)((const char*)(gbase) + (voff)[_i]), (PG8_LAS unsigned*)(lds + (bufoff) + ldsw + _i * 8192), 16, 0, 0); } while (0)
#define PG8_Q_At Aq
#define PG8_Q_B0 Bq0
#define PG8_Q_B1 Bq1
#define PG8_LD8(p0_, p1_) __builtin_shufflevector(*(const PG8_LAS i32x4*)(p0_), *(const PG8_LAS i32x4*)(p1_), 0, 1, 2, 3, 4, 5, 6, 7)
#define PG8_LDA(dst, b, h) do { if constexpr (FP8) { _Pragma("unroll") for (int m = 0; m < 4; ++m) PG8_Q_##dst[m] = PG8_LD8(lds + PG8_SA(b, h) + aoq0 + m * 2048, lds + PG8_SA(b, h) + aoq1 + m * 2048); } \
        else { _Pragma("unroll") for (int m = 0; m < 4; ++m) _Pragma("unroll") for (int k = 0; k < 2; ++k) dst[m][k] = *(const PG8_LAS bf16x8*)(lds + PG8_SA(b, h) + aoff + m * 2048 + k * 1024); } } while (0)
#define PG8_TR(dst, addr, OFF) asm volatile("ds_read_b64_tr_b16 %0, %1 offset:%2" : "=&v"(dst) : "v"(addr), "i"(OFF) : "memory")
#define PG8_LDB(dst, b, h) do { if constexpr (BKN) { _Pragma("unroll") for (int n = 0; n < 2; ++n) { const int ad_ = bbase[n] + PG8_SB(b, h); s16x4 l0_, h0_, l1_, h1_; \
            PG8_TR(l0_, ad_, 0); PG8_TR(h0_, ad_, 1024); PG8_TR(l1_, ad_, 8192); PG8_TR(h1_, ad_, 9216); \
            dst[n][0] = (bf16x8){l0_[0], l0_[1], l0_[2], l0_[3], h0_[0], h0_[1], h0_[2], h0_[3]}; dst[n][1] = (bf16x8){l1_[0], l1_[1], l1_[2], l1_[3], h1_[0], h1_[1], h1_[2], h1_[3]}; } } \
        else if constexpr (FP8) { _Pragma("unroll") for (int n = 0; n < 2; ++n) PG8_Q_##dst[n] = PG8_LD8(lds + PG8_SB(b, h) + boq0 + n * 2048, lds + PG8_SB(b, h) + boq1 + n * 2048); } \
        else { _Pragma("unroll") for (int n = 0; n < 2; ++n) _Pragma("unroll") for (int k = 0; k < 2; ++k) dst[n][k] = *(const PG8_LAS bf16x8*)(lds + PG8_SB(b, h) + boff + n * 2048 + k * 1024); } } while (0)
#define PG8_MMA(ai, bj, At, Bt) do { __builtin_amdgcn_s_setprio(1); if constexpr (FP8) { _Pragma("unroll") for (int m = 0; m < 4; ++m) _Pragma("unroll") for (int n = 0; n < 2; ++n) \
            asm volatile("v_mfma_scale_f32_16x16x128_f8f6f4 %0, %1, %2, %0, %3, %3 op_sel_hi:[0,0,0]" : "+v"(acc[ai][bj][m][n]) : "v"(PG8_Q_##Bt[n]), "v"(PG8_Q_##At[m]), "v"(sc1_)); } \
        else { _Pragma("unroll") for (int m = 0; m < 4; ++m) _Pragma("unroll") for (int n = 0; n < 2; ++n) _Pragma("unroll") for (int k = 0; k < 2; ++k) \
            acc[ai][bj][m][n] = __builtin_amdgcn_mfma_f32_16x16x32_bf16(Bt[n][k], At[m][k], acc[ai][bj][m][n], 0, 0, 0); } __builtin_amdgcn_s_setprio(0); } while (0)
#define PG8_WAIT_V(n) asm volatile("s_waitcnt vmcnt(" #n ")" ::: "memory")
#define PG8_WAIT_L(n) asm volatile("s_waitcnt lgkmcnt(" #n ")" ::: "memory")
#define PG8_BAR __builtin_amdgcn_s_barrier()
#define PG8_SCHED __builtin_amdgcn_sched_barrier(0)
    Unit cur, nxt; int ui = 0;
    if (!S.next(0, cur)) return;
    f32x4 acc[2][2][4][2];
#pragma unroll
    for (int a = 0; a < 2; ++a)
#pragma unroll
        for (int b = 0; b < 2; ++b)
#pragma unroll
            for (int m = 0; m < 4; ++m)
#pragma unroll
                for (int n = 0; n < 2; ++n) acc[a][b][m][n] = (f32x4){0.f, 0.f, 0.f, 0.f};
    bf16x8 At[4][2], B0[2][2], B1[2][2];
    i32x8 Aq[4], Bq0[2], Bq1[2]; const int sc1_ = 0x7F7F7F7F;
    const char* cA = GATHER ? (const char*)g.A : (const char*)g.A + (size_t)cur.pm * tstep; const char* cB = BKN ? (const char*)g.Bt + (size_t)(cur.pb >> 3) * ((size_t)K * 4096) + (size_t)(cur.pb & 7) * 512 : (const char*)g.Bt + (size_t)cur.pb * tstep;
    const size_t hA = GATHER ? 0 : hstep;
    if constexpr (GATHER) { PG8_GOFF(vA0, vA1, 0); } else {
#pragma unroll
        for (int i = 0; i < 2; ++i) { vA0[i] = voffA[i]; vA1[i] = voffA[i]; vN0[i] = voffA[i]; vN1[i] = voffA[i]; } }
    S.a_ready(cur);
    PG8_STAGE(PG8_SB(0, 0), cB, voffB); PG8_STAGE(PG8_SB(0, 1), cB + hstepB, voffB); PG8_STAGE(PG8_SA(0, 0), cA, vA0); PG8_STAGE(PG8_SA(0, 1), cA + hA, vA1);
    if (wr == 1) PG8_BAR;
    PG8_WAIT_V(2); PG8_BAR;
    PG8_STAGE(PG8_SB(1, 0), cB + kstepB, voffB); PG8_STAGE(PG8_SA(1, 0), cA + kstep, vA0); PG8_STAGE(PG8_SB(1, 1), cB + hstepB + kstepB, voffB);
    PG8_WAIT_V(6); PG8_BAR;
    for (;;) {
        const bool has_next = S.next(ui + 1, nxt);
        const char* nA = GATHER ? cA : (has_next ? (const char*)g.A + (size_t)nxt.pm * tstep : cA); const char* nB = has_next ? (BKN ? (const char*)g.Bt + (size_t)(nxt.pb >> 3) * ((size_t)K * 4096) + (size_t)(nxt.pb & 7) * 512 : (const char*)g.Bt + (size_t)nxt.pb * tstep) : cB;
        if constexpr (GATHER) { if (has_next) { PG8_GOFF(vN0, vN1, ui + 1); } else {
#pragma unroll
            for (int i = 0; i < 2; ++i) { vN0[i] = vA0[i]; vN1[i] = vA1[i]; } } }
#pragma unroll 1
        for (int t = 0; t < nt; t += 2) {
            const bool last = (t == nt - 2);
            unsigned s0[2], s1[2];
#pragma unroll
            for (int i = 0; i < 2; ++i) { s0[i] = (GATHER && last) ? vN0[i] : vA0[i]; s1[i] = (GATHER && last) ? vN1[i] : vA1[i]; }
            const char* a1 = cA + (size_t)(t + 1) * kstep;
            const char* a2 = last ? nA : cA + (size_t)(t + 2) * kstep; const char* b2 = last ? nB : cB + (size_t)(t + 2) * kstepB;
            const char* a3 = a2 + kstep; const char* b3 = b2 + kstepB;
            if (last && has_next) S.a_ready(nxt);
            PG8_LDB(B0, 0, 0); PG8_LDB(B1, 0, 1); PG8_SCHED; PG8_LDA(At, 0, 0); PG8_STAGE(PG8_SA(1, 1), a1 + hA, vA1);
            PG8_WAIT_V(8); PG8_WAIT_L(0); PG8_BAR; PG8_SCHED; PG8_MMA(0, 0, At, B0); PG8_MMA(0, 1, At, B1); PG8_BAR; PG8_SCHED;
            PG8_LDA(At, 0, 1); PG8_STAGE(PG8_SB(0, 0), b2, voffB); PG8_STAGE(PG8_SB(0, 1), b2 + hstepB, voffB); PG8_STAGE(PG8_SA(0, 0), a2, s0);
            PG8_WAIT_V(8); PG8_WAIT_L(0); PG8_BAR; PG8_SCHED; PG8_MMA(1, 0, At, B0); PG8_MMA(1, 1, At, B1); PG8_BAR; PG8_SCHED;
            PG8_LDB(B0, 1, 0); PG8_LDB(B1, 1, 1); PG8_SCHED; PG8_LDA(At, 1, 0); PG8_STAGE(PG8_SA(0, 1), a2 + hA, s1);
            PG8_WAIT_V(8); PG8_WAIT_L(0); PG8_BAR; PG8_SCHED; PG8_MMA(0, 0, At, B0); PG8_MMA(0, 1, At, B1); PG8_BAR; PG8_SCHED;
            PG8_LDA(At, 1, 1); PG8_STAGE(PG8_SB(1, 0), b3, voffB); PG8_STAGE(PG8_SB(1, 1), b3 + hstepB, voffB); PG8_STAGE(PG8_SA(1, 0), a3, s0);
            PG8_WAIT_V(8); PG8_WAIT_L(0); PG8_BAR; PG8_SCHED; PG8_MMA(1, 0, At, B0); PG8_MMA(1, 1, At, B1); PG8_BAR; PG8_SCHED;
        }
        if constexpr (ALIGN_EPI) { if (wr == 0) PG8_BAR; }
        if constexpr (FP8) { __builtin_amdgcn_sched_barrier(0); asm volatile("s_nop 15\n\ts_nop 15" ::: "memory"); __builtin_amdgcn_sched_barrier(0); }
        { int ln_ = lane; asm volatile("" : "+v"(ln_)); E(acc, cur, wr, wc, ln_ & 15, ln_ >> 4); } S.done(cur);
        if (!has_next) break;
#pragma unroll
        for (int a = 0; a < 2; ++a)
#pragma unroll
            for (int b = 0; b < 2; ++b)
#pragma unroll
                for (int m = 0; m < 4; ++m)
#pragma unroll
                    for (int n = 0; n < 2; ++n) acc[a][b][m][n] = (f32x4){0.f, 0.f, 0.f, 0.f};
        cur = nxt; cA = nA; cB = nB; ++ui;
#pragma unroll
        for (int i = 0; i < 2; ++i) { vA0[i] = vN0[i]; vA1[i] = vN1[i]; }
        if constexpr (ALIGN_EPI) { if (wr == 1) PG8_BAR; }
    }
    PG8_WAIT_V(0);
    if constexpr (!ALIGN_EPI) { if (wr == 0) PG8_BAR; }
    PG8_BAR;
#undef PG8_GOFF
#undef PG8_Q_At
#undef PG8_Q_B0
#undef PG8_Q_B1
#undef PG8_LD8
#undef PG8_TR
#undef PG8_SA
#undef PG8_SB
#undef PG8_STAGE
#undef PG8_LDA
#undef PG8_LDB
#undef PG8_MMA
#undef PG8_WAIT_V
#undef PG8_WAIT_L
#undef PG8_BAR
#undef PG8_SCHED
}
}

#define XB_TMO      128
#define XB_XCNT(j)  (256  + 64 * (j))
#define XB_XSUB(j)  (1280 + 64 * (j))
#define XB_XGEN(j)  (2304 + 64 * (j))
#define XB_TOP      3328
#define XB_TOPGEN   3392
#define XCD_BAR_WORDS 3456
#define XB_SPIN_CAP (1u << 18)
__device__ __forceinline__ unsigned xb_ld(unsigned* p)              { return __hip_atomic_load(p, __ATOMIC_RELAXED, __HIP_MEMORY_SCOPE_AGENT); }
__device__ __forceinline__ unsigned xb_add(unsigned* p, unsigned v) { return __hip_atomic_fetch_add(p, v, __ATOMIC_RELAXED, __HIP_MEMORY_SCOPE_AGENT); }
__device__ __forceinline__ unsigned xb_xcc_id() { return (unsigned)__builtin_amdgcn_s_getreg((3 << 11) | 20) & 0xFu; }
#define XB_SPIN(cond, bar) do { unsigned _sp = 0; while (cond) { __builtin_amdgcn_s_sleep(1); \
    if ((++_sp & 255u) == 0u) { if (xb_ld(&(bar)[XB_TMO])) break; if (_sp > XB_SPIN_CAP) { atomicAdd(&(bar)[XB_TMO], 1u); break; } } } } while (0)
struct XcdBarrier { unsigned* bar; unsigned x; volatile LAS unsigned* st; };
__device__ __forceinline__ XcdBarrier xcd_barrier_post(unsigned* bar, volatile LAS unsigned* st) {
    XcdBarrier b; b.bar = bar; b.x = xb_xcc_id(); b.st = st;
    if (threadIdx.x == 0) (void)xb_add(&bar[XB_XCNT(b.x)], 1u);
    return b;
}
__device__ __forceinline__ void xcd_barrier_complete(unsigned* bar, unsigned x, unsigned& nloc, unsigned& nx) {
    const unsigned G = gridDim.x * gridDim.y * gridDim.z;
    unsigned sum, cnt, mine, sp = 0u;
    for (;;) {
        sum = 0u; cnt = 0u; mine = 0u;
#pragma unroll
        for (unsigned j = 0; j < 16; ++j) { const unsigned c = xb_ld(&bar[XB_XCNT(j)]); sum += c; cnt += (c > 0u) ? 1u : 0u; mine = (j == x) ? c : mine; }
        if (sum == G) break;
        __builtin_amdgcn_s_sleep(1);
        if ((++sp & 255u) == 0u) { if (xb_ld(&bar[XB_TMO])) break; if (sp > XB_SPIN_CAP) { atomicAdd(&bar[XB_TMO], 1u); break; } }
    }
    nloc = mine > 0u ? mine : 1u; nx = cnt > 0u ? cnt : 1u;
}
__device__ __forceinline__ void xcd_barrier(const XcdBarrier& b) {
    asm volatile("s_waitcnt vmcnt(0)" ::: "memory");
    __syncthreads();
    if (threadIdx.x == 0) {
        unsigned* bar = b.bar;
        __builtin_amdgcn_s_waitcnt(0);
        unsigned nloc = b.st[0], nx = b.st[1];
        if (nloc == 0u) { xcd_barrier_complete(bar, b.x, nloc, nx); b.st[0] = nloc; b.st[1] = nx; }
        const unsigned old = xb_add(&bar[XB_XSUB(b.x)], 1u);
        const unsigned gen = old / nloc;
        if (old + 1u == (gen + 1u) * nloc) {
            __builtin_amdgcn_fence(__ATOMIC_RELEASE, "agent");
            asm volatile("s_waitcnt vmcnt(0)" ::: "memory");
            const unsigned og = xb_add(&bar[XB_TOP], 1u);
            const unsigned tg = og / nx;
            if (og + 1u == (tg + 1u) * nx) xb_add(&bar[XB_TOPGEN], 1u);
            else XB_SPIN(xb_ld(&bar[XB_TOPGEN]) == tg, bar);
            __builtin_amdgcn_fence(__ATOMIC_ACQUIRE, "agent");
            xb_add(&bar[XB_XGEN(b.x)], 1u);
            asm volatile("s_waitcnt vmcnt(0)" ::: "memory");
        } else {
            XB_SPIN(xb_ld(&bar[XB_XGEN(b.x)]) == gen, bar);
            __builtin_amdgcn_fence(__ATOMIC_ACQUIRE, "agent");
            asm volatile("s_waitcnt vmcnt(0)" ::: "memory");
        }
    }
    __syncthreads();
}

constexpr int NWAVES = 8;
struct Frame {
    LAS unsigned char* lds;
    unsigned* ctl;
    int tid, lane, wave, vcu, G;
    const float *x, *mem, *norm1_g, *w_in, *q_norm_g, *k_norm_g, *conv_w, *mem_norm_g, *w_mem_kv, *mem_q_norm_g, *mem_k_norm_g, *out_norm_g, *w_out, *norm2_g,
                *w_rg, *b_rg, *w_re, *b_re, *w_gate, *w_up, *w_down;
    float* out; unsigned char* ws;
};

__device__ __forceinline__ void p0_transpose_item(const float* W, int N, int k0, int n0, const float* ks, bf16* dst, int pitch, LAS float* scr, int lane) {
#pragma unroll 8
    for (int i = 0; i < 32; ++i) { const int kk = 2 * i + (lane >> 5); scr[kk * 33 + (lane & 31)] = __builtin_nontemporal_load(W + (size_t)(k0 + kk) * N + n0 + (lane & 31)); }
    const int c = lane & 7;
    float g[8];
#pragma unroll
    for (int j = 0; j < 8; ++j) g[j] = ks ? ks[k0 + 8 * c + j] : 1.0f;
    LDS_WAIT(); asm volatile("" ::: "memory");
#pragma unroll
    for (int j = 0; j < 4; ++j) { const int n = (lane >> 3) + 8 * j; const LAS float* s = scr + (8 * c) * 33 + n;
        v4u o; o.x = pk2(s[0 * 33] * g[0], s[1 * 33] * g[1]); o.y = pk2(s[2 * 33] * g[2], s[3 * 33] * g[3]); o.z = pk2(s[4 * 33] * g[4], s[5 * 33] * g[5]); o.w = pk2(s[6 * 33] * g[6], s[7 * 33] * g[7]);
        *(GAS v4u*)(dst + (size_t)n * pitch + k0 + 8 * c) = o; }
    LDS_WAIT(); asm volatile("" ::: "memory");
}
__device__ __forceinline__ void rms_row_to_bf16(const float* xrow, const float* gain, bf16* orow, int lane) {
    const GAS f32x4* xr = (const GAS f32x4*)xrow + lane; const GAS f32x4* gr = (const GAS f32x4*)gain + lane;
    f32x4 v[8]; float s = 0.f;
#pragma unroll
    for (int j = 0; j < 8; ++j) { v[j] = __builtin_nontemporal_load(xr + 64 * j); s += (v[j].x * v[j].x + v[j].y * v[j].y) + (v[j].z * v[j].z + v[j].w * v[j].w); }
    const float rstd = 1.0f / sqrtf(wave_sum(s) * (1.f / D) + EPS);
    GAS v2u* o8 = (GAS v2u*)orow + lane;
#pragma unroll
    for (int j = 0; j < 8; ++j) { const f32x4 gg = gr[64 * j]; v2u o; o.x = pk2(v[j].x * rstd * gg.x, v[j].y * rstd * gg.y); o.y = pk2(v[j].z * rstd * gg.z, v[j].w * rstd * gg.w); o8[64 * j] = o; }
}
__device__ __forceinline__ void p0_transpose_item_q(const float* W, int N, int k0, int n0, const float* ks, float sc, unsigned char* dst, int pitch, LAS float* scr, int lane) {
#pragma unroll 8
    for (int i = 0; i < 64; ++i) { const int kk = 2 * i + (lane >> 5); scr[kk * 33 + (lane & 31)] = __builtin_nontemporal_load(W + (size_t)(k0 + kk) * N + n0 + (lane & 31)); }
    const int c = lane & 15;
    float g[8];
#pragma unroll
    for (int j = 0; j < 8; ++j) g[j] = ks ? ks[k0 + 8 * c + j] * sc : sc;
    LDS_WAIT(); asm volatile("" ::: "memory");
#pragma unroll
    for (int j = 0; j < 8; ++j) { const int n = (lane >> 4) + 4 * j; const LAS float* s = scr + (8 * c) * 33 + n;
        v2u o; o.x = pk_fp8x4(s[0 * 33] * g[0], s[1 * 33] * g[1], s[2 * 33] * g[2], s[3 * 33] * g[3]); o.y = pk_fp8x4(s[4 * 33] * g[4], s[5 * 33] * g[5], s[6 * 33] * g[6], s[7 * 33] * g[7]);
        __builtin_nontemporal_store(o, (GAS v2u*)(dst + (size_t)n * pitch + k0 + 8 * c)); }
    LDS_WAIT(); asm volatile("" ::: "memory");
}
__device__ __forceinline__ void p0_item_q64(const float* W, int N, int k0, int n0, const float* ks, float sc, unsigned char* dst, int pitch, LAS unsigned char* scr, int lane) {
    const GAS float* src = (const GAS float*)(W + (size_t)k0 * N + n0 + lane);
    float g0 = sc, g1 = sc;
    if (ks) { g0 = ks[k0 + lane] * sc; g1 = ks[k0 + 64 + lane] * sc; }
#pragma unroll
    for (int h = 0; h < 2; ++h) {
        float v[64];
#pragma unroll
        for (int i = 0; i < 64; ++i) v[i] = __builtin_nontemporal_load(src + (size_t)(64 * h + i) * N);
        const float gh = h ? g1 : g0;
#pragma unroll
        for (int q = 0; q < 4; ++q) { v4u o;
#pragma unroll
            for (int d = 0; d < 4; ++d) { const int i = 16 * q + 4 * d;
                const float s0 = __builtin_bit_cast(float, __builtin_amdgcn_readlane(__builtin_bit_cast(int, gh), i)), s1 = __builtin_bit_cast(float, __builtin_amdgcn_readlane(__builtin_bit_cast(int, gh), i + 1));
                const float s2 = __builtin_bit_cast(float, __builtin_amdgcn_readlane(__builtin_bit_cast(int, gh), i + 2)), s3 = __builtin_bit_cast(float, __builtin_amdgcn_readlane(__builtin_bit_cast(int, gh), i + 3));
                o[d] = pk_fp8x4(v[i] * s0, v[i + 1] * s1, v[i + 2] * s2, v[i + 3] * s3); }
            *(LAS v4u*)(scr + lane * 144 + (4 * h + q) * 16) = o; }
    }
    LDS_WAIT(); asm volatile("" ::: "memory");
#pragma unroll
    for (int i = 0; i < 8; ++i) { const int row = 8 * i + (lane >> 3), ch = lane & 7;
        const v4u w = *(const LAS v4u*)(scr + row * 144 + ch * 16);
        __builtin_nontemporal_store(w, (GAS v4u*)(dst + (size_t)row * pitch + k0 + ch * 16)); }
    LDS_WAIT(); asm volatile("" ::: "memory");
}
__device__ __forceinline__ void p0_prologue(Frame& F) {
    LAS float* scr = (LAS float*)(F.lds + F.wave * 16896);
    const int gw = F.vcu * NWAVES + F.wave, NGW = F.G * NWAVES;
    bf16* Win_t = (bf16*)(F.ws + WS_WIN); bf16* Wmkv_t = (bf16*)(F.ws + WS_WMKV); bf16* Wout_t = (bf16*)(F.ws + WS_WOUT);
    constexpr int I_IN = 32 * 160, I_MKV = 32 * 32, I_OUT = 32 * 64;
    constexpr int NITEMS = I_IN + I_MKV + I_OUT;
    for (int it = gw; it < NITEMS; it += NGW) {
        int r = it;
        if (r < I_IN) { const int kb = r / 160, nb = r % 160; p0_transpose_item(F.w_in, PROJ, 64 * kb, 32 * nb, nullptr, Win_t + (size_t)(32 * nb) * D, D, scr, F.lane); continue; } r -= I_IN;
        if (r < I_MKV) { const int kb = r / 32, nb = r % 32; p0_transpose_item(F.w_mem_kv, 1024, 64 * kb, 32 * nb, nullptr, Wmkv_t + (size_t)(32 * nb) * D, D, scr, F.lane); continue; } r -= I_MKV;
        { const int kb = r / 64, nb = r % 64; p0_transpose_item(F.w_out, D, 64 * kb, 32 * nb, nullptr, Wout_t + (size_t)(32 * nb) * D, D, scr, F.lane); }
    }
    { unsigned char* Wgu_q = (unsigned char*)(F.ws + WS_WGU); unsigned char* Wd_q = (unsigned char*)(F.ws + WS_WD); LAS unsigned char* scq = F.lds + F.wave * 16896;
      constexpr int IPE = 256 + 256 + 256;
#pragma unroll 1
      for (int it = gw; it < 64 * IPE; it += NGW) { const int e = it / IPE; int r = it - e * IPE;
          if (r < 512) { const int up = r >> 8, q = r & 255, kb = q >> 4, nb = q & 15, n0 = 64 * nb;
              const float* W = (up ? F.w_up : F.w_gate) + (size_t)e * D * DEXP; const int drow = 256 * (n0 >> 7) + 128 * up + (n0 & 127);
              p0_item_q64(W, DEXP, 128 * kb, n0, F.norm2_g, SC_WGU, Wgu_q + ((size_t)e * 2048 + drow) * D, D, scq, F.lane); }
          else { const int q = r - 512, kb = q >> 5, nb = q & 31;
              p0_item_q64(F.w_down + (size_t)e * DEXP * D, D, 128 * kb, 64 * nb, nullptr, SC_WD, Wd_q + ((size_t)e * 2048 + 64 * nb) * DEXP, DEXP, scq, F.lane); } } }
    { bf16* WT = (bf16*)(F.ws + WS_WR); const int gt = (F.vcu * NWAVES + F.wave) * 64 + F.lane, NT = F.G * NWAVES * 64;
      for (int i = gt; i < 96 * 2048; i += NT) { const int n = i >> 11, k = i & 2047;
          float w = n < 64 ? F.w_re[k * 64 + n] : (n < 72 ? F.w_rg[k * 8 + (n - 64)] : 0.f); w *= F.norm2_g[k];
          const unsigned h = f2bf(w); const float hf = __builtin_bit_cast(float, h << 16);
          WT[i] = (bf16)h; WT[96 * 2048 + i] = (bf16)f2bf(w - hf); } }
    bf16* H = (bf16*)(F.ws + WS_H);
    for (int m = gw; m < T + 512; m += NGW) {
        if (m < T) rms_row_to_bf16(F.x + (size_t)m * D, F.norm1_g, H + (size_t)m * D, F.lane);
        else rms_row_to_bf16(F.mem + (size_t)(m - T) * D, F.mem_norm_g, H + (size_t)m * D, F.lane);
    }
}

namespace att {
constexpr int LDS_K = 0, LDS_V = 65536, LDS_STG = 131072, LDS_LI = LDS_STG + 16384, LDS_GT = LDS_LI + 8 * 256;
constexpr float CS = 0.08838834764831845f * LOG2E;
#define KSWZ(row, colB) ((row) * 256 + ((colB) ^ (((row) & 7) << 4)))
__device__ __forceinline__ int crow(int r, int hi) { return (r & 3) + 8 * (r >> 2) + 4 * hi; }
__device__ __forceinline__ int v_rd_base(int lane) { return ((lane & 3) << 3) | (((lane >> 2) & 3) << 6) | (((lane >> 4) & 1) << 5) | (((lane >> 5) & 1) << 8); }
template <int OFF> __device__ __forceinline__ s16x4 tr_read(int vb) { s16x4 r; asm volatile("ds_read_b64_tr_b16 %0, %1 offset:%2" : "=&v"(r) : "v"(vb), "i"(OFF) : "memory"); return r; }

struct RowMap { const char* base; long stride; int win0; bool wrap; };
__device__ __forceinline__ const char* rowptr(const RowMap& m, int p) { int sp = m.wrap ? m.win0 + ((p - m.win0) & 255) : p; sp = sp < 0 ? 0 : sp; return m.base + (long)sp * m.stride; }

__device__ __forceinline__ void dma_k(LAS unsigned char* Kl, int p0, int nrows, const RowMap& m, int wave, int lane) {
    asm volatile("" : "+v"(lane));
#pragma unroll 1
    for (int i = 0; i < nrows / 32; ++i) {
        const int prow0 = p0 + 32 * i + 4 * wave, prow = prow0 + (lane >> 4);
        const char* src = rowptr(m, prow) + (((lane & 15) ^ (prow & 7)) << 4);
        __builtin_amdgcn_global_load_lds((const unsigned*)src, (LAS unsigned*)(Kl + prow0 * 256), 16, 0, 0);
    }
}
__device__ __forceinline__ void dma_v(LAS unsigned char* Vl, int p0, int nrows, const RowMap& m, int wave, int lane) {
    asm volatile("" : "+v"(lane));
#pragma unroll 1
    for (int i = 0; i < nrows / 32; ++i) {
        const int ii = wave + 8 * i, g = (p0 >> 4) + (ii >> 2), q = ii & 3;
        const int kk = ((q >> 1) << 3) + ((lane & 31) >> 2), k = (kk & ~0xC) | ((kk & 4) << 1) | ((kk & 8) >> 1);
        const int c = 32 * (2 * (q & 1) + (lane >> 5)) + 8 * (lane & 3);
        const char* src = rowptr(m, 16 * g + k) + c * 2;
        __builtin_amdgcn_global_load_lds((const unsigned*)src, (LAS unsigned*)(Vl + g * 4096 + q * 1024), 16, 0, 0);
    }
}
__device__ __forceinline__ void dma_v2(LAS unsigned char* Vl, int p0, int nrows, const RowMap& m, int wave, int lane) {
    asm volatile("" : "+v"(lane));
#pragma unroll 1
    for (int i = 0; i < nrows / 32; ++i) {
        const int prow0 = p0 + 32 * i + 4 * wave, prow = prow0 + (lane >> 4);
        const char* src = rowptr(m, prow) + (((lane & 15) ^ ((prow & 7) << 1)) << 4);
        __builtin_amdgcn_global_load_lds((const unsigned*)src, (LAS unsigned*)(Vl + prow0 * 256), 16, 0, 0);
    }
}
__device__ __forceinline__ void load_q16(v4u (&raw)[4], const char* qrow, int kg) {
#pragma unroll
    for (int s = 0; s < 4; ++s) raw[s] = *(const GAS v4u*)(qrow + (32 * s + 8 * kg) * 2);
}
__device__ __forceinline__ void norm_q16(const v4u (&raw)[4], bf16x8 (&qr)[4], const LAS float* gt, int kg) {
    float ss = 0.f;
#pragma unroll
    for (int s = 0; s < 4; ++s)
#pragma unroll
        for (int j = 0; j < 4; ++j) { const float a = bflo(raw[s][j]), b = bfhi(raw[s][j]); ss += a * a + b * b; }
    ss += __shfl_xor(ss, 16); ss += __shfl_xor(ss, 32);
    const float rstd = 1.0f / sqrtf(ss * (1.f / HD) + EPS);
#pragma unroll
    for (int s = 0; s < 4; ++s) { const LAS f32x4* gp = (const LAS f32x4*)(gt + 32 * s + 8 * kg); const f32x4 g0 = gp[0], g1 = gp[1]; v4u o;
        o.x = cvtpk(bflo(raw[s].x) * rstd * g0.x, bfhi(raw[s].x) * rstd * g0.y); o.y = cvtpk(bflo(raw[s].y) * rstd * g0.z, bfhi(raw[s].y) * rstd * g0.w);
        o.z = cvtpk(bflo(raw[s].z) * rstd * g1.x, bfhi(raw[s].z) * rstd * g1.y); o.w = cvtpk(bflo(raw[s].w) * rstd * g1.z, bfhi(raw[s].w) * rstd * g1.w);
        qr[s] = __builtin_bit_cast(bf16x8, o); }
}
__device__ __forceinline__ void norm_k(LAS unsigned char* Kl, int p0, int nrows, const LAS float* gt, int tid) {
    asm volatile("" : "+v"(tid));
#pragma unroll 1
    for (int idx = tid; idx < nrows * 4; idx += 512) {
        const int row = p0 + (idx >> 2), qd = idx & 3;
        v4u w[4]; float ss = 0.f;
#pragma unroll
        for (int i = 0; i < 4; ++i) { w[i] = *(const LAS v4u*)(Kl + KSWZ(row, (4 * qd + i) * 16));
#pragma unroll
            for (int j = 0; j < 4; ++j) { const float a = bflo(w[i][j]), b = bfhi(w[i][j]); ss += a * a + b * b; } }
        ss += __shfl_xor(ss, 1); ss += __shfl_xor(ss, 2);
        const float rstd = 1.0f / sqrtf(ss * (1.f / HD) + EPS);
#pragma unroll
        for (int i = 0; i < 4; ++i) { const LAS f32x4* gp = (const LAS f32x4*)(gt + (4 * qd + i) * 8); const f32x4 g0 = gp[0], g1 = gp[1]; v4u o;
            o.x = cvtpk(bflo(w[i].x) * rstd * g0.x, bfhi(w[i].x) * rstd * g0.y); o.y = cvtpk(bflo(w[i].y) * rstd * g0.z, bfhi(w[i].y) * rstd * g0.w);
            o.z = cvtpk(bflo(w[i].z) * rstd * g1.x, bfhi(w[i].z) * rstd * g1.y); o.w = cvtpk(bflo(w[i].w) * rstd * g1.z, bfhi(w[i].w) * rstd * g1.w);
            *(LAS v4u*)(Kl + KSWZ(row, (4 * qd + i) * 16)) = o; }
    }
}
__device__ __forceinline__ float xsum32(float v) { unsigned a = __builtin_bit_cast(unsigned, v), b = a; asm volatile("s_nop 1\n\tv_permlane32_swap_b32 %0, %1" : "+v"(a), "+v"(b)); return __builtin_bit_cast(float, a) + __builtin_bit_cast(float, b); }
__device__ __forceinline__ void load_q(v4u (&raw)[8], const char* qrow, int hi) {
#pragma unroll
    for (int d0 = 0; d0 < 8; ++d0) raw[d0] = *(const GAS v4u*)(qrow + (d0 * 16 + hi * 8) * 2);
}
__device__ __forceinline__ void norm_q(const v4u (&raw)[8], bf16x8 (&qr)[8], const LAS float* gt, int hi) {
    float ss = 0.f;
#pragma unroll
    for (int d0 = 0; d0 < 8; ++d0)
#pragma unroll
        for (int j = 0; j < 4; ++j) { const float a = bflo(raw[d0][j]), b = bfhi(raw[d0][j]); ss += a * a + b * b; }
    ss = xsum32(ss);
    const float rstd = 1.0f / sqrtf(ss * (1.f / HD) + EPS);
#pragma unroll
    for (int d0 = 0; d0 < 8; ++d0) { const LAS f32x4* gp = (const LAS f32x4*)(gt + d0 * 16 + hi * 8); const f32x4 g0 = gp[0], g1 = gp[1]; v4u o;
        o.x = cvtpk(bflo(raw[d0].x) * rstd * g0.x, bfhi(raw[d0].x) * rstd * g0.y); o.y = cvtpk(bflo(raw[d0].y) * rstd * g0.z, bfhi(raw[d0].y) * rstd * g0.w);
        o.z = cvtpk(bflo(raw[d0].z) * rstd * g1.x, bfhi(raw[d0].z) * rstd * g1.y); o.w = cvtpk(bflo(raw[d0].w) * rstd * g1.z, bfhi(raw[d0].w) * rstd * g1.w);
        qr[d0] = __builtin_bit_cast(bf16x8, o); }
}
__device__ __forceinline__ f32x16 qk_tile(const LAS unsigned char* Kl, int pb, const bf16x8 (&qr)[8], int r32, int hi) {
    f32x16 p = {};
#pragma unroll
    for (int d0 = 0; d0 < 8; ++d0) { const bf16x8 kf = *(const LAS bf16x8*)(Kl + KSWZ(pb + r32, (d0 * 16 + hi * 8) * 2));
        p = __builtin_amdgcn_mfma_f32_32x32x16_bf16(kf, qr[d0], p, 0, 0, 0); }
    return p;
}
#define PK4(P, BASE, OUT) do { unsigned a0 = cvtpk(P[BASE + 0], P[BASE + 1]), a1 = cvtpk(P[BASE + 2], P[BASE + 3]);   \
    unsigned b0 = cvtpk(P[BASE + 4], P[BASE + 5]), b1 = cvtpk(P[BASE + 6], P[BASE + 7]);                              \
    auto r0 = __builtin_amdgcn_permlane32_swap(a0, b0, false, false); auto r1 = __builtin_amdgcn_permlane32_swap(a1, b1, false, false); \
    v4u w_ = {r0[0], r1[0], r0[1], r1[1]}; OUT = __builtin_bit_cast(bf16x8, w_); } while (0)
template <int OFF> __device__ __forceinline__ void pv_step(f32x16& o, int vb, bf16x8 pa) {
    const s16x4 l = tr_read<OFF>(vb), h = tr_read<OFF + 2048>(vb);
    asm volatile("s_waitcnt lgkmcnt(0)" ::: "memory"); __builtin_amdgcn_sched_barrier(0);
    o = __builtin_amdgcn_mfma_f32_32x32x16_bf16(pa, (bf16x8){l[0], l[1], l[2], l[3], h[0], h[1], h[2], h[3]}, o, 0, 0, 0);
}
__device__ __forceinline__ void store_block(const f32x16& o, const LAS float* il, LAS unsigned short* stg, char* dst0, long rstride, int lane) {
    asm volatile("" : "+v"(lane));
    const int r32 = lane & 31, hi = lane >> 5;
#pragma unroll
    for (int r = 0; r < 16; ++r) { const int row = crow(r, hi); stg[row * 32 + r32] = (unsigned short)f2bf(o[r] * il[row]); }
    LDS_WAIT(); asm volatile("" ::: "memory");
#pragma unroll
    for (int p = 0; p < 2; ++p) { const int row = 16 * p + (lane >> 2), ch = lane & 3;
        const v4u w = *(const LAS v4u*)((const LAS unsigned char*)stg + row * 64 + ch * 16);
        *(GAS v4u*)(dst0 + (long)row * rstride + ch * 16) = w; }
    LDS_WAIT(); asm volatile("" ::: "memory");
}
}

#define RAW_BAR() do { asm volatile("s_waitcnt lgkmcnt(0)" ::: "memory"); __builtin_amdgcn_s_barrier(); asm volatile("" ::: "memory"); } while (0)
__device__ __forceinline__ void p2_attention(Frame& F) {
    using namespace att;
    LAS unsigned char* Kl = F.lds + LDS_K; LAS unsigned char* Vl = F.lds + LDS_V;
    LAS unsigned short* stg = (LAS unsigned short*)(F.lds + LDS_STG + F.wave * 2048);
    LAS float* li = (LAS float*)(F.lds + LDS_LI + F.wave * 256);
    LAS float* gtab = (LAS float*)(F.lds + LDS_GT);
    LAS float* rk = (LAS float*)(F.lds + LDS_GT + 2048);
    volatile LAS int* QN = (volatile LAS int*)(F.lds + LDS_GT + 2048 + 1024);
    const int tid = F.tid, wave = F.wave;
    if (blockIdx.x < 8) {
        pg8::Gemm g{(const bf16*)(F.ws + WS_H), (const bf16*)(F.ws + WS_WIN), D, nullptr}; pg8::P1Order S{F.G, (int)blockIdx.x, 2560, 2568};
        pg8::EpiProj E{(bf16*)(F.ws + WS_R1), (bf16*)(F.ws + WS_MEMKV)};
        pg8::gemm_phase<pg8::EpiProj, pg8::P1Order>(F.lds, g, S, E);
        VM_WAIT(); __syncthreads();
        if (tid == 0) { __builtin_amdgcn_fence(__ATOMIC_RELEASE, "agent"); asm volatile("s_waitcnt vmcnt(0)" ::: "memory"); __hip_atomic_fetch_add(F.ctl + CW_KVREADY, 1u, RLX_AGENT); }
    }
    if (tid < 128) { gtab[tid] = F.q_norm_g[tid] * F.k_norm_g[tid]; gtab[128 + tid] = F.mem_q_norm_g[tid] * F.mem_k_norm_g[tid]; gtab[256 + tid] = F.mem_q_norm_g[tid]; gtab[384 + tid] = F.mem_k_norm_g[tid]; }
    if (tid == 0) QN[0] = 1 << 30;
    __syncthreads();
    float MD, MM;
    { float a = 0.f, c = 0.f;
#pragma unroll 1
      for (int i = 0; i < 128; ++i) { a = fmaxf(a, fabsf(gtab[i])); c = fmaxf(c, fabsf(gtab[128 + i])); }
      MD = a * (128.0f * 1.03f) * CS; MM = c * (128.0f * 1.03f) * CS; }
    const char* proj = (const char*)(F.ws + WS_R1);

    {
    const int j = wave & 3, dh = wave >> 2, w0 = 32 * j + 16 * dh;
    constexpr int NCHUNK = 6144 / 4;
    v4u qraw[4];
#define DECODE(u, br, b, h, r, nb, dil) const int br = (u) >> 11, _rem = (u) & 2047, b = _rem >> 10, h = (_rem >> 7) & 7, _w = _rem & 127, dil = 1 << (2 * br), _nps = 128 >> (2 * br), r = _w / _nps, nb = _w % _nps
    int u = 4 * F.vcu;
    bool have = F.vcu < NCHUNK;
    bool full = true;
    if (have) {
        DECODE(u, br, b, h, r, nb, dil);
        const long rs = (long)dil * PROJ * 2; const char* tb = proj + (size_t)(b * SEQ + r) * (PROJ * 2);
        RowMap mk{tb + (COL_K + h * HD) * 2, rs, 128 * nb - 128, true};
        dma_k(Kl, 0, 256, mk, wave, F.lane);
        load_q16(qraw, tb + (long)(128 * nb + w0 + (F.lane & 15)) * rs + (COL_Q + h * HD) * 2, F.lane >> 4);
    }
    while (have) {
        DECODE(u, br, b, h, r, nb, dil);
        int lane = F.lane; asm volatile("" : "+v"(lane));
        const int q16 = lane & 15, kg = lane >> 4;
        const int off = 128 * ((nb + 1) & 1);
        const long rs_ = (long)dil * PROJ * 2; const char* tb_ = proj + (size_t)(b * SEQ + r) * (PROJ * 2);
        asm volatile("s_waitcnt vmcnt(0)" ::: "memory"); RAW_BAR();
        { RowMap mv{tb_ + (COL_V + h * HD) * 2, rs_, 128 * nb - 128, true};
          if (full) dma_v2(Vl, 0, 256, mv, wave, lane); else dma_v2(Vl, 128 * (nb & 1), 128, mv, wave, lane); }
        if ((u & 3) == 0 && tid == 0) QN[0] = F.G + (int)__hip_atomic_fetch_add(F.ctl + CW_ATTQ, 1u, RLX_AGENT);
        { const int p0 = full ? 0 : 128 * (nb & 1), n4 = full ? 1024 : 512;
#pragma unroll 1
          for (int idx = tid; idx < n4; idx += 512) { const int row = p0 + (idx >> 2), qd = idx & 3; float ss = 0.f;
#pragma unroll
              for (int i = 0; i < 4; ++i) { const v4u w = *(const LAS v4u*)(Kl + KSWZ(row, (4 * qd + i) * 16));
#pragma unroll
                  for (int jj = 0; jj < 4; ++jj) { const float a = bflo(w[jj]), c = bfhi(w[jj]); ss += a * a + c * c; } }
              ss += __shfl_xor(ss, 1); ss += __shfl_xor(ss, 2);
              if (qd == 0) rk[row] = 1.0f / sqrtf(ss * (1.f / HD) + EPS); } }
        bf16x8 qr[4];
        norm_q16(qraw, qr, gtab, kg);
        f32x4 s[9];
#pragma unroll
        for (int t = 0; t < 9; ++t) { const int pb = (w0 + 16 * t + off) & 255; f32x4 a = {0.f, 0.f, 0.f, 0.f};
#pragma unroll
            for (int d = 0; d < 4; ++d) { const bf16x8 kf = *(const LAS bf16x8*)(Kl + KSWZ(pb + q16, 64 * d + 16 * kg));
                a = __builtin_amdgcn_mfma_f32_16x16x32_bf16(kf, qr[d], a, 0, 0, 0); }
            s[t] = a; }
        RAW_BAR();
        int un = u + 1; bool has_next = true;
        if ((un & 3) == 0) { const int nc = QN[0]; has_next = nc < NCHUNK; un = 4 * nc; }
        bool n_full = false;
        if (has_next) {
            DECODE(un, br2, b2, h2, r2, nb2, dil2);
            n_full = (un != u + 1) || (nb2 == 0);
            const long rs = (long)dil2 * PROJ * 2; const char* tb = proj + (size_t)(b2 * SEQ + r2) * (PROJ * 2);
            RowMap nmk{tb + (COL_K + h2 * HD) * 2, rs, 128 * nb2 - 128, true};
            if (n_full) dma_k(Kl, 0, 256, nmk, wave, lane); else dma_k(Kl, 128 * (nb2 & 1), 128, nmk, wave, lane);
            load_q16(qraw, tb + (long)(128 * nb2 + w0 + q16) * rs + (COL_Q + h2 * HD) * 2, kg);
        }
        const float bias2 = __builtin_amdgcn_exp2f(-(float)(h + 1)) * (float)dil * LOG2E;
        const float rowoff = bias2 * (float)(4 * kg - q16 - 128) - MD;
        float l = 0.f;
#pragma unroll
        for (int t = 0; t < 9; ++t) {
            const int pb = (w0 + 16 * t + off) & 255;
            const f32x4 rkv = *(const LAS f32x4*)(rk + pb + 4 * kg);
            const bool dead = (nb == 0) && (w0 + 16 * t < 128);
#pragma unroll
            for (int r_ = 0; r_ < 4; ++r_) {
                float v = fmaf(s[t][r_] * rkv[r_], CS, fmaf(bias2, (float)(16 * t + r_), rowoff));
                if (t == 0) v = (4 * kg + r_ >= q16) ? v : -1.0e30f;
                if (t == 8) v = (4 * kg + r_ <= q16) ? v : -1.0e30f;
                v = dead ? 0.f : __builtin_amdgcn_exp2f(v); s[t][r_] = v; l += v; }
        }
        l += __shfl_xor(l, 16); l += __shfl_xor(l, 32);
        bf16x8 pa[5];
#pragma unroll
        for (int sp = 0; sp < 5; ++sp) { v4u w; w.x = cvtpk(s[2 * sp][0], s[2 * sp][1]); w.y = cvtpk(s[2 * sp][2], s[2 * sp][3]);
            if (sp < 4) { w.z = cvtpk(s[2 * sp + 1][0], s[2 * sp + 1][1]); w.w = cvtpk(s[2 * sp + 1][2], s[2 * sp + 1][3]); } else { w.z = 0u; w.w = 0u; }
            pa[sp] = __builtin_bit_cast(bf16x8, w); }
        if (has_next) asm volatile("s_waitcnt vmcnt(8)" ::: "memory"); else asm volatile("s_waitcnt vmcnt(0)" ::: "memory");
        RAW_BAR();
        f32x4 o[8];
#pragma unroll
        for (int db = 0; db < 8; ++db) o[db] = (f32x4){0.f, 0.f, 0.f, 0.f};
        { const int qq = q16 >> 2, pp = q16 & 3;
#pragma unroll
          for (int sp = 0; sp < 5; ++sp) {
              const int ra = (w0 + 32 * sp + off + 4 * kg + qq) & 255, rb = (w0 + 32 * sp + 16 + off + 4 * kg + qq) & 255;
              const int va = (int)(uintptr_t)Vl + ra * 256 + 8 * pp, vb = (int)(uintptr_t)Vl + rb * 256 + 8 * pp, xa = (ra & 7) << 5, xb = (rb & 7) << 5;
#pragma unroll
              for (int dq = 0; dq < 2; ++dq) {
                  s16x4 la[4], lb[4];
#pragma unroll
                  for (int i = 0; i < 4; ++i) { const int db = 4 * dq + i;
                      asm volatile("ds_read_b64_tr_b16 %0, %1" : "=&v"(la[i]) : "v"(va + ((32 * db) ^ xa)) : "memory");
                      asm volatile("ds_read_b64_tr_b16 %0, %1" : "=&v"(lb[i]) : "v"(vb + ((32 * db) ^ xb)) : "memory"); }
                  asm volatile("s_waitcnt lgkmcnt(0)" ::: "memory"); __builtin_amdgcn_sched_barrier(0);
#pragma unroll
                  for (int i = 0; i < 4; ++i) { const int db = 4 * dq + i;
                      o[db] = __builtin_amdgcn_mfma_f32_16x16x32_bf16(pa[sp], (bf16x8){la[i][0], la[i][1], la[i][2], la[i][3], lb[i][0], lb[i][1], lb[i][2], lb[i][3]}, o[db], 0, 0, 0); }
              } } }
        const float il = 1.0f / l;
        if (kg == 0) li[q16] = il;
        LDS_WAIT(); asm volatile("" ::: "memory");
        const f32x4 ilr = *(const LAS f32x4*)(li + 4 * kg);
        const int tok0 = b * SEQ + r + dil * (128 * nb + w0);
        char* dst = (char*)(F.ws + WS_OPART) + ((size_t)br * T + tok0) * (ATTN_W * 2) + (h * HD) * 2;
#pragma unroll
        for (int hf = 0; hf < 2; ++hf) {
#pragma unroll
            for (int i = 0; i < 4; ++i)
#pragma unroll
                for (int r_ = 0; r_ < 4; ++r_) stg[(4 * kg + r_) * 64 + 16 * i + q16] = (unsigned short)f2bf(o[4 * hf + i][r_] * ilr[r_]);
            LDS_WAIT(); asm volatile("" ::: "memory");
#pragma unroll
            for (int p = 0; p < 2; ++p) { const int row = lane >> 2, ch = (lane & 3) + 4 * p;
                const v4u w = *(const LAS v4u*)((const LAS unsigned char*)stg + row * 128 + ch * 16);
                *(GAS v4u*)(dst + (long)row * ((long)dil * ATTN_W * 2) + hf * 128 + ch * 16) = w; }
            LDS_WAIT(); asm volatile("" ::: "memory");
        }
        if (kg == 0) ((float*)(F.ws + WS_LSE))[((size_t)br * T + tok0 + dil * q16) * 8 + h] = MD + __builtin_amdgcn_logf(l);
        have = has_next; u = un; full = n_full;
    }
#undef DECODE
    }

    VM_WAIT(); __syncthreads();
    if (wave == 0) { unsigned sp = 0;
        while (__builtin_amdgcn_readfirstlane(__hip_atomic_load(F.ctl + CW_KVREADY, RLX_AGENT)) < 8u) { __builtin_amdgcn_s_sleep(2); if (++sp > (1u << 22)) { if (F.lane == 0) __hip_atomic_store(F.ctl + CW_TMO, 1u, RLX_AGENT); break; } }
        __builtin_amdgcn_fence(__ATOMIC_ACQUIRE, "agent"); asm volatile("s_waitcnt vmcnt(0)" ::: "memory"); }
    __syncthreads();
    for (int it = F.vcu; it < 256; it += F.G) {
        const int combo = it >> 5, part = it & 31, b = combo >> 2, hm = combo & 3;
        const char* mkv = (const char*)(F.ws + WS_MEMKV) + (size_t)(b * NMEM) * 2048 + hm * 256;
        RowMap mk{mkv, 2048, 0, false}, mv{mkv + 1024, 2048, 0, false};
        __syncthreads();
        dma_k(Kl, 0, 256, mk, wave, F.lane); dma_v(Vl, 0, 256, mv, wave, F.lane);
        VM_WAIT(); __syncthreads();
        norm_k(Kl, 0, 256, gtab + 384, tid);
        __syncthreads();
        for (int qb = 0; qb < 2; ++qb) {
            int lane = F.lane; asm volatile("" : "+v"(lane));
            const int r32 = lane & 31, hi = lane >> 5, vbase = (int)(uintptr_t)Vl + v_rd_base(lane);
            const int tok = b * SEQ + part * 512 + qb * 256 + wave * 32 + r32;
            v4u raw[8]; bf16x8 qr[8];
            load_q(raw, proj + (size_t)tok * (PROJ * 2) + (COL_MQ + hm * HD) * 2, hi);
            norm_q(raw, qr, gtab + 256, hi);
            const float mc = -MM; float l = 0.f;
            f32x16 o[4] = {};
#pragma unroll 1
            for (int hk = 0; hk < 2; ++hk) {
                bf16x8 pa[8];
#pragma unroll
                for (int kt = 0; kt < 4; ++kt) { f32x16 s = qk_tile(Kl, 128 * hk + 32 * kt, qr, r32, hi);
#pragma unroll
                    for (int r = 0; r < 16; ++r) { s[r] = __builtin_amdgcn_exp2f(fmaf(s[r], CS, mc)); l += s[r]; }
                    PK4(s, 0, pa[2 * kt]); PK4(s, 8, pa[2 * kt + 1]); }
#pragma unroll
                for (int f = 0; f < 8; ++f) { const int vb = vbase + (8 * hk + f) * 4096;
                    pv_step<0>(o[0], vb, pa[f]); pv_step<512>(o[1], vb, pa[f]); pv_step<1024>(o[2], vb, pa[f]); pv_step<1536>(o[3], vb, pa[f]); }
            }
            l = xsum32(l);
            if (hi == 0) li[r32] = 1.0f / l;
            LDS_WAIT(); asm volatile("" ::: "memory");
            char* dst = (char*)(F.ws + WS_MEMO) + (size_t)(tok - r32) * (MEM_W * 2) + hm * 256;
#pragma unroll
            for (int d0 = 0; d0 < 4; ++d0) store_block(o[d0], li, stg, dst + d0 * 64, MEM_W * 2, lane);
        }
    }
}

__device__ __forceinline__ void unpack8(const v4u w, float (&f)[8]) { f[0] = bflo(w.x); f[1] = bfhi(w.x); f[2] = bflo(w.y); f[3] = bfhi(w.y); f[4] = bflo(w.z); f[5] = bfhi(w.z); f[6] = bflo(w.w); f[7] = bfhi(w.w); }
__device__ __forceinline__ void p3_combine(Frame& F) {
    const int gw = F.vcu * NWAVES + F.wave, NGW = F.G * NWAVES, lane = F.lane;
    const bf16* proj = (const bf16*)(F.ws + WS_R1); const bf16* opart = (const bf16*)(F.ws + WS_OPART); const float* lse = (const float*)(F.ws + WS_LSE);
    const bf16* memo = (const bf16*)(F.ws + WS_MEMO); bf16* Y = (bf16*)(F.ws + WS_Y);
    for (int t = gw; t < T; t += NGW) {
        float a[16]; float ssa = 0.f;
#pragma unroll
        for (int cc = 0; cc < 2; ++cc) { const int head = 4 * cc + (lane >> 4);
            const float l0 = lse[((size_t)0 * T + t) * 8 + head], l1 = lse[((size_t)1 * T + t) * 8 + head], l2 = lse[((size_t)2 * T + t) * 8 + head];
            const float mx = fmaxf(l0, fmaxf(l1, l2)); float w0 = __builtin_amdgcn_exp2f(l0 - mx), w1 = __builtin_amdgcn_exp2f(l1 - mx), w2 = __builtin_amdgcn_exp2f(l2 - mx);
            const float inv = 1.0f / (w0 + w1 + w2); w0 *= inv; w1 *= inv; w2 *= inv;
            float f0[8], f1[8], f2[8];
            unpack8(__builtin_nontemporal_load((const GAS v4u*)(opart + ((size_t)0 * T + t) * ATTN_W + cc * 512 + 8 * lane)), f0);
            unpack8(__builtin_nontemporal_load((const GAS v4u*)(opart + ((size_t)1 * T + t) * ATTN_W + cc * 512 + 8 * lane)), f1);
            unpack8(__builtin_nontemporal_load((const GAS v4u*)(opart + ((size_t)2 * T + t) * ATTN_W + cc * 512 + 8 * lane)), f2);
#pragma unroll
            for (int jj = 0; jj < 8; ++jj) { const float v = w0 * f0[jj] + w1 * f1[jj] + w2 * f2[jj]; a[8 * cc + jj] = v; ssa += v * v; } }
        float co[8]; float ssc = 0.f;
        { const int s = t & (SEQ - 1); float bg[8], c0[8], uu0[8], c1[8], uu1[8], c2[8], uu2[8];
          const bf16* p0 = proj + (size_t)t * PROJ + 8 * lane;
          unpack8(*(const GAS v4u*)(p0 + COL_B), bg); unpack8(*(const GAS v4u*)(p0 + COL_C), c0); unpack8(*(const GAS v4u*)(p0 + COL_U), uu0);
          if (s >= 1) { unpack8(*(const GAS v4u*)(p0 - PROJ + COL_C), c1); unpack8(*(const GAS v4u*)(p0 - PROJ + COL_U), uu1); }
          if (s >= 2) { unpack8(*(const GAS v4u*)(p0 - 2 * PROJ + COL_C), c2); unpack8(*(const GAS v4u*)(p0 - 2 * PROJ + COL_U), uu2); }
#pragma unroll
          for (int jj = 0; jj < 8; ++jj) { const int c = 8 * lane + jj;
              const float z0 = c0[jj] * uu0[jj], z1 = (s >= 1) ? c1[jj] * uu1[jj] : 0.f, z2 = (s >= 2) ? c2[jj] * uu2[jj] : 0.f;
              const float v = bg[jj] * (F.conv_w[c] * z2 + F.conv_w[CONV_W + c] * z1 + F.conv_w[2 * CONV_W + c] * z0); co[jj] = v; ssc += v * v; } }
        float mo[8]; float ssm = 0.f;
        unpack8(__builtin_nontemporal_load((const GAS v4u*)(memo + (size_t)t * MEM_W + 8 * lane)), mo);
#pragma unroll
        for (int jj = 0; jj < 8; ++jj) ssm += mo[jj] * mo[jj];
#pragma unroll
        for (int o = 1; o < 64; o <<= 1) { ssa += __shfl_xor(ssa, o); ssc += __shfl_xor(ssc, o); ssm += __shfl_xor(ssm, o); }
        const float ra = 1.0f / sqrtf(ssa * (1.f / ATTN_W) + EPS), rc = 1.0f / sqrtf(ssc * (1.f / CONV_W) + EPS), rm = 1.0f / sqrtf(ssm * (1.f / MEM_W) + EPS);
        bf16* yr = Y + (size_t)t * D;
#pragma unroll
        for (int cc = 0; cc < 2; ++cc) { const float* g = F.out_norm_g + cc * 512 + 8 * lane; v4u w;
            w.x = pk2(a[8 * cc + 0] * ra * g[0], a[8 * cc + 1] * ra * g[1]); w.y = pk2(a[8 * cc + 2] * ra * g[2], a[8 * cc + 3] * ra * g[3]);
            w.z = pk2(a[8 * cc + 4] * ra * g[4], a[8 * cc + 5] * ra * g[5]); w.w = pk2(a[8 * cc + 6] * ra * g[6], a[8 * cc + 7] * ra * g[7]);
            *(GAS v4u*)(yr + cc * 512 + 8 * lane) = w; }
        { const float* g = F.out_norm_g + ATTN_W + 8 * lane; v4u w;
          w.x = pk2(co[0] * rc * g[0], co[1] * rc * g[1]); w.y = pk2(co[2] * rc * g[2], co[3] * rc * g[3]); w.z = pk2(co[4] * rc * g[4], co[5] * rc * g[5]); w.w = pk2(co[6] * rc * g[6], co[7] * rc * g[7]);
          *(GAS v4u*)(yr + ATTN_W + 8 * lane) = w; }
        { const float* g = F.out_norm_g + ATTN_W + CONV_W + 8 * lane; v4u w;
          w.x = pk2(mo[0] * rm * g[0], mo[1] * rm * g[1]); w.y = pk2(mo[2] * rm * g[2], mo[3] * rm * g[3]); w.z = pk2(mo[4] * rm * g[4], mo[5] * rm * g[5]); w.w = pk2(mo[6] * rm * g[6], mo[7] * rm * g[7]);
          *(GAS v4u*)(yr + ATTN_W + CONV_W + 8 * lane) = w; }
    }
}

__device__ __forceinline__ float max8(float v) { v = fmaxf(v, __shfl_xor(v, 1)); v = fmaxf(v, __shfl_xor(v, 2)); v = fmaxf(v, __shfl_xor(v, 4)); return v; }
namespace rt {
constexpr int KC = 128, NCH = D / KC, BP = KC * 2 + 16, BUFB = 2 * 96 * BP;
__device__ __forceinline__ void issue_b(v4u (&bst)[6], const bf16* WT, int c, int tid) {
#pragma unroll
    for (int i = 0; i < 6; ++i) { const int p = tid + 512 * i, arr = p / 1536, rem = p - arr * 1536, n = rem >> 4, ch = rem & 15;
        bst[i] = *(const GAS v4u*)(WT + ((size_t)arr * 96 + n) * 2048 + c * KC + ch * 8); }
}
__device__ __forceinline__ void write_b(const v4u (&bst)[6], LAS unsigned char* buf, int tid) {
#pragma unroll
    for (int i = 0; i < 6; ++i) { const int p = tid + 512 * i, arr = p / 1536, rem = p - arr * 1536, n = rem >> 4, ch = rem & 15;
        *(LAS v4u*)(buf + arr * (96 * BP) + n * BP + ch * 16) = bst[i]; }
}
__device__ __forceinline__ void issue_a(f32x4 (&a)[4][2], const float* xrow, int c) {
#pragma unroll
    for (int ks = 0; ks < 4; ++ks) { a[ks][0] = *(const GAS f32x4*)(xrow + c * KC + ks * 32); a[ks][1] = *(const GAS f32x4*)(xrow + c * KC + ks * 32 + 4); }
}
__device__ __forceinline__ void compute(f32x4 (&acc)[6], float& ss, const f32x4 (&a)[4][2], const LAS unsigned char* buf, int fr, int kg) {
#pragma unroll
    for (int ks = 0; ks < 4; ++ks) {
        const f32x4 f0 = a[ks][0], f1 = a[ks][1];
        ss += (f0.x * f0.x + f0.y * f0.y) + (f0.z * f0.z + f0.w * f0.w) + (f1.x * f1.x + f1.y * f1.y) + (f1.z * f1.z + f1.w * f1.w);
        asm volatile("" : "+v"(ss));
        v4u h; h.x = cvtpk(f0.x, f0.y); h.y = cvtpk(f0.z, f0.w); h.z = cvtpk(f1.x, f1.y); h.w = cvtpk(f1.z, f1.w);
        v4u l; l.x = cvtpk(f0.x - bflo(h.x), f0.y - bfhi(h.x)); l.y = cvtpk(f0.z - bflo(h.y), f0.w - bfhi(h.y)); l.z = cvtpk(f1.x - bflo(h.z), f1.y - bfhi(h.z)); l.w = cvtpk(f1.z - bflo(h.w), f1.w - bfhi(h.w));
        const bf16x8 ah = __builtin_bit_cast(bf16x8, h), al = __builtin_bit_cast(bf16x8, l);
#pragma unroll
        for (int nb = 0; nb < 6; ++nb) { const LAS unsigned char* bp = buf + (nb * 16 + fr) * BP + (ks * 32 + 8 * kg) * 2;
            const bf16x8 bh = *(const LAS bf16x8*)bp, bl = *(const LAS bf16x8*)(bp + 96 * BP);
            acc[nb] = __builtin_amdgcn_mfma_f32_16x16x32_bf16(ah, bh, acc[nb], 0, 0, 0);
            acc[nb] = __builtin_amdgcn_mfma_f32_16x16x32_bf16(al, bh, acc[nb], 0, 0, 0);
            acc[nb] = __builtin_amdgcn_mfma_f32_16x16x32_bf16(ah, bl, acc[nb], 0, 0, 0); }
    }
}
}
__device__ __forceinline__ void p5_router(Frame& F) {
    using namespace rt;
    const int tid = F.tid, wave = F.wave;
    const float* X1 = F.out; const bf16* WT = (const bf16*)(F.ws + WS_WR);
    LAS unsigned char* Bl = F.lds;
    LAS float* Lg = (LAS float*)(F.lds + 2 * BUFB + wave * (16 * 97 * 4));
    unsigned* cnt = F.ctl + CW_CNT;
    int* tok_e = (int*)(F.ws + WS_TOK + TOK_E); int* tok_rank = (int*)(F.ws + WS_TOK + TOK_RANK);
    for (int mt = F.vcu; mt < T / 128; mt += F.G) {
        int lane = F.lane; asm volatile("" : "+v"(lane));
        const int fr = lane & 15, kg = lane >> 4;
        const int t0 = mt * 128 + wave * 16;
        const float* xrow = X1 + (size_t)(t0 + fr) * D + 8 * kg;
        f32x4 acc[6];
#pragma unroll
        for (int i = 0; i < 6; ++i) acc[i] = (f32x4){0.f, 0.f, 0.f, 0.f};
        float ss = 0.f;
        v4u bst[6]; f32x4 a0[4][2], a1[4][2];
        __syncthreads();
        issue_b(bst, WT, 0, tid); issue_a(a0, xrow, 0);
#pragma unroll 1
        for (int c = 0; c < NCH - 2; c += 2) {
            write_b(bst, Bl, tid); __syncthreads();
            issue_b(bst, WT, c + 1, tid); issue_a(a1, xrow, c + 1);
            compute(acc, ss, a0, Bl, fr, kg);
            write_b(bst, Bl + BUFB, tid); __syncthreads();
            issue_b(bst, WT, c + 2, tid); issue_a(a0, xrow, c + 2);
            compute(acc, ss, a1, Bl + BUFB, fr, kg);
        }
        write_b(bst, Bl, tid); __syncthreads();
        issue_b(bst, WT, NCH - 1, tid); issue_a(a1, xrow, NCH - 1);
        compute(acc, ss, a0, Bl, fr, kg);
        write_b(bst, Bl + BUFB, tid); __syncthreads();
        compute(acc, ss, a1, Bl + BUFB, fr, kg);
        ss += __shfl_xor(ss, 16); ss += __shfl_xor(ss, 32);
        const float rs_row = 1.0f / sqrtf(ss * (1.f / D) + EPS);
#pragma unroll
        for (int r = 0; r < 4; ++r) { const float rr = __shfl(rs_row, 4 * kg + r);
#pragma unroll
            for (int nb = 0; nb < 6; ++nb) Lg[(4 * kg + r) * 97 + nb * 16 + fr] = acc[nb][r] * rr; }
        LDS_WAIT(); asm volatile("" ::: "memory");
        const float be = F.b_re[lane], bg = F.b_rg[lane & 7];
        int my_e1 = 0, my_e2 = 0; float my_g1 = 0.f, my_g2 = 0.f;
#pragma unroll 4
        for (int tk = 0; tk < 16; ++tk) {
            const float gl = Lg[tk * 97 + 64 + (lane & 7)] + bg;
            const float el = Lg[tk * 97 + lane] + be;
            const float gmax = max8(gl);
            const int gi = __builtin_ctzll(__ballot(gl == gmax) & 0xFFull);
            float gs = __builtin_amdgcn_exp2f((gl - gmax) * LOG2E); gs += __shfl_xor(gs, 1); gs += __shfl_xor(gs, 2); gs += __shfl_xor(gs, 4);
            const float gwt = 1.0f / gs;
            const float v1 = __shfl(max8(el), 8 * gi);
            const int i1 = __builtin_ctzll((__ballot(el == v1) >> (8 * gi)) & 0xFFull);
            const float el2 = (lane == 8 * gi + i1) ? -3.0e38f : el;
            const float v2 = __shfl(max8(el2), 8 * gi);
            const int i2 = __builtin_ctzll((__ballot(el2 == v2) >> (8 * gi)) & 0xFFull);
            const float pr = __builtin_amdgcn_exp2f((v2 - v1) * LOG2E), den = 1.0f / (1.0f + pr);
            if (lane == tk) { my_e1 = 8 * gi + i1; my_e2 = 8 * gi + i2; my_g1 = gwt * den; my_g2 = gwt * pr * den; }
        }
        LAS unsigned* hist = (LAS unsigned*)(F.lds + MISC_OFF + 256);
        if (tid < 64) hist[tid] = 0u;
        __syncthreads();
        unsigned lr1 = 0u, lr2 = 0u;
        if (lane < 16) { lr1 = __hip_atomic_fetch_add(hist + my_e1, 1u, __ATOMIC_RELAXED, __HIP_MEMORY_SCOPE_WORKGROUP); lr2 = __hip_atomic_fetch_add(hist + my_e2, 1u, __ATOMIC_RELAXED, __HIP_MEMORY_SCOPE_WORKGROUP); }
        __syncthreads();
        if (tid < 64) { const unsigned c = hist[tid]; hist[64 + tid] = c ? __hip_atomic_fetch_add(cnt + 64 * tid, c, RLX_AGENT) : 0u; }
        __syncthreads();
        if (lane < 16) {
            const int t = t0 + lane;
            const int k1 = (int)(hist[64 + my_e1] + lr1), k2 = (int)(hist[64 + my_e2] + lr2);
            tok_e[2 * t] = my_e1; tok_e[2 * t + 1] = my_e2; tok_rank[2 * t] = k1; tok_rank[2 * t + 1] = k2;
            int* ltok = (int*)(F.ws + WS_LIST + LIST_TOK); float* lrs = (float*)(F.ws + WS_LIST + LIST_RSTD); float* lgt = (float*)(F.ws + WS_LIST + LIST_GATE);
            ltok[my_e1 * CAP + k1] = t; ltok[my_e2 * CAP + k2] = t; lrs[my_e1 * CAP + k1] = rs_row; lrs[my_e2 * CAP + k2] = rs_row; lgt[my_e1 * CAP + k1] = my_g1; lgt[my_e2 * CAP + k2] = my_g2;
        }
    }
}

constexpr int MOE_MT = MISC_OFF + 48, MOE_PST = MISC_OFF + 64, MOE_TE = MOE_PST + 256;
constexpr int MOE_TB = LDS_EXTRA, MOE_VR = MOE_TB + MAXTILES * 4, MOE_UT = MOE_VR + MAXTILES * 4, MOE_SCU = MOE_UT + 12 * 256 * 4;
constexpr int MOE_MAXU = 12;
static_assert(MOE_SCU + MOE_MAXU * 256 * 4 <= MISC_OFF && MOE_TE + MAXTILES * 4 <= LDS_BYTES, "LDS map");
__device__ __forceinline__ int moe_tables(Frame& F) {
    LAS int* PST = (LAS int*)(F.lds + MOE_PST); LAS int* TE = (LAS int*)(F.lds + MOE_TE); LAS int* MTp = (LAS int*)(F.lds + MOE_MT); LAS int* TB = (LAS int*)(F.lds + MOE_TB); LAS int* VR = (LAS int*)(F.lds + MOE_VR);
    __syncthreads();
    if (F.tid < 64) {
        const int c = (int)__hip_atomic_load(F.ctl + CW_CNT + 64 * F.tid, RLX_AGENT); const int nt = (c + 255) >> 8;
        int x = nt;
#pragma unroll
        for (int o = 1; o < 64; o <<= 1) { const int y = __shfl_up(x, o); if (F.lane >= o) x += y; }
        const int ex = x - nt; PST[F.tid] = ex; if (F.tid == 63) MTp[0] = x;
        for (int i = 0; i < nt; ++i) { TE[ex + i] = F.tid; TB[ex + i] = F.tid * CAP + 256 * i; VR[ex + i] = (c - 256 * i) < 256 ? (c - 256 * i) : 256; }
    }
    __syncthreads();
    return MTp[0];
}

__device__ __forceinline__ void p9_final(Frame& F) {
    (void)moe_tables(F);
    const LAS int* PST = (const LAS int*)(F.lds + MOE_PST);
    const int gw = F.vcu * NWAVES + F.wave, NGW = F.G * NWAVES, lane = F.lane;
    const int* tok_e = (const int*)(F.ws + WS_TOK + TOK_E); const int* tok_rank = (const int*)(F.ws + WS_TOK + TOK_RANK); const bf16* YB = (const bf16*)(F.ws + WS_R1);
    typedef int i32x2 __attribute__((ext_vector_type(2)));
    i32x2 ce = {0, 0}, cr = {0, 0};
    if (gw < T) { ce = *(const GAS i32x2*)(tok_e + 2 * gw); cr = *(const GAS i32x2*)(tok_rank + 2 * gw); }
    for (int t = gw; t < T; t += NGW) {
        const int s1 = PST[ce.x] * 256 + cr.x, s2 = PST[ce.y] * 256 + cr.y;
        if (t + NGW < T) { ce = *(const GAS i32x2*)(tok_e + 2 * (t + NGW)); cr = *(const GAS i32x2*)(tok_rank + 2 * (t + NGW)); }
        const GAS v4u* y1 = (const GAS v4u*)(YB + (size_t)s1 * D) + lane; const GAS v4u* y2 = (const GAS v4u*)(YB + (size_t)s2 * D) + lane;
        GAS f32x4* o = (GAS f32x4*)(F.out + (size_t)t * D) + 2 * lane;
#pragma unroll
        for (int i = 0; i < 4; ++i) { float a[8], b[8]; unpack8(__builtin_nontemporal_load(y1 + 64 * i), a); unpack8(__builtin_nontemporal_load(y2 + 64 * i), b);
            f32x4 v0 = __builtin_nontemporal_load(o + 128 * i), v1 = __builtin_nontemporal_load(o + 128 * i + 1);
            v0.x += a[0] + b[0]; v0.y += a[1] + b[1]; v0.z += a[2] + b[2]; v0.w += a[3] + b[3]; v1.x += a[4] + b[4]; v1.y += a[5] + b[5]; v1.z += a[6] + b[6]; v1.w += a[7] + b[7];
            __builtin_nontemporal_store(v0, o + 128 * i); __builtin_nontemporal_store(v1, o + 128 * i + 1); }
    }
}

constexpr int PER_PHASE = 10;
constexpr int N_LAUNCHES = MK_N_LAUNCHES;
struct Args { const float* in[21]; float* out; unsigned char* ws; int ph_lo, ph_hi, li, pad; };
__global__ void __launch_bounds__(NWAVES * 64, 2) hymba_fwd(Args args) {
    extern __shared__ __attribute__((aligned(16))) unsigned char lds[];
    Frame F;
    F.lds = (LAS unsigned char*)lds;
    F.tid = threadIdx.x; F.lane = F.tid & 63; F.wave = __builtin_amdgcn_readfirstlane(F.tid >> 6);
    F.G = gridDim.x; { const int bx = blockIdx.x; F.vcu = (F.G % 8 == 0) ? (bx % 8) * (F.G / 8) + bx / 8 : bx; }
    F.ws = args.ws; F.ctl = (unsigned*)(args.ws + WS_CTL); F.out = args.out;
    F.x = args.in[0]; F.mem = args.in[1]; F.norm1_g = args.in[2]; F.w_in = args.in[3]; F.q_norm_g = args.in[4]; F.k_norm_g = args.in[5]; F.conv_w = args.in[6];
    F.mem_norm_g = args.in[7]; F.w_mem_kv = args.in[8]; F.mem_q_norm_g = args.in[9]; F.mem_k_norm_g = args.in[10]; F.out_norm_g = args.in[11]; F.w_out = args.in[12];
    F.norm2_g = args.in[13]; F.w_rg = args.in[14]; F.b_rg = args.in[15]; F.w_re = args.in[16]; F.b_re = args.in[17]; F.w_gate = args.in[18]; F.w_up = args.in[19]; F.w_down = args.in[20];
    volatile LAS unsigned* MISC = (volatile LAS unsigned*)(F.lds + MISC_OFF);
    if (F.tid < 16) MISC[F.tid] = 0u;
    __syncthreads();
    const int lo = args.ph_lo, hi = args.ph_hi;
    const bool multi = (hi - lo) > 1;
    XcdBarrier bar; bar.bar = F.ctl + CW_BAR + args.li * XCD_BAR_WORDS; bar.x = 0; bar.st = nullptr;
    if (multi) bar = xcd_barrier_post(F.ctl + CW_BAR + args.li * XCD_BAR_WORDS, MISC + 8);
#define GRID_BAR() do { if (multi) xcd_barrier(bar); } while (0)
#define IN(k) (lo <= (k) && (k) < hi)
#define BOTH(k) (IN(k) && IN((k) + 1))
    if (IN(0)) { p0_prologue(F); if (BOTH(0)) GRID_BAR(); }
    if (IN(1)) {
        pg8::Gemm g{(const bf16*)(F.ws + WS_H), (const bf16*)(F.ws + WS_WIN), D, nullptr}; pg8::P1Order S{F.G, (int)blockIdx.x, 0, 2560};
        pg8::EpiProj E{(bf16*)(F.ws + WS_R1), (bf16*)(F.ws + WS_MEMKV)};
        pg8::gemm_phase<pg8::EpiProj, pg8::P1Order>(F.lds, g, S, E);
        if (BOTH(1)) GRID_BAR();
    }
    if (IN(2)) { p2_attention(F); if (BOTH(2)) GRID_BAR(); }
    if (IN(3)) { p3_combine(F); if (BOTH(3)) GRID_BAR(); }
    if (IN(4)) {
        pg8::Gemm g{(const bf16*)(F.ws + WS_Y), (const bf16*)(F.ws + WS_WOUT), D, nullptr}; pg8::StaticOrder S{T / 256, D / 256, F.G, (int)blockIdx.x};
        pg8::EpiResid E{F.x, F.out, (bf16*)(F.ws + WS_H)};
        pg8::gemm_phase<pg8::EpiResid, pg8::StaticOrder, false>(F.lds, g, S, E);
        if (BOTH(4)) GRID_BAR();
    }
    if (IN(5)) { p5_router(F); if (BOTH(5)) GRID_BAR(); }
    if (IN(7)) {
        const int MT = moe_tables(F);
        pg8::MoeOrder S{MT, F.G, (int)blockIdx.x, (const LAS int*)(F.lds + MOE_TE)};
        { const LAS int* TB = (const LAS int*)(F.lds + MOE_TB); const LAS int* VR = (const LAS int*)(F.lds + MOE_VR); LAS int* UT = (LAS int*)(F.lds + MOE_UT);
          const int* ltok = (const int*)(F.ws + WS_LIST + LIST_TOK); const float* lrs = (const float*)(F.ws + WS_LIST + LIST_RSTD); LAS float* SCU = (LAS float*)(F.lds + MOE_SCU);
          for (int i = 0; i < MOE_MAXU; ++i) { pg8::Unit u; if (!S.next(i, u)) break;
              if (F.tid < 256) { const bool ok = F.tid < VR[u.pm]; UT[i * 256 + F.tid] = ok ? ltok[TB[u.pm] + F.tid] : 0; SCU[i * 256 + F.tid] = ok ? lrs[TB[u.pm] + F.tid] : 0.f; } }
          __syncthreads(); }
        pg8::Gemm g{(const bf16*)(F.ws + WS_H), (const bf16*)(F.ws + WS_WGU), D, (const LAS int*)(F.lds + MOE_UT)};
        pg8::EpiSwiGLU E{(bf16*)(F.ws + WS_OPART), (const LAS float*)(F.lds + MOE_SCU)};
        pg8::gemm_phase<pg8::EpiSwiGLU, pg8::MoeOrder, true, true, false, true>(F.lds, g, S, E);
        if (BOTH(7)) GRID_BAR();
    }
    if (IN(8)) {
        const int MT = moe_tables(F);
        pg8::Gemm g{(const bf16*)(F.ws + WS_OPART), (const bf16*)(F.ws + WS_WD), DEXP, nullptr}; pg8::MoeOrder S{MT, F.G, (int)blockIdx.x, (const LAS int*)(F.lds + MOE_TE)};
        { const LAS int* TB = (const LAS int*)(F.lds + MOE_TB); const LAS int* VR = (const LAS int*)(F.lds + MOE_VR); LAS float* SCU = (LAS float*)(F.lds + MOE_SCU);
          const float* lgt = (const float*)(F.ws + WS_LIST + LIST_GATE);
          for (int i = 0; i < MOE_MAXU; ++i) { pg8::Unit u; if (!S.next(i, u)) break;
              if (F.tid < 256) SCU[i * 256 + F.tid] = (F.tid < VR[u.pm]) ? lgt[TB[u.pm] + F.tid] : 0.f; }
          __syncthreads(); }
        pg8::EpiDown E{(bf16*)(F.ws + WS_R1), (const LAS float*)(F.lds + MOE_SCU)};
        pg8::gemm_phase<pg8::EpiDown, pg8::MoeOrder, true, false, false, true>(F.lds, g, S, E);
        if (BOTH(8)) GRID_BAR();
    }
    if (IN(9)) { p9_final(F); }
#undef IN
#undef BOTH
#undef GRID_BAR
}

extern "C" void kernel_launch(void* const* d_in, const int* in_sizes, int n_in, void* d_out, int out_size, void* d_ws, size_t ws_size, hipStream_t stream) {
    static int grid = 0;
    if (grid == 0) {
        if (n_in != 21 || in_sizes[0] != T * D || out_size != T * D || ws_size < WS_END) { fprintf(stderr, "kernel_launch: shape/workspace mismatch (n_in %d, ws %zu < %zu); nothing launched\n", n_in, ws_size, (size_t)WS_END); grid = -1; return; }
        int dev = 0, cus = 0, per_cu = 0;
        if (hipGetDevice(&dev) != hipSuccess || hipDeviceGetAttribute(&cus, hipDeviceAttributeMultiprocessorCount, dev) != hipSuccess) { grid = -1; return; }
        if (hipFuncSetAttribute((const void*)hymba_fwd, hipFuncAttributeMaxDynamicSharedMemorySize, LDS_BYTES) != hipSuccess) { fprintf(stderr, "kernel_launch: hipFuncSetAttribute failed\n"); grid = -1; return; }
        if (hipOccupancyMaxActiveBlocksPerMultiprocessor(&per_cu, (const void*)hymba_fwd, NWAVES * 64, LDS_BYTES) != hipSuccess || per_cu < 1) { fprintf(stderr, "kernel_launch: occupancy query reports %d\n", per_cu); }
        (void)hipGetLastError();
        grid = cus;
    }
    if (grid < 0) return;
    if (hipMemsetAsync((char*)d_ws + WS_CTL, 0, CTL_ZERO_BYTES, stream) != hipSuccess) { fprintf(stderr, "kernel_launch: memset failed\n"); return; }
    Args a{};
    for (int i = 0; i < 21; ++i) a.in[i] = (const float*)d_in[i];
    a.out = (float*)d_out; a.ws = (unsigned char*)d_ws;
    int los[4], his[4], nl = 0;
#if defined(PROBE_REPEAT)
    los[nl] = 0; his[nl] = PROBE_REPEAT + 1; ++nl; los[nl] = PROBE_REPEAT; his[nl] = PROBE_REPEAT + 1; ++nl; if (PROBE_REPEAT + 1 < PER_PHASE) { los[nl] = PROBE_REPEAT + 1; his[nl] = PER_PHASE; ++nl; }
#else
    los[nl] = 0; his[nl] = PER_PHASE; ++nl;
#endif
    for (int li = 0; li < nl; ++li) {
        a.ph_lo = los[li]; a.ph_hi = his[li]; a.li = li;
#if defined(PROBE_REPEAT)
        if (li == 1) { (void)hipMemsetAsync((char*)d_ws + WS_CTL + CW_ATTQ * 4, 0, 64, stream); if (PROBE_REPEAT == 5) (void)hipMemsetAsync((char*)d_ws + WS_CTL + CW_CNT * 4, 0, 64 * 256, stream); }
#endif
        hipLaunchKernelGGL(hymba_fwd, dim3(grid), dim3(NWAVES * 64), LDS_BYTES, stream, a);
        const hipError_t le = hipPeekAtLastError();
        if (le != hipSuccess) { fprintf(stderr, "kernel_launch: launch %d failed: %s\n", li, hipGetErrorName(le)); break; }
    }
}
```

```cpp
#include <hip/hip_runtime.h>
#include <cstdio>
#include <cstdint>

#ifndef MK_N_LAUNCHES
#define MK_N_LAUNCHES 1
#endif

#define GAS __attribute__((address_space(1)))
#define LAS __attribute__((address_space(3)))
typedef unsigned short bf16;
typedef unsigned v4u __attribute__((ext_vector_type(4)));
typedef unsigned v2u __attribute__((ext_vector_type(2)));
typedef float f32x4 __attribute__((ext_vector_type(4)));
typedef float f32x16 __attribute__((ext_vector_type(16)));
typedef short bf16x8 __attribute__((ext_vector_type(8)));
typedef short s16x4 __attribute__((ext_vector_type(4)));
#define LDS_WAIT() asm volatile("s_waitcnt lgkmcnt(0)" ::: "memory")
#define VM_WAIT() asm volatile("s_waitcnt vmcnt(0)" ::: "memory")
#define RLX_AGENT __ATOMIC_RELAXED, __HIP_MEMORY_SCOPE_AGENT

constexpr int BATCH = 2, SEQ = 16384, T = BATCH * SEQ, D = 2048, PROJ = 5120;
constexpr int NH = 8, HD = 128, ATTN_W = 1024, CONV_W = 512, MEM_W = 512, NMEM = 256, NMH = 4;
constexpr int COL_Q = 0, COL_K = 1024, COL_V = 2048, COL_B = 3072, COL_C = 3584, COL_U = 4096, COL_MQ = 4608;
constexpr int NEXP = 64, DEXP = 1024;
constexpr int RMAX = 81920;
constexpr int MAXTILES = RMAX / 256;
constexpr float EPS = 1e-6f;
constexpr float LOG2E = 1.4426950408889634f;

constexpr size_t MiB = 1u << 20;
constexpr size_t WS_CTL = 0, CTL_ZERO_BYTES = 1 * MiB;
constexpr size_t WS_WIN = 1 * MiB;
constexpr size_t WS_WMKV = WS_WIN + (size_t)PROJ * D * 2;
constexpr size_t WS_WOUT = 25 * MiB;
constexpr size_t WS_WR = 33 * MiB;
constexpr size_t WS_WGU = 34 * MiB;
constexpr size_t WS_WD = WS_WGU + 512 * MiB;
constexpr size_t WS_H = WS_WD + 256 * MiB;
constexpr size_t WS_MEMKV = WS_H + 130 * MiB;
constexpr size_t WS_R1 = WS_MEMKV + 1 * MiB;
constexpr size_t WS_OPART = WS_R1 + 320 * MiB;
constexpr size_t WS_LSE = WS_OPART + 192 * MiB;
constexpr size_t WS_MEMO = WS_LSE + 3 * MiB;
constexpr size_t WS_Y = WS_MEMO + 32 * MiB;
constexpr size_t WS_TOK = WS_Y + 128 * MiB;
constexpr size_t WS_LIST = WS_TOK + 4 * MiB;
constexpr size_t WS_END = WS_LIST + 24 * MiB;
constexpr int CAP = T;
constexpr size_t LIST_TOK = 0, LIST_RSTD = 8 * MiB, LIST_GATE = 16 * MiB;
constexpr size_t TOK_E = 0, TOK_RANK = 256 * 1024, TOK_GATE = 512 * 1024, TOK_RSTD = 768 * 1024, TOK_SLOT = 1024 * 1024, SLOT_RSTD = 1536 * 1024, SLOT_GATE = 2048 * 1024;
static_assert(WS_WMKV + 1024 * (size_t)D * 2 <= WS_WOUT && WS_WOUT + 8 * MiB <= WS_WR && WS_WR + 2048 * 72 * 4 <= WS_WGU, "ws map");
static_assert((size_t)(T + 512) * D * 2 <= 130 * MiB && (size_t)RMAX * D * 2 <= 320 * MiB && (size_t)RMAX * DEXP * 2 <= 192 * MiB && SLOT_GATE + RMAX * 4 <= 4 * MiB, "ws map");

constexpr int CW_TMO = 0, CW_CODE = 1;
constexpr int CW_CNT = 8192;
constexpr int CW_BAR = 16384;
constexpr int CW_KVREADY = 512, CW_ATTQ = 576;

constexpr int RING_BYTES = 131072;
constexpr int LDS_EXTRA = RING_BYTES;
constexpr int MISC_OFF = 163840 - 2048;
constexpr int LDS_BYTES = 163840;

__device__ __forceinline__ unsigned f2bf(float f) { unsigned u = __builtin_bit_cast(unsigned, f); return (u + 0x7fffu + ((u >> 16) & 1u)) >> 16; }
__device__ __forceinline__ unsigned pk2(float lo, float hi) { return f2bf(lo) | (f2bf(hi) << 16); }
__device__ __forceinline__ unsigned cvtpk(float lo, float hi) { unsigned r; asm volatile("v_cvt_pk_bf16_f32 %0, %1, %2" : "=v"(r) : "v"(lo), "v"(hi)); return r; }
__device__ __forceinline__ unsigned pk_fp8x4(float a, float b, float c, float d) { unsigned w = 0u; w = __builtin_amdgcn_cvt_pk_fp8_f32(a, b, w, false); w = __builtin_amdgcn_cvt_pk_fp8_f32(c, d, w, true); return w; }
constexpr float SC_WGU = 128.0f, SC_ACT = 4.0f, SC_WD = 64.0f, SC_Y = 64.0f;
__device__ __forceinline__ float bflo(unsigned w) { return __builtin_bit_cast(float, w << 16); }
__device__ __forceinline__ float bfhi(unsigned w) { return __builtin_bit_cast(float, w & 0xffff0000u); }
__device__ __forceinline__ float wave_sum(float v) {
#pragma unroll
    for (int o = 1; o < 64; o <<= 1) v += __shfl_xor(v, o);
    return v;
}

namespace pg8 {
#define PG8_LAS __attribute__((address_space(3)))
typedef unsigned short bf16_t;
typedef unsigned u32x4 __attribute__((ext_vector_type(4)));
typedef int i32x4 __attribute__((ext_vector_type(4)));
typedef int i32x8 __attribute__((ext_vector_type(8)));
constexpr int BM = 256, BK = 64, HALF = 128, HTB = HALF * BK * 2, STAGE_BYTES = 8 * HTB, NXCD = 8, WGM = 8;
__host__ __device__ __forceinline__ int lds_byte(int r, int c) { const int st = (r >> 4) * 2 + (c >> 5), rr = r & 15, cc = c & 31, ob = rr * 64 + cc * 2; return st * 1024 + (ob ^ (((ob >> 9) & 1) << 5)); }
__host__ __device__ __forceinline__ void stage_rc(int b, int& R, int& C) { const int st = b / 1024, sb = b % 1024, swz = sb ^ (((sb >> 9) & 1) << 5); R = (st >> 1) * 16 + swz / 64; C = (st & 1) * 32 + (swz % 64) / 2; }
__host__ __device__ __forceinline__ int perm32(int rho) { const int n = rho >> 4, i = rho & 15; return 8 * (i >> 2) + 4 * n + (i & 3); }

struct Unit { int pm, pn, pb, ui; };
struct Gemm { const bf16_t* A; const bf16_t* Bt; int K; const PG8_LAS int* ut; };

__device__ __forceinline__ void tile_of(int L, int nM, int nN, int& pm, int& pn) {
    const int nwg = nM * nN;
    int wgid = L; { const int q = nwg / NXCD, r = nwg % NXCD, xcd = wgid % NXCD, off = wgid / NXCD; wgid = (xcd < r ? xcd * (q + 1) : r * (q + 1) + (xcd - r) * q) + off; }
    const int nig = WGM * nN, gid = wgid / nig, fm = gid * WGM, gsz = (nM - fm) < WGM ? (nM - fm) : WGM;
    pm = fm + ((wgid % nig) % gsz); pn = (wgid % nig) / gsz;
}
struct StaticOrder {
    int nM, nN, G, c;
    __device__ __forceinline__ bool next(int i, Unit& u) const { const long L = (long)i * G + c; if (L >= (long)nM * nN) return false; tile_of((int)L, nM, nN, u.pm, u.pn); u.pb = u.pn; return true; }
    __device__ __forceinline__ void a_ready(const Unit&) const {}
    __device__ __forceinline__ void done(const Unit&) const {}
};
struct P1Order {
    int G, c, lo, hi;
    __device__ __forceinline__ bool next(int i, Unit& u) const { const long L = (long)lo + (long)i * G + c; if (L >= hi) return false;
        if (L < 2560) tile_of((int)L, 128, 20, u.pm, u.pn); else { const int k = (int)L - 2560; u.pm = 128 + (k >> 2); u.pn = 20 + (k & 3); }
        u.pb = u.pn; return true; }
    __device__ __forceinline__ void a_ready(const Unit&) const {}
    __device__ __forceinline__ void done(const Unit&) const {}
};
struct MoeOrder {
    int nM, G, c; const LAS int* te;
    __device__ __forceinline__ bool next(int i, Unit& u) const { const long L = (long)i * G + c; if (L >= (long)nM * 8) return false; tile_of((int)L, nM, 8, u.pm, u.pn); u.pb = te[u.pm] * 8 + u.pn; u.ui = i; return true; }
    __device__ __forceinline__ void a_ready(const Unit&) const {}
    __device__ __forceinline__ void done(const Unit&) const {}
};

struct EpiProj {
    static constexpr bool PERM = true, AFTER_DRAIN = false;
    bf16_t* O; bf16_t* O2;
    __device__ __forceinline__ void operator()(const f32x4 (&acc)[2][2][4][2], const Unit& u, int wr, int wc, int fr, int fq) const {
        int row0 = u.pm * BM + wr * 64 + fr, col0 = u.pn * BM + wc * 32 + 8 * fq, ldc = PROJ; bf16_t* base = O;
        if (u.pm >= 128) { row0 -= 128 * BM; col0 -= 20 * BM; ldc = 1024; base = O2; }
#pragma unroll
        for (int ai = 0; ai < 2; ++ai)
#pragma unroll
            for (int m = 0; m < 4; ++m) { bf16_t* rowp = base + (size_t)(row0 + ai * HALF + m * 16) * ldc + col0;
#pragma unroll
                for (int bj = 0; bj < 2; ++bj) { const f32x4 v0 = acc[ai][bj][m][0], v1 = acc[ai][bj][m][1];
                    u32x4 w; w.x = cvtpk(v0[0], v0[1]); w.y = cvtpk(v0[2], v0[3]); w.z = cvtpk(v1[0], v1[1]); w.w = cvtpk(v1[2], v1[3]);
                    *(u32x4*)(rowp + bj * HALF) = w; } }
    }
};
struct EpiResid {
    static constexpr bool PERM = true, AFTER_DRAIN = false;
    const float* X; float* X1; bf16_t* X1B;
    __device__ __forceinline__ void operator()(const f32x4 (&acc)[2][2][4][2], const Unit& u, int wr, int wc, int fr, int fq) const {
        const int row0 = u.pm * BM + wr * 64 + fr, col0 = u.pn * BM + wc * 32 + 8 * fq;
#pragma unroll
        for (int ai = 0; ai < 2; ++ai)
#pragma unroll
            for (int m = 0; m < 4; ++m) { const size_t off = (size_t)(row0 + ai * HALF + m * 16) * D + col0;
#pragma unroll
                for (int bj = 0; bj < 2; ++bj) { const f32x4 xa = __builtin_nontemporal_load((const f32x4*)(X + off + bj * HALF)), xb = __builtin_nontemporal_load((const f32x4*)(X + off + bj * HALF + 4));
                    const f32x4 v0 = acc[ai][bj][m][0] + xa, v1 = acc[ai][bj][m][1] + xb;
                    *(f32x4*)(X1 + off + bj * HALF) = v0; *(f32x4*)(X1 + off + bj * HALF + 4) = v1;
                    v2u w; w.x = pk_fp8x4(v0[0], v0[1], v0[2], v0[3]); w.y = pk_fp8x4(v1[0], v1[1], v1[2], v1[3]);
                    *(v2u*)((unsigned char*)X1B + off + bj * HALF) = w; }
                asm volatile("" ::: "memory"); }
    }
};
struct EpiSwiGLU {
    static constexpr bool PERM = true, AFTER_DRAIN = false;
    bf16_t* ACT; const PG8_LAS float* RSU;
    __device__ __forceinline__ void operator()(const f32x4 (&acc)[2][2][4][2], const Unit& u, int wr, int wc, int fr, int fq) const {
        const int row0 = u.pm * BM + wr * 64 + fr, col0 = u.pn * HALF + wc * 32 + 8 * fq; const PG8_LAS float* rsu = RSU + u.ui * 256 + wr * 64 + fr;
#pragma unroll
        for (int ai = 0; ai < 2; ++ai)
#pragma unroll
            for (int m = 0; m < 4; ++m) { const int row = row0 + ai * HALF + m * 16; const float rs = rsu[ai * HALF + m * 16] * (1.0f / SC_WGU); float o[8];
#pragma unroll
                for (int n = 0; n < 2; ++n)
#pragma unroll
                    for (int j = 0; j < 4; ++j) { const float g = acc[ai][0][m][n][j] * rs, uu = acc[ai][1][m][n][j] * rs;
                        o[n * 4 + j] = g * __builtin_amdgcn_rcpf(1.0f + __builtin_amdgcn_exp2f(-g * LOG2E)) * uu * SC_ACT; }
                v2u w; w.x = pk_fp8x4(o[0], o[1], o[2], o[3]); w.y = pk_fp8x4(o[4], o[5], o[6], o[7]);
                *(v2u*)((unsigned char*)ACT + (size_t)row * DEXP + col0) = w; }
    }
};
struct EpiDown {
    static constexpr bool PERM = true, AFTER_DRAIN = false;
    bf16_t* Y; const PG8_LAS float* GTU;
    __device__ __forceinline__ void operator()(const f32x4 (&acc)[2][2][4][2], const Unit& u, int wr, int wc, int fr, int fq) const {
        const int row0 = u.pm * BM + wr * 64 + fr, col0 = u.pn * BM + wc * 32 + 8 * fq; const PG8_LAS float* gtu = GTU + u.ui * 256 + wr * 64 + fr;
#pragma unroll
        for (int ai = 0; ai < 2; ++ai)
#pragma unroll
            for (int m = 0; m < 4; ++m) { const int row = row0 + ai * HALF + m * 16; const float gt = gtu[ai * HALF + m * 16] * (SC_Y / (SC_ACT * SC_WD)); unsigned char* rowp = (unsigned char*)Y + (size_t)row * D + col0;
#pragma unroll
                for (int bj = 0; bj < 2; ++bj) { const f32x4 v0 = acc[ai][bj][m][0] * gt, v1 = acc[ai][bj][m][1] * gt;
                    v2u w; w.x = pk_fp8x4(v0[0], v0[1], v0[2], v0[3]); w.y = pk_fp8x4(v1[0], v1[1], v1[2], v1[3]);
                    *(v2u*)(rowp + bj * HALF) = w; } }
    }
};

template <class Epi, class Sched, bool ALIGN_EPI = true, bool GATHER = false, bool BKN = false, bool FP8 = false>
__device__ __forceinline__ void gemm_phase(PG8_LAS unsigned char* lds, const Gemm g, const Sched& S, const Epi& E) {
    static_assert(!(FP8 && BKN), "the fp8 path takes N-major B");
    const int tid = threadIdx.x, wid = __builtin_amdgcn_readfirstlane(tid >> 6), lane = tid & 63, wr = wid >> 2, wc = wid & 3, fr = lane & 15, fq = lane >> 4;
    const int K = FP8 ? g.K / 2 : g.K, nt = K / BK;
    unsigned voffA[2], voffB[2]; int gR[2], gC[2];
#pragma unroll
    for (int i = 0; i < 2; ++i) { int R, C; stage_rc(tid * 16 + i * 8192, R, C); const int Rb = Epi::PERM ? ((R & ~31) + perm32(R & 31)) : R; gR[i] = R; gC[i] = C;
        voffA[i] = (unsigned)(R * K + C) * 2u; voffB[i] = (unsigned)(Rb * K + C) * 2u; }
    unsigned vA0[2], vA1[2], vN0[2], vN1[2];
#define PG8_GOFF(dst0, dst1, ui_) do { _Pragma("unroll") for (int _i = 0; _i < 2; ++_i) { \
        dst0[_i] = ((unsigned)g.ut[(ui_) * 256 + gR[_i]] * (unsigned)K + (unsigned)gC[_i]) * 2u; dst1[_i] = ((unsigned)g.ut[(ui_) * 256 + 128 + gR[_i]] * (unsigned)K + (unsigned)gC[_i]) * 2u; } } while (0)
    const size_t kstep = (size_t)(BK * 2);
    const size_t hstep = (size_t)HALF * K * 2;
    const size_t tstep = 2 * hstep;
    const size_t kstepB = BKN ? (size_t)BK * 4096 : kstep, hstepB = BKN ? (size_t)256 : hstep;
    if constexpr (BKN) {
#pragma unroll
        for (int i = 0; i < 2; ++i) { const int p = tid * 16 + i * 8192, kk = p >> 8, c16p = (p & 255) >> 4, sw = (kk & 3) | (((kk >> 3) & 1) << 2);
            voffB[i] = (unsigned)(kk * 4096 + ((c16p ^ (sw << 1)) << 4)); } }
    int bbase[2];
    { const int q = fr >> 2, p = fr & 3, sw = q | ((fq & 1) << 2);
#pragma unroll
      for (int n = 0; n < 2; ++n) bbase[n] = (int)(uintptr_t)lds + (8 * fq + q) * 256 + (((4 * wc + 2 * n + (p >> 1)) ^ (sw << 1)) << 4) + 8 * (p & 1); }
    const unsigned ldsw = (unsigned)wid * 1024u;
    const int aoff = lds_byte(wr * 64 + fr, fq * 8), boff = lds_byte(wc * 32 + fr, fq * 8);
    const int aoq0 = lds_byte(wr * 64 + fr, fq * 16), aoq1 = lds_byte(wr * 64 + fr, fq * 16 + 8), boq0 = lds_byte(wc * 32 + fr, fq * 16), boq1 = lds_byte(wc * 32 + fr, fq * 16 + 8);
#define PG8_SA(b, h) (((b) * 2 + (h)) * HTB)
#define PG8_SB(b, h) ((4 + (b) * 2 + (h)) * HTB)
#define PG8_STAGE(bufoff, gbase, voff) do { _Pragma("unroll") for (int _i = 0; _i < 2; ++_i) \
        __builtin_amdgcn_global_load_lds((const unsigned*)((const char*)(gbase) + (voff)[_i]), (PG8_LAS unsigned*)(lds + (bufoff) + ldsw + _i * 8192), 16, 0, 0); } while (0)
#define PG8_Q_At Aq
#define PG8_Q_B0 Bq0
#define PG8_Q_B1 Bq1
#define PG8_LD8(p0_, p1_) __builtin_shufflevector(*(const PG8_LAS i32x4*)(p0_), *(const PG8_LAS i32x4*)(p1_), 0, 1, 2, 3, 4, 5, 6, 7)
#define PG8_LDA(dst, b, h) do { if constexpr (FP8) { _Pragma("unroll") for (int m = 0; m < 4; ++m) PG8_Q_##dst[m] = PG8_LD8(lds + PG8_SA(b, h) + aoq0 + m * 2048, lds + PG8_SA(b, h) + aoq1 + m * 2048); } \
        else { _Pragma("unroll") for (int m = 0; m < 4; ++m) _Pragma("unroll") for (int k = 0; k < 2; ++k) dst[m][k] = *(const PG8_LAS bf16x8*)(lds + PG8_SA(b, h) + aoff + m * 2048 + k * 1024); } } while (0)
#define PG8_TR(dst, addr, OFF) asm volatile("ds_read_b64_tr_b16 %0, %1 offset:%2" : "=&v"(dst) : "v"(addr), "i"(OFF) : "memory")
#define PG8_LDB(dst, b, h) do { if constexpr (BKN) { _Pragma("unroll") for (int n = 0; n < 2; ++n) { const int ad_ = bbase[n] + PG8_SB(b, h); s16x4 l0_, h0_, l1_, h1_; \
            PG8_TR(l0_, ad_, 0); PG8_TR(h0_, ad_, 1024); PG8_TR(l1_, ad_, 8192); PG8_TR(h1_, ad_, 9216); \
            dst[n][0] = (bf16x8){l0_[0], l0_[1], l0_[2], l0_[3], h0_[0], h0_[1], h0_[2], h0_[3]}; dst[n][1] = (bf16x8){l1_[0], l1_[1], l1_[2], l1_[3], h1_[0], h1_[1], h1_[2], h1_[3]}; } } \
        else if constexpr (FP8) { _Pragma("unroll") for (int n = 0; n < 2; ++n) PG8_Q_##dst[n] = PG8_LD8(lds + PG8_SB(b, h) + boq0 + n * 2048, lds + PG8_SB(b, h) + boq1 + n * 2048); } \
        else { _Pragma("unroll") for (int n = 0; n < 2; ++n) _Pragma("unroll") for (int k = 0; k < 2; ++k) dst[n][k] = *(const PG8_LAS bf16x8*)(lds + PG8_SB(b, h) + boff + n * 2048 + k * 1024); } } while (0)
#define PG8_MMA(ai, bj, At, Bt) do { __builtin_amdgcn_s_setprio(1); if constexpr (FP8) { _Pragma("unroll") for (int m = 0; m < 4; ++m) _Pragma("unroll") for (int n = 0; n < 2; ++n) \
            asm volatile("v_mfma_scale_f32_16x16x128_f8f6f4 %0, %1, %2, %0, %3, %3 op_sel_hi:[0,0,0]" : "+v"(acc[ai][bj][m][n]) : "v"(PG8_Q_##Bt[n]), "v"(PG8_Q_##At[m]), "v"(sc1_)); } \
        else { _Pragma("unroll") for (int m = 0; m < 4; ++m) _Pragma("unroll") for (int n = 0; n < 2; ++n) _Pragma("unroll") for (int k = 0; k < 2; ++k) \
            acc[ai][bj][m][n] = __builtin_amdgcn_mfma_f32_16x16x32_bf16(Bt[n][k], At[m][k], acc[ai][bj][m][n], 0, 0, 0); } __builtin_amdgcn_s_setprio(0); } while (0)
#define PG8_WAIT_V(n) asm volatile("s_waitcnt vmcnt(" #n ")" ::: "memory")
#define PG8_WAIT_L(n) asm volatile("s_waitcnt lgkmcnt(" #n ")" ::: "memory")
#define PG8_BAR __builtin_amdgcn_s_barrier()
#define PG8_SCHED __builtin_amdgcn_sched_barrier(0)
    Unit cur, nxt; int ui = 0;
    if (!S.next(0, cur)) return;
    f32x4 acc[2][2][4][2];
#pragma unroll
    for (int a = 0; a < 2; ++a)
#pragma unroll
        for (int b = 0; b < 2; ++b)
#pragma unroll
            for (int m = 0; m < 4; ++m)
#pragma unroll
                for (int n = 0; n < 2; ++n) acc[a][b][m][n] = (f32x4){0.f, 0.f, 0.f, 0.f};
    bf16x8 At[4][2], B0[2][2], B1[2][2];
    i32x8 Aq[4], Bq0[2], Bq1[2]; const int sc1_ = 0x7F7F7F7F;
    const char* cA = GATHER ? (const char*)g.A : (const char*)g.A + (size_t)cur.pm * tstep; const char* cB = BKN ? (const char*)g.Bt + (size_t)(cur.pb >> 3) * ((size_t)K * 4096) + (size_t)(cur.pb & 7) * 512 : (const char*)g.Bt + (size_t)cur.pb * tstep;
    const size_t hA = GATHER ? 0 : hstep;
    if constexpr (GATHER) { PG8_GOFF(vA0, vA1, 0); } else {
#pragma unroll
        for (int i = 0; i < 2; ++i) { vA0[i] = voffA[i]; vA1[i] = voffA[i]; vN0[i] = voffA[i]; vN1[i] = voffA[i]; } }
    S.a_ready(cur);
    PG8_STAGE(PG8_SB(0, 0), cB, voffB); PG8_STAGE(PG8_SB(0, 1), cB + hstepB, voffB); PG8_STAGE(PG8_SA(0, 0), cA, vA0); PG8_STAGE(PG8_SA(0, 1), cA + hA, vA1);
    if (wr == 1) PG8_BAR;
    PG8_WAIT_V(2); PG8_BAR;
    PG8_STAGE(PG8_SB(1, 0), cB + kstepB, voffB); PG8_STAGE(PG8_SA(1, 0), cA + kstep, vA0); PG8_STAGE(PG8_SB(1, 1), cB + hstepB + kstepB, voffB);
    PG8_WAIT_V(6); PG8_BAR;
    for (;;) {
        const bool has_next = S.next(ui + 1, nxt);
        const char* nA = GATHER ? cA : (has_next ? (const char*)g.A + (size_t)nxt.pm * tstep : cA); const char* nB = has_next ? (BKN ? (const char*)g.Bt + (size_t)(nxt.pb >> 3) * ((size_t)K * 4096) + (size_t)(nxt.pb & 7) * 512 : (const char*)g.Bt + (size_t)nxt.pb * tstep) : cB;
        if constexpr (GATHER) { if (has_next) { PG8_GOFF(vN0, vN1, ui + 1); } else {
#pragma unroll
            for (int i = 0; i < 2; ++i) { vN0[i] = vA0[i]; vN1[i] = vA1[i]; } } }
#pragma unroll 1
        for (int t = 0; t < nt; t += 2) {
            const bool last = (t == nt - 2);
            unsigned s0[2], s1[2];
#pragma unroll
            for (int i = 0; i < 2; ++i) { s0[i] = (GATHER && last) ? vN0[i] : vA0[i]; s1[i] = (GATHER && last) ? vN1[i] : vA1[i]; }
            const char* a1 = cA + (size_t)(t + 1) * kstep;
            const char* a2 = last ? nA : cA + (size_t)(t + 2) * kstep; const char* b2 = last ? nB : cB + (size_t)(t + 2) * kstepB;
            const char* a3 = a2 + kstep; const char* b3 = b2 + kstepB;
            if (last && has_next) S.a_ready(nxt);
            PG8_LDB(B0, 0, 0); PG8_LDB(B1, 0, 1); PG8_SCHED; PG8_LDA(At, 0, 0); PG8_STAGE(PG8_SA(1, 1), a1 + hA, vA1);
            PG8_WAIT_V(8); PG8_WAIT_L(0); PG8_BAR; PG8_SCHED; PG8_MMA(0, 0, At, B0); PG8_MMA(0, 1, At, B1); PG8_BAR; PG8_SCHED;
            PG8_LDA(At, 0, 1); PG8_STAGE(PG8_SB(0, 0), b2, voffB); PG8_STAGE(PG8_SB(0, 1), b2 + hstepB, voffB); PG8_STAGE(PG8_SA(0, 0), a2, s0);
            PG8_WAIT_V(8); PG8_WAIT_L(0); PG8_BAR; PG8_SCHED; PG8_MMA(1, 0, At, B0); PG8_MMA(1, 1, At, B1); PG8_BAR; PG8_SCHED;
            PG8_LDB(B0, 1, 0); PG8_LDB(B1, 1, 1); PG8_SCHED; PG8_LDA(At, 1, 0); PG8_STAGE(PG8_SA(0, 1), a2 + hA, s1);
            PG8_WAIT_V(8); PG8_WAIT_L(0); PG8_BAR; PG8_SCHED; PG8_MMA(0, 0, At, B0); PG8_MMA(0, 1, At, B1); PG8_BAR; PG8_SCHED;
            PG8_LDA(At, 1, 1); PG8_STAGE(PG8_SB(1, 0), b3, voffB); PG8_STAGE(PG8_SB(1, 1), b3 + hstepB, voffB); PG8_STAGE(PG8_SA(1, 0), a3, s0);
            PG8_WAIT_V(8); PG8_WAIT_L(0); PG8_BAR; PG8_SCHED; PG8_MMA(1, 0, At, B0); PG8_MMA(1, 1, At, B1); PG8_BAR; PG8_SCHED;
        }
        if constexpr (ALIGN_EPI) { if (wr == 0) PG8_BAR; }
        if constexpr (FP8) { __builtin_amdgcn_sched_barrier(0); asm volatile("s_nop 15\n\ts_nop 15" ::: "memory"); __builtin_amdgcn_sched_barrier(0); }
        { int ln_ = lane; asm volatile("" : "+v"(ln_)); E(acc, cur, wr, wc, ln_ & 15, ln_ >> 4); } S.done(cur);
        if (!has_next) break;
#pragma unroll
        for (int a = 0; a < 2; ++a)
#pragma unroll
            for (int b = 0; b < 2; ++b)
#pragma unroll
                for (int m = 0; m < 4; ++m)
#pragma unroll
                    for (int n = 0; n < 2; ++n) acc[a][b][m][n] = (f32x4){0.f, 0.f, 0.f, 0.f};
        cur = nxt; cA = nA; cB = nB; ++ui;
#pragma unroll
        for (int i = 0; i < 2; ++i) { vA0[i] = vN0[i]; vA1[i] = vN1[i]; }
        if constexpr (ALIGN_EPI) { if (wr == 1) PG8_BAR; }
    }
    PG8_WAIT_V(0);
    if constexpr (!ALIGN_EPI) { if (wr == 0) PG8_BAR; }
    PG8_BAR;
#undef PG8_GOFF
#undef PG8_Q_At
#undef PG8_Q_B0
#undef PG8_Q_B1
#undef PG8_LD8
#undef PG8_TR
#undef PG8_SA
#undef PG8_SB
#undef PG8_STAGE
#undef PG8_LDA
#undef PG8_LDB
#undef PG8_MMA
#undef PG8_WAIT_V
#undef PG8_WAIT_L
#undef PG8_BAR
#undef PG8_SCHED
}
}

#define XB_TMO      128
#define XB_XCNT(j)  (256  + 64 * (j))
#define XB_XSUB(j)  (1280 + 64 * (j))
#define XB_XGEN(j)  (2304 + 64 * (j))
#define XB_TOP      3328
#define XB_TOPGEN   3392
#define XCD_BAR_WORDS 3456
#define XB_SPIN_CAP (1u << 18)
__device__ __forceinline__ unsigned xb_ld(unsigned* p)              { return __hip_atomic_load(p, __ATOMIC_RELAXED, __HIP_MEMORY_SCOPE_AGENT); }
__device__ __forceinline__ unsigned xb_add(unsigned* p, unsigned v) { return __hip_atomic_fetch_add(p, v, __ATOMIC_RELAXED, __HIP_MEMORY_SCOPE_AGENT); }
__device__ __forceinline__ unsigned xb_xcc_id() { return (unsigned)__builtin_amdgcn_s_getreg((3 << 11) | 20) & 0xFu; }
#define XB_SPIN(cond, bar) do { unsigned _sp = 0; while (cond) { __builtin_amdgcn_s_sleep(1); \
    if ((++_sp & 255u) == 0u) { if (xb_ld(&(bar)[XB_TMO])) break; if (_sp > XB_SPIN_CAP) { atomicAdd(&(bar)[XB_TMO], 1u); break; } } } } while (0)
struct XcdBarrier { unsigned* bar; unsigned x; volatile LAS unsigned* st; };
__device__ __forceinline__ XcdBarrier xcd_barrier_post(unsigned* bar, volatile LAS unsigned* st) {
    XcdBarrier b; b.bar = bar; b.x = xb_xcc_id(); b.st = st;
    if (threadIdx.x == 0) (void)xb_add(&bar[XB_XCNT(b.x)], 1u);
    return b;
}
__device__ __forceinline__ void xcd_barrier_complete(unsigned* bar, unsigned x, unsigned& nloc, unsigned& nx) {
    const unsigned G = gridDim.x * gridDim.y * gridDim.z;
    unsigned sum, cnt, mine, sp = 0u;
    for (;;) {
        sum = 0u; cnt = 0u; mine = 0u;
#pragma unroll
        for (unsigned j = 0; j < 16; ++j) { const unsigned c = xb_ld(&bar[XB_XCNT(j)]); sum += c; cnt += (c > 0u) ? 1u : 0u; mine = (j == x) ? c : mine; }
        if (sum == G) break;
        __builtin_amdgcn_s_sleep(1);
        if ((++sp & 255u) == 0u) { if (xb_ld(&bar[XB_TMO])) break; if (sp > XB_SPIN_CAP) { atomicAdd(&bar[XB_TMO], 1u); break; } }
    }
    nloc = mine > 0u ? mine : 1u; nx = cnt > 0u ? cnt : 1u;
}
__device__ __forceinline__ void xcd_barrier(const XcdBarrier& b) {
    asm volatile("s_waitcnt vmcnt(0)" ::: "memory");
    __syncthreads();
    if (threadIdx.x == 0) {
        unsigned* bar = b.bar;
        __builtin_amdgcn_s_waitcnt(0);
        unsigned nloc = b.st[0], nx = b.st[1];
        if (nloc == 0u) { xcd_barrier_complete(bar, b.x, nloc, nx); b.st[0] = nloc; b.st[1] = nx; }
        const unsigned old = xb_add(&bar[XB_XSUB(b.x)], 1u);
        const unsigned gen = old / nloc;
        if (old + 1u == (gen + 1u) * nloc) {
            __builtin_amdgcn_fence(__ATOMIC_RELEASE, "agent");
            asm volatile("s_waitcnt vmcnt(0)" ::: "memory");
            const unsigned og = xb_add(&bar[XB_TOP], 1u);
            const unsigned tg = og / nx;
            if (og + 1u == (tg + 1u) * nx) xb_add(&bar[XB_TOPGEN], 1u);
            else XB_SPIN(xb_ld(&bar[XB_TOPGEN]) == tg, bar);
            __builtin_amdgcn_fence(__ATOMIC_ACQUIRE, "agent");
            xb_add(&bar[XB_XGEN(b.x)], 1u);
            asm volatile("s_waitcnt vmcnt(0)" ::: "memory");
        } else {
            XB_SPIN(xb_ld(&bar[XB_XGEN(b.x)]) == gen, bar);
            __builtin_amdgcn_fence(__ATOMIC_ACQUIRE, "agent");
            asm volatile("s_waitcnt vmcnt(0)" ::: "memory");
        }
    }
    __syncthreads();
}

constexpr int NWAVES = 8;
struct Frame {
    LAS unsigned char* lds;
    unsigned* ctl;
    int tid, lane, wave, vcu, G;
    const float *x, *mem, *norm1_g, *w_in, *q_norm_g, *k_norm_g, *conv_w, *mem_norm_g, *w_mem_kv, *mem_q_norm_g, *mem_k_norm_g, *out_norm_g, *w_out, *norm2_g,
                *w_rg, *b_rg, *w_re, *b_re, *w_gate, *w_up, *w_down;
    float* out; unsigned char* ws;
};

__device__ __forceinline__ void p0_transpose_item(const float* W, int N, int k0, int n0, const float* ks, bf16* dst, int pitch, LAS float* scr, int lane) {
#pragma unroll 8
    for (int i = 0; i < 32; ++i) { const int kk = 2 * i + (lane >> 5); scr[kk * 33 + (lane & 31)] = __builtin_nontemporal_load(W + (size_t)(k0 + kk) * N + n0 + (lane & 31)); }
    const int c = lane & 7;
    float g[8];
#pragma unroll
    for (int j = 0; j < 8; ++j) g[j] = ks ? ks[k0 + 8 * c + j] : 1.0f;
    LDS_WAIT(); asm volatile("" ::: "memory");
#pragma unroll
    for (int j = 0; j < 4; ++j) { const int n = (lane >> 3) + 8 * j; const LAS float* s = scr + (8 * c) * 33 + n;
        v4u o; o.x = pk2(s[0 * 33] * g[0], s[1 * 33] * g[1]); o.y = pk2(s[2 * 33] * g[2], s[3 * 33] * g[3]); o.z = pk2(s[4 * 33] * g[4], s[5 * 33] * g[5]); o.w = pk2(s[6 * 33] * g[6], s[7 * 33] * g[7]);
        *(GAS v4u*)(dst + (size_t)n * pitch + k0 + 8 * c) = o; }
    LDS_WAIT(); asm volatile("" ::: "memory");
}
__device__ __forceinline__ void rms_row_to_bf16(const float* xrow, const float* gain, bf16* orow, int lane) {
    const GAS f32x4* xr = (const GAS f32x4*)xrow + lane; const GAS f32x4* gr = (const GAS f32x4*)gain + lane;
    f32x4 v[8]; float s = 0.f;
#pragma unroll
    for (int j = 0; j < 8; ++j) { v[j] = __builtin_nontemporal_load(xr + 64 * j); s += (v[j].x * v[j].x + v[j].y * v[j].y) + (v[j].z * v[j].z + v[j].w * v[j].w); }
    const float rstd = 1.0f / sqrtf(wave_sum(s) * (1.f / D) + EPS);
    GAS v2u* o8 = (GAS v2u*)orow + lane;
#pragma unroll
    for (int j = 0; j < 8; ++j) { const f32x4 gg = gr[64 * j]; v2u o; o.x = pk2(v[j].x * rstd * gg.x, v[j].y * rstd * gg.y); o.y = pk2(v[j].z * rstd * gg.z, v[j].w * rstd * gg.w); o8[64 * j] = o; }
}
__device__ __forceinline__ void p0_transpose_item_q(const float* W, int N, int k0, int n0, const float* ks, float sc, unsigned char* dst, int pitch, LAS float* scr, int lane) {
#pragma unroll 8
    for (int i = 0; i < 64; ++i) { const int kk = 2 * i + (lane >> 5); scr[kk * 33 + (lane & 31)] = __builtin_nontemporal_load(W + (size_t)(k0 + kk) * N + n0 + (lane & 31)); }
    const int c = lane & 15;
    float g[8];
#pragma unroll
    for (int j = 0; j < 8; ++j) g[j] = ks ? ks[k0 + 8 * c + j] * sc : sc;
    LDS_WAIT(); asm volatile("" ::: "memory");
#pragma unroll
    for (int j = 0; j < 8; ++j) { const int n = (lane >> 4) + 4 * j; const LAS float* s = scr + (8 * c) * 33 + n;
        v2u o; o.x = pk_fp8x4(s[0 * 33] * g[0], s[1 * 33] * g[1], s[2 * 33] * g[2], s[3 * 33] * g[3]); o.y = pk_fp8x4(s[4 * 33] * g[4], s[5 * 33] * g[5], s[6 * 33] * g[6], s[7 * 33] * g[7]);
        __builtin_nontemporal_store(o, (GAS v2u*)(dst + (size_t)n * pitch + k0 + 8 * c)); }
    LDS_WAIT(); asm volatile("" ::: "memory");
}
__device__ __forceinline__ void p0_item_q64(const float* W, int N, int k0, int n0, const float* ks, float sc, unsigned char* dst, int pitch, LAS unsigned char* scr, int lane) {
    const GAS float* src = (const GAS float*)(W + (size_t)k0 * N + n0 + lane);
    float g0 = sc, g1 = sc;
    if (ks) { g0 = ks[k0 + lane] * sc; g1 = ks[k0 + 64 + lane] * sc; }
#pragma unroll
    for (int h = 0; h < 2; ++h) {
        float v[64];
#pragma unroll
        for (int i = 0; i < 64; ++i) v[i] = __builtin_nontemporal_load(src + (size_t)(64 * h + i) * N);
        const float gh = h ? g1 : g0;
#pragma unroll
        for (int q = 0; q < 4; ++q) { v4u o;
#pragma unroll
            for (int d = 0; d < 4; ++d) { const int i = 16 * q + 4 * d;
                const float s0 = __builtin_bit_cast(float, __builtin_amdgcn_readlane(__builtin_bit_cast(int, gh), i)), s1 = __builtin_bit_cast(float, __builtin_amdgcn_readlane(__builtin_bit_cast(int, gh), i + 1));
                const float s2 = __builtin_bit_cast(float, __builtin_amdgcn_readlane(__builtin_bit_cast(int, gh), i + 2)), s3 = __builtin_bit_cast(float, __builtin_amdgcn_readlane(__builtin_bit_cast(int, gh), i + 3));
                o[d] = pk_fp8x4(v[i] * s0, v[i + 1] * s1, v[i + 2] * s2, v[i + 3] * s3); }
            *(LAS v4u*)(scr + lane * 144 + (4 * h + q) * 16) = o; }
    }
    LDS_WAIT(); asm volatile("" ::: "memory");
#pragma unroll
    for (int i = 0; i < 8; ++i) { const int row = 8 * i + (lane >> 3), ch = lane & 7;
        const v4u w = *(const LAS v4u*)(scr + row * 144 + ch * 16);
        __builtin_nontemporal_store(w, (GAS v4u*)(dst + (size_t)row * pitch + k0 + ch * 16)); }
    LDS_WAIT(); asm volatile("" ::: "memory");
}
__device__ __forceinline__ void p0_prologue(Frame& F) {
    LAS float* scr = (LAS float*)(F.lds + F.wave * 16896);
    const int gw = F.vcu * NWAVES + F.wave, NGW = F.G * NWAVES;
    bf16* Win_t = (bf16*)(F.ws + WS_WIN); bf16* Wmkv_t = (bf16*)(F.ws + WS_WMKV); bf16* Wout_t = (bf16*)(F.ws + WS_WOUT);
    constexpr int I_IN = 32 * 160, I_MKV = 32 * 32, I_OUT = 32 * 64;
    constexpr int NITEMS = I_IN + I_MKV + I_OUT;
    for (int it = gw; it < NITEMS; it += NGW) {
        int r = it;
        if (r < I_IN) { const int kb = r / 160, nb = r % 160; p0_transpose_item(F.w_in, PROJ, 64 * kb, 32 * nb, nullptr, Win_t + (size_t)(32 * nb) * D, D, scr, F.lane); continue; } r -= I_IN;
        if (r < I_MKV) { const int kb = r / 32, nb = r % 32; p0_transpose_item(F.w_mem_kv, 1024, 64 * kb, 32 * nb, nullptr, Wmkv_t + (size_t)(32 * nb) * D, D, scr, F.lane); continue; } r -= I_MKV;
        { const int kb = r / 64, nb = r % 64; p0_transpose_item(F.w_out, D, 64 * kb, 32 * nb, nullptr, Wout_t + (size_t)(32 * nb) * D, D, scr, F.lane); }
    }
    { unsigned char* Wgu_q = (unsigned char*)(F.ws + WS_WGU); unsigned char* Wd_q = (unsigned char*)(F.ws + WS_WD); LAS unsigned char* scq = F.lds + F.wave * 16896;
      constexpr int IPE = 256 + 256 + 256;
#pragma unroll 1
      for (int it = gw; it < 64 * IPE; it += NGW) { const int e = it / IPE; int r = it - e * IPE;
          if (r < 512) { const int up = r >> 8, q = r & 255, kb = q >> 4, nb = q & 15, n0 = 64 * nb;
              const float* W = (up ? F.w_up : F.w_gate) + (size_t)e * D * DEXP; const int drow = 256 * (n0 >> 7) + 128 * up + (n0 & 127);
              p0_item_q64(W, DEXP, 128 * kb, n0, F.norm2_g, SC_WGU, Wgu_q + ((size_t)e * 2048 + drow) * D, D, scq, F.lane); }
          else { const int q = r - 512, kb = q >> 5, nb = q & 31;
              p0_item_q64(F.w_down + (size_t)e * DEXP * D, D, 128 * kb, 64 * nb, nullptr, SC_WD, Wd_q + ((size_t)e * 2048 + 64 * nb) * DEXP, DEXP, scq, F.lane); } } }
    { bf16* WT = (bf16*)(F.ws + WS_WR); const int gt = (F.vcu * NWAVES + F.wave) * 64 + F.lane, NT = F.G * NWAVES * 64;
      for (int i = gt; i < 96 * 2048; i += NT) { const int n = i >> 11, k = i & 2047;
          float w = n < 64 ? F.w_re[k * 64 + n] : (n < 72 ? F.w_rg[k * 8 + (n - 64)] : 0.f); w *= F.norm2_g[k];
          const unsigned h = f2bf(w); const float hf = __builtin_bit_cast(float, h << 16);
          WT[i] = (bf16)h; WT[96 * 2048 + i] = (bf16)f2bf(w - hf); } }
    bf16* H = (bf16*)(F.ws + WS_H);
    for (int m = gw; m < T + 512; m += NGW) {
        if (m < T) rms_row_to_bf16(F.x + (size_t)m * D, F.norm1_g, H + (size_t)m * D, F.lane);
        else rms_row_to_bf16(F.mem + (size_t)(m - T) * D, F.mem_norm_g, H + (size_t)m * D, F.lane);
    }
}

namespace att {
constexpr int LDS_K = 0, LDS_V = 65536, LDS_STG = 131072, LDS_LI = LDS_STG + 16384, LDS_GT = LDS_LI + 8 * 256;
constexpr float CS = 0.08838834764831845f * LOG2E;
#define KSWZ(row, colB) ((row) * 256 + ((colB) ^ (((row) & 7) << 4)))
__device__ __forceinline__ int crow(int r, int hi) { return (r & 3) + 8 * (r >> 2) + 4 * hi; }
__device__ __forceinline__ int v_rd_base(int lane) { return ((lane & 3) << 3) | (((lane >> 2) & 3) << 6) | (((lane >> 4) & 1) << 5) | (((lane >> 5) & 1) << 8); }
template <int OFF> __device__ __forceinline__ s16x4 tr_read(int vb) { s16x4 r; asm volatile("ds_read_b64_tr_b16 %0, %1 offset:%2" : "=&v"(r) : "v"(vb), "i"(OFF) : "memory"); return r; }

struct RowMap { const char* base; long stride; int win0; bool wrap; };
__device__ __forceinline__ const char* rowptr(const RowMap& m, int p) { int sp = m.wrap ? m.win0 + ((p - m.win0) & 255) : p; sp = sp < 0 ? 0 : sp; return m.base + (long)sp * m.stride; }

__device__ __forceinline__ void dma_k(LAS unsigned char* Kl, int p0, int nrows, const RowMap& m, int wave, int lane) {
    asm volatile("" : "+v"(lane));
#pragma unroll 1
    for (int i = 0; i < nrows / 32; ++i) {
        const int prow0 = p0 + 32 * i + 4 * wave, prow = prow0 + (lane >> 4);
        const char* src = rowptr(m, prow) + (((lane & 15) ^ (prow & 7)) << 4);
        __builtin_amdgcn_global_load_lds((const unsigned*)src, (LAS unsigned*)(Kl + prow0 * 256), 16, 0, 0);
    }
}
__device__ __forceinline__ void dma_v(LAS unsigned char* Vl, int p0, int nrows, const RowMap& m, int wave, int lane) {
    asm volatile("" : "+v"(lane));
#pragma unroll 1
    for (int i = 0; i < nrows / 32; ++i) {
        const int ii = wave + 8 * i, g = (p0 >> 4) + (ii >> 2), q = ii & 3;
        const int kk = ((q >> 1) << 3) + ((lane & 31) >> 2), k = (kk & ~0xC) | ((kk & 4) << 1) | ((kk & 8) >> 1);
        const int c = 32 * (2 * (q & 1) + (lane >> 5)) + 8 * (lane & 3);
        const char* src = rowptr(m, 16 * g + k) + c * 2;
        __builtin_amdgcn_global_load_lds((const unsigned*)src, (LAS unsigned*)(Vl + g * 4096 + q * 1024), 16, 0, 0);
    }
}
__device__ __forceinline__ void dma_v2(LAS unsigned char* Vl, int p0, int nrows, const RowMap& m, int wave, int lane) {
    asm volatile("" : "+v"(lane));
#pragma unroll 1
    for (int i = 0; i < nrows / 32; ++i) {
        const int prow0 = p0 + 32 * i + 4 * wave, prow = prow0 + (lane >> 4);
        const char* src = rowptr(m, prow) + (((lane & 15) ^ ((prow & 7) << 1)) << 4);
        __builtin_amdgcn_global_load_lds((const unsigned*)src, (LAS unsigned*)(Vl + prow0 * 256), 16, 0, 0);
    }
}
__device__ __forceinline__ void load_q16(v4u (&raw)[4], const char* qrow, int kg) {
#pragma unroll
    for (int s = 0; s < 4; ++s) raw[s] = *(const GAS v4u*)(qrow + (32 * s + 8 * kg) * 2);
}
__device__ __forceinline__ void norm_q16(const v4u (&raw)[4], bf16x8 (&qr)[4], const LAS float* gt, int kg) {
    float ss = 0.f;
#pragma unroll
    for (int s = 0; s < 4; ++s)
#pragma unroll
        for (int j = 0; j < 4; ++j) { const float a = bflo(raw[s][j]), b = bfhi(raw[s][j]); ss += a * a + b * b; }
    ss += __shfl_xor(ss, 16); ss += __shfl_xor(ss, 32);
    const float rstd = 1.0f / sqrtf(ss * (1.f / HD) + EPS);
#pragma unroll
    for (int s = 0; s < 4; ++s) { const LAS f32x4* gp = (const LAS f32x4*)(gt + 32 * s + 8 * kg); const f32x4 g0 = gp[0], g1 = gp[1]; v4u o;
        o.x = cvtpk(bflo(raw[s].x) * rstd * g0.x, bfhi(raw[s].x) * rstd * g0.y); o.y = cvtpk(bflo(raw[s].y) * rstd * g0.z, bfhi(raw[s].y) * rstd * g0.w);
        o.z = cvtpk(bflo(raw[s].z) * rstd * g1.x, bfhi(raw[s].z) * rstd * g1.y); o.w = cvtpk(bflo(raw[s].w) * rstd * g1.z, bfhi(raw[s].w) * rstd * g1.w);
        qr[s] = __builtin_bit_cast(bf16x8, o); }
}
__device__ __forceinline__ void norm_k(LAS unsigned char* Kl, int p0, int nrows, const LAS float* gt, int tid) {
    asm volatile("" : "+v"(tid));
#pragma unroll 1
    for (int idx = tid; idx < nrows * 4; idx += 512) {
        const int row = p0 + (idx >> 2), qd = idx & 3;
        v4u w[4]; float ss = 0.f;
#pragma unroll
        for (int i = 0; i < 4; ++i) { w[i] = *(const LAS v4u*)(Kl + KSWZ(row, (4 * qd + i) * 16));
#pragma unroll
            for (int j = 0; j < 4; ++j) { const float a = bflo(w[i][j]), b = bfhi(w[i][j]); ss += a * a + b * b; } }
        ss += __shfl_xor(ss, 1); ss += __shfl_xor(ss, 2);
        const float rstd = 1.0f / sqrtf(ss * (1.f / HD) + EPS);
#pragma unroll
        for (int i = 0; i < 4; ++i) { const LAS f32x4* gp = (const LAS f32x4*)(gt + (4 * qd + i) * 8); const f32x4 g0 = gp[0], g1 = gp[1]; v4u o;
            o.x = cvtpk(bflo(w[i].x) * rstd * g0.x, bfhi(w[i].x) * rstd * g0.y); o.y = cvtpk(bflo(w[i].y) * rstd * g0.z, bfhi(w[i].y) * rstd * g0.w);
            o.z = cvtpk(bflo(w[i].z) * rstd * g1.x, bfhi(w[i].z) * rstd * g1.y); o.w = cvtpk(bflo(w[i].w) * rstd * g1.z, bfhi(w[i].w) * rstd * g1.w);
            *(LAS v4u*)(Kl + KSWZ(row, (4 * qd + i) * 16)) = o; }
    }
}
__device__ __forceinline__ float xsum32(float v) { unsigned a = __builtin_bit_cast(unsigned, v), b = a; asm volatile("s_nop 1\n\tv_permlane32_swap_b32 %0, %1" : "+v"(a), "+v"(b)); return __builtin_bit_cast(float, a) + __builtin_bit_cast(float, b); }
__device__ __forceinline__ void load_q(v4u (&raw)[8], const char* qrow, int hi) {
#pragma unroll
    for (int d0 = 0; d0 < 8; ++d0) raw[d0] = *(const GAS v4u*)(qrow + (d0 * 16 + hi * 8) * 2);
}
__device__ __forceinline__ void norm_q(const v4u (&raw)[8], bf16x8 (&qr)[8], const LAS float* gt, int hi) {
    float ss = 0.f;
#pragma unroll
    for (int d0 = 0; d0 < 8; ++d0)
#pragma unroll
        for (int j = 0; j < 4; ++j) { const float a = bflo(raw[d0][j]), b = bfhi(raw[d0][j]); ss += a * a + b * b; }
    ss = xsum32(ss);
    const float rstd = 1.0f / sqrtf(ss * (1.f / HD) + EPS);
#pragma unroll
    for (int d0 = 0; d0 < 8; ++d0) { const LAS f32x4* gp = (const LAS f32x4*)(gt + d0 * 16 + hi * 8); const f32x4 g0 = gp[0], g1 = gp[1]; v4u o;
        o.x = cvtpk(bflo(raw[d0].x) * rstd * g0.x, bfhi(raw[d0].x) * rstd * g0.y); o.y = cvtpk(bflo(raw[d0].y) * rstd * g0.z, bfhi(raw[d0].y) * rstd * g0.w);
        o.z = cvtpk(bflo(raw[d0].z) * rstd * g1.x, bfhi(raw[d0].z) * rstd * g1.y); o.w = cvtpk(bflo(raw[d0].w) * rstd * g1.z, bfhi(raw[d0].w) * rstd * g1.w);
        qr[d0] = __builtin_bit_cast(bf16x8, o); }
}
__device__ __forceinline__ f32x16 qk_tile(const LAS unsigned char* Kl, int pb, const bf16x8 (&qr)[8], int r32, int hi) {
    f32x16 p = {};
#pragma unroll
    for (int d0 = 0; d0 < 8; ++d0) { const bf16x8 kf = *(const LAS bf16x8*)(Kl + KSWZ(pb + r32, (d0 * 16 + hi * 8) * 2));
        p = __builtin_amdgcn_mfma_f32_32x32x16_bf16(kf, qr[d0], p, 0, 0, 0); }
    return p;
}
#define PK4(P, BASE, OUT) do { unsigned a0 = cvtpk(P[BASE + 0], P[BASE + 1]), a1 = cvtpk(P[BASE + 2], P[BASE + 3]);   \
    unsigned b0 = cvtpk(P[BASE + 4], P[BASE + 5]), b1 = cvtpk(P[BASE + 6], P[BASE + 7]);                              \
    auto r0 = __builtin_amdgcn_permlane32_swap(a0, b0, false, false); auto r1 = __builtin_amdgcn_permlane32_swap(a1, b1, false, false); \
    v4u w_ = {r0[0], r1[0], r0[1], r1[1]}; OUT = __builtin_bit_cast(bf16x8, w_); } while (0)
template <int OFF> __device__ __forceinline__ void pv_step(f32x16& o, int vb, bf16x8 pa) {
    const s16x4 l = tr_read<OFF>(vb), h = tr_read<OFF + 2048>(vb);
    asm volatile("s_waitcnt lgkmcnt(0)" ::: "memory"); __builtin_amdgcn_sched_barrier(0);
    o = __builtin_amdgcn_mfma_f32_32x32x16_bf16(pa, (bf16x8){l[0], l[1], l[2], l[3], h[0], h[1], h[2], h[3]}, o, 0, 0, 0);
}
__device__ __forceinline__ void store_block(const f32x16& o, const LAS float* il, LAS unsigned short* stg, char* dst0, long rstride, int lane) {
    asm volatile("" : "+v"(lane));
    const int r32 = lane & 31, hi = lane >> 5;
#pragma unroll
    for (int r = 0; r < 16; ++r) { const int row = crow(r, hi); stg[row * 32 + r32] = (unsigned short)f2bf(o[r] * il[row]); }
    LDS_WAIT(); asm volatile("" ::: "memory");
#pragma unroll
    for (int p = 0; p < 2; ++p) { const int row = 16 * p + (lane >> 2), ch = lane & 3;
        const v4u w = *(const LAS v4u*)((const LAS unsigned char*)stg + row * 64 + ch * 16);
        *(GAS v4u*)(dst0 + (long)row * rstride + ch * 16) = w; }
    LDS_WAIT(); asm volatile("" ::: "memory");
}
}

#define RAW_BAR() do { asm volatile("s_waitcnt lgkmcnt(0)" ::: "memory"); __builtin_amdgcn_s_barrier(); asm volatile("" ::: "memory"); } while (0)
__device__ __forceinline__ void p2_attention(Frame& F) {
    using namespace att;
    LAS unsigned char* Kl = F.lds + LDS_K; LAS unsigned char* Vl = F.lds + LDS_V;
    LAS unsigned short* stg = (LAS unsigned short*)(F.lds + LDS_STG + F.wave * 2048);
    LAS float* li = (LAS float*)(F.lds + LDS_LI + F.wave * 256);
    LAS float* gtab = (LAS float*)(F.lds + LDS_GT);
    LAS float* rk = (LAS float*)(F.lds + LDS_GT + 2048);
    volatile LAS int* QN = (volatile LAS int*)(F.lds + LDS_GT + 2048 + 1024);
    const int tid = F.tid, wave = F.wave;
    if (blockIdx.x < 8) {
        pg8::Gemm g{(const bf16*)(F.ws + WS_H), (const bf16*)(F.ws + WS_WIN), D, nullptr}; pg8::P1Order S{F.G, (int)blockIdx.x, 2560, 2568};
        pg8::EpiProj E{(bf16*)(F.ws + WS_R1), (bf16*)(F.ws + WS_MEMKV)};
        pg8::gemm_phase<pg8::EpiProj, pg8::P1Order>(F.lds, g, S, E);
        VM_WAIT(); __syncthreads();
        if (tid == 0) { __builtin_amdgcn_fence(__ATOMIC_RELEASE, "agent"); asm volatile("s_waitcnt vmcnt(0)" ::: "memory"); __hip_atomic_fetch_add(F.ctl + CW_KVREADY, 1u, RLX_AGENT); }
    }
    if (tid < 128) { gtab[tid] = F.q_norm_g[tid] * F.k_norm_g[tid]; gtab[128 + tid] = F.mem_q_norm_g[tid] * F.mem_k_norm_g[tid]; gtab[256 + tid] = F.mem_q_norm_g[tid]; gtab[384 + tid] = F.mem_k_norm_g[tid]; }
    if (tid == 0) QN[0] = 1 << 30;
    __syncthreads();
    float MD, MM;
    { float a = 0.f, c = 0.f;
#pragma unroll 1
      for (int i = 0; i < 128; ++i) { a = fmaxf(a, fabsf(gtab[i])); c = fmaxf(c, fabsf(gtab[128 + i])); }
      MD = a * (128.0f * 1.03f) * CS; MM = c * (128.0f * 1.03f) * CS; }
    const char* proj = (const char*)(F.ws + WS_R1);

    {
    const int j = wave & 3, dh = wave >> 2, w0 = 32 * j + 16 * dh;
    constexpr int NCHUNK = 6144 / 4;
    v4u qraw[4];
#define DECODE(u, br, b, h, r, nb, dil) const int br = (u) >> 11, _rem = (u) & 2047, b = _rem >> 10, h = (_rem >> 7) & 7, _w = _rem & 127, dil = 1 << (2 * br), _nps = 128 >> (2 * br), r = _w / _nps, nb = _w % _nps
    int u = 4 * F.vcu;
    bool have = F.vcu < NCHUNK;
    bool full = true;
    if (have) {
        DECODE(u, br, b, h, r, nb, dil);
        const long rs = (long)dil * PROJ * 2; const char* tb = proj + (size_t)(b * SEQ + r) * (PROJ * 2);
        RowMap mk{tb + (COL_K + h * HD) * 2, rs, 128 * nb - 128, true};
        dma_k(Kl, 0, 256, mk, wave, F.lane);
        load_q16(qraw, tb + (long)(128 * nb + w0 + (F.lane & 15)) * rs + (COL_Q + h * HD) * 2, F.lane >> 4);
    }
    while (have) {
        DECODE(u, br, b, h, r, nb, dil);
        int lane = F.lane; asm volatile("" : "+v"(lane));
        const int q16 = lane & 15, kg = lane >> 4;
        const int off = 128 * ((nb + 1) & 1);
        const long rs_ = (long)dil * PROJ * 2; const char* tb_ = proj + (size_t)(b * SEQ + r) * (PROJ * 2);
        asm volatile("s_waitcnt vmcnt(0)" ::: "memory"); RAW_BAR();
        { RowMap mv{tb_ + (COL_V + h * HD) * 2, rs_, 128 * nb - 128, true};
          if (full) dma_v2(Vl, 0, 256, mv, wave, lane); else dma_v2(Vl, 128 * (nb & 1), 128, mv, wave, lane); }
        if ((u & 3) == 0 && tid == 0) QN[0] = F.G + (int)__hip_atomic_fetch_add(F.ctl + CW_ATTQ, 1u, RLX_AGENT);
        { const int p0 = full ? 0 : 128 * (nb & 1), n4 = full ? 1024 : 512;
#pragma unroll 1
          for (int idx = tid; idx < n4; idx += 512) { const int row = p0 + (idx >> 2), qd = idx & 3; float ss = 0.f;
#pragma unroll
              for (int i = 0; i < 4; ++i) { const v4u w = *(const LAS v4u*)(Kl + KSWZ(row, (4 * qd + i) * 16));
#pragma unroll
                  for (int jj = 0; jj < 4; ++jj) { const float a = bflo(w[jj]), c = bfhi(w[jj]); ss += a * a + c * c; } }
              ss += __shfl_xor(ss, 1); ss += __shfl_xor(ss, 2);
              if (qd == 0) rk[row] = 1.0f / sqrtf(ss * (1.f / HD) + EPS); } }
        bf16x8 qr[4];
        norm_q16(qraw, qr, gtab, kg);
        f32x4 s[9];
#pragma unroll
        for (int t = 0; t < 9; ++t) { const int pb = (w0 + 16 * t + off) & 255; f32x4 a = {0.f, 0.f, 0.f, 0.f};
#pragma unroll
            for (int d = 0; d < 4; ++d) { const bf16x8 kf = *(const LAS bf16x8*)(Kl + KSWZ(pb + q16, 64 * d + 16 * kg));
                a = __builtin_amdgcn_mfma_f32_16x16x32_bf16(kf, qr[d], a, 0, 0, 0); }
            s[t] = a; }
        RAW_BAR();
        int un = u + 1; bool has_next = true;
        if ((un & 3) == 0) { const int nc = QN[0]; has_next = nc < NCHUNK; un = 4 * nc; }
        bool n_full = false;
        if (has_next) {
            DECODE(un, br2, b2, h2, r2, nb2, dil2);
            n_full = (un != u + 1) || (nb2 == 0);
            const long rs = (long)dil2 * PROJ * 2; const char* tb = proj + (size_t)(b2 * SEQ + r2) * (PROJ * 2);
            RowMap nmk{tb + (COL_K + h2 * HD) * 2, rs, 128 * nb2 - 128, true};
            if (n_full) dma_k(Kl, 0, 256, nmk, wave, lane); else dma_k(Kl, 128 * (nb2 & 1), 128, nmk, wave, lane);
            load_q16(qraw, tb + (long)(128 * nb2 + w0 + q16) * rs + (COL_Q + h2 * HD) * 2, kg);
        }
        const float bias2 = __builtin_amdgcn_exp2f(-(float)(h + 1)) * (float)dil * LOG2E;
        const float rowoff = bias2 * (float)(4 * kg - q16 - 128) - MD;
        float l = 0.f;
#pragma unroll
        for (int t = 0; t < 9; ++t) {
            const int pb = (w0 + 16 * t + off) & 255;
            const f32x4 rkv = *(const LAS f32x4*)(rk + pb + 4 * kg);
            const bool dead = (nb == 0) && (w0 + 16 * t < 128);
#pragma unroll
            for (int r_ = 0; r_ < 4; ++r_) {
                float v = fmaf(s[t][r_] * rkv[r_], CS, fmaf(bias2, (float)(16 * t + r_), rowoff));
                if (t == 0) v = (4 * kg + r_ >= q16) ? v : -1.0e30f;
                if (t == 8) v = (4 * kg + r_ <= q16) ? v : -1.0e30f;
                v = dead ? 0.f : __builtin_amdgcn_exp2f(v); s[t][r_] = v; l += v; }
        }
        l += __shfl_xor(l, 16); l += __shfl_xor(l, 32);
        bf16x8 pa[5];
#pragma unroll
        for (int sp = 0; sp < 5; ++sp) { v4u w; w.x = cvtpk(s[2 * sp][0], s[2 * sp][1]); w.y = cvtpk(s[2 * sp][2], s[2 * sp][3]);
            if (sp < 4) { w.z = cvtpk(s[2 * sp + 1][0], s[2 * sp + 1][1]); w.w = cvtpk(s[2 * sp + 1][2], s[2 * sp + 1][3]); } else { w.z = 0u; w.w = 0u; }
            pa[sp] = __builtin_bit_cast(bf16x8, w); }
        if (has_next) asm volatile("s_waitcnt vmcnt(8)" ::: "memory"); else asm volatile("s_waitcnt vmcnt(0)" ::: "memory");
        RAW_BAR();
        f32x4 o[8];
#pragma unroll
        for (int db = 0; db < 8; ++db) o[db] = (f32x4){0.f, 0.f, 0.f, 0.f};
        { const int qq = q16 >> 2, pp = q16 & 3;
#pragma unroll
          for (int sp = 0; sp < 5; ++sp) {
              const int ra = (w0 + 32 * sp + off + 4 * kg + qq) & 255, rb = (w0 + 32 * sp + 16 + off + 4 * kg + qq) & 255;
              const int va = (int)(uintptr_t)Vl + ra * 256 + 8 * pp, vb = (int)(uintptr_t)Vl + rb * 256 + 8 * pp, xa = (ra & 7) << 5, xb = (rb & 7) << 5;
#pragma unroll
              for (int dq = 0; dq < 2; ++dq) {
                  s16x4 la[4], lb[4];
#pragma unroll
                  for (int i = 0; i < 4; ++i) { const int db = 4 * dq + i;
                      asm volatile("ds_read_b64_tr_b16 %0, %1" : "=&v"(la[i]) : "v"(va + ((32 * db) ^ xa)) : "memory");
                      asm volatile("ds_read_b64_tr_b16 %0, %1" : "=&v"(lb[i]) : "v"(vb + ((32 * db) ^ xb)) : "memory"); }
                  asm volatile("s_waitcnt lgkmcnt(0)" ::: "memory"); __builtin_amdgcn_sched_barrier(0);
#pragma unroll
                  for (int i = 0; i < 4; ++i) { const int db = 4 * dq + i;
                      o[db] = __builtin_amdgcn_mfma_f32_16x16x32_bf16(pa[sp], (bf16x8){la[i][0], la[i][1], la[i][2], la[i][3], lb[i][0], lb[i][1], lb[i][2], lb[i][3]}, o[db], 0, 0, 0); }
              } } }
        const float il = 1.0f / l;
        if (kg == 0) li[q16] = il;
        LDS_WAIT(); asm volatile("" ::: "memory");
        const f32x4 ilr = *(const LAS f32x4*)(li + 4 * kg);
        const int tok0 = b * SEQ + r + dil * (128 * nb + w0);
        char* dst = (char*)(F.ws + WS_OPART) + ((size_t)br * T + tok0) * (ATTN_W * 2) + (h * HD) * 2;
#pragma unroll
        for (int hf = 0; hf < 2; ++hf) {
#pragma unroll
            for (int i = 0; i < 4; ++i)
#pragma unroll
                for (int r_ = 0; r_ < 4; ++r_) stg[(4 * kg + r_) * 64 + 16 * i + q16] = (unsigned short)f2bf(o[4 * hf + i][r_] * ilr[r_]);
            LDS_WAIT(); asm volatile("" ::: "memory");
#pragma unroll
            for (int p = 0; p < 2; ++p) { const int row = lane >> 2, ch = (lane & 3) + 4 * p;
                const v4u w = *(const LAS v4u*)((const LAS unsigned char*)stg + row * 128 + ch * 16);
                *(GAS v4u*)(dst + (long)row * ((long)dil * ATTN_W * 2) + hf * 128 + ch * 16) = w; }
            LDS_WAIT(); asm volatile("" ::: "memory");
        }
        if (kg == 0) ((float*)(F.ws + WS_LSE))[((size_t)br * T + tok0 + dil * q16) * 8 + h] = MD + __builtin_amdgcn_logf(l);
        have = has_next; u = un; full = n_full;
    }
#undef DECODE
    }

    VM_WAIT(); __syncthreads();
    if (wave == 0) { unsigned sp = 0;
        while (__builtin_amdgcn_readfirstlane(__hip_atomic_load(F.ctl + CW_KVREADY, RLX_AGENT)) < 8u) { __builtin_amdgcn_s_sleep(2); if (++sp > (1u << 22)) { if (F.lane == 0) __hip_atomic_store(F.ctl + CW_TMO, 1u, RLX_AGENT); break; } }
        __builtin_amdgcn_fence(__ATOMIC_ACQUIRE, "agent"); asm volatile("s_waitcnt vmcnt(0)" ::: "memory"); }
    __syncthreads();
    for (int it = F.vcu; it < 256; it += F.G) {
        const int combo = it >> 5, part = it & 31, b = combo >> 2, hm = combo & 3;
        const char* mkv = (const char*)(F.ws + WS_MEMKV) + (size_t)(b * NMEM) * 2048 + hm * 256;
        RowMap mk{mkv, 2048, 0, false}, mv{mkv + 1024, 2048, 0, false};
        __syncthreads();
        dma_k(Kl, 0, 256, mk, wave, F.lane); dma_v(Vl, 0, 256, mv, wave, F.lane);
        VM_WAIT(); __syncthreads();
        norm_k(Kl, 0, 256, gtab + 384, tid);
        __syncthreads();
        for (int qb = 0; qb < 2; ++qb) {
            int lane = F.lane; asm volatile("" : "+v"(lane));
            const int r32 = lane & 31, hi = lane >> 5, vbase = (int)(uintptr_t)Vl + v_rd_base(lane);
            const int tok = b * SEQ + part * 512 + qb * 256 + wave * 32 + r32;
            v4u raw[8]; bf16x8 qr[8];
            load_q(raw, proj + (size_t)tok * (PROJ * 2) + (COL_MQ + hm * HD) * 2, hi);
            norm_q(raw, qr, gtab + 256, hi);
            const float mc = -MM; float l = 0.f;
            f32x16 o[4] = {};
#pragma unroll 1
            for (int hk = 0; hk < 2; ++hk) {
                bf16x8 pa[8];
#pragma unroll
                for (int kt = 0; kt < 4; ++kt) { f32x16 s = qk_tile(Kl, 128 * hk + 32 * kt, qr, r32, hi);
#pragma unroll
                    for (int r = 0; r < 16; ++r) { s[r] = __builtin_amdgcn_exp2f(fmaf(s[r], CS, mc)); l += s[r]; }
                    PK4(s, 0, pa[2 * kt]); PK4(s, 8, pa[2 * kt + 1]); }
#pragma unroll
                for (int f = 0; f < 8; ++f) { const int vb = vbase + (8 * hk + f) * 4096;
                    pv_step<0>(o[0], vb, pa[f]); pv_step<512>(o[1], vb, pa[f]); pv_step<1024>(o[2], vb, pa[f]); pv_step<1536>(o[3], vb, pa[f]); }
            }
            l = xsum32(l);
            if (hi == 0) li[r32] = 1.0f / l;
            LDS_WAIT(); asm volatile("" ::: "memory");
            char* dst = (char*)(F.ws + WS_MEMO) + (size_t)(tok - r32) * (MEM_W * 2) + hm * 256;
#pragma unroll
            for (int d0 = 0; d0 < 4; ++d0) store_block(o[d0], li, stg, dst + d0 * 64, MEM_W * 2, lane);
        }
    }
}

__device__ __forceinline__ void unpack8(const v4u w, float (&f)[8]) { f[0] = bflo(w.x); f[1] = bfhi(w.x); f[2] = bflo(w.y); f[3] = bfhi(w.y); f[4] = bflo(w.z); f[5] = bfhi(w.z); f[6] = bflo(w.w); f[7] = bfhi(w.w); }
__device__ __forceinline__ void p3_combine(Frame& F) {
    const int gw = F.vcu * NWAVES + F.wave, NGW = F.G * NWAVES, lane = F.lane;
    const bf16* proj = (const bf16*)(F.ws + WS_R1); const bf16* opart = (const bf16*)(F.ws + WS_OPART); const float* lse = (const float*)(F.ws + WS_LSE);
    const bf16* memo = (const bf16*)(F.ws + WS_MEMO); bf16* Y = (bf16*)(F.ws + WS_Y);
    for (int t = gw; t < T; t += NGW) {
        float a[16]; float ssa = 0.f;
#pragma unroll
        for (int cc = 0; cc < 2; ++cc) { const int head = 4 * cc + (lane >> 4);
            const float l0 = lse[((size_t)0 * T + t) * 8 + head], l1 = lse[((size_t)1 * T + t) * 8 + head], l2 = lse[((size_t)2 * T + t) * 8 + head];
            const float mx = fmaxf(l0, fmaxf(l1, l2)); float w0 = __builtin_amdgcn_exp2f(l0 - mx), w1 = __builtin_amdgcn_exp2f(l1 - mx), w2 = __builtin_amdgcn_exp2f(l2 - mx);
            const float inv = 1.0f / (w0 + w1 + w2); w0 *= inv; w1 *= inv; w2 *= inv;
            float f0[8], f1[8], f2[8];
            unpack8(__builtin_nontemporal_load((const GAS v4u*)(opart + ((size_t)0 * T + t) * ATTN_W + cc * 512 + 8 * lane)), f0);
            unpack8(__builtin_nontemporal_load((const GAS v4u*)(opart + ((size_t)1 * T + t) * ATTN_W + cc * 512 + 8 * lane)), f1);
            unpack8(__builtin_nontemporal_load((const GAS v4u*)(opart + ((size_t)2 * T + t) * ATTN_W + cc * 512 + 8 * lane)), f2);
#pragma unroll
            for (int jj = 0; jj < 8; ++jj) { const float v = w0 * f0[jj] + w1 * f1[jj] + w2 * f2[jj]; a[8 * cc + jj] = v; ssa += v * v; } }
        float co[8]; float ssc = 0.f;
        { const int s = t & (SEQ - 1); float bg[8], c0[8], uu0[8], c1[8], uu1[8], c2[8], uu2[8];
          const bf16* p0 = proj + (size_t)t * PROJ + 8 * lane;
          unpack8(*(const GAS v4u*)(p0 + COL_B), bg); unpack8(*(const GAS v4u*)(p0 + COL_C), c0); unpack8(*(const GAS v4u*)(p0 + COL_U), uu0);
          if (s >= 1) { unpack8(*(const GAS v4u*)(p0 - PROJ + COL_C), c1); unpack8(*(const GAS v4u*)(p0 - PROJ + COL_U), uu1); }
          if (s >= 2) { unpack8(*(const GAS v4u*)(p0 - 2 * PROJ + COL_C), c2); unpack8(*(const GAS v4u*)(p0 - 2 * PROJ + COL_U), uu2); }
#pragma unroll
          for (int jj = 0; jj < 8; ++jj) { const int c = 8 * lane + jj;
              const float z0 = c0[jj] * uu0[jj], z1 = (s >= 1) ? c1[jj] * uu1[jj] : 0.f, z2 = (s >= 2) ? c2[jj] * uu2[jj] : 0.f;
              const float v = bg[jj] * (F.conv_w[c] * z2 + F.conv_w[CONV_W + c] * z1 + F.conv_w[2 * CONV_W + c] * z0); co[jj] = v; ssc += v * v; } }
        float mo[8]; float ssm = 0.f;
        unpack8(__builtin_nontemporal_load((const GAS v4u*)(memo + (size_t)t * MEM_W + 8 * lane)), mo);
#pragma unroll
        for (int jj = 0; jj < 8; ++jj) ssm += mo[jj] * mo[jj];
#pragma unroll
        for (int o = 1; o < 64; o <<= 1) { ssa += __shfl_xor(ssa, o); ssc += __shfl_xor(ssc, o); ssm += __shfl_xor(ssm, o); }
        const float ra = 1.0f / sqrtf(ssa * (1.f / ATTN_W) + EPS), rc = 1.0f / sqrtf(ssc * (1.f / CONV_W) + EPS), rm = 1.0f / sqrtf(ssm * (1.f / MEM_W) + EPS);
        bf16* yr = Y + (size_t)t * D;
#pragma unroll
        for (int cc = 0; cc < 2; ++cc) { const float* g = F.out_norm_g + cc * 512 + 8 * lane; v4u w;
            w.x = pk2(a[8 * cc + 0] * ra * g[0], a[8 * cc + 1] * ra * g[1]); w.y = pk2(a[8 * cc + 2] * ra * g[2], a[8 * cc + 3] * ra * g[3]);
            w.z = pk2(a[8 * cc + 4] * ra * g[4], a[8 * cc + 5] * ra * g[5]); w.w = pk2(a[8 * cc + 6] * ra * g[6], a[8 * cc + 7] * ra * g[7]);
            *(GAS v4u*)(yr + cc * 512 + 8 * lane) = w; }
        { const float* g = F.out_norm_g + ATTN_W + 8 * lane; v4u w;
          w.x = pk2(co[0] * rc * g[0], co[1] * rc * g[1]); w.y = pk2(co[2] * rc * g[2], co[3] * rc * g[3]); w.z = pk2(co[4] * rc * g[4], co[5] * rc * g[5]); w.w = pk2(co[6] * rc * g[6], co[7] * rc * g[7]);
          *(GAS v4u*)(yr + ATTN_W + 8 * lane) = w; }
        { const float* g = F.out_norm_g + ATTN_W + CONV_W + 8 * lane; v4u w;
          w.x = pk2(mo[0] * rm * g[0], mo[1] * rm * g[1]); w.y = pk2(mo[2] * rm * g[2], mo[3] * rm * g[3]); w.z = pk2(mo[4] * rm * g[4], mo[5] * rm * g[5]); w.w = pk2(mo[6] * rm * g[6], mo[7] * rm * g[7]);
          *(GAS v4u*)(yr + ATTN_W + CONV_W + 8 * lane) = w; }
    }
}

__device__ __forceinline__ float max8(float v) { v = fmaxf(v, __shfl_xor(v, 1)); v = fmaxf(v, __shfl_xor(v, 2)); v = fmaxf(v, __shfl_xor(v, 4)); return v; }
namespace rt {
constexpr int KC = 128, NCH = D / KC, BP = KC * 2 + 16, BUFB = 2 * 96 * BP;
__device__ __forceinline__ void issue_b(v4u (&bst)[6], const bf16* WT, int c, int tid) {
#pragma unroll
    for (int i = 0; i < 6; ++i) { const int p = tid + 512 * i, arr = p / 1536, rem = p - arr * 1536, n = rem >> 4, ch = rem & 15;
        bst[i] = *(const GAS v4u*)(WT + ((size_t)arr * 96 + n) * 2048 + c * KC + ch * 8); }
}
__device__ __forceinline__ void write_b(const v4u (&bst)[6], LAS unsigned char* buf, int tid) {
#pragma unroll
    for (int i = 0; i < 6; ++i) { const int p = tid + 512 * i, arr = p / 1536, rem = p - arr * 1536, n = rem >> 4, ch = rem & 15;
        *(LAS v4u*)(buf + arr * (96 * BP) + n * BP + ch * 16) = bst[i]; }
}
__device__ __forceinline__ void issue_a(f32x4 (&a)[4][2], const float* xrow, int c) {
#pragma unroll
    for (int ks = 0; ks < 4; ++ks) { a[ks][0] = *(const GAS f32x4*)(xrow + c * KC + ks * 32); a[ks][1] = *(const GAS f32x4*)(xrow + c * KC + ks * 32 + 4); }
}
__device__ __forceinline__ void compute(f32x4 (&acc)[6], float& ss, const f32x4 (&a)[4][2], const LAS unsigned char* buf, int fr, int kg) {
#pragma unroll
    for (int ks = 0; ks < 4; ++ks) {
        const f32x4 f0 = a[ks][0], f1 = a[ks][1];
        ss += (f0.x * f0.x + f0.y * f0.y) + (f0.z * f0.z + f0.w * f0.w) + (f1.x * f1.x + f1.y * f1.y) + (f1.z * f1.z + f1.w * f1.w);
        asm volatile("" : "+v"(ss));
        v4u h; h.x = cvtpk(f0.x, f0.y); h.y = cvtpk(f0.z, f0.w); h.z = cvtpk(f1.x, f1.y); h.w = cvtpk(f1.z, f1.w);
        v4u l; l.x = cvtpk(f0.x - bflo(h.x), f0.y - bfhi(h.x)); l.y = cvtpk(f0.z - bflo(h.y), f0.w - bfhi(h.y)); l.z = cvtpk(f1.x - bflo(h.z), f1.y - bfhi(h.z)); l.w = cvtpk(f1.z - bflo(h.w), f1.w - bfhi(h.w));
        const bf16x8 ah = __builtin_bit_cast(bf16x8, h), al = __builtin_bit_cast(bf16x8, l);
#pragma unroll
        for (int nb = 0; nb < 6; ++nb) { const LAS unsigned char* bp = buf + (nb * 16 + fr) * BP + (ks * 32 + 8 * kg) * 2;
            const bf16x8 bh = *(const LAS bf16x8*)bp, bl = *(const LAS bf16x8*)(bp + 96 * BP);
            acc[nb] = __builtin_amdgcn_mfma_f32_16x16x32_bf16(ah, bh, acc[nb], 0, 0, 0);
            acc[nb] = __builtin_amdgcn_mfma_f32_16x16x32_bf16(al, bh, acc[nb], 0, 0, 0);
            acc[nb] = __builtin_amdgcn_mfma_f32_16x16x32_bf16(ah, bl, acc[nb], 0, 0, 0); }
    }
}
}
__device__ __forceinline__ void p5_router(Frame& F) {
    using namespace rt;
    const int tid = F.tid, wave = F.wave;
    const float* X1 = F.out; const bf16* WT = (const bf16*)(F.ws + WS_WR);
    LAS unsigned char* Bl = F.lds;
    LAS float* Lg = (LAS float*)(F.lds + 2 * BUFB + wave * (16 * 97 * 4));
    unsigned* cnt = F.ctl + CW_CNT;
    int* tok_e = (int*)(F.ws + WS_TOK + TOK_E); int* tok_rank = (int*)(F.ws + WS_TOK + TOK_RANK);
    for (int mt = F.vcu; mt < T / 128; mt += F.G) {
        int lane = F.lane; asm volatile("" : "+v"(lane));
        const int fr = lane & 15, kg = lane >> 4;
        const int t0 = mt * 128 + wave * 16;
        const float* xrow = X1 + (size_t)(t0 + fr) * D + 8 * kg;
        f32x4 acc[6];
#pragma unroll
        for (int i = 0; i < 6; ++i) acc[i] = (f32x4){0.f, 0.f, 0.f, 0.f};
        float ss = 0.f;
        v4u bst[6]; f32x4 a0[4][2], a1[4][2];
        __syncthreads();
        issue_b(bst, WT, 0, tid); issue_a(a0, xrow, 0);
#pragma unroll 1
        for (int c = 0; c < NCH - 2; c += 2) {
            write_b(bst, Bl, tid); __syncthreads();
            issue_b(bst, WT, c + 1, tid); issue_a(a1, xrow, c + 1);
            compute(acc, ss, a0, Bl, fr, kg);
            write_b(bst, Bl + BUFB, tid); __syncthreads();
            issue_b(bst, WT, c + 2, tid); issue_a(a0, xrow, c + 2);
            compute(acc, ss, a1, Bl + BUFB, fr, kg);
        }
        write_b(bst, Bl, tid); __syncthreads();
        issue_b(bst, WT, NCH - 1, tid); issue_a(a1, xrow, NCH - 1);
        compute(acc, ss, a0, Bl, fr, kg);
        write_b(bst, Bl + BUFB, tid); __syncthreads();
        compute(acc, ss, a1, Bl + BUFB, fr, kg);
        ss += __shfl_xor(ss, 16); ss += __shfl_xor(ss, 32);
        const float rs_row = 1.0f / sqrtf(ss * (1.f / D) + EPS);
#pragma unroll
        for (int r = 0; r < 4; ++r) { const float rr = __shfl(rs_row, 4 * kg + r);
#pragma unroll
            for (int nb = 0; nb < 6; ++nb) Lg[(4 * kg + r) * 97 + nb * 16 + fr] = acc[nb][r] * rr; }
        LDS_WAIT(); asm volatile("" ::: "memory");
        const float be = F.b_re[lane], bg = F.b_rg[lane & 7];
        int my_e1 = 0, my_e2 = 0; float my_g1 = 0.f, my_g2 = 0.f;
#pragma unroll 4
        for (int tk = 0; tk < 16; ++tk) {
            const float gl = Lg[tk * 97 + 64 + (lane & 7)] + bg;
            const float el = Lg[tk * 97 + lane] + be;
            const float gmax = max8(gl);
            const int gi = __builtin_ctzll(__ballot(gl == gmax) & 0xFFull);
            float gs = __builtin_amdgcn_exp2f((gl - gmax) * LOG2E); gs += __shfl_xor(gs, 1); gs += __shfl_xor(gs, 2); gs += __shfl_xor(gs, 4);
            const float gwt = 1.0f / gs;
            const float v1 = __shfl(max8(el), 8 * gi);
            const int i1 = __builtin_ctzll((__ballot(el == v1) >> (8 * gi)) & 0xFFull);
            const float el2 = (lane == 8 * gi + i1) ? -3.0e38f : el;
            const float v2 = __shfl(max8(el2), 8 * gi);
            const int i2 = __builtin_ctzll((__ballot(el2 == v2) >> (8 * gi)) & 0xFFull);
            const float pr = __builtin_amdgcn_exp2f((v2 - v1) * LOG2E), den = 1.0f / (1.0f + pr);
            if (lane == tk) { my_e1 = 8 * gi + i1; my_e2 = 8 * gi + i2; my_g1 = gwt * den; my_g2 = gwt * pr * den; }
        }
        LAS unsigned* hist = (LAS unsigned*)(F.lds + MISC_OFF + 256);
        if (tid < 64) hist[tid] = 0u;
        __syncthreads();
        unsigned lr1 = 0u, lr2 = 0u;
        if (lane < 16) { lr1 = __hip_atomic_fetch_add(hist + my_e1, 1u, __ATOMIC_RELAXED, __HIP_MEMORY_SCOPE_WORKGROUP); lr2 = __hip_atomic_fetch_add(hist + my_e2, 1u, __ATOMIC_RELAXED, __HIP_MEMORY_SCOPE_WORKGROUP); }
        __syncthreads();
        if (tid < 64) { const unsigned c = hist[tid]; hist[64 + tid] = c ? __hip_atomic_fetch_add(cnt + 64 * tid, c, RLX_AGENT) : 0u; }
        __syncthreads();
        if (lane < 16) {
            const int t = t0 + lane;
            const int k1 = (int)(hist[64 + my_e1] + lr1), k2 = (int)(hist[64 + my_e2] + lr2);
            tok_e[2 * t] = my_e1; tok_e[2 * t + 1] = my_e2; tok_rank[2 * t] = k1; tok_rank[2 * t + 1] = k2;
            int* ltok = (int*)(F.ws + WS_LIST + LIST_TOK); float* lrs = (float*)(F.ws + WS_LIST + LIST_RSTD); float* lgt = (float*)(F.ws + WS_LIST + LIST_GATE);
            ltok[my_e1 * CAP + k1] = t; ltok[my_e2 * CAP + k2] = t; lrs[my_e1 * CAP + k1] = rs_row; lrs[my_e2 * CAP + k2] = rs_row; lgt[my_e1 * CAP + k1] = my_g1; lgt[my_e2 * CAP + k2] = my_g2;
        }
    }
}

constexpr int MOE_MT = MISC_OFF + 48, MOE_PST = MISC_OFF + 64, MOE_TE = MOE_PST + 256;
constexpr int MOE_TB = LDS_EXTRA, MOE_VR = MOE_TB + MAXTILES * 4, MOE_UT = MOE_VR + MAXTILES * 4, MOE_SCU = MOE_UT + 12 * 256 * 4;
constexpr int MOE_MAXU = 12;
static_assert(MOE_SCU + MOE_MAXU * 256 * 4 <= MISC_OFF && MOE_TE + MAXTILES * 4 <= LDS_BYTES, "LDS map");
__device__ __forceinline__ int moe_tables(Frame& F) {
    LAS int* PST = (LAS int*)(F.lds + MOE_PST); LAS int* TE = (LAS int*)(F.lds + MOE_TE); LAS int* MTp = (LAS int*)(F.lds + MOE_MT); LAS int* TB = (LAS int*)(F.lds + MOE_TB); LAS int* VR = (LAS int*)(F.lds + MOE_VR);
    __syncthreads();
    if (F.tid < 64) {
        const int c = (int)__hip_atomic_load(F.ctl + CW_CNT + 64 * F.tid, RLX_AGENT); const int nt = (c + 255) >> 8;
        int x = nt;
#pragma unroll
        for (int o = 1; o < 64; o <<= 1) { const int y = __shfl_up(x, o); if (F.lane >= o) x += y; }
        const int ex = x - nt; PST[F.tid] = ex; if (F.tid == 63) MTp[0] = x;
        for (int i = 0; i < nt; ++i) { TE[ex + i] = F.tid; TB[ex + i] = F.tid * CAP + 256 * i; VR[ex + i] = (c - 256 * i) < 256 ? (c - 256 * i) : 256; }
    }
    __syncthreads();
    return MTp[0];
}

__device__ __forceinline__ void unpack8q(const v2u w, float (&f)[8]) {
    typedef float f32x2_ __attribute__((ext_vector_type(2)));
    const f32x2_ p0 = __builtin_amdgcn_cvt_pk_f32_fp8((int)w.x, false), p1 = __builtin_amdgcn_cvt_pk_f32_fp8((int)w.x, true), p2 = __builtin_amdgcn_cvt_pk_f32_fp8((int)w.y, false), p3 = __builtin_amdgcn_cvt_pk_f32_fp8((int)w.y, true);
    constexpr float q = 1.0f / SC_Y; f[0] = p0.x * q; f[1] = p0.y * q; f[2] = p1.x * q; f[3] = p1.y * q; f[4] = p2.x * q; f[5] = p2.y * q; f[6] = p3.x * q; f[7] = p3.y * q;
}
__device__ __forceinline__ void p9_final(Frame& F) {
    (void)moe_tables(F);
    const LAS int* PST = (const LAS int*)(F.lds + MOE_PST);
    const int gw = F.vcu * NWAVES + F.wave, NGW = F.G * NWAVES, lane = F.lane;
    const int* tok_e = (const int*)(F.ws + WS_TOK + TOK_E); const int* tok_rank = (const int*)(F.ws + WS_TOK + TOK_RANK); const bf16* YB = (const bf16*)(F.ws + WS_R1);
    typedef int i32x2 __attribute__((ext_vector_type(2)));
    i32x2 ce = {0, 0}, cr = {0, 0};
    if (gw < T) { ce = *(const GAS i32x2*)(tok_e + 2 * gw); cr = *(const GAS i32x2*)(tok_rank + 2 * gw); }
    for (int t = gw; t < T; t += NGW) {
        const int s1 = PST[ce.x] * 256 + cr.x, s2 = PST[ce.y] * 256 + cr.y;
        if (t + NGW < T) { ce = *(const GAS i32x2*)(tok_e + 2 * (t + NGW)); cr = *(const GAS i32x2*)(tok_rank + 2 * (t + NGW)); }
        const GAS v2u* y1 = (const GAS v2u*)((const unsigned char*)YB + (size_t)s1 * D) + lane; const GAS v2u* y2 = (const GAS v2u*)((const unsigned char*)YB + (size_t)s2 * D) + lane;
        GAS f32x4* o = (GAS f32x4*)(F.out + (size_t)t * D) + 2 * lane;
#pragma unroll
        for (int i = 0; i < 4; ++i) { float a[8], b[8]; unpack8q(__builtin_nontemporal_load(y1 + 64 * i), a); unpack8q(__builtin_nontemporal_load(y2 + 64 * i), b);
            f32x4 v0 = __builtin_nontemporal_load(o + 128 * i), v1 = __builtin_nontemporal_load(o + 128 * i + 1);
            v0.x += a[0] + b[0]; v0.y += a[1] + b[1]; v0.z += a[2] + b[2]; v0.w += a[3] + b[3]; v1.x += a[4] + b[4]; v1.y += a[5] + b[5]; v1.z += a[6] + b[6]; v1.w += a[7] + b[7];
            __builtin_nontemporal_store(v0, o + 128 * i); __builtin_nontemporal_store(v1, o + 128 * i + 1); }
    }
}

constexpr int PER_PHASE = 10;
constexpr int N_LAUNCHES = MK_N_LAUNCHES;
struct Args { const float* in[21]; float* out; unsigned char* ws; int ph_lo, ph_hi, li, pad; };
__global__ void __launch_bounds__(NWAVES * 64, 2) hymba_fwd(Args args) {
    extern __shared__ __attribute__((aligned(16))) unsigned char lds[];
    Frame F;
    F.lds = (LAS unsigned char*)lds;
    F.tid = threadIdx.x; F.lane = F.tid & 63; F.wave = __builtin_amdgcn_readfirstlane(F.tid >> 6);
    F.G = gridDim.x; { const int bx = blockIdx.x; F.vcu = (F.G % 8 == 0) ? (bx % 8) * (F.G / 8) + bx / 8 : bx; }
    F.ws = args.ws; F.ctl = (unsigned*)(args.ws + WS_CTL); F.out = args.out;
    F.x = args.in[0]; F.mem = args.in[1]; F.norm1_g = args.in[2]; F.w_in = args.in[3]; F.q_norm_g = args.in[4]; F.k_norm_g = args.in[5]; F.conv_w = args.in[6];
    F.mem_norm_g = args.in[7]; F.w_mem_kv = args.in[8]; F.mem_q_norm_g = args.in[9]; F.mem_k_norm_g = args.in[10]; F.out_norm_g = args.in[11]; F.w_out = args.in[12];
    F.norm2_g = args.in[13]; F.w_rg = args.in[14]; F.b_rg = args.in[15]; F.w_re = args.in[16]; F.b_re = args.in[17]; F.w_gate = args.in[18]; F.w_up = args.in[19]; F.w_down = args.in[20];
    volatile LAS unsigned* MISC = (volatile LAS unsigned*)(F.lds + MISC_OFF);
    if (F.tid < 16) MISC[F.tid] = 0u;
    __syncthreads();
    const int lo = args.ph_lo, hi = args.ph_hi;
    const bool multi = (hi - lo) > 1;
    XcdBarrier bar; bar.bar = F.ctl + CW_BAR + args.li * XCD_BAR_WORDS; bar.x = 0; bar.st = nullptr;
    if (multi) bar = xcd_barrier_post(F.ctl + CW_BAR + args.li * XCD_BAR_WORDS, MISC + 8);
#define GRID_BAR() do { if (multi) xcd_barrier(bar); } while (0)
#define IN(k) (lo <= (k) && (k) < hi)
#define BOTH(k) (IN(k) && IN((k) + 1))
    if (IN(0)) { p0_prologue(F); if (BOTH(0)) GRID_BAR(); }
    if (IN(1)) {
        pg8::Gemm g{(const bf16*)(F.ws + WS_H), (const bf16*)(F.ws + WS_WIN), D, nullptr}; pg8::P1Order S{F.G, (int)blockIdx.x, 0, 2560};
        pg8::EpiProj E{(bf16*)(F.ws + WS_R1), (bf16*)(F.ws + WS_MEMKV)};
        pg8::gemm_phase<pg8::EpiProj, pg8::P1Order>(F.lds, g, S, E);
        if (BOTH(1)) GRID_BAR();
    }
    if (IN(2)) { p2_attention(F); if (BOTH(2)) GRID_BAR(); }
    if (IN(3)) { p3_combine(F); if (BOTH(3)) GRID_BAR(); }
    if (IN(4)) {
        pg8::Gemm g{(const bf16*)(F.ws + WS_Y), (const bf16*)(F.ws + WS_WOUT), D, nullptr}; pg8::StaticOrder S{T / 256, D / 256, F.G, (int)blockIdx.x};
        pg8::EpiResid E{F.x, F.out, (bf16*)(F.ws + WS_H)};
        pg8::gemm_phase<pg8::EpiResid, pg8::StaticOrder, false>(F.lds, g, S, E);
        if (BOTH(4)) GRID_BAR();
    }
    if (IN(5)) { p5_router(F); if (BOTH(5)) GRID_BAR(); }
    if (IN(7)) {
        const int MT = moe_tables(F);
        pg8::MoeOrder S{MT, F.G, (int)blockIdx.x, (const LAS int*)(F.lds + MOE_TE)};
        { const LAS int* TB = (const LAS int*)(F.lds + MOE_TB); const LAS int* VR = (const LAS int*)(F.lds + MOE_VR); LAS int* UT = (LAS int*)(F.lds + MOE_UT);
          const int* ltok = (const int*)(F.ws + WS_LIST + LIST_TOK); const float* lrs = (const float*)(F.ws + WS_LIST + LIST_RSTD); LAS float* SCU = (LAS float*)(F.lds + MOE_SCU);
          for (int i = 0; i < MOE_MAXU; ++i) { pg8::Unit u; if (!S.next(i, u)) break;
              if (F.tid < 256) { const bool ok = F.tid < VR[u.pm]; UT[i * 256 + F.tid] = ok ? ltok[TB[u.pm] + F.tid] : 0; SCU[i * 256 + F.tid] = ok ? lrs[TB[u.pm] + F.tid] : 0.f; } }
          __syncthreads(); }
        pg8::Gemm g{(const bf16*)(F.ws + WS_H), (const bf16*)(F.ws + WS_WGU), D, (const LAS int*)(F.lds + MOE_UT)};
        pg8::EpiSwiGLU E{(bf16*)(F.ws + WS_OPART), (const LAS float*)(F.lds + MOE_SCU)};
        pg8::gemm_phase<pg8::EpiSwiGLU, pg8::MoeOrder, true, true, false, true>(F.lds, g, S, E);
        if (BOTH(7)) GRID_BAR();
    }
    if (IN(8)) {
        const int MT = moe_tables(F);
        pg8::Gemm g{(const bf16*)(F.ws + WS_OPART), (const bf16*)(F.ws + WS_WD), DEXP, nullptr}; pg8::MoeOrder S{MT, F.G, (int)blockIdx.x, (const LAS int*)(F.lds + MOE_TE)};
        { const LAS int* TB = (const LAS int*)(F.lds + MOE_TB); const LAS int* VR = (const LAS int*)(F.lds + MOE_VR); LAS float* SCU = (LAS float*)(F.lds + MOE_SCU);
          const float* lgt = (const float*)(F.ws + WS_LIST + LIST_GATE);
          for (int i = 0; i < MOE_MAXU; ++i) { pg8::Unit u; if (!S.next(i, u)) break;
              if (F.tid < 256) SCU[i * 256 + F.tid] = (F.tid < VR[u.pm]) ? lgt[TB[u.pm] + F.tid] : 0.f; }
          __syncthreads(); }
        pg8::EpiDown E{(bf16*)(F.ws + WS_R1), (const LAS float*)(F.lds + MOE_SCU)};
        pg8::gemm_phase<pg8::EpiDown, pg8::MoeOrder, true, false, false, true>(F.lds, g, S, E);
        if (BOTH(8)) GRID_BAR();
    }
    if (IN(9)) { p9_final(F); }
#undef IN
#undef BOTH
#undef GRID_BAR
}

extern "C" void kernel_launch(void* const* d_in, const int* in_sizes, int n_in, void* d_out, int out_size, void* d_ws, size_t ws_size, hipStream_t stream) {
    static int grid = 0;
    if (grid == 0) {
        if (n_in != 21 || in_sizes[0] != T * D || out_size != T * D || ws_size < WS_END) { fprintf(stderr, "kernel_launch: shape/workspace mismatch (n_in %d, ws %zu < %zu); nothing launched\n", n_in, ws_size, (size_t)WS_END); grid = -1; return; }
        int dev = 0, cus = 0, per_cu = 0;
        if (hipGetDevice(&dev) != hipSuccess || hipDeviceGetAttribute(&cus, hipDeviceAttributeMultiprocessorCount, dev) != hipSuccess) { grid = -1; return; }
        if (hipFuncSetAttribute((const void*)hymba_fwd, hipFuncAttributeMaxDynamicSharedMemorySize, LDS_BYTES) != hipSuccess) { fprintf(stderr, "kernel_launch: hipFuncSetAttribute failed\n"); grid = -1; return; }
        if (hipOccupancyMaxActiveBlocksPerMultiprocessor(&per_cu, (const void*)hymba_fwd, NWAVES * 64, LDS_BYTES) != hipSuccess || per_cu < 1) { fprintf(stderr, "kernel_launch: occupancy query reports %d\n", per_cu); }
        (void)hipGetLastError();
        grid = cus;
    }
    if (grid < 0) return;
    if (hipMemsetAsync((char*)d_ws + WS_CTL, 0, CTL_ZERO_BYTES, stream) != hipSuccess) { fprintf(stderr, "kernel_launch: memset failed\n"); return; }
    Args a{};
    for (int i = 0; i < 21; ++i) a.in[i] = (const float*)d_in[i];
    a.out = (float*)d_out; a.ws = (unsigned char*)d_ws;
    int los[4], his[4], nl = 0;
#if defined(PROBE_REPEAT)
    los[nl] = 0; his[nl] = PROBE_REPEAT + 1; ++nl; los[nl] = PROBE_REPEAT; his[nl] = PROBE_REPEAT + 1; ++nl; if (PROBE_REPEAT + 1 < PER_PHASE) { los[nl] = PROBE_REPEAT + 1; his[nl] = PER_PHASE; ++nl; }
#else
    los[nl] = 0; his[nl] = PER_PHASE; ++nl;
#endif
    for (int li = 0; li < nl; ++li) {
        a.ph_lo = los[li]; a.ph_hi = his[li]; a.li = li;
#if defined(PROBE_REPEAT)
        if (li == 1) { (void)hipMemsetAsync((char*)d_ws + WS_CTL + CW_ATTQ * 4, 0, 64, stream); if (PROBE_REPEAT == 5) (void)hipMemsetAsync((char*)d_ws + WS_CTL + CW_CNT * 4, 0, 64 * 256, stream); }
#endif
        hipLaunchKernelGGL(hymba_fwd, dim3(grid), dim3(NWAVES * 64), LDS_BYTES, stream, a);
        const hipError_t le = hipPeekAtLastError();
        if (le != hipSuccess) { fprintf(stderr, "kernel_launch: launch %d failed: %s\n", li, hipGetErrorName(le)); break; }
    }
}
```

```cpp
#include <hip/hip_runtime.h>
#include <cstdio>
#include <cstdint>

#ifndef MK_N_LAUNCHES
#define MK_N_LAUNCHES 1
#endif

#define GAS __attribute__((address_space(1)))
#define LAS __attribute__((address_space(3)))
typedef unsigned short bf16;
typedef unsigned v4u __attribute__((ext_vector_type(4)));
typedef unsigned v2u __attribute__((ext_vector_type(2)));
typedef float f32x4 __attribute__((ext_vector_type(4)));
typedef float f32x16 __attribute__((ext_vector_type(16)));
typedef short bf16x8 __attribute__((ext_vector_type(8)));
typedef short s16x4 __attribute__((ext_vector_type(4)));
#define LDS_WAIT() asm volatile("s_waitcnt lgkmcnt(0)" ::: "memory")
#define VM_WAIT() asm volatile("s_waitcnt vmcnt(0)" ::: "memory")
#define RLX_AGENT __ATOMIC_RELAXED, __HIP_MEMORY_SCOPE_AGENT

constexpr int BATCH = 2, SEQ = 16384, T = BATCH * SEQ, D = 2048, PROJ = 5120;
constexpr int NH = 8, HD = 128, ATTN_W = 1024, CONV_W = 512, MEM_W = 512, NMEM = 256, NMH = 4;
constexpr int COL_Q = 0, COL_K = 1024, COL_V = 2048, COL_B = 3072, COL_C = 3584, COL_U = 4096, COL_MQ = 4608;
constexpr int NEXP = 64, DEXP = 1024;
constexpr int RMAX = 81920;
constexpr int MAXTILES = RMAX / 256;
constexpr float EPS = 1e-6f;
constexpr float LOG2E = 1.4426950408889634f;

constexpr size_t MiB = 1u << 20;
constexpr size_t WS_CTL = 0, CTL_ZERO_BYTES = 1 * MiB;
constexpr size_t WS_WIN = 1 * MiB;
constexpr size_t WS_WMKV = WS_WIN + (size_t)PROJ * D * 2;
constexpr size_t WS_WOUT = 25 * MiB;
constexpr size_t WS_WR = 33 * MiB;
constexpr size_t WS_WGU = 34 * MiB;
constexpr size_t WS_X1H = WS_WGU + 256 * MiB;
constexpr size_t WS_WD = WS_WGU + 512 * MiB;
constexpr size_t WS_H = WS_WD + 256 * MiB;
constexpr size_t WS_MEMKV = WS_H + 130 * MiB;
constexpr size_t WS_R1 = WS_MEMKV + 1 * MiB;
constexpr size_t WS_OPART = WS_R1 + 320 * MiB;
constexpr size_t WS_LSE = WS_OPART + 192 * MiB;
constexpr size_t WS_MEMO = WS_LSE + 3 * MiB;
constexpr size_t WS_Y = WS_MEMO + 32 * MiB;
constexpr size_t WS_TOK = WS_Y + 128 * MiB;
constexpr size_t WS_LIST = WS_TOK + 4 * MiB;
constexpr size_t WS_END = WS_LIST + 24 * MiB;
constexpr int CAP = T;
constexpr size_t LIST_TOK = 0, LIST_RSTD = 8 * MiB, LIST_GATE = 16 * MiB;
constexpr size_t TOK_E = 0, TOK_RANK = 256 * 1024, TOK_GATE = 512 * 1024, TOK_RSTD = 768 * 1024, TOK_SLOT = 1024 * 1024, SLOT_RSTD = 1536 * 1024, SLOT_GATE = 2048 * 1024;
static_assert(WS_WMKV + 1024 * (size_t)D * 2 <= WS_WOUT && WS_WOUT + 8 * MiB <= WS_WR && WS_WR + 2048 * 72 * 4 <= WS_WGU, "ws map");
static_assert((size_t)(T + 512) * D * 2 <= 130 * MiB && (size_t)RMAX * D * 2 <= 320 * MiB && (size_t)RMAX * DEXP * 2 <= 192 * MiB && SLOT_GATE + RMAX * 4 <= 4 * MiB, "ws map");

constexpr int CW_TMO = 0, CW_CODE = 1;
constexpr int CW_CNT = 8192;
constexpr int CW_BAR = 16384;
constexpr int CW_KVREADY = 512, CW_ATTQ = 576;

constexpr int RING_BYTES = 131072;
constexpr int LDS_EXTRA = RING_BYTES;
constexpr int MISC_OFF = 163840 - 2048;
constexpr int LDS_BYTES = 163840;

__device__ __forceinline__ unsigned f2bf(float f) { unsigned u = __builtin_bit_cast(unsigned, f); return (u + 0x7fffu + ((u >> 16) & 1u)) >> 16; }
__device__ __forceinline__ unsigned pk2(float lo, float hi) { return f2bf(lo) | (f2bf(hi) << 16); }
__device__ __forceinline__ unsigned cvtpk(float lo, float hi) { unsigned r; asm volatile("v_cvt_pk_bf16_f32 %0, %1, %2" : "=v"(r) : "v"(lo), "v"(hi)); return r; }
__device__ __forceinline__ unsigned pk_fp8x4(float a, float b, float c, float d) { unsigned w = 0u; w = __builtin_amdgcn_cvt_pk_fp8_f32(a, b, w, false); w = __builtin_amdgcn_cvt_pk_fp8_f32(c, d, w, true); return w; }
constexpr float SC_WGU = 128.0f, SC_ACT = 4.0f, SC_WD = 64.0f, SC_Y = 64.0f;
__device__ __forceinline__ float bflo(unsigned w) { return __builtin_bit_cast(float, w << 16); }
__device__ __forceinline__ float bfhi(unsigned w) { return __builtin_bit_cast(float, w & 0xffff0000u); }
__device__ __forceinline__ float wave_sum(float v) {
#pragma unroll
    for (int o = 1; o < 64; o <<= 1) v += __shfl_xor(v, o);
    return v;
}

namespace pg8 {
#define PG8_LAS __attribute__((address_space(3)))
typedef unsigned short bf16_t;
typedef unsigned u32x4 __attribute__((ext_vector_type(4)));
typedef int i32x4 __attribute__((ext_vector_type(4)));
typedef int i32x8 __attribute__((ext_vector_type(8)));
constexpr int BM = 256, BK = 64, HALF = 128, HTB = HALF * BK * 2, STAGE_BYTES = 8 * HTB, NXCD = 8, WGM = 8;
__host__ __device__ __forceinline__ int lds_byte(int r, int c) { const int st = (r >> 4) * 2 + (c >> 5), rr = r & 15, cc = c & 31, ob = rr * 64 + cc * 2; return st * 1024 + (ob ^ (((ob >> 9) & 1) << 5)); }
__host__ __device__ __forceinline__ void stage_rc(int b, int& R, int& C) { const int st = b / 1024, sb = b % 1024, swz = sb ^ (((sb >> 9) & 1) << 5); R = (st >> 1) * 16 + swz / 64; C = (st & 1) * 32 + (swz % 64) / 2; }
__host__ __device__ __forceinline__ int perm32(int rho) { const int n = rho >> 4, i = rho & 15; return 8 * (i >> 2) + 4 * n + (i & 3); }

struct Unit { int pm, pn, pb, ui; };
struct Gemm { const bf16_t* A; const bf16_t* Bt; int K; const PG8_LAS int* ut; };

__device__ __forceinline__ void tile_of(int L, int nM, int nN, int& pm, int& pn) {
    const int nwg = nM * nN;
    int wgid = L; { const int q = nwg / NXCD, r = nwg % NXCD, xcd = wgid % NXCD, off = wgid / NXCD; wgid = (xcd < r ? xcd * (q + 1) : r * (q + 1) + (xcd - r) * q) + off; }
    const int nig = WGM * nN, gid = wgid / nig, fm = gid * WGM, gsz = (nM - fm) < WGM ? (nM - fm) : WGM;
    pm = fm + ((wgid % nig) % gsz); pn = (wgid % nig) / gsz;
}
struct StaticOrder {
    int nM, nN, G, c;
    __device__ __forceinline__ bool next(int i, Unit& u) const { const long L = (long)i * G + c; if (L >= (long)nM * nN) return false; tile_of((int)L, nM, nN, u.pm, u.pn); u.pb = u.pn; return true; }
    __device__ __forceinline__ void a_ready(const Unit&) const {}
    __device__ __forceinline__ void done(const Unit&) const {}
};
struct P1Order {
    int G, c, lo, hi;
    __device__ __forceinline__ bool next(int i, Unit& u) const { const long L = (long)lo + (long)i * G + c; if (L >= hi) return false;
        if (L < 2560) tile_of((int)L, 128, 20, u.pm, u.pn); else { const int k = (int)L - 2560; u.pm = 128 + (k >> 2); u.pn = 20 + (k & 3); }
        u.pb = u.pn; return true; }
    __device__ __forceinline__ void a_ready(const Unit&) const {}
    __device__ __forceinline__ void done(const Unit&) const {}
};
struct MoeOrder {
    int nM, G, c; const LAS int* te;
    __device__ __forceinline__ bool next(int i, Unit& u) const { const long L = (long)i * G + c; if (L >= (long)nM * 8) return false; tile_of((int)L, nM, 8, u.pm, u.pn); u.pb = te[u.pm] * 8 + u.pn; u.ui = i; return true; }
    __device__ __forceinline__ void a_ready(const Unit&) const {}
    __device__ __forceinline__ void done(const Unit&) const {}
};

struct EpiProj {
    static constexpr bool PERM = true, AFTER_DRAIN = false;
    bf16_t* O; bf16_t* O2;
    __device__ __forceinline__ void operator()(const f32x4 (&acc)[2][2][4][2], const Unit& u, int wr, int wc, int fr, int fq) const {
        int row0 = u.pm * BM + wr * 64 + fr, col0 = u.pn * BM + wc * 32 + 8 * fq, ldc = PROJ; bf16_t* base = O;
        if (u.pm >= 128) { row0 -= 128 * BM; col0 -= 20 * BM; ldc = 1024; base = O2; }
#pragma unroll
        for (int ai = 0; ai < 2; ++ai)
#pragma unroll
            for (int m = 0; m < 4; ++m) { bf16_t* rowp = base + (size_t)(row0 + ai * HALF + m * 16) * ldc + col0;
#pragma unroll
                for (int bj = 0; bj < 2; ++bj) { const f32x4 v0 = acc[ai][bj][m][0], v1 = acc[ai][bj][m][1];
                    u32x4 w; w.x = cvtpk(v0[0], v0[1]); w.y = cvtpk(v0[2], v0[3]); w.z = cvtpk(v1[0], v1[1]); w.w = cvtpk(v1[2], v1[3]);
                    *(u32x4*)(rowp + bj * HALF) = w; } }
    }
};
struct EpiResid {
    static constexpr bool PERM = true, AFTER_DRAIN = false;
    const float* X; bf16_t* X1; bf16_t* X1B;
    __device__ __forceinline__ void operator()(const f32x4 (&acc)[2][2][4][2], const Unit& u, int wr, int wc, int fr, int fq) const {
        const int row0 = u.pm * BM + wr * 64 + fr, col0 = u.pn * BM + wc * 32 + 8 * fq;
#pragma unroll
        for (int ai = 0; ai < 2; ++ai)
#pragma unroll
            for (int m = 0; m < 4; ++m) { const size_t off = (size_t)(row0 + ai * HALF + m * 16) * D + col0;
#pragma unroll
                for (int bj = 0; bj < 2; ++bj) { const f32x4 xa = __builtin_nontemporal_load((const f32x4*)(X + off + bj * HALF)), xb = __builtin_nontemporal_load((const f32x4*)(X + off + bj * HALF + 4));
                    const f32x4 v0 = acc[ai][bj][m][0] + xa, v1 = acc[ai][bj][m][1] + xb;
                    { u32x4 h_; h_.x = cvtpk(v0[0], v0[1]); h_.y = cvtpk(v0[2], v0[3]); h_.z = cvtpk(v1[0], v1[1]); h_.w = cvtpk(v1[2], v1[3]); *(u32x4*)(X1 + off + bj * HALF) = h_; }
                    v2u w; w.x = pk_fp8x4(v0[0], v0[1], v0[2], v0[3]); w.y = pk_fp8x4(v1[0], v1[1], v1[2], v1[3]);
                    *(v2u*)((unsigned char*)X1B + off + bj * HALF) = w; }
                asm volatile("" ::: "memory"); }
    }
};
struct EpiSwiGLU {
    static constexpr bool PERM = true, AFTER_DRAIN = false;
    bf16_t* ACT; const PG8_LAS float* RSU;
    __device__ __forceinline__ void operator()(const f32x4 (&acc)[2][2][4][2], const Unit& u, int wr, int wc, int fr, int fq) const {
        const int row0 = u.pm * BM + wr * 64 + fr, col0 = u.pn * HALF + wc * 32 + 8 * fq; const PG8_LAS float* rsu = RSU + u.ui * 256 + wr * 64 + fr;
#pragma unroll
        for (int ai = 0; ai < 2; ++ai)
#pragma unroll
            for (int m = 0; m < 4; ++m) { const int row = row0 + ai * HALF + m * 16; const float rs = rsu[ai * HALF + m * 16] * (1.0f / SC_WGU); float o[8];
#pragma unroll
                for (int n = 0; n < 2; ++n)
#pragma unroll
                    for (int j = 0; j < 4; ++j) { const float g = acc[ai][0][m][n][j] * rs, uu = acc[ai][1][m][n][j] * rs;
                        o[n * 4 + j] = g * __builtin_amdgcn_rcpf(1.0f + __builtin_amdgcn_exp2f(-g * LOG2E)) * uu * SC_ACT; }
                v2u w; w.x = pk_fp8x4(o[0], o[1], o[2], o[3]); w.y = pk_fp8x4(o[4], o[5], o[6], o[7]);
                *(v2u*)((unsigned char*)ACT + (size_t)row * DEXP + col0) = w; }
    }
};
struct EpiDown {
    static constexpr bool PERM = true, AFTER_DRAIN = false;
    bf16_t* Y; const PG8_LAS float* GTU;
    __device__ __forceinline__ void operator()(const f32x4 (&acc)[2][2][4][2], const Unit& u, int wr, int wc, int fr, int fq) const {
        const int row0 = u.pm * BM + wr * 64 + fr, col0 = u.pn * BM + wc * 32 + 8 * fq; const PG8_LAS float* gtu = GTU + u.ui * 256 + wr * 64 + fr;
#pragma unroll
        for (int ai = 0; ai < 2; ++ai)
#pragma unroll
            for (int m = 0; m < 4; ++m) { const int row = row0 + ai * HALF + m * 16; const float gt = gtu[ai * HALF + m * 16] * (SC_Y / (SC_ACT * SC_WD)); unsigned char* rowp = (unsigned char*)Y + (size_t)row * D + col0;
#pragma unroll
                for (int bj = 0; bj < 2; ++bj) { const f32x4 v0 = acc[ai][bj][m][0] * gt, v1 = acc[ai][bj][m][1] * gt;
                    v2u w; w.x = pk_fp8x4(v0[0], v0[1], v0[2], v0[3]); w.y = pk_fp8x4(v1[0], v1[1], v1[2], v1[3]);
                    *(v2u*)(rowp + bj * HALF) = w; } }
    }
};

template <class Epi, class Sched, bool ALIGN_EPI = true, bool GATHER = false, bool BKN = false, bool FP8 = false>
__device__ __forceinline__ void gemm_phase(PG8_LAS unsigned char* lds, const Gemm g, const Sched& S, const Epi& E) {
    static_assert(!(FP8 && BKN), "the fp8 path takes N-major B");
    const int tid = threadIdx.x, wid = __builtin_amdgcn_readfirstlane(tid >> 6), lane = tid & 63, wr = wid >> 2, wc = wid & 3, fr = lane & 15, fq = lane >> 4;
    const int K = FP8 ? g.K / 2 : g.K, nt = K / BK;
    unsigned voffA[2], voffB[2]; int gR[2], gC[2];
#pragma unroll
    for (int i = 0; i < 2; ++i) { int R, C; stage_rc(tid * 16 + i * 8192, R, C); const int Rb = Epi::PERM ? ((R & ~31) + perm32(R & 31)) : R; gR[i] = R; gC[i] = C;
        voffA[i] = (unsigned)(R * K + C) * 2u; voffB[i] = (unsigned)(Rb * K + C) * 2u; }
    unsigned vA0[2], vA1[2], vN0[2], vN1[2];
#define PG8_GOFF(dst0, dst1, ui_) do { _Pragma("unroll") for (int _i = 0; _i < 2; ++_i) { \
        dst0[_i] = ((unsigned)g.ut[(ui_) * 256 + gR[_i]] * (unsigned)K + (unsigned)gC[_i]) * 2u; dst1[_i] = ((unsigned)g.ut[(ui_) * 256 + 128 + gR[_i]] * (unsigned)K + (unsigned)gC[_i]) * 2u; } } while (0)
    const size_t kstep = (size_t)(BK * 2);
    const size_t hstep = (size_t)HALF * K * 2;
    const size_t tstep = 2 * hstep;
    const size_t kstepB = BKN ? (size_t)BK * 4096 : kstep, hstepB = BKN ? (size_t)256 : hstep;
    if constexpr (BKN) {
#pragma unroll
        for (int i = 0; i < 2; ++i) { const int p = tid * 16 + i * 8192, kk = p >> 8, c16p = (p & 255) >> 4, sw = (kk & 3) | (((kk >> 3) & 1) << 2);
            voffB[i] = (unsigned)(kk * 4096 + ((c16p ^ (sw << 1)) << 4)); } }
    int bbase[2];
    { const int q = fr >> 2, p = fr & 3, sw = q | ((fq & 1) << 2);
#pragma unroll
      for (int n = 0; n < 2; ++n) bbase[n] = (int)(uintptr_t)lds + (8 * fq + q) * 256 + (((4 * wc + 2 * n + (p >> 1)) ^ (sw << 1)) << 4) + 8 * (p & 1); }
    const unsigned ldsw = (unsigned)wid * 1024u;
    const int aoff = lds_byte(wr * 64 + fr, fq * 8), boff = lds_byte(wc * 32 + fr, fq * 8);
    const int aoq0 = lds_byte(wr * 64 + fr, fq * 16), aoq1 = lds_byte(wr * 64 + fr, fq * 16 + 8), boq0 = lds_byte(wc * 32 + fr, fq * 16), boq1 = lds_byte(wc * 32 + fr, fq * 16 + 8);
#define PG8_SA(b, h) (((b) * 2 + (h)) * HTB)
#define PG8_SB(b, h) ((4 + (b) * 2 + (h)) * HTB)
#define PG8_STAGE(bufoff, gbase, voff) do { _Pragma("unroll") for (int _i = 0; _i < 2; ++_i) \
        __builtin_amdgcn_global_load_lds((const unsigned*)((const char*)(gbase) + (voff)[_i]), (PG8_LAS unsigned*)(lds + (bufoff) + ldsw + _i * 8192), 16, 0, 0); } while (0)
#define PG8_Q_At Aq
#define PG8_Q_B0 Bq0
#define PG8_Q_B1 Bq1
#define PG8_LD8(p0_, p1_) __builtin_shufflevector(*(const PG8_LAS i32x4*)(p0_), *(const PG8_LAS i32x4*)(p1_), 0, 1, 2, 3, 4, 5, 6, 7)
#define PG8_LDA(dst, b, h) do { if constexpr (FP8) { _Pragma("unroll") for (int m = 0; m < 4; ++m) PG8_Q_##dst[m] = PG8_LD8(lds + PG8_SA(b, h) + aoq0 + m * 2048, lds + PG8_SA(b, h) + aoq1 + m * 2048); } \
        else { _Pragma("unroll") for (int m = 0; m < 4; ++m) _Pragma("unroll") for (int k = 0; k < 2; ++k) dst[m][k] = *(const PG8_LAS bf16x8*)(lds + PG8_SA(b, h) + aoff + m * 2048 + k * 1024); } } while (0)
#define PG8_TR(dst, addr, OFF) asm volatile("ds_read_b64_tr_b16 %0, %1 offset:%2" : "=&v"(dst) : "v"(addr), "i"(OFF) : "memory")
#define PG8_LDB(dst, b, h) do { if constexpr (BKN) { _Pragma("unroll") for (int n = 0; n < 2; ++n) { const int ad_ = bbase[n] + PG8_SB(b, h); s16x4 l0_, h0_, l1_, h1_; \
            PG8_TR(l0_, ad_, 0); PG8_TR(h0_, ad_, 1024); PG8_TR(l1_, ad_, 8192); PG8_TR(h1_, ad_, 9216); \
            dst[n][0] = (bf16x8){l0_[0], l0_[1], l0_[2], l0_[3], h0_[0], h0_[1], h0_[2], h0_[3]}; dst[n][1] = (bf16x8){l1_[0], l1_[1], l1_[2], l1_[3], h1_[0], h1_[1], h1_[2], h1_[3]}; } } \
        else if constexpr (FP8) { _Pragma("unroll") for (int n = 0; n < 2; ++n) PG8_Q_##dst[n] = PG8_LD8(lds + PG8_SB(b, h) + boq0 + n * 2048, lds + PG8_SB(b, h) + boq1 + n * 2048); } \
        else { _Pragma("unroll") for (int n = 0; n < 2; ++n) _Pragma("unroll") for (int k = 0; k < 2; ++k) dst[n][k] = *(const PG8_LAS bf16x8*)(lds + PG8_SB(b, h) + boff + n * 2048 + k * 1024); } } while (0)
#define PG8_MMA(ai, bj, At, Bt) do { __builtin_amdgcn_s_setprio(1); if constexpr (FP8) { _Pragma("unroll") for (int m = 0; m < 4; ++m) _Pragma("unroll") for (int n = 0; n < 2; ++n) \
            asm volatile("v_mfma_scale_f32_16x16x128_f8f6f4 %0, %1, %2, %0, %3, %3 op_sel_hi:[0,0,0]" : "+v"(acc[ai][bj][m][n]) : "v"(PG8_Q_##Bt[n]), "v"(PG8_Q_##At[m]), "v"(sc1_)); } \
        else { _Pragma("unroll") for (int m = 0; m < 4; ++m) _Pragma("unroll") for (int n = 0; n < 2; ++n) _Pragma("unroll") for (int k = 0; k < 2; ++k) \
            acc[ai][bj][m][n] = __builtin_amdgcn_mfma_f32_16x16x32_bf16(Bt[n][k], At[m][k], acc[ai][bj][m][n], 0, 0, 0); } __builtin_amdgcn_s_setprio(0); } while (0)
#define PG8_WAIT_V(n) asm volatile("s_waitcnt vmcnt(" #n ")" ::: "memory")
#define PG8_WAIT_L(n) asm volatile("s_waitcnt lgkmcnt(" #n ")" ::: "memory")
#define PG8_BAR __builtin_amdgcn_s_barrier()
#define PG8_SCHED __builtin_amdgcn_sched_barrier(0)
    Unit cur, nxt; int ui = 0;
    if (!S.next(0, cur)) return;
    f32x4 acc[2][2][4][2];
#pragma unroll
    for (int a = 0; a < 2; ++a)
#pragma unroll
        for (int b = 0; b < 2; ++b)
#pragma unroll
            for (int m = 0; m < 4; ++m)
#pragma unroll
                for (int n = 0; n < 2; ++n) acc[a][b][m][n] = (f32x4){0.f, 0.f, 0.f, 0.f};
    bf16x8 At[4][2], B0[2][2], B1[2][2];
    i32x8 Aq[4], Bq0[2], Bq1[2]; const int sc1_ = 0x7F7F7F7F;
    const char* cA = GATHER ? (const char*)g.A : (const char*)g.A + (size_t)cur.pm * tstep; const char* cB = BKN ? (const char*)g.Bt + (size_t)(cur.pb >> 3) * ((size_t)K * 4096) + (size_t)(cur.pb & 7) * 512 : (const char*)g.Bt + (size_t)cur.pb * tstep;
    const size_t hA = GATHER ? 0 : hstep;
    if constexpr (GATHER) { PG8_GOFF(vA0, vA1, 0); } else {
#pragma unroll
        for (int i = 0; i < 2; ++i) { vA0[i] = voffA[i]; vA1[i] = voffA[i]; vN0[i] = voffA[i]; vN1[i] = voffA[i]; } }
    S.a_ready(cur);
    PG8_STAGE(PG8_SB(0, 0), cB, voffB); PG8_STAGE(PG8_SB(0, 1), cB + hstepB, voffB); PG8_STAGE(PG8_SA(0, 0), cA, vA0); PG8_STAGE(PG8_SA(0, 1), cA + hA, vA1);
    if (wr == 1) PG8_BAR;
    PG8_WAIT_V(2); PG8_BAR;
    PG8_STAGE(PG8_SB(1, 0), cB + kstepB, voffB); PG8_STAGE(PG8_SA(1, 0), cA + kstep, vA0); PG8_STAGE(PG8_SB(1, 1), cB + hstepB + kstepB, voffB);
    PG8_WAIT_V(6); PG8_BAR;
    for (;;) {
        const bool has_next = S.next(ui + 1, nxt);
        const char* nA = GATHER ? cA : (has_next ? (const char*)g.A + (size_t)nxt.pm * tstep : cA); const char* nB = has_next ? (BKN ? (const char*)g.Bt + (size_t)(nxt.pb >> 3) * ((size_t)K * 4096) + (size_t)(nxt.pb & 7) * 512 : (const char*)g.Bt + (size_t)nxt.pb * tstep) : cB;
        if constexpr (GATHER) { if (has_next) { PG8_GOFF(vN0, vN1, ui + 1); } else {
#pragma unroll
            for (int i = 0; i < 2; ++i) { vN0[i] = vA0[i]; vN1[i] = vA1[i]; } } }
#pragma unroll 1
        for (int t = 0; t < nt; t += 2) {
            const bool last = (t == nt - 2);
            unsigned s0[2], s1[2];
#pragma unroll
            for (int i = 0; i < 2; ++i) { s0[i] = (GATHER && last) ? vN0[i] : vA0[i]; s1[i] = (GATHER && last) ? vN1[i] : vA1[i]; }
            const char* a1 = cA + (size_t)(t + 1) * kstep;
            const char* a2 = last ? nA : cA + (size_t)(t + 2) * kstep; const char* b2 = last ? nB : cB + (size_t)(t + 2) * kstepB;
            const char* a3 = a2 + kstep; const char* b3 = b2 + kstepB;
            if (last && has_next) S.a_ready(nxt);
            PG8_LDB(B0, 0, 0); PG8_LDB(B1, 0, 1); PG8_SCHED; PG8_LDA(At, 0, 0); PG8_STAGE(PG8_SA(1, 1), a1 + hA, vA1);
            PG8_WAIT_V(8); PG8_WAIT_L(0); PG8_BAR; PG8_SCHED; PG8_MMA(0, 0, At, B0); PG8_MMA(0, 1, At, B1); PG8_BAR; PG8_SCHED;
            PG8_LDA(At, 0, 1); PG8_STAGE(PG8_SB(0, 0), b2, voffB); PG8_STAGE(PG8_SB(0, 1), b2 + hstepB, voffB); PG8_STAGE(PG8_SA(0, 0), a2, s0);
            PG8_WAIT_V(8); PG8_WAIT_L(0); PG8_BAR; PG8_SCHED; PG8_MMA(1, 0, At, B0); PG8_MMA(1, 1, At, B1); PG8_BAR; PG8_SCHED;
            PG8_LDB(B0, 1, 0); PG8_LDB(B1, 1, 1); PG8_SCHED; PG8_LDA(At, 1, 0); PG8_STAGE(PG8_SA(0, 1), a2 + hA, s1);
            PG8_WAIT_V(8); PG8_WAIT_L(0); PG8_BAR; PG8_SCHED; PG8_MMA(0, 0, At, B0); PG8_MMA(0, 1, At, B1); PG8_BAR; PG8_SCHED;
            PG8_LDA(At, 1, 1); PG8_STAGE(PG8_SB(1, 0), b3, voffB); PG8_STAGE(PG8_SB(1, 1), b3 + hstepB, voffB); PG8_STAGE(PG8_SA(1, 0), a3, s0);
            PG8_WAIT_V(8); PG8_WAIT_L(0); PG8_BAR; PG8_SCHED; PG8_MMA(1, 0, At, B0); PG8_MMA(1, 1, At, B1); PG8_BAR; PG8_SCHED;
        }
        if constexpr (ALIGN_EPI) { if (wr == 0) PG8_BAR; }
        if constexpr (FP8) { __builtin_amdgcn_sched_barrier(0); asm volatile("s_nop 15\n\ts_nop 15" ::: "memory"); __builtin_amdgcn_sched_barrier(0); }
        { int ln_ = lane; asm volatile("" : "+v"(ln_)); E(acc, cur, wr, wc, ln_ & 15, ln_ >> 4); } S.done(cur);
        if (!has_next) break;
#pragma unroll
        for (int a = 0; a < 2; ++a)
#pragma unroll
            for (int b = 0; b < 2; ++b)
#pragma unroll
                for (int m = 0; m < 4; ++m)
#pragma unroll
                    for (int n = 0; n < 2; ++n) acc[a][b][m][n] = (f32x4){0.f, 0.f, 0.f, 0.f};
        cur = nxt; cA = nA; cB = nB; ++ui;
#pragma unroll
        for (int i = 0; i < 2; ++i) { vA0[i] = vN0[i]; vA1[i] = vN1[i]; }
        if constexpr (ALIGN_EPI) { if (wr == 1) PG8_BAR; }
    }
    PG8_WAIT_V(0);
    if constexpr (!ALIGN_EPI) { if (wr == 0) PG8_BAR; }
    PG8_BAR;
#undef PG8_GOFF
#undef PG8_Q_At
#undef PG8_Q_B0
#undef PG8_Q_B1
#undef PG8_LD8
#undef PG8_TR
#undef PG8_SA
#undef PG8_SB
#undef PG8_STAGE
#undef PG8_LDA
#undef PG8_LDB
#undef PG8_MMA
#undef PG8_WAIT_V
#undef PG8_WAIT_L
#undef PG8_BAR
#undef PG8_SCHED
}
}

#define XB_TMO      128
#define XB_XCNT(j)  (256  + 64 * (j))
#define XB_XSUB(j)  (1280 + 64 * (j))
#define XB_XGEN(j)  (2304 + 64 * (j))
#define XB_TOP      3328
#define XB_TOPGEN   3392
#define XCD_BAR_WORDS 3456
#define XB_SPIN_CAP (1u << 18)
__device__ __forceinline__ unsigned xb_ld(unsigned* p)              { return __hip_atomic_load(p, __ATOMIC_RELAXED, __HIP_MEMORY_SCOPE_AGENT); }
__device__ __forceinline__ unsigned xb_add(unsigned* p, unsigned v) { return __hip_atomic_fetch_add(p, v, __ATOMIC_RELAXED, __HIP_MEMORY_SCOPE_AGENT); }
__device__ __forceinline__ unsigned xb_xcc_id() { return (unsigned)__builtin_amdgcn_s_getreg((3 << 11) | 20) & 0xFu; }
#define XB_SPIN(cond, bar) do { unsigned _sp = 0; while (cond) { __builtin_amdgcn_s_sleep(1); \
    if ((++_sp & 255u) == 0u) { if (xb_ld(&(bar)[XB_TMO])) break; if (_sp > XB_SPIN_CAP) { atomicAdd(&(bar)[XB_TMO], 1u); break; } } } } while (0)
struct XcdBarrier { unsigned* bar; unsigned x; volatile LAS unsigned* st; };
__device__ __forceinline__ XcdBarrier xcd_barrier_post(unsigned* bar, volatile LAS unsigned* st) {
    XcdBarrier b; b.bar = bar; b.x = xb_xcc_id(); b.st = st;
    if (threadIdx.x == 0) (void)xb_add(&bar[XB_XCNT(b.x)], 1u);
    return b;
}
__device__ __forceinline__ void xcd_barrier_complete(unsigned* bar, unsigned x, unsigned& nloc, unsigned& nx) {
    const unsigned G = gridDim.x * gridDim.y * gridDim.z;
    unsigned sum, cnt, mine, sp = 0u;
    for (;;) {
        sum = 0u; cnt = 0u; mine = 0u;
#pragma unroll
        for (unsigned j = 0; j < 16; ++j) { const unsigned c = xb_ld(&bar[XB_XCNT(j)]); sum += c; cnt += (c > 0u) ? 1u : 0u; mine = (j == x) ? c : mine; }
        if (sum == G) break;
        __builtin_amdgcn_s_sleep(1);
        if ((++sp & 255u) == 0u) { if (xb_ld(&bar[XB_TMO])) break; if (sp > XB_SPIN_CAP) { atomicAdd(&bar[XB_TMO], 1u); break; } }
    }
    nloc = mine > 0u ? mine : 1u; nx = cnt > 0u ? cnt : 1u;
}
__device__ __forceinline__ void xcd_barrier(const XcdBarrier& b) {
    asm volatile("s_waitcnt vmcnt(0)" ::: "memory");
    __syncthreads();
    if (threadIdx.x == 0) {
        unsigned* bar = b.bar;
        __builtin_amdgcn_s_waitcnt(0);
        unsigned nloc = b.st[0], nx = b.st[1];
        if (nloc == 0u) { xcd_barrier_complete(bar, b.x, nloc, nx); b.st[0] = nloc; b.st[1] = nx; }
        const unsigned old = xb_add(&bar[XB_XSUB(b.x)], 1u);
        const unsigned gen = old / nloc;
        if (old + 1u == (gen + 1u) * nloc) {
            __builtin_amdgcn_fence(__ATOMIC_RELEASE, "agent");
            asm volatile("s_waitcnt vmcnt(0)" ::: "memory");
            const unsigned og = xb_add(&bar[XB_TOP], 1u);
            const unsigned tg = og / nx;
            if (og + 1u == (tg + 1u) * nx) xb_add(&bar[XB_TOPGEN], 1u);
            else XB_SPIN(xb_ld(&bar[XB_TOPGEN]) == tg, bar);
            __builtin_amdgcn_fence(__ATOMIC_ACQUIRE, "agent");
            xb_add(&bar[XB_XGEN(b.x)], 1u);
            asm volatile("s_waitcnt vmcnt(0)" ::: "memory");
        } else {
            XB_SPIN(xb_ld(&bar[XB_XGEN(b.x)]) == gen, bar);
            __builtin_amdgcn_fence(__ATOMIC_ACQUIRE, "agent");
            asm volatile("s_waitcnt vmcnt(0)" ::: "memory");
        }
    }
    __syncthreads();
}

constexpr int NWAVES = 8;
struct Frame {
    LAS unsigned char* lds;
    unsigned* ctl;
    int tid, lane, wave, vcu, G;
    const float *x, *mem, *norm1_g, *w_in, *q_norm_g, *k_norm_g, *conv_w, *mem_norm_g, *w_mem_kv, *mem_q_norm_g, *mem_k_norm_g, *out_norm_g, *w_out, *norm2_g,
                *w_rg, *b_rg, *w_re, *b_re, *w_gate, *w_up, *w_down;
    float* out; unsigned char* ws;
};

__device__ __forceinline__ void p0_transpose_item(const float* W, int N, int k0, int n0, const float* ks, bf16* dst, int pitch, LAS float* scr, int lane) {
#pragma unroll 8
    for (int i = 0; i < 32; ++i) { const int kk = 2 * i + (lane >> 5); scr[kk * 33 + (lane & 31)] = __builtin_nontemporal_load(W + (size_t)(k0 + kk) * N + n0 + (lane & 31)); }
    const int c = lane & 7;
    float g[8];
#pragma unroll
    for (int j = 0; j < 8; ++j) g[j] = ks ? ks[k0 + 8 * c + j] : 1.0f;
    LDS_WAIT(); asm volatile("" ::: "memory");
#pragma unroll
    for (int j = 0; j < 4; ++j) { const int n = (lane >> 3) + 8 * j; const LAS float* s = scr + (8 * c) * 33 + n;
        v4u o; o.x = pk2(s[0 * 33] * g[0], s[1 * 33] * g[1]); o.y = pk2(s[2 * 33] * g[2], s[3 * 33] * g[3]); o.z = pk2(s[4 * 33] * g[4], s[5 * 33] * g[5]); o.w = pk2(s[6 * 33] * g[6], s[7 * 33] * g[7]);
        *(GAS v4u*)(dst + (size_t)n * pitch + k0 + 8 * c) = o; }
    LDS_WAIT(); asm volatile("" ::: "memory");
}
__device__ __forceinline__ void rms_row_to_bf16(const float* xrow, const float* gain, bf16* orow, int lane) {
    const GAS f32x4* xr = (const GAS f32x4*)xrow + lane; const GAS f32x4* gr = (const GAS f32x4*)gain + lane;
    f32x4 v[8]; float s = 0.f;
#pragma unroll
    for (int j = 0; j < 8; ++j) { v[j] = __builtin_nontemporal_load(xr + 64 * j); s += (v[j].x * v[j].x + v[j].y * v[j].y) + (v[j].z * v[j].z + v[j].w * v[j].w); }
    const float rstd = 1.0f / sqrtf(wave_sum(s) * (1.f / D) + EPS);
    GAS v2u* o8 = (GAS v2u*)orow + lane;
#pragma unroll
    for (int j = 0; j < 8; ++j) { const f32x4 gg = gr[64 * j]; v2u o; o.x = pk2(v[j].x * rstd * gg.x, v[j].y * rstd * gg.y); o.y = pk2(v[j].z * rstd * gg.z, v[j].w * rstd * gg.w); o8[64 * j] = o; }
}
__device__ __forceinline__ void p0_transpose_item_q(const float* W, int N, int k0, int n0, const float* ks, float sc, unsigned char* dst, int pitch, LAS float* scr, int lane) {
#pragma unroll 8
    for (int i = 0; i < 64; ++i) { const int kk = 2 * i + (lane >> 5); scr[kk * 33 + (lane & 31)] = __builtin_nontemporal_load(W + (size_t)(k0 + kk) * N + n0 + (lane & 31)); }
    const int c = lane & 15;
    float g[8];
#pragma unroll
    for (int j = 0; j < 8; ++j) g[j] = ks ? ks[k0 + 8 * c + j] * sc : sc;
    LDS_WAIT(); asm volatile("" ::: "memory");
#pragma unroll
    for (int j = 0; j < 8; ++j) { const int n = (lane >> 4) + 4 * j; const LAS float* s = scr + (8 * c) * 33 + n;
        v2u o; o.x = pk_fp8x4(s[0 * 33] * g[0], s[1 * 33] * g[1], s[2 * 33] * g[2], s[3 * 33] * g[3]); o.y = pk_fp8x4(s[4 * 33] * g[4], s[5 * 33] * g[5], s[6 * 33] * g[6], s[7 * 33] * g[7]);
        __builtin_nontemporal_store(o, (GAS v2u*)(dst + (size_t)n * pitch + k0 + 8 * c)); }
    LDS_WAIT(); asm volatile("" ::: "memory");
}
__device__ __forceinline__ void p0_item_q64(const float* W, int N, int k0, int n0, const float* ks, float sc, unsigned char* dst, int pitch, LAS unsigned char* scr, int lane) {
    const GAS float* src = (const GAS float*)(W + (size_t)k0 * N + n0 + lane);
    float g0 = sc, g1 = sc;
    if (ks) { g0 = ks[k0 + lane] * sc; g1 = ks[k0 + 64 + lane] * sc; }
#pragma unroll
    for (int h = 0; h < 2; ++h) {
        float v[64];
#pragma unroll
        for (int i = 0; i < 64; ++i) v[i] = __builtin_nontemporal_load(src + (size_t)(64 * h + i) * N);
        const float gh = h ? g1 : g0;
#pragma unroll
        for (int q = 0; q < 4; ++q) { v4u o;
#pragma unroll
            for (int d = 0; d < 4; ++d) { const int i = 16 * q + 4 * d;
                const float s0 = __builtin_bit_cast(float, __builtin_amdgcn_readlane(__builtin_bit_cast(int, gh), i)), s1 = __builtin_bit_cast(float, __builtin_amdgcn_readlane(__builtin_bit_cast(int, gh), i + 1));
                const float s2 = __builtin_bit_cast(float, __builtin_amdgcn_readlane(__builtin_bit_cast(int, gh), i + 2)), s3 = __builtin_bit_cast(float, __builtin_amdgcn_readlane(__builtin_bit_cast(int, gh), i + 3));
                o[d] = pk_fp8x4(v[i] * s0, v[i + 1] * s1, v[i + 2] * s2, v[i + 3] * s3); }
            *(LAS v4u*)(scr + lane * 144 + (4 * h + q) * 16) = o; }
    }
    LDS_WAIT(); asm volatile("" ::: "memory");
#pragma unroll
    for (int i = 0; i < 8; ++i) { const int row = 8 * i + (lane >> 3), ch = lane & 7;
        const v4u w = *(const LAS v4u*)(scr + row * 144 + ch * 16);
        __builtin_nontemporal_store(w, (GAS v4u*)(dst + (size_t)row * pitch + k0 + ch * 16)); }
    LDS_WAIT(); asm volatile("" ::: "memory");
}
__device__ __forceinline__ void p0_prologue(Frame& F) {
    LAS float* scr = (LAS float*)(F.lds + F.wave * 16896);
    const int gw = F.vcu * NWAVES + F.wave, NGW = F.G * NWAVES;
    bf16* Win_t = (bf16*)(F.ws + WS_WIN); bf16* Wmkv_t = (bf16*)(F.ws + WS_WMKV); bf16* Wout_t = (bf16*)(F.ws + WS_WOUT);
    constexpr int I_IN = 32 * 160, I_MKV = 32 * 32, I_OUT = 32 * 64;
    constexpr int NITEMS = I_IN + I_MKV + I_OUT;
    for (int it = gw; it < NITEMS; it += NGW) {
        int r = it;
        if (r < I_IN) { const int kb = r / 160, nb = r % 160; p0_transpose_item(F.w_in, PROJ, 64 * kb, 32 * nb, nullptr, Win_t + (size_t)(32 * nb) * D, D, scr, F.lane); continue; } r -= I_IN;
        if (r < I_MKV) { const int kb = r / 32, nb = r % 32; p0_transpose_item(F.w_mem_kv, 1024, 64 * kb, 32 * nb, nullptr, Wmkv_t + (size_t)(32 * nb) * D, D, scr, F.lane); continue; } r -= I_MKV;
        { const int kb = r / 64, nb = r % 64; p0_transpose_item(F.w_out, D, 64 * kb, 32 * nb, nullptr, Wout_t + (size_t)(32 * nb) * D, D, scr, F.lane); }
    }
    { unsigned char* Wgu_q = (unsigned char*)(F.ws + WS_WGU); unsigned char* Wd_q = (unsigned char*)(F.ws + WS_WD); LAS unsigned char* scq = F.lds + F.wave * 16896;
      constexpr int IPE = 256 + 256 + 256;
#pragma unroll 1
      for (int it = gw; it < 64 * IPE; it += NGW) { const int e = it / IPE; int r = it - e * IPE;
          if (r < 512) { const int up = r >> 8, q = r & 255, kb = q >> 4, nb = q & 15, n0 = 64 * nb;
              const float* W = (up ? F.w_up : F.w_gate) + (size_t)e * D * DEXP; const int drow = 256 * (n0 >> 7) + 128 * up + (n0 & 127);
              p0_item_q64(W, DEXP, 128 * kb, n0, F.norm2_g, SC_WGU, Wgu_q + ((size_t)e * 2048 + drow) * D, D, scq, F.lane); }
          else { const int q = r - 512, kb = q >> 5, nb = q & 31;
              p0_item_q64(F.w_down + (size_t)e * DEXP * D, D, 128 * kb, 64 * nb, nullptr, SC_WD, Wd_q + ((size_t)e * 2048 + 64 * nb) * DEXP, DEXP, scq, F.lane); } } }
    { bf16* WT = (bf16*)(F.ws + WS_WR); const int gt = (F.vcu * NWAVES + F.wave) * 64 + F.lane, NT = F.G * NWAVES * 64;
      for (int i = gt; i < 96 * 2048; i += NT) { const int n = i >> 11, k = i & 2047;
          float w = n < 64 ? F.w_re[k * 64 + n] : (n < 72 ? F.w_rg[k * 8 + (n - 64)] : 0.f); w *= F.norm2_g[k];
          const unsigned h = f2bf(w); const float hf = __builtin_bit_cast(float, h << 16);
          WT[i] = (bf16)h; WT[96 * 2048 + i] = (bf16)f2bf(w - hf); } }
    bf16* H = (bf16*)(F.ws + WS_H);
    for (int m = gw; m < T + 512; m += NGW) {
        if (m < T) rms_row_to_bf16(F.x + (size_t)m * D, F.norm1_g, H + (size_t)m * D, F.lane);
        else rms_row_to_bf16(F.mem + (size_t)(m - T) * D, F.mem_norm_g, H + (size_t)m * D, F.lane);
    }
}

namespace att {
constexpr int LDS_K = 0, LDS_V = 65536, LDS_STG = 131072, LDS_LI = LDS_STG + 16384, LDS_GT = LDS_LI + 8 * 256;
constexpr float CS = 0.08838834764831845f * LOG2E;
#define KSWZ(row, colB) ((row) * 256 + ((colB) ^ (((row) & 7) << 4)))
__device__ __forceinline__ int crow(int r, int hi) { return (r & 3) + 8 * (r >> 2) + 4 * hi; }
__device__ __forceinline__ int v_rd_base(int lane) { return ((lane & 3) << 3) | (((lane >> 2) & 3) << 6) | (((lane >> 4) & 1) << 5) | (((lane >> 5) & 1) << 8); }
template <int OFF> __device__ __forceinline__ s16x4 tr_read(int vb) { s16x4 r; asm volatile("ds_read_b64_tr_b16 %0, %1 offset:%2" : "=&v"(r) : "v"(vb), "i"(OFF) : "memory"); return r; }

struct RowMap { const char* base; long stride; int win0; bool wrap; };
__device__ __forceinline__ const char* rowptr(const RowMap& m, int p) { int sp = m.wrap ? m.win0 + ((p - m.win0) & 255) : p; sp = sp < 0 ? 0 : sp; return m.base + (long)sp * m.stride; }

__device__ __forceinline__ void dma_k(LAS unsigned char* Kl, int p0, int nrows, const RowMap& m, int wave, int lane) {
    asm volatile("" : "+v"(lane));
#pragma unroll 1
    for (int i = 0; i < nrows / 32; ++i) {
        const int prow0 = p0 + 32 * i + 4 * wave, prow = prow0 + (lane >> 4);
        const char* src = rowptr(m, prow) + (((lane & 15) ^ (prow & 7)) << 4);
        __builtin_amdgcn_global_load_lds((const unsigned*)src, (LAS unsigned*)(Kl + prow0 * 256), 16, 0, 0);
    }
}
__device__ __forceinline__ void dma_v(LAS unsigned char* Vl, int p0, int nrows, const RowMap& m, int wave, int lane) {
    asm volatile("" : "+v"(lane));
#pragma unroll 1
    for (int i = 0; i < nrows / 32; ++i) {
        const int ii = wave + 8 * i, g = (p0 >> 4) + (ii >> 2), q = ii & 3;
        const int kk = ((q >> 1) << 3) + ((lane & 31) >> 2), k = (kk & ~0xC) | ((kk & 4) << 1) | ((kk & 8) >> 1);
        const int c = 32 * (2 * (q & 1) + (lane >> 5)) + 8 * (lane & 3);
        const char* src = rowptr(m, 16 * g + k) + c * 2;
        __builtin_amdgcn_global_load_lds((const unsigned*)src, (LAS unsigned*)(Vl + g * 4096 + q * 1024), 16, 0, 0);
    }
}
__device__ __forceinline__ void dma_v2(LAS unsigned char* Vl, int p0, int nrows, const RowMap& m, int wave, int lane) {
    asm volatile("" : "+v"(lane));
#pragma unroll 1
    for (int i = 0; i < nrows / 32; ++i) {
        const int prow0 = p0 + 32 * i + 4 * wave, prow = prow0 + (lane >> 4);
        const char* src = rowptr(m, prow) + (((lane & 15) ^ ((prow & 7) << 1)) << 4);
        __builtin_amdgcn_global_load_lds((const unsigned*)src, (LAS unsigned*)(Vl + prow0 * 256), 16, 0, 0);
    }
}
__device__ __forceinline__ void load_q16(v4u (&raw)[4], const char* qrow, int kg) {
#pragma unroll
    for (int s = 0; s < 4; ++s) raw[s] = *(const GAS v4u*)(qrow + (32 * s + 8 * kg) * 2);
}
__device__ __forceinline__ void norm_q16(const v4u (&raw)[4], bf16x8 (&qr)[4], const LAS float* gt, int kg) {
    float ss = 0.f;
#pragma unroll
    for (int s = 0; s < 4; ++s)
#pragma unroll
        for (int j = 0; j < 4; ++j) { const float a = bflo(raw[s][j]), b = bfhi(raw[s][j]); ss += a * a + b * b; }
    ss += __shfl_xor(ss, 16); ss += __shfl_xor(ss, 32);
    const float rstd = 1.0f / sqrtf(ss * (1.f / HD) + EPS);
#pragma unroll
    for (int s = 0; s < 4; ++s) { const LAS f32x4* gp = (const LAS f32x4*)(gt + 32 * s + 8 * kg); const f32x4 g0 = gp[0], g1 = gp[1]; v4u o;
        o.x = cvtpk(bflo(raw[s].x) * rstd * g0.x, bfhi(raw[s].x) * rstd * g0.y); o.y = cvtpk(bflo(raw[s].y) * rstd * g0.z, bfhi(raw[s].y) * rstd * g0.w);
        o.z = cvtpk(bflo(raw[s].z) * rstd * g1.x, bfhi(raw[s].z) * rstd * g1.y); o.w = cvtpk(bflo(raw[s].w) * rstd * g1.z, bfhi(raw[s].w) * rstd * g1.w);
        qr[s] = __builtin_bit_cast(bf16x8, o); }
}
__device__ __forceinline__ void norm_k(LAS unsigned char* Kl, int p0, int nrows, const LAS float* gt, int tid) {
    asm volatile("" : "+v"(tid));
#pragma unroll 1
    for (int idx = tid; idx < nrows * 4; idx += 512) {
        const int row = p0 + (idx >> 2), qd = idx & 3;
        v4u w[4]; float ss = 0.f;
#pragma unroll
        for (int i = 0; i < 4; ++i) { w[i] = *(const LAS v4u*)(Kl + KSWZ(row, (4 * qd + i) * 16));
#pragma unroll
            for (int j = 0; j < 4; ++j) { const float a = bflo(w[i][j]), b = bfhi(w[i][j]); ss += a * a + b * b; } }
        ss += __shfl_xor(ss, 1); ss += __shfl_xor(ss, 2);
        const float rstd = 1.0f / sqrtf(ss * (1.f / HD) + EPS);
#pragma unroll
        for (int i = 0; i < 4; ++i) { const LAS f32x4* gp = (const LAS f32x4*)(gt + (4 * qd + i) * 8); const f32x4 g0 = gp[0], g1 = gp[1]; v4u o;
            o.x = cvtpk(bflo(w[i].x) * rstd * g0.x, bfhi(w[i].x) * rstd * g0.y); o.y = cvtpk(bflo(w[i].y) * rstd * g0.z, bfhi(w[i].y) * rstd * g0.w);
            o.z = cvtpk(bflo(w[i].z) * rstd * g1.x, bfhi(w[i].z) * rstd * g1.y); o.w = cvtpk(bflo(w[i].w) * rstd * g1.z, bfhi(w[i].w) * rstd * g1.w);
            *(LAS v4u*)(Kl + KSWZ(row, (4 * qd + i) * 16)) = o; }
    }
}
__device__ __forceinline__ float xsum32(float v) { unsigned a = __builtin_bit_cast(unsigned, v), b = a; asm volatile("s_nop 1\n\tv_permlane32_swap_b32 %0, %1" : "+v"(a), "+v"(b)); return __builtin_bit_cast(float, a) + __builtin_bit_cast(float, b); }
__device__ __forceinline__ void load_q(v4u (&raw)[8], const char* qrow, int hi) {
#pragma unroll
    for (int d0 = 0; d0 < 8; ++d0) raw[d0] = *(const GAS v4u*)(qrow + (d0 * 16 + hi * 8) * 2);
}
__device__ __forceinline__ void norm_q(const v4u (&raw)[8], bf16x8 (&qr)[8], const LAS float* gt, int hi) {
    float ss = 0.f;
#pragma unroll
    for (int d0 = 0; d0 < 8; ++d0)
#pragma unroll
        for (int j = 0; j < 4; ++j) { const float a = bflo(raw[d0][j]), b = bfhi(raw[d0][j]); ss += a * a + b * b; }
    ss = xsum32(ss);
    const float rstd = 1.0f / sqrtf(ss * (1.f / HD) + EPS);
#pragma unroll
    for (int d0 = 0; d0 < 8; ++d0) { const LAS f32x4* gp = (const LAS f32x4*)(gt + d0 * 16 + hi * 8); const f32x4 g0 = gp[0], g1 = gp[1]; v4u o;
        o.x = cvtpk(bflo(raw[d0].x) * rstd * g0.x, bfhi(raw[d0].x) * rstd * g0.y); o.y = cvtpk(bflo(raw[d0].y) * rstd * g0.z, bfhi(raw[d0].y) * rstd * g0.w);
        o.z = cvtpk(bflo(raw[d0].z) * rstd * g1.x, bfhi(raw[d0].z) * rstd * g1.y); o.w = cvtpk(bflo(raw[d0].w) * rstd * g1.z, bfhi(raw[d0].w) * rstd * g1.w);
        qr[d0] = __builtin_bit_cast(bf16x8, o); }
}
__device__ __forceinline__ f32x16 qk_tile(const LAS unsigned char* Kl, int pb, const bf16x8 (&qr)[8], int r32, int hi) {
    f32x16 p = {};
#pragma unroll
    for (int d0 = 0; d0 < 8; ++d0) { const bf16x8 kf = *(const LAS bf16x8*)(Kl + KSWZ(pb + r32, (d0 * 16 + hi * 8) * 2));
        p = __builtin_amdgcn_mfma_f32_32x32x16_bf16(kf, qr[d0], p, 0, 0, 0); }
    return p;
}
#define PK4(P, BASE, OUT) do { unsigned a0 = cvtpk(P[BASE + 0], P[BASE + 1]), a1 = cvtpk(P[BASE + 2], P[BASE + 3]);   \
    unsigned b0 = cvtpk(P[BASE + 4], P[BASE + 5]), b1 = cvtpk(P[BASE + 6], P[BASE + 7]);                              \
    auto r0 = __builtin_amdgcn_permlane32_swap(a0, b0, false, false); auto r1 = __builtin_amdgcn_permlane32_swap(a1, b1, false, false); \
    v4u w_ = {r0[0], r1[0], r0[1], r1[1]}; OUT = __builtin_bit_cast(bf16x8, w_); } while (0)
template <int OFF> __device__ __forceinline__ void pv_step(f32x16& o, int vb, bf16x8 pa) {
    const s16x4 l = tr_read<OFF>(vb), h = tr_read<OFF + 2048>(vb);
    asm volatile("s_waitcnt lgkmcnt(0)" ::: "memory"); __builtin_amdgcn_sched_barrier(0);
    o = __builtin_amdgcn_mfma_f32_32x32x16_bf16(pa, (bf16x8){l[0], l[1], l[2], l[3], h[0], h[1], h[2], h[3]}, o, 0, 0, 0);
}
__device__ __forceinline__ void store_block(const f32x16& o, const LAS float* il, LAS unsigned short* stg, char* dst0, long rstride, int lane) {
    asm volatile("" : "+v"(lane));
    const int r32 = lane & 31, hi = lane >> 5;
#pragma unroll
    for (int r = 0; r < 16; ++r) { const int row = crow(r, hi); stg[row * 32 + r32] = (unsigned short)f2bf(o[r] * il[row]); }
    LDS_WAIT(); asm volatile("" ::: "memory");
#pragma unroll
    for (int p = 0; p < 2; ++p) { const int row = 16 * p + (lane >> 2), ch = lane & 3;
        const v4u w = *(const LAS v4u*)((const LAS unsigned char*)stg + row * 64 + ch * 16);
        *(GAS v4u*)(dst0 + (long)row * rstride + ch * 16) = w; }
    LDS_WAIT(); asm volatile("" ::: "memory");
}
}

#define RAW_BAR() do { asm volatile("s_waitcnt lgkmcnt(0)" ::: "memory"); __builtin_amdgcn_s_barrier(); asm volatile("" ::: "memory"); } while (0)
__device__ __forceinline__ void p2_attention(Frame& F) {
    using namespace att;
    LAS unsigned char* Kl = F.lds + LDS_K; LAS unsigned char* Vl = F.lds + LDS_V;
    LAS unsigned short* stg = (LAS unsigned short*)(F.lds + LDS_STG + F.wave * 2048);
    LAS float* li = (LAS float*)(F.lds + LDS_LI + F.wave * 256);
    LAS float* gtab = (LAS float*)(F.lds + LDS_GT);
    LAS float* rk = (LAS float*)(F.lds + LDS_GT + 2048);
    volatile LAS int* QN = (volatile LAS int*)(F.lds + LDS_GT + 2048 + 1024);
    const int tid = F.tid, wave = F.wave;
    if (blockIdx.x < 8) {
        pg8::Gemm g{(const bf16*)(F.ws + WS_H), (const bf16*)(F.ws + WS_WIN), D, nullptr}; pg8::P1Order S{F.G, (int)blockIdx.x, 2560, 2568};
        pg8::EpiProj E{(bf16*)(F.ws + WS_R1), (bf16*)(F.ws + WS_MEMKV)};
        pg8::gemm_phase<pg8::EpiProj, pg8::P1Order>(F.lds, g, S, E);
        VM_WAIT(); __syncthreads();
        if (tid == 0) { __builtin_amdgcn_fence(__ATOMIC_RELEASE, "agent"); asm volatile("s_waitcnt vmcnt(0)" ::: "memory"); __hip_atomic_fetch_add(F.ctl + CW_KVREADY, 1u, RLX_AGENT); }
    }
    if (tid < 128) { gtab[tid] = F.q_norm_g[tid] * F.k_norm_g[tid]; gtab[128 + tid] = F.mem_q_norm_g[tid] * F.mem_k_norm_g[tid]; gtab[256 + tid] = F.mem_q_norm_g[tid]; gtab[384 + tid] = F.mem_k_norm_g[tid]; }
    if (tid == 0) QN[0] = 1 << 30;
    __syncthreads();
    float MD, MM;
    { float a = 0.f, c = 0.f;
#pragma unroll 1
      for (int i = 0; i < 128; ++i) { a = fmaxf(a, fabsf(gtab[i])); c = fmaxf(c, fabsf(gtab[128 + i])); }
      MD = a * (128.0f * 1.03f) * CS; MM = c * (128.0f * 1.03f) * CS; }
    const char* proj = (const char*)(F.ws + WS_R1);

    {
    const int j = wave & 3, dh = wave >> 2, w0 = 32 * j + 16 * dh;
    constexpr int NCHUNK = 6144 / 4;
    v4u qraw[4];
#define DECODE(u, br, b, h, r, nb, dil) const int br = (u) >> 11, _rem = (u) & 2047, b = _rem >> 10, h = (_rem >> 7) & 7, _w = _rem & 127, dil = 1 << (2 * br), _nps = 128 >> (2 * br), r = _w / _nps, nb = _w % _nps
    int u = 4 * F.vcu;
    bool have = F.vcu < NCHUNK;
    bool full = true;
    if (have) {
        DECODE(u, br, b, h, r, nb, dil);
        const long rs = (long)dil * PROJ * 2; const char* tb = proj + (size_t)(b * SEQ + r) * (PROJ * 2);
        RowMap mk{tb + (COL_K + h * HD) * 2, rs, 128 * nb - 128, true};
        dma_k(Kl, 0, 256, mk, wave, F.lane);
        load_q16(qraw, tb + (long)(128 * nb + w0 + (F.lane & 15)) * rs + (COL_Q + h * HD) * 2, F.lane >> 4);
    }
    while (have) {
        DECODE(u, br, b, h, r, nb, dil);
        int lane = F.lane; asm volatile("" : "+v"(lane));
        const int q16 = lane & 15, kg = lane >> 4;
        const int off = 128 * ((nb + 1) & 1);
        const long rs_ = (long)dil * PROJ * 2; const char* tb_ = proj + (size_t)(b * SEQ + r) * (PROJ * 2);
        asm volatile("s_waitcnt vmcnt(0)" ::: "memory"); RAW_BAR();
        { RowMap mv{tb_ + (COL_V + h * HD) * 2, rs_, 128 * nb - 128, true};
          if (full) dma_v2(Vl, 0, 256, mv, wave, lane); else dma_v2(Vl, 128 * (nb & 1), 128, mv, wave, lane); }
        if ((u & 3) == 0 && tid == 0) QN[0] = F.G + (int)__hip_atomic_fetch_add(F.ctl + CW_ATTQ, 1u, RLX_AGENT);
        { const int p0 = full ? 0 : 128 * (nb & 1), n4 = full ? 1024 : 512;
#pragma unroll 1
          for (int idx = tid; idx < n4; idx += 512) { const int row = p0 + (idx >> 2), qd = idx & 3; float ss = 0.f;
#pragma unroll
              for (int i = 0; i < 4; ++i) { const v4u w = *(const LAS v4u*)(Kl + KSWZ(row, (4 * qd + i) * 16));
#pragma unroll
                  for (int jj = 0; jj < 4; ++jj) { const float a = bflo(w[jj]), c = bfhi(w[jj]); ss += a * a + c * c; } }
              ss += __shfl_xor(ss, 1); ss += __shfl_xor(ss, 2);
              if (qd == 0) rk[row] = 1.0f / sqrtf(ss * (1.f / HD) + EPS); } }
        bf16x8 qr[4];
        norm_q16(qraw, qr, gtab, kg);
        f32x4 s[9];
#pragma unroll
        for (int t = 0; t < 9; ++t) { const int pb = (w0 + 16 * t + off) & 255; f32x4 a = {0.f, 0.f, 0.f, 0.f};
#pragma unroll
            for (int d = 0; d < 4; ++d) { const bf16x8 kf = *(const LAS bf16x8*)(Kl + KSWZ(pb + q16, 64 * d + 16 * kg));
                a = __builtin_amdgcn_mfma_f32_16x16x32_bf16(kf, qr[d], a, 0, 0, 0); }
            s[t] = a; }
        RAW_BAR();
        int un = u + 1; bool has_next = true;
        if ((un & 3) == 0) { const int nc = QN[0]; has_next = nc < NCHUNK; un = 4 * nc; }
        bool n_full = false;
        if (has_next) {
            DECODE(un, br2, b2, h2, r2, nb2, dil2);
            n_full = (un != u + 1) || (nb2 == 0);
            const long rs = (long)dil2 * PROJ * 2; const char* tb = proj + (size_t)(b2 * SEQ + r2) * (PROJ * 2);
            RowMap nmk{tb + (COL_K + h2 * HD) * 2, rs, 128 * nb2 - 128, true};
            if (n_full) dma_k(Kl, 0, 256, nmk, wave, lane); else dma_k(Kl, 128 * (nb2 & 1), 128, nmk, wave, lane);
            load_q16(qraw, tb + (long)(128 * nb2 + w0 + q16) * rs + (COL_Q + h2 * HD) * 2, kg);
        }
        const float bias2 = __builtin_amdgcn_exp2f(-(float)(h + 1)) * (float)dil * LOG2E;
        const float rowoff = bias2 * (float)(4 * kg - q16 - 128) - MD;
        float l = 0.f;
#pragma unroll
        for (int t = 0; t < 9; ++t) {
            const int pb = (w0 + 16 * t + off) & 255;
            const f32x4 rkv = *(const LAS f32x4*)(rk + pb + 4 * kg);
            const bool dead = (nb == 0) && (w0 + 16 * t < 128);
#pragma unroll
            for (int r_ = 0; r_ < 4; ++r_) {
                float v = fmaf(s[t][r_] * rkv[r_], CS, fmaf(bias2, (float)(16 * t + r_), rowoff));
                if (t == 0) v = (4 * kg + r_ >= q16) ? v : -1.0e30f;
                if (t == 8) v = (4 * kg + r_ <= q16) ? v : -1.0e30f;
                v = dead ? 0.f : __builtin_amdgcn_exp2f(v); s[t][r_] = v; l += v; }
        }
        l += __shfl_xor(l, 16); l += __shfl_xor(l, 32);
        bf16x8 pa[5];
#pragma unroll
        for (int sp = 0; sp < 5; ++sp) { v4u w; w.x = cvtpk(s[2 * sp][0], s[2 * sp][1]); w.y = cvtpk(s[2 * sp][2], s[2 * sp][3]);
            if (sp < 4) { w.z = cvtpk(s[2 * sp + 1][0], s[2 * sp + 1][1]); w.w = cvtpk(s[2 * sp + 1][2], s[2 * sp + 1][3]); } else { w.z = 0u; w.w = 0u; }
            pa[sp] = __builtin_bit_cast(bf16x8, w); }
        if (has_next) asm volatile("s_waitcnt vmcnt(8)" ::: "memory"); else asm volatile("s_waitcnt vmcnt(0)" ::: "memory");
        RAW_BAR();
        f32x4 o[8];
#pragma unroll
        for (int db = 0; db < 8; ++db) o[db] = (f32x4){0.f, 0.f, 0.f, 0.f};
        { const int qq = q16 >> 2, pp = q16 & 3;
#pragma unroll
          for (int sp = 0; sp < 5; ++sp) {
              const int ra = (w0 + 32 * sp + off + 4 * kg + qq) & 255, rb = (w0 + 32 * sp + 16 + off + 4 * kg + qq) & 255;
              const int va = (int)(uintptr_t)Vl + ra * 256 + 8 * pp, vb = (int)(uintptr_t)Vl + rb * 256 + 8 * pp, xa = (ra & 7) << 5, xb = (rb & 7) << 5;
#pragma unroll
              for (int dq = 0; dq < 2; ++dq) {
                  s16x4 la[4], lb[4];
#pragma unroll
                  for (int i = 0; i < 4; ++i) { const int db = 4 * dq + i;
                      asm volatile("ds_read_b64_tr_b16 %0, %1" : "=&v"(la[i]) : "v"(va + ((32 * db) ^ xa)) : "memory");
                      asm volatile("ds_read_b64_tr_b16 %0, %1" : "=&v"(lb[i]) : "v"(vb + ((32 * db) ^ xb)) : "memory"); }
                  asm volatile("s_waitcnt lgkmcnt(0)" ::: "memory"); __builtin_amdgcn_sched_barrier(0);
#pragma unroll
                  for (int i = 0; i < 4; ++i) { const int db = 4 * dq + i;
                      o[db] = __builtin_amdgcn_mfma_f32_16x16x32_bf16(pa[sp], (bf16x8){la[i][0], la[i][1], la[i][2], la[i][3], lb[i][0], lb[i][1], lb[i][2], lb[i][3]}, o[db], 0, 0, 0); }
              } } }
        const float il = 1.0f / l;
        if (kg == 0) li[q16] = il;
        LDS_WAIT(); asm volatile("" ::: "memory");
        const f32x4 ilr = *(const LAS f32x4*)(li + 4 * kg);
        const int tok0 = b * SEQ + r + dil * (128 * nb + w0);
        char* dst = (char*)(F.ws + WS_OPART) + ((size_t)br * T + tok0) * (ATTN_W * 2) + (h * HD) * 2;
#pragma unroll
        for (int hf = 0; hf < 2; ++hf) {
#pragma unroll
            for (int i = 0; i < 4; ++i)
#pragma unroll
                for (int r_ = 0; r_ < 4; ++r_) stg[(4 * kg + r_) * 64 + 16 * i + q16] = (unsigned short)f2bf(o[4 * hf + i][r_] * ilr[r_]);
            LDS_WAIT(); asm volatile("" ::: "memory");
#pragma unroll
            for (int p = 0; p < 2; ++p) { const int row = lane >> 2, ch = (lane & 3) + 4 * p;
                const v4u w = *(const LAS v4u*)((const LAS unsigned char*)stg + row * 128 + ch * 16);
                *(GAS v4u*)(dst + (long)row * ((long)dil * ATTN_W * 2) + hf * 128 + ch * 16) = w; }
            LDS_WAIT(); asm volatile("" ::: "memory");
        }
        if (kg == 0) ((float*)(F.ws + WS_LSE))[((size_t)br * T + tok0 + dil * q16) * 8 + h] = MD + __builtin_amdgcn_logf(l);
        have = has_next; u = un; full = n_full;
    }
#undef DECODE
    }

    VM_WAIT(); __syncthreads();
    if (wave == 0) { unsigned sp = 0;
        while (__builtin_amdgcn_readfirstlane(__hip_atomic_load(F.ctl + CW_KVREADY, RLX_AGENT)) < 8u) { __builtin_amdgcn_s_sleep(2); if (++sp > (1u << 22)) { if (F.lane == 0) __hip_atomic_store(F.ctl + CW_TMO, 1u, RLX_AGENT); break; } }
        __builtin_amdgcn_fence(__ATOMIC_ACQUIRE, "agent"); asm volatile("s_waitcnt vmcnt(0)" ::: "memory"); }
    __syncthreads();
    for (int it = F.vcu; it < 256; it += F.G) {
        const int combo = it >> 5, part = it & 31, b = combo >> 2, hm = combo & 3;
        const char* mkv = (const char*)(F.ws + WS_MEMKV) + (size_t)(b * NMEM) * 2048 + hm * 256;
        RowMap mk{mkv, 2048, 0, false}, mv{mkv + 1024, 2048, 0, false};
        __syncthreads();
        dma_k(Kl, 0, 256, mk, wave, F.lane); dma_v(Vl, 0, 256, mv, wave, F.lane);
        VM_WAIT(); __syncthreads();
        norm_k(Kl, 0, 256, gtab + 384, tid);
        __syncthreads();
        for (int qb = 0; qb < 2; ++qb) {
            int lane = F.lane; asm volatile("" : "+v"(lane));
            const int r32 = lane & 31, hi = lane >> 5, vbase = (int)(uintptr_t)Vl + v_rd_base(lane);
            const int tok = b * SEQ + part * 512 + qb * 256 + wave * 32 + r32;
            v4u raw[8]; bf16x8 qr[8];
            load_q(raw, proj + (size_t)tok * (PROJ * 2) + (COL_MQ + hm * HD) * 2, hi);
            norm_q(raw, qr, gtab + 256, hi);
            const float mc = -MM; float l = 0.f;
            f32x16 o[4] = {};
#pragma unroll 1
            for (int hk = 0; hk < 2; ++hk) {
                bf16x8 pa[8];
#pragma unroll
                for (int kt = 0; kt < 4; ++kt) { f32x16 s = qk_tile(Kl, 128 * hk + 32 * kt, qr, r32, hi);
#pragma unroll
                    for (int r = 0; r < 16; ++r) { s[r] = __builtin_amdgcn_exp2f(fmaf(s[r], CS, mc)); l += s[r]; }
                    PK4(s, 0, pa[2 * kt]); PK4(s, 8, pa[2 * kt + 1]); }
#pragma unroll
                for (int f = 0; f < 8; ++f) { const int vb = vbase + (8 * hk + f) * 4096;
                    pv_step<0>(o[0], vb, pa[f]); pv_step<512>(o[1], vb, pa[f]); pv_step<1024>(o[2], vb, pa[f]); pv_step<1536>(o[3], vb, pa[f]); }
            }
            l = xsum32(l);
            if (hi == 0) li[r32] = 1.0f / l;
            LDS_WAIT(); asm volatile("" ::: "memory");
            char* dst = (char*)(F.ws + WS_MEMO) + (size_t)(tok - r32) * (MEM_W * 2) + hm * 256;
#pragma unroll
            for (int d0 = 0; d0 < 4; ++d0) store_block(o[d0], li, stg, dst + d0 * 64, MEM_W * 2, lane);
        }
    }
}

__device__ __forceinline__ void unpack8(const v4u w, float (&f)[8]) { f[0] = bflo(w.x); f[1] = bfhi(w.x); f[2] = bflo(w.y); f[3] = bfhi(w.y); f[4] = bflo(w.z); f[5] = bfhi(w.z); f[6] = bflo(w.w); f[7] = bfhi(w.w); }
__device__ __forceinline__ void p3_combine(Frame& F) {
    const int gw = F.vcu * NWAVES + F.wave, NGW = F.G * NWAVES, lane = F.lane;
    const bf16* proj = (const bf16*)(F.ws + WS_R1); const bf16* opart = (const bf16*)(F.ws + WS_OPART); const float* lse = (const float*)(F.ws + WS_LSE);
    const bf16* memo = (const bf16*)(F.ws + WS_MEMO); bf16* Y = (bf16*)(F.ws + WS_Y);
    for (int t = gw; t < T; t += NGW) {
        float a[16]; float ssa = 0.f;
#pragma unroll
        for (int cc = 0; cc < 2; ++cc) { const int head = 4 * cc + (lane >> 4);
            const float l0 = lse[((size_t)0 * T + t) * 8 + head], l1 = lse[((size_t)1 * T + t) * 8 + head], l2 = lse[((size_t)2 * T + t) * 8 + head];
            const float mx = fmaxf(l0, fmaxf(l1, l2)); float w0 = __builtin_amdgcn_exp2f(l0 - mx), w1 = __builtin_amdgcn_exp2f(l1 - mx), w2 = __builtin_amdgcn_exp2f(l2 - mx);
            const float inv = 1.0f / (w0 + w1 + w2); w0 *= inv; w1 *= inv; w2 *= inv;
            float f0[8], f1[8], f2[8];
            unpack8(__builtin_nontemporal_load((const GAS v4u*)(opart + ((size_t)0 * T + t) * ATTN_W + cc * 512 + 8 * lane)), f0);
            unpack8(__builtin_nontemporal_load((const GAS v4u*)(opart + ((size_t)1 * T + t) * ATTN_W + cc * 512 + 8 * lane)), f1);
            unpack8(__builtin_nontemporal_load((const GAS v4u*)(opart + ((size_t)2 * T + t) * ATTN_W + cc * 512 + 8 * lane)), f2);
#pragma unroll
            for (int jj = 0; jj < 8; ++jj) { const float v = w0 * f0[jj] + w1 * f1[jj] + w2 * f2[jj]; a[8 * cc + jj] = v; ssa += v * v; } }
        float co[8]; float ssc = 0.f;
        { const int s = t & (SEQ - 1); float bg[8], c0[8], uu0[8], c1[8], uu1[8], c2[8], uu2[8];
          const bf16* p0 = proj + (size_t)t * PROJ + 8 * lane;
          unpack8(*(const GAS v4u*)(p0 + COL_B), bg); unpack8(*(const GAS v4u*)(p0 + COL_C), c0); unpack8(*(const GAS v4u*)(p0 + COL_U), uu0);
          if (s >= 1) { unpack8(*(const GAS v4u*)(p0 - PROJ + COL_C), c1); unpack8(*(const GAS v4u*)(p0 - PROJ + COL_U), uu1); }
          if (s >= 2) { unpack8(*(const GAS v4u*)(p0 - 2 * PROJ + COL_C), c2); unpack8(*(const GAS v4u*)(p0 - 2 * PROJ + COL_U), uu2); }
#pragma unroll
          for (int jj = 0; jj < 8; ++jj) { const int c = 8 * lane + jj;
              const float z0 = c0[jj] * uu0[jj], z1 = (s >= 1) ? c1[jj] * uu1[jj] : 0.f, z2 = (s >= 2) ? c2[jj] * uu2[jj] : 0.f;
              const float v = bg[jj] * (F.conv_w[c] * z2 + F.conv_w[CONV_W + c] * z1 + F.conv_w[2 * CONV_W + c] * z0); co[jj] = v; ssc += v * v; } }
        float mo[8]; float ssm = 0.f;
        unpack8(__builtin_nontemporal_load((const GAS v4u*)(memo + (size_t)t * MEM_W + 8 * lane)), mo);
#pragma unroll
        for (int jj = 0; jj < 8; ++jj) ssm += mo[jj] * mo[jj];
#pragma unroll
        for (int o = 1; o < 64; o <<= 1) { ssa += __shfl_xor(ssa, o); ssc += __shfl_xor(ssc, o); ssm += __shfl_xor(ssm, o); }
        const float ra = 1.0f / sqrtf(ssa * (1.f / ATTN_W) + EPS), rc = 1.0f / sqrtf(ssc * (1.f / CONV_W) + EPS), rm = 1.0f / sqrtf(ssm * (1.f / MEM_W) + EPS);
        bf16* yr = Y + (size_t)t * D;
#pragma unroll
        for (int cc = 0; cc < 2; ++cc) { const float* g = F.out_norm_g + cc * 512 + 8 * lane; v4u w;
            w.x = pk2(a[8 * cc + 0] * ra * g[0], a[8 * cc + 1] * ra * g[1]); w.y = pk2(a[8 * cc + 2] * ra * g[2], a[8 * cc + 3] * ra * g[3]);
            w.z = pk2(a[8 * cc + 4] * ra * g[4], a[8 * cc + 5] * ra * g[5]); w.w = pk2(a[8 * cc + 6] * ra * g[6], a[8 * cc + 7] * ra * g[7]);
            *(GAS v4u*)(yr + cc * 512 + 8 * lane) = w; }
        { const float* g = F.out_norm_g + ATTN_W + 8 * lane; v4u w;
          w.x = pk2(co[0] * rc * g[0], co[1] * rc * g[1]); w.y = pk2(co[2] * rc * g[2], co[3] * rc * g[3]); w.z = pk2(co[4] * rc * g[4], co[5] * rc * g[5]); w.w = pk2(co[6] * rc * g[6], co[7] * rc * g[7]);
          *(GAS v4u*)(yr + ATTN_W + 8 * lane) = w; }
        { const float* g = F.out_norm_g + ATTN_W + CONV_W + 8 * lane; v4u w;
          w.x = pk2(mo[0] * rm * g[0], mo[1] * rm * g[1]); w.y = pk2(mo[2] * rm * g[2], mo[3] * rm * g[3]); w.z = pk2(mo[4] * rm * g[4], mo[5] * rm * g[5]); w.w = pk2(mo[6] * rm * g[6], mo[7] * rm * g[7]);
          *(GAS v4u*)(yr + ATTN_W + CONV_W + 8 * lane) = w; }
    }
}

__device__ __forceinline__ float max8(float v) { v = fmaxf(v, __shfl_xor(v, 1)); v = fmaxf(v, __shfl_xor(v, 2)); v = fmaxf(v, __shfl_xor(v, 4)); return v; }
namespace rt {
constexpr int KC = 128, NCH = D / KC, BP = KC * 2 + 16, BUFB = 2 * 96 * BP;
__device__ __forceinline__ void issue_b(v4u (&bst)[6], const bf16* WT, int c, int tid) {
#pragma unroll
    for (int i = 0; i < 6; ++i) { const int p = tid + 512 * i, arr = p / 1536, rem = p - arr * 1536, n = rem >> 4, ch = rem & 15;
        bst[i] = *(const GAS v4u*)(WT + ((size_t)arr * 96 + n) * 2048 + c * KC + ch * 8); }
}
__device__ __forceinline__ void write_b(const v4u (&bst)[6], LAS unsigned char* buf, int tid) {
#pragma unroll
    for (int i = 0; i < 6; ++i) { const int p = tid + 512 * i, arr = p / 1536, rem = p - arr * 1536, n = rem >> 4, ch = rem & 15;
        *(LAS v4u*)(buf + arr * (96 * BP) + n * BP + ch * 16) = bst[i]; }
}
__device__ __forceinline__ void issue_a(v4u (&a)[4], const bf16* xrow, int c) {
#pragma unroll
    for (int ks = 0; ks < 4; ++ks) a[ks] = *(const GAS v4u*)(xrow + c * KC + ks * 32);
}
__device__ __forceinline__ void compute(f32x4 (&acc)[6], float& ss, const v4u (&a)[4], const LAS unsigned char* buf, int fr, int kg) {
#pragma unroll
    for (int ks = 0; ks < 4; ++ks) {
        const v4u h = a[ks];
#pragma unroll
        for (int j = 0; j < 4; ++j) { const float lo_ = bflo(h[j]), hi_ = bfhi(h[j]); ss += lo_ * lo_ + hi_ * hi_; }
        asm volatile("" : "+v"(ss));
        const bf16x8 ah = __builtin_bit_cast(bf16x8, h);
#pragma unroll
        for (int nb = 0; nb < 6; ++nb) { const LAS unsigned char* bp = buf + (nb * 16 + fr) * BP + (ks * 32 + 8 * kg) * 2;
            const bf16x8 bh = *(const LAS bf16x8*)bp, bl = *(const LAS bf16x8*)(bp + 96 * BP);
            acc[nb] = __builtin_amdgcn_mfma_f32_16x16x32_bf16(ah, bh, acc[nb], 0, 0, 0);
            acc[nb] = __builtin_amdgcn_mfma_f32_16x16x32_bf16(ah, bl, acc[nb], 0, 0, 0); }
    }
}
}
__device__ __forceinline__ void p5_router(Frame& F) {
    using namespace rt;
    const int tid = F.tid, wave = F.wave;
    const bf16* X1 = (const bf16*)(F.ws + WS_X1H); const bf16* WT = (const bf16*)(F.ws + WS_WR);
    LAS unsigned char* Bl = F.lds;
    LAS float* Lg = (LAS float*)(F.lds + 2 * BUFB + wave * (16 * 97 * 4));
    unsigned* cnt = F.ctl + CW_CNT;
    int* tok_e = (int*)(F.ws + WS_TOK + TOK_E); int* tok_rank = (int*)(F.ws + WS_TOK + TOK_RANK);
    for (int mt = F.vcu; mt < T / 128; mt += F.G) {
        int lane = F.lane; asm volatile("" : "+v"(lane));
        const int fr = lane & 15, kg = lane >> 4;
        const int t0 = mt * 128 + wave * 16;
        const bf16* xrow = X1 + (size_t)(t0 + fr) * D + 8 * kg;
        f32x4 acc[6];
#pragma unroll
        for (int i = 0; i < 6; ++i) acc[i] = (f32x4){0.f, 0.f, 0.f, 0.f};
        float ss = 0.f;
        v4u bst[6]; v4u a0[4], a1[4];
        __syncthreads();
        issue_b(bst, WT, 0, tid); issue_a(a0, xrow, 0);
#pragma unroll 1
        for (int c = 0; c < NCH - 2; c += 2) {
            write_b(bst, Bl, tid); __syncthreads();
            issue_b(bst, WT, c + 1, tid); issue_a(a1, xrow, c + 1);
            compute(acc, ss, a0, Bl, fr, kg);
            write_b(bst, Bl + BUFB, tid); __syncthreads();
            issue_b(bst, WT, c + 2, tid); issue_a(a0, xrow, c + 2);
            compute(acc, ss, a1, Bl + BUFB, fr, kg);
        }
        write_b(bst, Bl, tid); __syncthreads();
        issue_b(bst, WT, NCH - 1, tid); issue_a(a1, xrow, NCH - 1);
        compute(acc, ss, a0, Bl, fr, kg);
        write_b(bst, Bl + BUFB, tid); __syncthreads();
        compute(acc, ss, a1, Bl + BUFB, fr, kg);
        ss += __shfl_xor(ss, 16); ss += __shfl_xor(ss, 32);
        const float rs_row = 1.0f / sqrtf(ss * (1.f / D) + EPS);
#pragma unroll
        for (int r = 0; r < 4; ++r) { const float rr = __shfl(rs_row, 4 * kg + r);
#pragma unroll
            for (int nb = 0; nb < 6; ++nb) Lg[(4 * kg + r) * 97 + nb * 16 + fr] = acc[nb][r] * rr; }
        LDS_WAIT(); asm volatile("" ::: "memory");
        const float be = F.b_re[lane], bg = F.b_rg[lane & 7];
        int my_e1 = 0, my_e2 = 0; float my_g1 = 0.f, my_g2 = 0.f;
#pragma unroll 4
        for (int tk = 0; tk < 16; ++tk) {
            const float gl = Lg[tk * 97 + 64 + (lane & 7)] + bg;
            const float el = Lg[tk * 97 + lane] + be;
            const float gmax = max8(gl);
            const int gi = __builtin_ctzll(__ballot(gl == gmax) & 0xFFull);
            float gs = __builtin_amdgcn_exp2f((gl - gmax) * LOG2E); gs += __shfl_xor(gs, 1); gs += __shfl_xor(gs, 2); gs += __shfl_xor(gs, 4);
            const float gwt = 1.0f / gs;
            const float v1 = __shfl(max8(el), 8 * gi);
            const int i1 = __builtin_ctzll((__ballot(el == v1) >> (8 * gi)) & 0xFFull);
            const float el2 = (lane == 8 * gi + i1) ? -3.0e38f : el;
            const float v2 = __shfl(max8(el2), 8 * gi);
            const int i2 = __builtin_ctzll((__ballot(el2 == v2) >> (8 * gi)) & 0xFFull);
            const float pr = __builtin_amdgcn_exp2f((v2 - v1) * LOG2E), den = 1.0f / (1.0f + pr);
            if (lane == tk) { my_e1 = 8 * gi + i1; my_e2 = 8 * gi + i2; my_g1 = gwt * den; my_g2 = gwt * pr * den; }
        }
        LAS unsigned* hist = (LAS unsigned*)(F.lds + MISC_OFF + 256);
        if (tid < 64) hist[tid] = 0u;
        __syncthreads();
        unsigned lr1 = 0u, lr2 = 0u;
        if (lane < 16) { lr1 = __hip_atomic_fetch_add(hist + my_e1, 1u, __ATOMIC_RELAXED, __HIP_MEMORY_SCOPE_WORKGROUP); lr2 = __hip_atomic_fetch_add(hist + my_e2, 1u, __ATOMIC_RELAXED, __HIP_MEMORY_SCOPE_WORKGROUP); }
        __syncthreads();
        if (tid < 64) { const unsigned c = hist[tid]; hist[64 + tid] = c ? __hip_atomic_fetch_add(cnt + 64 * tid, c, RLX_AGENT) : 0u; }
        __syncthreads();
        if (lane < 16) {
            const int t = t0 + lane;
            const int k1 = (int)(hist[64 + my_e1] + lr1), k2 = (int)(hist[64 + my_e2] + lr2);
            tok_e[2 * t] = my_e1; tok_e[2 * t + 1] = my_e2; tok_rank[2 * t] = k1; tok_rank[2 * t + 1] = k2;
            int* ltok = (int*)(F.ws + WS_LIST + LIST_TOK); float* lrs = (float*)(F.ws + WS_LIST + LIST_RSTD); float* lgt = (float*)(F.ws + WS_LIST + LIST_GATE);
            ltok[my_e1 * CAP + k1] = t; ltok[my_e2 * CAP + k2] = t; lrs[my_e1 * CAP + k1] = rs_row; lrs[my_e2 * CAP + k2] = rs_row; lgt[my_e1 * CAP + k1] = my_g1; lgt[my_e2 * CAP + k2] = my_g2;
        }
    }
}

constexpr int MOE_MT = MISC_OFF + 48, MOE_PST = MISC_OFF + 64, MOE_TE = MOE_PST + 256;
constexpr int MOE_TB = LDS_EXTRA, MOE_VR = MOE_TB + MAXTILES * 4, MOE_UT = MOE_VR + MAXTILES * 4, MOE_SCU = MOE_UT + 12 * 256 * 4;
constexpr int MOE_MAXU = 12;
static_assert(MOE_SCU + MOE_MAXU * 256 * 4 <= MISC_OFF && MOE_TE + MAXTILES * 4 <= LDS_BYTES, "LDS map");
__device__ __forceinline__ int moe_tables(Frame& F) {
    LAS int* PST = (LAS int*)(F.lds + MOE_PST); LAS int* TE = (LAS int*)(F.lds + MOE_TE); LAS int* MTp = (LAS int*)(F.lds + MOE_MT); LAS int* TB = (LAS int*)(F.lds + MOE_TB); LAS int* VR = (LAS int*)(F.lds + MOE_VR);
    __syncthreads();
    if (F.tid < 64) {
        const int c = (int)__hip_atomic_load(F.ctl + CW_CNT + 64 * F.tid, RLX_AGENT); const int nt = (c + 255) >> 8;
        int x = nt;
#pragma unroll
        for (int o = 1; o < 64; o <<= 1) { const int y = __shfl_up(x, o); if (F.lane >= o) x += y; }
        const int ex = x - nt; PST[F.tid] = ex; if (F.tid == 63) MTp[0] = x;
        for (int i = 0; i < nt; ++i) { TE[ex + i] = F.tid; TB[ex + i] = F.tid * CAP + 256 * i; VR[ex + i] = (c - 256 * i) < 256 ? (c - 256 * i) : 256; }
    }
    __syncthreads();
    return MTp[0];
}

__device__ __forceinline__ void unpack8q(const v2u w, float (&f)[8]) {
    typedef float f32x2_ __attribute__((ext_vector_type(2)));
    const f32x2_ p0 = __builtin_amdgcn_cvt_pk_f32_fp8((int)w.x, false), p1 = __builtin_amdgcn_cvt_pk_f32_fp8((int)w.x, true), p2 = __builtin_amdgcn_cvt_pk_f32_fp8((int)w.y, false), p3 = __builtin_amdgcn_cvt_pk_f32_fp8((int)w.y, true);
    constexpr float q = 1.0f / SC_Y; f[0] = p0.x * q; f[1] = p0.y * q; f[2] = p1.x * q; f[3] = p1.y * q; f[4] = p2.x * q; f[5] = p2.y * q; f[6] = p3.x * q; f[7] = p3.y * q;
}
__device__ __forceinline__ void p9_final(Frame& F) {
    (void)moe_tables(F);
    const LAS int* PST = (const LAS int*)(F.lds + MOE_PST);
    const int gw = F.vcu * NWAVES + F.wave, NGW = F.G * NWAVES, lane = F.lane;
    const int* tok_e = (const int*)(F.ws + WS_TOK + TOK_E); const int* tok_rank = (const int*)(F.ws + WS_TOK + TOK_RANK); const bf16* YB = (const bf16*)(F.ws + WS_R1);
    typedef int i32x2 __attribute__((ext_vector_type(2)));
    i32x2 ce = {0, 0}, cr = {0, 0};
    if (gw < T) { ce = *(const GAS i32x2*)(tok_e + 2 * gw); cr = *(const GAS i32x2*)(tok_rank + 2 * gw); }
    for (int t = gw; t < T; t += NGW) {
        const int s1 = PST[ce.x] * 256 + cr.x, s2 = PST[ce.y] * 256 + cr.y;
        if (t + NGW < T) { ce = *(const GAS i32x2*)(tok_e + 2 * (t + NGW)); cr = *(const GAS i32x2*)(tok_rank + 2 * (t + NGW)); }
        const GAS v2u* y1 = (const GAS v2u*)((const unsigned char*)YB + (size_t)s1 * D) + lane; const GAS v2u* y2 = (const GAS v2u*)((const unsigned char*)YB + (size_t)s2 * D) + lane;
        GAS f32x4* o = (GAS f32x4*)(F.out + (size_t)t * D) + 2 * lane; const GAS v4u* xh = (const GAS v4u*)((const bf16*)(F.ws + WS_X1H) + (size_t)t * D) + lane;
#pragma unroll
        for (int i = 0; i < 4; ++i) { float a[8], b[8], xf[8]; unpack8q(__builtin_nontemporal_load(y1 + 64 * i), a); unpack8q(__builtin_nontemporal_load(y2 + 64 * i), b); unpack8(__builtin_nontemporal_load(xh + 64 * i), xf);
            f32x4 v0 = {xf[0], xf[1], xf[2], xf[3]}, v1 = {xf[4], xf[5], xf[6], xf[7]};
            v0.x += a[0] + b[0]; v0.y += a[1] + b[1]; v0.z += a[2] + b[2]; v0.w += a[3] + b[3]; v1.x += a[4] + b[4]; v1.y += a[5] + b[5]; v1.z += a[6] + b[6]; v1.w += a[7] + b[7];
            __builtin_nontemporal_store(v0, o + 128 * i); __builtin_nontemporal_store(v1, o + 128 * i + 1); }
    }
}

constexpr int PER_PHASE = 10;
constexpr int N_LAUNCHES = MK_N_LAUNCHES;
struct Args { const float* in[21]; float* out; unsigned char* ws; int ph_lo, ph_hi, li, pad; };
__global__ void __launch_bounds__(NWAVES * 64, 2) hymba_fwd(Args args) {
    extern __shared__ __attribute__((aligned(16))) unsigned char lds[];
    Frame F;
    F.lds = (LAS unsigned char*)lds;
    F.tid = threadIdx.x; F.lane = F.tid & 63; F.wave = __builtin_amdgcn_readfirstlane(F.tid >> 6);
    F.G = gridDim.x; { const int bx = blockIdx.x; F.vcu = (F.G % 8 == 0) ? (bx % 8) * (F.G / 8) + bx / 8 : bx; }
    F.ws = args.ws; F.ctl = (unsigned*)(args.ws + WS_CTL); F.out = args.out;
    F.x = args.in[0]; F.mem = args.in[1]; F.norm1_g = args.in[2]; F.w_in = args.in[3]; F.q_norm_g = args.in[4]; F.k_norm_g = args.in[5]; F.conv_w = args.in[6];
    F.mem_norm_g = args.in[7]; F.w_mem_kv = args.in[8]; F.mem_q_norm_g = args.in[9]; F.mem_k_norm_g = args.in[10]; F.out_norm_g = args.in[11]; F.w_out = args.in[12];
    F.norm2_g = args.in[13]; F.w_rg = args.in[14]; F.b_rg = args.in[15]; F.w_re = args.in[16]; F.b_re = args.in[17]; F.w_gate = args.in[18]; F.w_up = args.in[19]; F.w_down = args.in[20];
    volatile LAS unsigned* MISC = (volatile LAS unsigned*)(F.lds + MISC_OFF);
    if (F.tid < 16) MISC[F.tid] = 0u;
    __syncthreads();
    const int lo = args.ph_lo, hi = args.ph_hi;
    const bool multi = (hi - lo) > 1;
    XcdBarrier bar; bar.bar = F.ctl + CW_BAR + args.li * XCD_BAR_WORDS; bar.x = 0; bar.st = nullptr;
    if (multi) bar = xcd_barrier_post(F.ctl + CW_BAR + args.li * XCD_BAR_WORDS, MISC + 8);
#define GRID_BAR() do { if (multi) xcd_barrier(bar); } while (0)
#define IN(k) (lo <= (k) && (k) < hi)
#define BOTH(k) (IN(k) && IN((k) + 1))
    if (IN(0)) { p0_prologue(F); if (BOTH(0)) GRID_BAR(); }
    if (IN(1)) {
        pg8::Gemm g{(const bf16*)(F.ws + WS_H), (const bf16*)(F.ws + WS_WIN), D, nullptr}; pg8::P1Order S{F.G, (int)blockIdx.x, 0, 2560};
        pg8::EpiProj E{(bf16*)(F.ws + WS_R1), (bf16*)(F.ws + WS_MEMKV)};
        pg8::gemm_phase<pg8::EpiProj, pg8::P1Order>(F.lds, g, S, E);
        if (BOTH(1)) GRID_BAR();
    }
    if (IN(2)) { p2_attention(F); if (BOTH(2)) GRID_BAR(); }
    if (IN(3)) { p3_combine(F); if (BOTH(3)) GRID_BAR(); }
    if (IN(4)) {
        pg8::Gemm g{(const bf16*)(F.ws + WS_Y), (const bf16*)(F.ws + WS_WOUT), D, nullptr}; pg8::StaticOrder S{T / 256, D / 256, F.G, (int)blockIdx.x};
        pg8::EpiResid E{F.x, (bf16*)(F.ws + WS_X1H), (bf16*)(F.ws + WS_H)};
        pg8::gemm_phase<pg8::EpiResid, pg8::StaticOrder, false>(F.lds, g, S, E);
        if (BOTH(4)) GRID_BAR();
    }
    if (IN(5)) { p5_router(F); if (BOTH(5)) GRID_BAR(); }
    if (IN(7)) {
        const int MT = moe_tables(F);
        pg8::MoeOrder S{MT, F.G, (int)blockIdx.x, (const LAS int*)(F.lds + MOE_TE)};
        { const LAS int* TB = (const LAS int*)(F.lds + MOE_TB); const LAS int* VR = (const LAS int*)(F.lds + MOE_VR); LAS int* UT = (LAS int*)(F.lds + MOE_UT);
          const int* ltok = (const int*)(F.ws + WS_LIST + LIST_TOK); const float* lrs = (const float*)(F.ws + WS_LIST + LIST_RSTD); LAS float* SCU = (LAS float*)(F.lds + MOE_SCU);
          for (int i = 0; i < MOE_MAXU; ++i) { pg8::Unit u; if (!S.next(i, u)) break;
              if (F.tid < 256) { const bool ok = F.tid < VR[u.pm]; UT[i * 256 + F.tid] = ok ? ltok[TB[u.pm] + F.tid] : 0; SCU[i * 256 + F.tid] = ok ? lrs[TB[u.pm] + F.tid] : 0.f; } }
          __syncthreads(); }
        pg8::Gemm g{(const bf16*)(F.ws + WS_H), (const bf16*)(F.ws + WS_WGU), D, (const LAS int*)(F.lds + MOE_UT)};
        pg8::EpiSwiGLU E{(bf16*)(F.ws + WS_OPART), (const LAS float*)(F.lds + MOE_SCU)};
        pg8::gemm_phase<pg8::EpiSwiGLU, pg8::MoeOrder, true, true, false, true>(F.lds, g, S, E);
        if (BOTH(7)) GRID_BAR();
    }
    if (IN(8)) {
        const int MT = moe_tables(F);
        pg8::Gemm g{(const bf16*)(F.ws + WS_OPART), (const bf16*)(F.ws + WS_WD), DEXP, nullptr}; pg8::MoeOrder S{MT, F.G, (int)blockIdx.x, (const LAS int*)(F.lds + MOE_TE)};
        { const LAS int* TB = (const LAS int*)(F.lds + MOE_TB); const LAS int* VR = (const LAS int*)(F.lds + MOE_VR); LAS float* SCU = (LAS float*)(F.lds + MOE_SCU);
          const float* lgt = (const float*)(F.ws + WS_LIST + LIST_GATE);
          for (int i = 0; i < MOE_MAXU; ++i) { pg8::Unit u; if (!S.next(i, u)) break;
              if (F.tid < 256) SCU[i * 256 + F.tid] = (F.tid < VR[u.pm]) ? lgt[TB[u.pm] + F.tid] : 0.f; }
          __syncthreads(); }
        pg8::EpiDown E{(bf16*)(F.ws + WS_R1), (const LAS float*)(F.lds + MOE_SCU)};
        pg8::gemm_phase<pg8::EpiDown, pg8::MoeOrder, true, false, false, true>(F.lds, g, S, E);
        if (BOTH(8)) GRID_BAR();
    }
    if (IN(9)) { p9_final(F); }
#undef IN
#undef BOTH
#undef GRID_BAR
}

extern "C" void kernel_launch(void* const* d_in, const int* in_sizes, int n_in, void* d_out, int out_size, void* d_ws, size_t ws_size, hipStream_t stream) {
    static int grid = 0;
    if (grid == 0) {
        if (n_in != 21 || in_sizes[0] != T * D || out_size != T * D || ws_size < WS_END) { fprintf(stderr, "kernel_launch: shape/workspace mismatch (n_in %d, ws %zu < %zu); nothing launched\n", n_in, ws_size, (size_t)WS_END); grid = -1; return; }
        int dev = 0, cus = 0, per_cu = 0;
        if (hipGetDevice(&dev) != hipSuccess || hipDeviceGetAttribute(&cus, hipDeviceAttributeMultiprocessorCount, dev) != hipSuccess) { grid = -1; return; }
        if (hipFuncSetAttribute((const void*)hymba_fwd, hipFuncAttributeMaxDynamicSharedMemorySize, LDS_BYTES) != hipSuccess) { fprintf(stderr, "kernel_launch: hipFuncSetAttribute failed\n"); grid = -1; return; }
        if (hipOccupancyMaxActiveBlocksPerMultiprocessor(&per_cu, (const void*)hymba_fwd, NWAVES * 64, LDS_BYTES) != hipSuccess || per_cu < 1) { fprintf(stderr, "kernel_launch: occupancy query reports %d\n", per_cu); }
        (void)hipGetLastError();
        grid = cus;
    }
    if (grid < 0) return;
    if (hipMemsetAsync((char*)d_ws + WS_CTL, 0, CTL_ZERO_BYTES, stream) != hipSuccess) { fprintf(stderr, "kernel_launch: memset failed\n"); return; }
    Args a{};
    for (int i = 0; i < 21; ++i) a.in[i] = (const float*)d_in[i];
    a.out = (float*)d_out; a.ws = (unsigned char*)d_ws;
    int los[4], his[4], nl = 0;
#if defined(PROBE_REPEAT)
    los[nl] = 0; his[nl] = PROBE_REPEAT + 1; ++nl; los[nl] = PROBE_REPEAT; his[nl] = PROBE_REPEAT + 1; ++nl; if (PROBE_REPEAT + 1 < PER_PHASE) { los[nl] = PROBE_REPEAT + 1; his[nl] = PER_PHASE; ++nl; }
#else
    los[nl] = 0; his[nl] = PER_PHASE; ++nl;
#endif
    for (int li = 0; li < nl; ++li) {
        a.ph_lo = los[li]; a.ph_hi = his[li]; a.li = li;
#if defined(PROBE_REPEAT)
        if (li == 1) { (void)hipMemsetAsync((char*)d_ws + WS_CTL + CW_ATTQ * 4, 0, 64, stream); if (PROBE_REPEAT == 5) (void)hipMemsetAsync((char*)d_ws + WS_CTL + CW_CNT * 4, 0, 64 * 256, stream); }
#endif
        hipLaunchKernelGGL(hymba_fwd, dim3(grid), dim3(NWAVES * 64), LDS_BYTES, stream, a);
        const hipError_t le = hipPeekAtLastError();
        if (le != hipSuccess) { fprintf(stderr, "kernel_launch: launch %d failed: %s\n", li, hipGetErrorName(le)); break; }
    }
}
```

```cpp
#include <hip/hip_runtime.h>
#include <cstdio>
#include <cstdint>

#ifndef MK_N_LAUNCHES
#define MK_N_LAUNCHES 1
#endif

#define GAS __attribute__((address_space(1)))
#define LAS __attribute__((address_space(3)))
typedef unsigned short bf16;
typedef unsigned v4u __attribute__((ext_vector_type(4)));
typedef unsigned v2u __attribute__((ext_vector_type(2)));
typedef float f32x4 __attribute__((ext_vector_type(4)));
typedef float f32x16 __attribute__((ext_vector_type(16)));
typedef short bf16x8 __attribute__((ext_vector_type(8)));
typedef short s16x4 __attribute__((ext_vector_type(4)));
#define LDS_WAIT() asm volatile("s_waitcnt lgkmcnt(0)" ::: "memory")
#define VM_WAIT() asm volatile("s_waitcnt vmcnt(0)" ::: "memory")
#define RLX_AGENT __ATOMIC_RELAXED, __HIP_MEMORY_SCOPE_AGENT

constexpr int BATCH = 2, SEQ = 16384, T = BATCH * SEQ, D = 2048, PROJ = 5120;
constexpr int NH = 8, HD = 128, ATTN_W = 1024, CONV_W = 512, MEM_W = 512, NMEM = 256, NMH = 4;
constexpr int COL_Q = 0, COL_K = 1024, COL_V = 2048, COL_B = 3072, COL_C = 3584, COL_U = 4096, COL_MQ = 4608;
constexpr int NEXP = 64, DEXP = 1024;
constexpr int RMAX = 81920;
constexpr int MAXTILES = RMAX / 256;
constexpr float EPS = 1e-6f;
constexpr float LOG2E = 1.4426950408889634f;

constexpr size_t MiB = 1u << 20;
constexpr size_t WS_CTL = 0, CTL_ZERO_BYTES = 1 * MiB;
constexpr size_t WS_WIN = 1 * MiB;
constexpr size_t WS_WMKV = WS_WIN + (size_t)PROJ * D * 2;
constexpr size_t WS_WOUT = 25 * MiB;
constexpr size_t WS_WR = 33 * MiB;
constexpr size_t WS_WGU = 34 * MiB;
constexpr size_t WS_X1H = WS_WGU + 256 * MiB;
constexpr size_t WS_WD = WS_WGU + 512 * MiB;
constexpr size_t WS_H = WS_WD + 256 * MiB;
constexpr size_t WS_MEMKV = WS_H + 130 * MiB;
constexpr size_t WS_R1 = WS_MEMKV + 1 * MiB;
constexpr size_t WS_OPART = WS_R1 + 320 * MiB;
constexpr size_t WS_LSE = WS_OPART + 192 * MiB;
constexpr size_t WS_MEMO = WS_LSE + 3 * MiB;
constexpr size_t WS_Y = WS_MEMO + 32 * MiB;
constexpr size_t WS_TOK = WS_Y + 128 * MiB;
constexpr size_t WS_LIST = WS_TOK + 4 * MiB;
constexpr size_t WS_END = WS_LIST + 24 * MiB;
constexpr int CAP = T;
constexpr size_t LIST_TOK = 0, LIST_RSTD = 8 * MiB, LIST_GATE = 16 * MiB;
constexpr size_t TOK_E = 0, TOK_RANK = 256 * 1024, TOK_GATE = 512 * 1024, TOK_RSTD = 768 * 1024, TOK_SLOT = 1024 * 1024, SLOT_RSTD = 1536 * 1024, SLOT_GATE = 2048 * 1024;
static_assert(WS_WMKV + 1024 * (size_t)D * 2 <= WS_WOUT && WS_WOUT + 8 * MiB <= WS_WR && WS_WR + 2048 * 72 * 4 <= WS_WGU, "ws map");
static_assert((size_t)(T + 512) * D * 2 <= 130 * MiB && (size_t)RMAX * D * 2 <= 320 * MiB && (size_t)RMAX * DEXP * 2 <= 192 * MiB && SLOT_GATE + RMAX * 4 <= 4 * MiB, "ws map");

constexpr int CW_TMO = 0, CW_CODE = 1;
constexpr int CW_CNT = 8192;
constexpr int CW_BAR = 16384;
constexpr int CW_KVREADY = 512, CW_ATTQ = 576;

constexpr int RING_BYTES = 131072;
constexpr int LDS_EXTRA = RING_BYTES;
constexpr int MISC_OFF = 163840 - 2048;
constexpr int LDS_BYTES = 163840;

__device__ __forceinline__ unsigned f2bf(float f) { unsigned u = __builtin_bit_cast(unsigned, f); return (u + 0x7fffu + ((u >> 16) & 1u)) >> 16; }
__device__ __forceinline__ unsigned pk2(float lo, float hi) { return f2bf(lo) | (f2bf(hi) << 16); }
__device__ __forceinline__ unsigned cvtpk(float lo, float hi) { unsigned r; asm volatile("v_cvt_pk_bf16_f32 %0, %1, %2" : "=v"(r) : "v"(lo), "v"(hi)); return r; }
__device__ __forceinline__ unsigned pk_fp8x4(float a, float b, float c, float d) { unsigned w = 0u; w = __builtin_amdgcn_cvt_pk_fp8_f32(a, b, w, false); w = __builtin_amdgcn_cvt_pk_fp8_f32(c, d, w, true); return w; }
constexpr float SC_WGU = 128.0f, SC_ACT = 4.0f, SC_WD = 64.0f, SC_Y = 64.0f;
__device__ __forceinline__ float bflo(unsigned w) { return __builtin_bit_cast(float, w << 16); }
__device__ __forceinline__ float bfhi(unsigned w) { return __builtin_bit_cast(float, w & 0xffff0000u); }
__device__ __forceinline__ float wave_sum(float v) {
#pragma unroll
    for (int o = 1; o < 64; o <<= 1) v += __shfl_xor(v, o);
    return v;
}

namespace pg8 {
#define PG8_LAS __attribute__((address_space(3)))
typedef unsigned short bf16_t;
typedef unsigned u32x4 __attribute__((ext_vector_type(4)));
typedef int i32x4 __attribute__((ext_vector_type(4)));
typedef int i32x8 __attribute__((ext_vector_type(8)));
constexpr int BM = 256, BK = 64, HALF = 128, HTB = HALF * BK * 2, STAGE_BYTES = 8 * HTB, NXCD = 8, WGM = 8;
__host__ __device__ __forceinline__ int lds_byte(int r, int c) { const int st = (r >> 4) * 2 + (c >> 5), rr = r & 15, cc = c & 31, ob = rr * 64 + cc * 2; return st * 1024 + (ob ^ (((ob >> 9) & 1) << 5)); }
__host__ __device__ __forceinline__ void stage_rc(int b, int& R, int& C) { const int st = b / 1024, sb = b % 1024, swz = sb ^ (((sb >> 9) & 1) << 5); R = (st >> 1) * 16 + swz / 64; C = (st & 1) * 32 + (swz % 64) / 2; }
__host__ __device__ __forceinline__ int perm32(int rho) { const int n = rho >> 4, i = rho & 15; return 8 * (i >> 2) + 4 * n + (i & 3); }

struct Unit { int pm, pn, pb, ui; };
struct Gemm { const bf16_t* A; const bf16_t* Bt; int K; const PG8_LAS int* ut; };

__device__ __forceinline__ void tile_of(int L, int nM, int nN, int& pm, int& pn) {
    const int nwg = nM * nN;
    int wgid = L; { const int q = nwg / NXCD, r = nwg % NXCD, xcd = wgid % NXCD, off = wgid / NXCD; wgid = (xcd < r ? xcd * (q + 1) : r * (q + 1) + (xcd - r) * q) + off; }
    const int nig = WGM * nN, gid = wgid / nig, fm = gid * WGM, gsz = (nM - fm) < WGM ? (nM - fm) : WGM;
    pm = fm + ((wgid % nig) % gsz); pn = (wgid % nig) / gsz;
}
struct StaticOrder {
    int nM, nN, G, c;
    __device__ __forceinline__ bool next(int i, Unit& u) const { const long L = (long)i * G + c; if (L >= (long)nM * nN) return false; tile_of((int)L, nM, nN, u.pm, u.pn); u.pb = u.pn; return true; }
    __device__ __forceinline__ void a_ready(const Unit&) const {}
    __device__ __forceinline__ void done(const Unit&) const {}
};
struct P1Order {
    int G, c, lo, hi;
    __device__ __forceinline__ bool next(int i, Unit& u) const { const long L = (long)lo + (long)i * G + c; if (L >= hi) return false;
        if (L < 2560) tile_of((int)L, 128, 20, u.pm, u.pn); else { const int k = (int)L - 2560; u.pm = 128 + (k >> 2); u.pn = 20 + (k & 3); }
        u.pb = u.pn; return true; }
    __device__ __forceinline__ void a_ready(const Unit&) const {}
    __device__ __forceinline__ void done(const Unit&) const {}
};
struct MoeOrder {
    int nM, G, c; const LAS int* te;
    __device__ __forceinline__ bool next(int i, Unit& u) const { const long L = (long)i * G + c; if (L >= (long)nM * 8) return false; tile_of((int)L, nM, 8, u.pm, u.pn); u.pb = te[u.pm] * 8 + u.pn; u.ui = i; return true; }
    __device__ __forceinline__ void a_ready(const Unit&) const {}
    __device__ __forceinline__ void done(const Unit&) const {}
};

struct EpiProj {
    static constexpr bool PERM = true, AFTER_DRAIN = false;
    bf16_t* O; bf16_t* O2;
    __device__ __forceinline__ void operator()(const f32x4 (&acc)[2][2][4][2], const Unit& u, int wr, int wc, int fr, int fq) const {
        int row0 = u.pm * BM + wr * 64 + fr, col0 = u.pn * BM + wc * 32 + 8 * fq, ldc = PROJ; bf16_t* base = O;
        if (u.pm >= 128) { row0 -= 128 * BM; col0 -= 20 * BM; ldc = 1024; base = O2; }
#pragma unroll
        for (int ai = 0; ai < 2; ++ai)
#pragma unroll
            for (int m = 0; m < 4; ++m) { bf16_t* rowp = base + (size_t)(row0 + ai * HALF + m * 16) * ldc + col0;
#pragma unroll
                for (int bj = 0; bj < 2; ++bj) { const f32x4 v0 = acc[ai][bj][m][0], v1 = acc[ai][bj][m][1];
                    u32x4 w; w.x = cvtpk(v0[0], v0[1]); w.y = cvtpk(v0[2], v0[3]); w.z = cvtpk(v1[0], v1[1]); w.w = cvtpk(v1[2], v1[3]);
                    *(u32x4*)(rowp + bj * HALF) = w; } }
    }
};
struct EpiResid {
    static constexpr bool PERM = true, AFTER_DRAIN = false;
    const float* X; bf16_t* X1; bf16_t* X1B;
    __device__ __forceinline__ void operator()(const f32x4 (&acc)[2][2][4][2], const Unit& u, int wr, int wc, int fr, int fq) const {
        const int row0 = u.pm * BM + wr * 64 + fr, col0 = u.pn * BM + wc * 32 + 8 * fq;
#pragma unroll
        for (int ai = 0; ai < 2; ++ai)
#pragma unroll
            for (int m = 0; m < 4; ++m) { const size_t off = (size_t)(row0 + ai * HALF + m * 16) * D + col0;
#pragma unroll
                for (int bj = 0; bj < 2; ++bj) { const f32x4 xa = __builtin_nontemporal_load((const f32x4*)(X + off + bj * HALF)), xb = __builtin_nontemporal_load((const f32x4*)(X + off + bj * HALF + 4));
                    const f32x4 v0 = acc[ai][bj][m][0] + xa, v1 = acc[ai][bj][m][1] + xb;
                    { u32x4 h_; h_.x = cvtpk(v0[0], v0[1]); h_.y = cvtpk(v0[2], v0[3]); h_.z = cvtpk(v1[0], v1[1]); h_.w = cvtpk(v1[2], v1[3]); *(u32x4*)(X1 + off + bj * HALF) = h_; }
                    v2u w; w.x = pk_fp8x4(v0[0], v0[1], v0[2], v0[3]); w.y = pk_fp8x4(v1[0], v1[1], v1[2], v1[3]);
                    *(v2u*)((unsigned char*)X1B + off + bj * HALF) = w; }
                asm volatile("" ::: "memory"); }
    }
};
struct EpiSwiGLU {
    static constexpr bool PERM = true, AFTER_DRAIN = false;
    bf16_t* ACT; const PG8_LAS float* RSU;
    __device__ __forceinline__ void operator()(const f32x4 (&acc)[2][2][4][2], const Unit& u, int wr, int wc, int fr, int fq) const {
        const int row0 = u.pm * BM + wr * 64 + fr, col0 = u.pn * HALF + wc * 32 + 8 * fq; const PG8_LAS float* rsu = RSU + u.ui * 256 + wr * 64 + fr;
#pragma unroll
        for (int ai = 0; ai < 2; ++ai)
#pragma unroll
            for (int m = 0; m < 4; ++m) { const int row = row0 + ai * HALF + m * 16; const float rs = rsu[ai * HALF + m * 16] * (1.0f / SC_WGU); float o[8];
#pragma unroll
                for (int n = 0; n < 2; ++n)
#pragma unroll
                    for (int j = 0; j < 4; ++j) { const float g = acc[ai][0][m][n][j] * rs, uu = acc[ai][1][m][n][j] * rs;
                        o[n * 4 + j] = g * __builtin_amdgcn_rcpf(1.0f + __builtin_amdgcn_exp2f(-g * LOG2E)) * uu * SC_ACT; }
                v2u w; w.x = pk_fp8x4(o[0], o[1], o[2], o[3]); w.y = pk_fp8x4(o[4], o[5], o[6], o[7]);
                *(v2u*)((unsigned char*)ACT + (size_t)row * DEXP + col0) = w; }
    }
};
struct EpiDown {
    static constexpr bool PERM = true, AFTER_DRAIN = false;
    bf16_t* Y; const PG8_LAS float* GTU;
    __device__ __forceinline__ void operator()(const f32x4 (&acc)[2][2][4][2], const Unit& u, int wr, int wc, int fr, int fq) const {
        const int row0 = u.pm * BM + wr * 64 + fr, col0 = u.pn * BM + wc * 32 + 8 * fq; const PG8_LAS float* gtu = GTU + u.ui * 256 + wr * 64 + fr;
#pragma unroll
        for (int ai = 0; ai < 2; ++ai)
#pragma unroll
            for (int m = 0; m < 4; ++m) { const int row = row0 + ai * HALF + m * 16; const float gt = gtu[ai * HALF + m * 16] * (SC_Y / (SC_ACT * SC_WD)); unsigned char* rowp = (unsigned char*)Y + (size_t)row * D + col0;
#pragma unroll
                for (int bj = 0; bj < 2; ++bj) { const f32x4 v0 = acc[ai][bj][m][0] * gt, v1 = acc[ai][bj][m][1] * gt;
                    v2u w; w.x = pk_fp8x4(v0[0], v0[1], v0[2], v0[3]); w.y = pk_fp8x4(v1[0], v1[1], v1[2], v1[3]);
                    *(v2u*)(rowp + bj * HALF) = w; } }
    }
};

template <class Epi, class Sched, bool ALIGN_EPI = true, bool GATHER = false, bool BKN = false, bool FP8 = false>
__device__ __forceinline__ void gemm_phase(PG8_LAS unsigned char* lds, const Gemm g, const Sched& S, const Epi& E) {
    static_assert(!(FP8 && BKN), "the fp8 path takes N-major B");
    const int tid = threadIdx.x, wid = __builtin_amdgcn_readfirstlane(tid >> 6), lane = tid & 63, wr = wid >> 2, wc = wid & 3, fr = lane & 15, fq = lane >> 4;
    const int K = FP8 ? g.K / 2 : g.K, nt = K / BK;
    unsigned voffA[2], voffB[2]; int gR[2], gC[2];
#pragma unroll
    for (int i = 0; i < 2; ++i) { int R, C; stage_rc(tid * 16 + i * 8192, R, C); const int Rb = Epi::PERM ? ((R & ~31) + perm32(R & 31)) : R; gR[i] = R; gC[i] = C;
        voffA[i] = (unsigned)(R * K + C) * 2u; voffB[i] = (unsigned)(Rb * K + C) * 2u; }
    unsigned vA0[2], vA1[2], vN0[2], vN1[2];
#define PG8_GOFF(dst0, dst1, ui_) do { _Pragma("unroll") for (int _i = 0; _i < 2; ++_i) { \
        dst0[_i] = ((unsigned)g.ut[(ui_) * 256 + gR[_i]] * (unsigned)K + (unsigned)gC[_i]) * 2u; dst1[_i] = ((unsigned)g.ut[(ui_) * 256 + 128 + gR[_i]] * (unsigned)K + (unsigned)gC[_i]) * 2u; } } while (0)
    const size_t kstep = (size_t)(BK * 2);
    const size_t hstep = (size_t)HALF * K * 2;
    const size_t tstep = 2 * hstep;
    const size_t kstepB = BKN ? (size_t)BK * 4096 : kstep, hstepB = BKN ? (size_t)256 : hstep;
    if constexpr (BKN) {
#pragma unroll
        for (int i = 0; i < 2; ++i) { const int p = tid * 16 + i * 8192, kk = p >> 8, c16p = (p & 255) >> 4, sw = (kk & 3) | (((kk >> 3) & 1) << 2);
            voffB[i] = (unsigned)(kk * 4096 + ((c16p ^ (sw << 1)) << 4)); } }
    int bbase[2];
    { const int q = fr >> 2, p = fr & 3, sw = q | ((fq & 1) << 2);
#pragma unroll
      for (int n = 0; n < 2; ++n) bbase[n] = (int)(uintptr_t)lds + (8 * fq + q) * 256 + (((4 * wc + 2 * n + (p >> 1)) ^ (sw << 1)) << 4) + 8 * (p & 1); }
    const unsigned ldsw = (unsigned)wid * 1024u;
    const int aoff = lds_byte(wr * 64 + fr, fq * 8), boff = lds_byte(wc * 32 + fr, fq * 8);
    const int aoq0 = lds_byte(wr * 64 + fr, fq * 16), aoq1 = lds_byte(wr * 64 + fr, fq * 16 + 8), boq0 = lds_byte(wc * 32 + fr, fq * 16), boq1 = lds_byte(wc * 32 + fr, fq * 16 + 8);
#define PG8_SA(b, h) (((b) * 2 + (h)) * HTB)
#define PG8_SB(b, h) ((4 + (b) * 2 + (h)) * HTB)
#define PG8_STAGE(bufoff, gbase, voff) do { _Pragma("unroll") for (int _i = 0; _i < 2; ++_i) \
        __builtin_amdgcn_global_load_lds((const unsigned*)((const char*)(gbase) + (voff)[_i]), (PG8_LAS unsigned*)(lds + (bufoff) + ldsw + _i * 8192), 16, 0, 0); } while (0)
#define PG8_Q_At Aq
#define PG8_Q_B0 Bq0
#define PG8_Q_B1 Bq1
#define PG8_LD8(p0_, p1_) __builtin_shufflevector(*(const PG8_LAS i32x4*)(p0_), *(const PG8_LAS i32x4*)(p1_), 0, 1, 2, 3, 4, 5, 6, 7)
#define PG8_LDA(dst, b, h) do { if constexpr (FP8) { _Pragma("unroll") for (int m = 0; m < 4; ++m) PG8_Q_##dst[m] = PG8_LD8(lds + PG8_SA(b, h) + aoq0 + m * 2048, lds + PG8_SA(b, h) + aoq1 + m * 2048); } \
        else { _Pragma("unroll") for (int m = 0; m < 4; ++m) _Pragma("unroll") for (int k = 0; k < 2; ++k) dst[m][k] = *(const PG8_LAS bf16x8*)(lds + PG8_SA(b, h) + aoff + m * 2048 + k * 1024); } } while (0)
#define PG8_TR(dst, addr, OFF) asm volatile("ds_read_b64_tr_b16 %0, %1 offset:%2" : "=&v"(dst) : "v"(addr), "i"(OFF) : "memory")
#define PG8_LDB(dst, b, h) do { if constexpr (BKN) { _Pragma("unroll") for (int n = 0; n < 2; ++n) { const int ad_ = bbase[n] + PG8_SB(b, h); s16x4 l0_, h0_, l1_, h1_; \
            PG8_TR(l0_, ad_, 0); PG8_TR(h0_, ad_, 1024); PG8_TR(l1_, ad_, 8192); PG8_TR(h1_, ad_, 9216); \
            dst[n][0] = (bf16x8){l0_[0], l0_[1], l0_[2], l0_[3], h0_[0], h0_[1], h0_[2], h0_[3]}; dst[n][1] = (bf16x8){l1_[0], l1_[1], l1_[2], l1_[3], h1_[0], h1_[1], h1_[2], h1_[3]}; } } \
        else if constexpr (FP8) { _Pragma("unroll") for (int n = 0; n < 2; ++n) PG8_Q_##dst[n] = PG8_LD8(lds + PG8_SB(b, h) + boq0 + n * 2048, lds + PG8_SB(b, h) + boq1 + n * 2048); } \
        else { _Pragma("unroll") for (int n = 0; n < 2; ++n) _Pragma("unroll") for (int k = 0; k < 2; ++k) dst[n][k] = *(const PG8_LAS bf16x8*)(lds + PG8_SB(b, h) + boff + n * 2048 + k * 1024); } } while (0)
#define PG8_MMA(ai, bj, At, Bt) do { __builtin_amdgcn_s_setprio(1); if constexpr (FP8) { _Pragma("unroll") for (int m = 0; m < 4; ++m) _Pragma("unroll") for (int n = 0; n < 2; ++n) \
            asm volatile("v_mfma_scale_f32_16x16x128_f8f6f4 %0, %1, %2, %0, %3, %3 op_sel_hi:[0,0,0]" : "+v"(acc[ai][bj][m][n]) : "v"(PG8_Q_##Bt[n]), "v"(PG8_Q_##At[m]), "v"(sc1_)); } \
        else { _Pragma("unroll") for (int m = 0; m < 4; ++m) _Pragma("unroll") for (int n = 0; n < 2; ++n) _Pragma("unroll") for (int k = 0; k < 2; ++k) \
            acc[ai][bj][m][n] = __builtin_amdgcn_mfma_f32_16x16x32_bf16(Bt[n][k], At[m][k], acc[ai][bj][m][n], 0, 0, 0); } __builtin_amdgcn_s_setprio(0); } while (0)
#define PG8_WAIT_V(n) asm volatile("s_waitcnt vmcnt(" #n ")" ::: "memory")
#define PG8_WAIT_L(n) asm volatile("s_waitcnt lgkmcnt(" #n ")" ::: "memory")
#define PG8_BAR __builtin_amdgcn_s_barrier()
#define PG8_SCHED __builtin_amdgcn_sched_barrier(0)
    Unit cur, nxt; int ui = 0;
    if (!S.next(0, cur)) return;
    f32x4 acc[2][2][4][2];
#pragma unroll
    for (int a = 0; a < 2; ++a)
#pragma unroll
        for (int b = 0; b < 2; ++b)
#pragma unroll
            for (int m = 0; m < 4; ++m)
#pragma unroll
                for (int n = 0; n < 2; ++n) acc[a][b][m][n] = (f32x4){0.f, 0.f, 0.f, 0.f};
    bf16x8 At[4][2], B0[2][2], B1[2][2];
    i32x8 Aq[4], Bq0[2], Bq1[2]; const int sc1_ = 0x7F7F7F7F;
    const char* cA = GATHER ? (const char*)g.A : (const char*)g.A + (size_t)cur.pm * tstep; const char* cB = BKN ? (const char*)g.Bt + (size_t)(cur.pb >> 3) * ((size_t)K * 4096) + (size_t)(cur.pb & 7) * 512 : (const char*)g.Bt + (size_t)cur.pb * tstep;
    const size_t hA = GATHER ? 0 : hstep;
    if constexpr (GATHER) { PG8_GOFF(vA0, vA1, 0); } else {
#pragma unroll
        for (int i = 0; i < 2; ++i) { vA0[i] = voffA[i]; vA1[i] = voffA[i]; vN0[i] = voffA[i]; vN1[i] = voffA[i]; } }
    S.a_ready(cur);
    PG8_STAGE(PG8_SB(0, 0), cB, voffB); PG8_STAGE(PG8_SB(0, 1), cB + hstepB, voffB); PG8_STAGE(PG8_SA(0, 0), cA, vA0); PG8_STAGE(PG8_SA(0, 1), cA + hA, vA1);
    if (wr == 1) PG8_BAR;
    PG8_WAIT_V(2); PG8_BAR;
    PG8_STAGE(PG8_SB(1, 0), cB + kstepB, voffB); PG8_STAGE(PG8_SA(1, 0), cA + kstep, vA0); PG8_STAGE(PG8_SB(1, 1), cB + hstepB + kstepB, voffB);
    PG8_WAIT_V(6); PG8_BAR;
    for (;;) {
        const bool has_next = S.next(ui + 1, nxt);
        const char* nA = GATHER ? cA : (has_next ? (const char*)g.A + (size_t)nxt.pm * tstep : cA); const char* nB = has_next ? (BKN ? (const char*)g.Bt + (size_t)(nxt.pb >> 3) * ((size_t)K * 4096) + (size_t)(nxt.pb & 7) * 512 : (const char*)g.Bt + (size_t)nxt.pb * tstep) : cB;
        if constexpr (GATHER) { if (has_next) { PG8_GOFF(vN0, vN1, ui + 1); } else {
#pragma unroll
            for (int i = 0; i < 2; ++i) { vN0[i] = vA0[i]; vN1[i] = vA1[i]; } } }
#pragma unroll 1
        for (int t = 0; t < nt; t += 2) {
            const bool last = (t == nt - 2);
            unsigned s0[2], s1[2];
#pragma unroll
            for (int i = 0; i < 2; ++i) { s0[i] = (GATHER && last) ? vN0[i] : vA0[i]; s1[i] = (GATHER && last) ? vN1[i] : vA1[i]; }
            const char* a1 = cA + (size_t)(t + 1) * kstep;
            const char* a2 = last ? nA : cA + (size_t)(t + 2) * kstep; const char* b2 = last ? nB : cB + (size_t)(t + 2) * kstepB;
            const char* a3 = a2 + kstep; const char* b3 = b2 + kstepB;
            if (last && has_next) S.a_ready(nxt);
            PG8_LDB(B0, 0, 0); PG8_LDB(B1, 0, 1); PG8_SCHED; PG8_LDA(At, 0, 0); PG8_STAGE(PG8_SA(1, 1), a1 + hA, vA1);
            PG8_WAIT_V(8); PG8_WAIT_L(0); PG8_BAR; PG8_SCHED; PG8_MMA(0, 0, At, B0); PG8_MMA(0, 1, At, B1); PG8_BAR; PG8_SCHED;
            PG8_LDA(At, 0, 1); PG8_STAGE(PG8_SB(0, 0), b2, voffB); PG8_STAGE(PG8_SB(0, 1), b2 + hstepB, voffB); PG8_STAGE(PG8_SA(0, 0), a2, s0);
            PG8_WAIT_V(8); PG8_WAIT_L(0); PG8_BAR; PG8_SCHED; PG8_MMA(1, 0, At, B0); PG8_MMA(1, 1, At, B1); PG8_BAR; PG8_SCHED;
            PG8_LDB(B0, 1, 0); PG8_LDB(B1, 1, 1); PG8_SCHED; PG8_LDA(At, 1, 0); PG8_STAGE(PG8_SA(0, 1), a2 + hA, s1);
            PG8_WAIT_V(8); PG8_WAIT_L(0); PG8_BAR; PG8_SCHED; PG8_MMA(0, 0, At, B0); PG8_MMA(0, 1, At, B1); PG8_BAR; PG8_SCHED;
            PG8_LDA(At, 1, 1); PG8_STAGE(PG8_SB(1, 0), b3, voffB); PG8_STAGE(PG8_SB(1, 1), b3 + hstepB, voffB); PG8_STAGE(PG8_SA(1, 0), a3, s0);
            PG8_WAIT_V(8); PG8_WAIT_L(0); PG8_BAR; PG8_SCHED; PG8_MMA(1, 0, At, B0); PG8_MMA(1, 1, At, B1); PG8_BAR; PG8_SCHED;
        }
        if constexpr (ALIGN_EPI) { if (wr == 0) PG8_BAR; }
        if constexpr (FP8) { __builtin_amdgcn_sched_barrier(0); asm volatile("s_nop 15\n\ts_nop 15" ::: "memory"); __builtin_amdgcn_sched_barrier(0); }
        { int ln_ = lane; asm volatile("" : "+v"(ln_)); E(acc, cur, wr, wc, ln_ & 15, ln_ >> 4); } S.done(cur);
        if (!has_next) break;
#pragma unroll
        for (int a = 0; a < 2; ++a)
#pragma unroll
            for (int b = 0; b < 2; ++b)
#pragma unroll
                for (int m = 0; m < 4; ++m)
#pragma unroll
                    for (int n = 0; n < 2; ++n) acc[a][b][m][n] = (f32x4){0.f, 0.f, 0.f, 0.f};
        cur = nxt; cA = nA; cB = nB; ++ui;
#pragma unroll
        for (int i = 0; i < 2; ++i) { vA0[i] = vN0[i]; vA1[i] = vN1[i]; }
        if constexpr (ALIGN_EPI) { if (wr == 1) PG8_BAR; }
    }
    PG8_WAIT_V(0);
    if constexpr (!ALIGN_EPI) { if (wr == 0) PG8_BAR; }
    PG8_BAR;
#undef PG8_GOFF
#undef PG8_Q_At
#undef PG8_Q_B0
#undef PG8_Q_B1
#undef PG8_LD8
#undef PG8_TR
#undef PG8_SA
#undef PG8_SB
#undef PG8_STAGE
#undef PG8_LDA
#undef PG8_LDB
#undef PG8_MMA
#undef PG8_WAIT_V
#undef PG8_WAIT_L
#undef PG8_BAR
#undef PG8_SCHED
}
}

#define XB_TMO      128
#define XB_XCNT(j)  (256  + 64 * (j))
#define XB_XSUB(j)  (1280 + 64 * (j))
#define XB_XGEN(j)  (2304 + 64 * (j))
#define XB_TOP      3328
#define XB_TOPGEN   3392
#define XCD_BAR_WORDS 3456
#define XB_SPIN_CAP (1u << 18)
__device__ __forceinline__ unsigned xb_ld(unsigned* p)              { return __hip_atomic_load(p, __ATOMIC_RELAXED, __HIP_MEMORY_SCOPE_AGENT); }
__device__ __forceinline__ unsigned xb_add(unsigned* p, unsigned v) { return __hip_atomic_fetch_add(p, v, __ATOMIC_RELAXED, __HIP_MEMORY_SCOPE_AGENT); }
__device__ __forceinline__ unsigned xb_xcc_id() { return (unsigned)__builtin_amdgcn_s_getreg((3 << 11) | 20) & 0xFu; }
#define XB_SPIN(cond, bar) do { unsigned _sp = 0; while (cond) { __builtin_amdgcn_s_sleep(1); \
    if ((++_sp & 255u) == 0u) { if (xb_ld(&(bar)[XB_TMO])) break; if (_sp > XB_SPIN_CAP) { atomicAdd(&(bar)[XB_TMO], 1u); break; } } } } while (0)
struct XcdBarrier { unsigned* bar; unsigned x; volatile LAS unsigned* st; };
__device__ __forceinline__ XcdBarrier xcd_barrier_post(unsigned* bar, volatile LAS unsigned* st) {
    XcdBarrier b; b.bar = bar; b.x = xb_xcc_id(); b.st = st;
    if (threadIdx.x == 0) (void)xb_add(&bar[XB_XCNT(b.x)], 1u);
    return b;
}
__device__ __forceinline__ void xcd_barrier_complete(unsigned* bar, unsigned x, unsigned& nloc, unsigned& nx) {
    const unsigned G = gridDim.x * gridDim.y * gridDim.z;
    unsigned sum, cnt, mine, sp = 0u;
    for (;;) {
        sum = 0u; cnt = 0u; mine = 0u;
#pragma unroll
        for (unsigned j = 0; j < 16; ++j) { const unsigned c = xb_ld(&bar[XB_XCNT(j)]); sum += c; cnt += (c > 0u) ? 1u : 0u; mine = (j == x) ? c : mine; }
        if (sum == G) break;
        __builtin_amdgcn_s_sleep(1);
        if ((++sp & 255u) == 0u) { if (xb_ld(&bar[XB_TMO])) break; if (sp > XB_SPIN_CAP) { atomicAdd(&bar[XB_TMO], 1u); break; } }
    }
    nloc = mine > 0u ? mine : 1u; nx = cnt > 0u ? cnt : 1u;
}
__device__ __forceinline__ void xcd_barrier(const XcdBarrier& b) {
    asm volatile("s_waitcnt vmcnt(0)" ::: "memory");
    __syncthreads();
    if (threadIdx.x == 0) {
        unsigned* bar = b.bar;
        __builtin_amdgcn_s_waitcnt(0);
        unsigned nloc = b.st[0], nx = b.st[1];
        if (nloc == 0u) { xcd_barrier_complete(bar, b.x, nloc, nx); b.st[0] = nloc; b.st[1] = nx; }
        const unsigned old = xb_add(&bar[XB_XSUB(b.x)], 1u);
        const unsigned gen = old / nloc;
        if (old + 1u == (gen + 1u) * nloc) {
            __builtin_amdgcn_fence(__ATOMIC_RELEASE, "agent");
            asm volatile("s_waitcnt vmcnt(0)" ::: "memory");
            const unsigned og = xb_add(&bar[XB_TOP], 1u);
            const unsigned tg = og / nx;
            if (og + 1u == (tg + 1u) * nx) xb_add(&bar[XB_TOPGEN], 1u);
            else XB_SPIN(xb_ld(&bar[XB_TOPGEN]) == tg, bar);
            __builtin_amdgcn_fence(__ATOMIC_ACQUIRE, "agent");
            xb_add(&bar[XB_XGEN(b.x)], 1u);
            asm volatile("s_waitcnt vmcnt(0)" ::: "memory");
        } else {
            XB_SPIN(xb_ld(&bar[XB_XGEN(b.x)]) == gen, bar);
            __builtin_amdgcn_fence(__ATOMIC_ACQUIRE, "agent");
            asm volatile("s_waitcnt vmcnt(0)" ::: "memory");
        }
    }
    __syncthreads();
}

constexpr int NWAVES = 8;
struct Frame {
    LAS unsigned char* lds;
    unsigned* ctl;
    int tid, lane, wave, vcu, G;
    const float *x, *mem, *norm1_g, *w_in, *q_norm_g, *k_norm_g, *conv_w, *mem_norm_g, *w_mem_kv, *mem_q_norm_g, *mem_k_norm_g, *out_norm_g, *w_out, *norm2_g,
                *w_rg, *b_rg, *w_re, *b_re, *w_gate, *w_up, *w_down;
    float* out; unsigned char* ws;
};

__device__ __forceinline__ void p0_transpose_item(const float* W, int N, int k0, int n0, const float* ks, bf16* dst, int pitch, LAS float* scr, int lane) {
#pragma unroll 8
    for (int i = 0; i < 32; ++i) { const int kk = 2 * i + (lane >> 5); scr[kk * 33 + (lane & 31)] = __builtin_nontemporal_load(W + (size_t)(k0 + kk) * N + n0 + (lane & 31)); }
    const int c = lane & 7;
    float g[8];
#pragma unroll
    for (int j = 0; j < 8; ++j) g[j] = ks ? ks[k0 + 8 * c + j] : 1.0f;
    LDS_WAIT(); asm volatile("" ::: "memory");
#pragma unroll
    for (int j = 0; j < 4; ++j) { const int n = (lane >> 3) + 8 * j; const LAS float* s = scr + (8 * c) * 33 + n;
        v4u o; o.x = pk2(s[0 * 33] * g[0], s[1 * 33] * g[1]); o.y = pk2(s[2 * 33] * g[2], s[3 * 33] * g[3]); o.z = pk2(s[4 * 33] * g[4], s[5 * 33] * g[5]); o.w = pk2(s[6 * 33] * g[6], s[7 * 33] * g[7]);
        *(GAS v4u*)(dst + (size_t)n * pitch + k0 + 8 * c) = o; }
    LDS_WAIT(); asm volatile("" ::: "memory");
}
__device__ __forceinline__ void rms_row_to_bf16(const float* xrow, const float* gain, bf16* orow, int lane) {
    const GAS f32x4* xr = (const GAS f32x4*)xrow + lane; const GAS f32x4* gr = (const GAS f32x4*)gain + lane;
    f32x4 v[8]; float s = 0.f;
#pragma unroll
    for (int j = 0; j < 8; ++j) { v[j] = __builtin_nontemporal_load(xr + 64 * j); s += (v[j].x * v[j].x + v[j].y * v[j].y) + (v[j].z * v[j].z + v[j].w * v[j].w); }
    const float rstd = 1.0f / sqrtf(wave_sum(s) * (1.f / D) + EPS);
    GAS v2u* o8 = (GAS v2u*)orow + lane;
#pragma unroll
    for (int j = 0; j < 8; ++j) { const f32x4 gg = gr[64 * j]; v2u o; o.x = pk2(v[j].x * rstd * gg.x, v[j].y * rstd * gg.y); o.y = pk2(v[j].z * rstd * gg.z, v[j].w * rstd * gg.w); o8[64 * j] = o; }
}
__device__ __forceinline__ void p0_transpose_item_q(const float* W, int N, int k0, int n0, const float* ks, float sc, unsigned char* dst, int pitch, LAS float* scr, int lane) {
#pragma unroll 8
    for (int i = 0; i < 64; ++i) { const int kk = 2 * i + (lane >> 5); scr[kk * 33 + (lane & 31)] = __builtin_nontemporal_load(W + (size_t)(k0 + kk) * N + n0 + (lane & 31)); }
    const int c = lane & 15;
    float g[8];
#pragma unroll
    for (int j = 0; j < 8; ++j) g[j] = ks ? ks[k0 + 8 * c + j] * sc : sc;
    LDS_WAIT(); asm volatile("" ::: "memory");
#pragma unroll
    for (int j = 0; j < 8; ++j) { const int n = (lane >> 4) + 4 * j; const LAS float* s = scr + (8 * c) * 33 + n;
        v2u o; o.x = pk_fp8x4(s[0 * 33] * g[0], s[1 * 33] * g[1], s[2 * 33] * g[2], s[3 * 33] * g[3]); o.y = pk_fp8x4(s[4 * 33] * g[4], s[5 * 33] * g[5], s[6 * 33] * g[6], s[7 * 33] * g[7]);
        __builtin_nontemporal_store(o, (GAS v2u*)(dst + (size_t)n * pitch + k0 + 8 * c)); }
    LDS_WAIT(); asm volatile("" ::: "memory");
}
__device__ __forceinline__ void p0_item_q64(const float* W, int N, int k0, int n0, const float* ks, float sc, unsigned char* dst, int pitch, LAS unsigned char* scr, int lane) {
    const GAS float* src = (const GAS float*)(W + (size_t)k0 * N + n0 + lane);
    float g0 = sc, g1 = sc;
    if (ks) { g0 = ks[k0 + lane] * sc; g1 = ks[k0 + 64 + lane] * sc; }
#pragma unroll
    for (int h = 0; h < 2; ++h) {
        float v[64];
#pragma unroll
        for (int i = 0; i < 64; ++i) v[i] = __builtin_nontemporal_load(src + (size_t)(64 * h + i) * N);
        const float gh = h ? g1 : g0;
#pragma unroll
        for (int q = 0; q < 4; ++q) { v4u o;
#pragma unroll
            for (int d = 0; d < 4; ++d) { const int i = 16 * q + 4 * d;
                const float s0 = __builtin_bit_cast(float, __builtin_amdgcn_readlane(__builtin_bit_cast(int, gh), i)), s1 = __builtin_bit_cast(float, __builtin_amdgcn_readlane(__builtin_bit_cast(int, gh), i + 1));
                const float s2 = __builtin_bit_cast(float, __builtin_amdgcn_readlane(__builtin_bit_cast(int, gh), i + 2)), s3 = __builtin_bit_cast(float, __builtin_amdgcn_readlane(__builtin_bit_cast(int, gh), i + 3));
                o[d] = pk_fp8x4(v[i] * s0, v[i + 1] * s1, v[i + 2] * s2, v[i + 3] * s3); }
            *(LAS v4u*)(scr + lane * 144 + (4 * h + q) * 16) = o; }
    }
    LDS_WAIT(); asm volatile("" ::: "memory");
#pragma unroll
    for (int i = 0; i < 8; ++i) { const int row = 8 * i + (lane >> 3), ch = lane & 7;
        const v4u w = *(const LAS v4u*)(scr + row * 144 + ch * 16);
        __builtin_nontemporal_store(w, (GAS v4u*)(dst + (size_t)row * pitch + k0 + ch * 16)); }
    LDS_WAIT(); asm volatile("" ::: "memory");
}
__device__ __forceinline__ void p0_prologue(Frame& F) {
    LAS float* scr = (LAS float*)(F.lds + F.wave * 16896);
    const int gw = F.vcu * NWAVES + F.wave, NGW = F.G * NWAVES;
    bf16* Win_t = (bf16*)(F.ws + WS_WIN); bf16* Wmkv_t = (bf16*)(F.ws + WS_WMKV); bf16* Wout_t = (bf16*)(F.ws + WS_WOUT);
    constexpr int I_IN = 32 * 160, I_MKV = 32 * 32, I_OUT = 32 * 64;
    constexpr int NITEMS = I_IN + I_MKV + I_OUT;
    for (int it = gw; it < NITEMS; it += NGW) {
        int r = it;
        if (r < I_IN) { const int kb = r / 160, nb = r % 160; p0_transpose_item(F.w_in, PROJ, 64 * kb, 32 * nb, nullptr, Win_t + (size_t)(32 * nb) * D, D, scr, F.lane); continue; } r -= I_IN;
        if (r < I_MKV) { const int kb = r / 32, nb = r % 32; p0_transpose_item(F.w_mem_kv, 1024, 64 * kb, 32 * nb, nullptr, Wmkv_t + (size_t)(32 * nb) * D, D, scr, F.lane); continue; } r -= I_MKV;
        { const int kb = r / 64, nb = r % 64; p0_transpose_item(F.w_out, D, 64 * kb, 32 * nb, nullptr, Wout_t + (size_t)(32 * nb) * D, D, scr, F.lane); }
    }
    { unsigned char* Wgu_q = (unsigned char*)(F.ws + WS_WGU); unsigned char* Wd_q = (unsigned char*)(F.ws + WS_WD); LAS unsigned char* scq = F.lds + F.wave * 16896;
      constexpr int IPE = 256 + 256 + 256;
#pragma unroll 1
      for (int it = gw; it < 64 * IPE; it += NGW) { const int e = it / IPE; int r = it - e * IPE;
          if (r < 512) { const int up = r >> 8, q = r & 255, kb = q >> 4, nb = q & 15, n0 = 64 * nb;
              const float* W = (up ? F.w_up : F.w_gate) + (size_t)e * D * DEXP; const int drow = 256 * (n0 >> 7) + 128 * up + (n0 & 127);
              p0_item_q64(W, DEXP, 128 * kb, n0, F.norm2_g, SC_WGU, Wgu_q + ((size_t)e * 2048 + drow) * D, D, scq, F.lane); }
          else { const int q = r - 512, kb = q >> 5, nb = q & 31;
              p0_item_q64(F.w_down + (size_t)e * DEXP * D, D, 128 * kb, 64 * nb, nullptr, SC_WD, Wd_q + ((size_t)e * 2048 + 64 * nb) * DEXP, DEXP, scq, F.lane); } } }
    { bf16* WT = (bf16*)(F.ws + WS_WR); const int gt = (F.vcu * NWAVES + F.wave) * 64 + F.lane, NT = F.G * NWAVES * 64;
      for (int i = gt; i < 96 * 2048; i += NT) { const int n = i >> 11, k = i & 2047;
          float w = n < 64 ? F.w_re[k * 64 + n] : (n < 72 ? F.w_rg[k * 8 + (n - 64)] : 0.f); w *= F.norm2_g[k];
          const unsigned h = f2bf(w); const float hf = __builtin_bit_cast(float, h << 16);
          WT[i] = (bf16)h; WT[96 * 2048 + i] = (bf16)f2bf(w - hf); } }
    bf16* H = (bf16*)(F.ws + WS_H);
    for (int m = gw; m < T + 512; m += NGW) {
        if (m < T) rms_row_to_bf16(F.x + (size_t)m * D, F.norm1_g, H + (size_t)m * D, F.lane);
        else rms_row_to_bf16(F.mem + (size_t)(m - T) * D, F.mem_norm_g, H + (size_t)m * D, F.lane);
    }
}

namespace att {
constexpr int LDS_K = 0, LDS_V = 65536, LDS_STG = 131072, LDS_LI = LDS_STG + 16384, LDS_GT = LDS_LI + 8 * 256;
constexpr float CS = 0.08838834764831845f * LOG2E;
#define KSWZ(row, colB) ((row) * 256 + ((colB) ^ (((row) & 7) << 4)))
__device__ __forceinline__ int crow(int r, int hi) { return (r & 3) + 8 * (r >> 2) + 4 * hi; }
__device__ __forceinline__ int v_rd_base(int lane) { return ((lane & 3) << 3) | (((lane >> 2) & 3) << 6) | (((lane >> 4) & 1) << 5) | (((lane >> 5) & 1) << 8); }
template <int OFF> __device__ __forceinline__ s16x4 tr_read(int vb) { s16x4 r; asm volatile("ds_read_b64_tr_b16 %0, %1 offset:%2" : "=&v"(r) : "v"(vb), "i"(OFF) : "memory"); return r; }

struct RowMap { const char* base; long stride; int win0; bool wrap; };
__device__ __forceinline__ const char* rowptr(const RowMap& m, int p) { int sp = m.wrap ? m.win0 + ((p - m.win0) & 255) : p; sp = sp < 0 ? 0 : sp; return m.base + (long)sp * m.stride; }

__device__ __forceinline__ void dma_k(LAS unsigned char* Kl, int p0, int nrows, const RowMap& m, int wave, int lane) {
    asm volatile("" : "+v"(lane));
#pragma unroll 1
    for (int i = 0; i < nrows / 32; ++i) {
        const int prow0 = p0 + 32 * i + 4 * wave, prow = prow0 + (lane >> 4);
        const char* src = rowptr(m, prow) + (((lane & 15) ^ (prow & 7)) << 4);
        __builtin_amdgcn_global_load_lds((const unsigned*)src, (LAS unsigned*)(Kl + prow0 * 256), 16, 0, 0);
    }
}
__device__ __forceinline__ void dma_v(LAS unsigned char* Vl, int p0, int nrows, const RowMap& m, int wave, int lane) {
    asm volatile("" : "+v"(lane));
#pragma unroll 1
    for (int i = 0; i < nrows / 32; ++i) {
        const int ii = wave + 8 * i, g = (p0 >> 4) + (ii >> 2), q = ii & 3;
        const int kk = ((q >> 1) << 3) + ((lane & 31) >> 2), k = (kk & ~0xC) | ((kk & 4) << 1) | ((kk & 8) >> 1);
        const int c = 32 * (2 * (q & 1) + (lane >> 5)) + 8 * (lane & 3);
        const char* src = rowptr(m, 16 * g + k) + c * 2;
        __builtin_amdgcn_global_load_lds((const unsigned*)src, (LAS unsigned*)(Vl + g * 4096 + q * 1024), 16, 0, 0);
    }
}
__device__ __forceinline__ void dma_v2(LAS unsigned char* Vl, int p0, int nrows, const RowMap& m, int wave, int lane) {
    asm volatile("" : "+v"(lane));
#pragma unroll 1
    for (int i = 0; i < nrows / 32; ++i) {
        const int prow0 = p0 + 32 * i + 4 * wave, prow = prow0 + (lane >> 4);
        const char* src = rowptr(m, prow) + (((lane & 15) ^ ((prow & 7) << 1)) << 4);
        __builtin_amdgcn_global_load_lds((const unsigned*)src, (LAS unsigned*)(Vl + prow0 * 256), 16, 0, 0);
    }
}
__device__ __forceinline__ void load_q16(v4u (&raw)[4], const char* qrow, int kg) {
#pragma unroll
    for (int s = 0; s < 4; ++s) raw[s] = *(const GAS v4u*)(qrow + (32 * s + 8 * kg) * 2);
}
__device__ __forceinline__ void norm_q16(const v4u (&raw)[4], bf16x8 (&qr)[4], const LAS float* gt, int kg) {
    float ss = 0.f;
#pragma unroll
    for (int s = 0; s < 4; ++s)
#pragma unroll
        for (int j = 0; j < 4; ++j) { const float a = bflo(raw[s][j]), b = bfhi(raw[s][j]); ss += a * a + b * b; }
    ss += __shfl_xor(ss, 16); ss += __shfl_xor(ss, 32);
    const float rstd = 1.0f / sqrtf(ss * (1.f / HD) + EPS);
#pragma unroll
    for (int s = 0; s < 4; ++s) { const LAS f32x4* gp = (const LAS f32x4*)(gt + 32 * s + 8 * kg); const f32x4 g0 = gp[0], g1 = gp[1]; v4u o;
        o.x = cvtpk(bflo(raw[s].x) * rstd * g0.x, bfhi(raw[s].x) * rstd * g0.y); o.y = cvtpk(bflo(raw[s].y) * rstd * g0.z, bfhi(raw[s].y) * rstd * g0.w);
        o.z = cvtpk(bflo(raw[s].z) * rstd * g1.x, bfhi(raw[s].z) * rstd * g1.y); o.w = cvtpk(bflo(raw[s].w) * rstd * g1.z, bfhi(raw[s].w) * rstd * g1.w);
        qr[s] = __builtin_bit_cast(bf16x8, o); }
}
__device__ __forceinline__ void norm_k(LAS unsigned char* Kl, int p0, int nrows, const LAS float* gt, int tid) {
    asm volatile("" : "+v"(tid));
#pragma unroll 1
    for (int idx = tid; idx < nrows * 4; idx += 512) {
        const int row = p0 + (idx >> 2), qd = idx & 3;
        v4u w[4]; float ss = 0.f;
#pragma unroll
        for (int i = 0; i < 4; ++i) { w[i] = *(const LAS v4u*)(Kl + KSWZ(row, (4 * qd + i) * 16));
#pragma unroll
            for (int j = 0; j < 4; ++j) { const float a = bflo(w[i][j]), b = bfhi(w[i][j]); ss += a * a + b * b; } }
        ss += __shfl_xor(ss, 1); ss += __shfl_xor(ss, 2);
        const float rstd = 1.0f / sqrtf(ss * (1.f / HD) + EPS);
#pragma unroll
        for (int i = 0; i < 4; ++i) { const LAS f32x4* gp = (const LAS f32x4*)(gt + (4 * qd + i) * 8); const f32x4 g0 = gp[0], g1 = gp[1]; v4u o;
            o.x = cvtpk(bflo(w[i].x) * rstd * g0.x, bfhi(w[i].x) * rstd * g0.y); o.y = cvtpk(bflo(w[i].y) * rstd * g0.z, bfhi(w[i].y) * rstd * g0.w);
            o.z = cvtpk(bflo(w[i].z) * rstd * g1.x, bfhi(w[i].z) * rstd * g1.y); o.w = cvtpk(bflo(w[i].w) * rstd * g1.z, bfhi(w[i].w) * rstd * g1.w);
            *(LAS v4u*)(Kl + KSWZ(row, (4 * qd + i) * 16)) = o; }
    }
}
__device__ __forceinline__ float xsum32(float v) { unsigned a = __builtin_bit_cast(unsigned, v), b = a; asm volatile("s_nop 1\n\tv_permlane32_swap_b32 %0, %1" : "+v"(a), "+v"(b)); return __builtin_bit_cast(float, a) + __builtin_bit_cast(float, b); }
__device__ __forceinline__ void load_q(v4u (&raw)[8], const char* qrow, int hi) {
#pragma unroll
    for (int d0 = 0; d0 < 8; ++d0) raw[d0] = *(const GAS v4u*)(qrow + (d0 * 16 + hi * 8) * 2);
}
__device__ __forceinline__ void norm_q(const v4u (&raw)[8], bf16x8 (&qr)[8], const LAS float* gt, int hi) {
    float ss = 0.f;
#pragma unroll
    for (int d0 = 0; d0 < 8; ++d0)
#pragma unroll
        for (int j = 0; j < 4; ++j) { const float a = bflo(raw[d0][j]), b = bfhi(raw[d0][j]); ss += a * a + b * b; }
    ss = xsum32(ss);
    const float rstd = 1.0f / sqrtf(ss * (1.f / HD) + EPS);
#pragma unroll
    for (int d0 = 0; d0 < 8; ++d0) { const LAS f32x4* gp = (const LAS f32x4*)(gt + d0 * 16 + hi * 8); const f32x4 g0 = gp[0], g1 = gp[1]; v4u o;
        o.x = cvtpk(bflo(raw[d0].x) * rstd * g0.x, bfhi(raw[d0].x) * rstd * g0.y); o.y = cvtpk(bflo(raw[d0].y) * rstd * g0.z, bfhi(raw[d0].y) * rstd * g0.w);
        o.z = cvtpk(bflo(raw[d0].z) * rstd * g1.x, bfhi(raw[d0].z) * rstd * g1.y); o.w = cvtpk(bflo(raw[d0].w) * rstd * g1.z, bfhi(raw[d0].w) * rstd * g1.w);
        qr[d0] = __builtin_bit_cast(bf16x8, o); }
}
__device__ __forceinline__ f32x16 qk_tile(const LAS unsigned char* Kl, int pb, const bf16x8 (&qr)[8], int r32, int hi) {
    f32x16 p = {};
#pragma unroll
    for (int d0 = 0; d0 < 8; ++d0) { const bf16x8 kf = *(const LAS bf16x8*)(Kl + KSWZ(pb + r32, (d0 * 16 + hi * 8) * 2));
        p = __builtin_amdgcn_mfma_f32_32x32x16_bf16(kf, qr[d0], p, 0, 0, 0); }
    return p;
}
#define PK4(P, BASE, OUT) do { unsigned a0 = cvtpk(P[BASE + 0], P[BASE + 1]), a1 = cvtpk(P[BASE + 2], P[BASE + 3]);   \
    unsigned b0 = cvtpk(P[BASE + 4], P[BASE + 5]), b1 = cvtpk(P[BASE + 6], P[BASE + 7]);                              \
    auto r0 = __builtin_amdgcn_permlane32_swap(a0, b0, false, false); auto r1 = __builtin_amdgcn_permlane32_swap(a1, b1, false, false); \
    v4u w_ = {r0[0], r1[0], r0[1], r1[1]}; OUT = __builtin_bit_cast(bf16x8, w_); } while (0)
template <int OFF> __device__ __forceinline__ void pv_step(f32x16& o, int vb, bf16x8 pa) {
    const s16x4 l = tr_read<OFF>(vb), h = tr_read<OFF + 2048>(vb);
    asm volatile("s_waitcnt lgkmcnt(0)" ::: "memory"); __builtin_amdgcn_sched_barrier(0);
    o = __builtin_amdgcn_mfma_f32_32x32x16_bf16(pa, (bf16x8){l[0], l[1], l[2], l[3], h[0], h[1], h[2], h[3]}, o, 0, 0, 0);
}
__device__ __forceinline__ void store_block(const f32x16& o, const LAS float* il, LAS unsigned short* stg, char* dst0, long rstride, int lane) {
    asm volatile("" : "+v"(lane));
    const int r32 = lane & 31, hi = lane >> 5;
#pragma unroll
    for (int r = 0; r < 16; ++r) { const int row = crow(r, hi); stg[row * 32 + r32] = (unsigned short)f2bf(o[r] * il[row]); }
    LDS_WAIT(); asm volatile("" ::: "memory");
#pragma unroll
    for (int p = 0; p < 2; ++p) { const int row = 16 * p + (lane >> 2), ch = lane & 3;
        const v4u w = *(const LAS v4u*)((const LAS unsigned char*)stg + row * 64 + ch * 16);
        *(GAS v4u*)(dst0 + (long)row * rstride + ch * 16) = w; }
    LDS_WAIT(); asm volatile("" ::: "memory");
}
}

#define RAW_BAR() do { asm volatile("s_waitcnt lgkmcnt(0)" ::: "memory"); __builtin_amdgcn_s_barrier(); asm volatile("" ::: "memory"); } while (0)
__device__ __forceinline__ void p2_attention(Frame& F) {
    using namespace att;
    LAS unsigned char* Kl = F.lds + LDS_K; LAS unsigned char* Vl = F.lds + LDS_V;
    LAS unsigned short* stg = (LAS unsigned short*)(F.lds + LDS_STG + F.wave * 2048);
    LAS float* li = (LAS float*)(F.lds + LDS_LI + F.wave * 256);
    LAS float* gtab = (LAS float*)(F.lds + LDS_GT);
    LAS float* rk = (LAS float*)(F.lds + LDS_GT + 2048);
    volatile LAS int* QN = (volatile LAS int*)(F.lds + LDS_GT + 2048 + 1024);
    const int tid = F.tid, wave = F.wave;
    if (blockIdx.x < 8) {
        pg8::Gemm g{(const bf16*)(F.ws + WS_H), (const bf16*)(F.ws + WS_WIN), D, nullptr}; pg8::P1Order S{F.G, (int)blockIdx.x, 2560, 2568};
        pg8::EpiProj E{(bf16*)(F.ws + WS_R1), (bf16*)(F.ws + WS_MEMKV)};
        pg8::gemm_phase<pg8::EpiProj, pg8::P1Order>(F.lds, g, S, E);
        VM_WAIT(); __syncthreads();
        if (tid == 0) { __builtin_amdgcn_fence(__ATOMIC_RELEASE, "agent"); asm volatile("s_waitcnt vmcnt(0)" ::: "memory"); __hip_atomic_fetch_add(F.ctl + CW_KVREADY, 1u, RLX_AGENT); }
    }
    if (tid < 128) { gtab[tid] = F.q_norm_g[tid] * F.k_norm_g[tid]; gtab[128 + tid] = F.mem_q_norm_g[tid] * F.mem_k_norm_g[tid]; gtab[256 + tid] = F.mem_q_norm_g[tid]; gtab[384 + tid] = F.mem_k_norm_g[tid]; }
    if (tid == 0) QN[0] = 1 << 30;
    __syncthreads();
    float MD, MM;
    { float a = 0.f, c = 0.f;
#pragma unroll 1
      for (int i = 0; i < 128; ++i) { a = fmaxf(a, fabsf(gtab[i])); c = fmaxf(c, fabsf(gtab[128 + i])); }
      MD = a * (128.0f * 1.03f) * CS; MM = c * (128.0f * 1.03f) * CS; }
    const char* proj = (const char*)(F.ws + WS_R1);

    {
    const int j = wave & 3, dh = wave >> 2, w0 = 32 * j + 16 * dh;
    constexpr int NCHUNK = 6144 / 4;
    v4u qraw[4];
#define DECODE(u, br, b, h, r, nb, dil) const int br = (u) >> 11, _rem = (u) & 2047, b = _rem >> 10, h = (_rem >> 7) & 7, _w = _rem & 127, dil = 1 << (2 * br), _nps = 128 >> (2 * br), r = _w / _nps, nb = _w % _nps
    int u = 4 * F.vcu;
    bool have = F.vcu < NCHUNK;
    bool full = true;
    if (have) {
        DECODE(u, br, b, h, r, nb, dil);
        const long rs = (long)dil * PROJ * 2; const char* tb = proj + (size_t)(b * SEQ + r) * (PROJ * 2);
        RowMap mk{tb + (COL_K + h * HD) * 2, rs, 128 * nb - 128, true};
        dma_k(Kl, 0, 256, mk, wave, F.lane);
        load_q16(qraw, tb + (long)(128 * nb + w0 + (F.lane & 15)) * rs + (COL_Q + h * HD) * 2, F.lane >> 4);
    }
    while (have) {
        DECODE(u, br, b, h, r, nb, dil);
        int lane = F.lane; asm volatile("" : "+v"(lane));
        const int q16 = lane & 15, kg = lane >> 4;
        const int off = 128 * ((nb + 1) & 1);
        const long rs_ = (long)dil * PROJ * 2; const char* tb_ = proj + (size_t)(b * SEQ + r) * (PROJ * 2);
        asm volatile("s_waitcnt vmcnt(0)" ::: "memory"); RAW_BAR();
        { RowMap mv{tb_ + (COL_V + h * HD) * 2, rs_, 128 * nb - 128, true};
          if (full) dma_v2(Vl, 0, 256, mv, wave, lane); else dma_v2(Vl, 128 * (nb & 1), 128, mv, wave, lane); }
        if ((u & 3) == 0 && tid == 0) QN[0] = F.G + (int)__hip_atomic_fetch_add(F.ctl + CW_ATTQ, 1u, RLX_AGENT);
        { const int p0 = full ? 0 : 128 * (nb & 1), n4 = full ? 1024 : 512;
#pragma unroll 1
          for (int idx = tid; idx < n4; idx += 512) { const int row = p0 + (idx >> 2), qd = idx & 3; float ss = 0.f;
#pragma unroll
              for (int i = 0; i < 4; ++i) { const v4u w = *(const LAS v4u*)(Kl + KSWZ(row, (4 * qd + i) * 16));
#pragma unroll
                  for (int jj = 0; jj < 4; ++jj) { const float a = bflo(w[jj]), c = bfhi(w[jj]); ss += a * a + c * c; } }
              ss += __shfl_xor(ss, 1); ss += __shfl_xor(ss, 2);
              if (qd == 0) rk[row] = 1.0f / sqrtf(ss * (1.f / HD) + EPS); } }
        bf16x8 qr[4];
        norm_q16(qraw, qr, gtab, kg);
        f32x4 s[9];
#pragma unroll
        for (int t = 0; t < 9; ++t) { const int pb = (w0 + 16 * t + off) & 255; f32x4 a = {0.f, 0.f, 0.f, 0.f};
#pragma unroll
            for (int d = 0; d < 4; ++d) { const bf16x8 kf = *(const LAS bf16x8*)(Kl + KSWZ(pb + q16, 64 * d + 16 * kg));
                a = __builtin_amdgcn_mfma_f32_16x16x32_bf16(kf, qr[d], a, 0, 0, 0); }
            s[t] = a; }
        RAW_BAR();
        int un = u + 1; bool has_next = true;
        if ((un & 3) == 0) { const int nc = QN[0]; has_next = nc < NCHUNK; un = 4 * nc; }
        bool n_full = false;
        if (has_next) {
            DECODE(un, br2, b2, h2, r2, nb2, dil2);
            n_full = (un != u + 1) || (nb2 == 0);
            const long rs = (long)dil2 * PROJ * 2; const char* tb = proj + (size_t)(b2 * SEQ + r2) * (PROJ * 2);
            RowMap nmk{tb + (COL_K + h2 * HD) * 2, rs, 128 * nb2 - 128, true};
            if (n_full) dma_k(Kl, 0, 256, nmk, wave, lane); else dma_k(Kl, 128 * (nb2 & 1), 128, nmk, wave, lane);
            load_q16(qraw, tb + (long)(128 * nb2 + w0 + q16) * rs + (COL_Q + h2 * HD) * 2, kg);
        }
        const float bias2 = __builtin_amdgcn_exp2f(-(float)(h + 1)) * (float)dil * LOG2E;
        const float rowoff = bias2 * (float)(4 * kg - q16 - 128) - MD;
        float l = 0.f;
#pragma unroll
        for (int t = 0; t < 9; ++t) {
            const int pb = (w0 + 16 * t + off) & 255;
            const f32x4 rkv = *(const LAS f32x4*)(rk + pb + 4 * kg);
            const bool dead = (nb == 0) && (w0 + 16 * t < 128);
#pragma unroll
            for (int r_ = 0; r_ < 4; ++r_) {
                float v = fmaf(s[t][r_] * rkv[r_], CS, fmaf(bias2, (float)(16 * t + r_), rowoff));
                if (t == 0) v = (4 * kg + r_ >= q16) ? v : -1.0e30f;
                if (t == 8) v = (4 * kg + r_ <= q16) ? v : -1.0e30f;
                v = dead ? 0.f : __builtin_amdgcn_exp2f(v); s[t][r_] = v; l += v; }
        }
        l += __shfl_xor(l, 16); l += __shfl_xor(l, 32);
        bf16x8 pa[5];
#pragma unroll
        for (int sp = 0; sp < 5; ++sp) { v4u w; w.x = cvtpk(s[2 * sp][0], s[2 * sp][1]); w.y = cvtpk(s[2 * sp][2], s[2 * sp][3]);
            if (sp < 4) { w.z = cvtpk(s[2 * sp + 1][0], s[2 * sp + 1][1]); w.w = cvtpk(s[2 * sp + 1][2], s[2 * sp + 1][3]); } else { w.z = 0u; w.w = 0u; }
            pa[sp] = __builtin_bit_cast(bf16x8, w); }
        if (has_next) asm volatile("s_waitcnt vmcnt(8)" ::: "memory"); else asm volatile("s_waitcnt vmcnt(0)" ::: "memory");
        RAW_BAR();
        f32x4 o[8];
#pragma unroll
        for (int db = 0; db < 8; ++db) o[db] = (f32x4){0.f, 0.f, 0.f, 0.f};
        { const int qq = q16 >> 2, pp = q16 & 3;
#pragma unroll
          for (int sp = 0; sp < 5; ++sp) {
              const int ra = (w0 + 32 * sp + off + 4 * kg + qq) & 255, rb = (w0 + 32 * sp + 16 + off + 4 * kg + qq) & 255;
              const int va = (int)(uintptr_t)Vl + ra * 256 + 8 * pp, vb = (int)(uintptr_t)Vl + rb * 256 + 8 * pp, xa = (ra & 7) << 5, xb = (rb & 7) << 5;
#pragma unroll
              for (int dq = 0; dq < 2; ++dq) {
                  s16x4 la[4], lb[4];
#pragma unroll
                  for (int i = 0; i < 4; ++i) { const int db = 4 * dq + i;
                      asm volatile("ds_read_b64_tr_b16 %0, %1" : "=&v"(la[i]) : "v"(va + ((32 * db) ^ xa)) : "memory");
                      asm volatile("ds_read_b64_tr_b16 %0, %1" : "=&v"(lb[i]) : "v"(vb + ((32 * db) ^ xb)) : "memory"); }
                  asm volatile("s_waitcnt lgkmcnt(0)" ::: "memory"); __builtin_amdgcn_sched_barrier(0);
#pragma unroll
                  for (int i = 0; i < 4; ++i) { const int db = 4 * dq + i;
                      o[db] = __builtin_amdgcn_mfma_f32_16x16x32_bf16(pa[sp], (bf16x8){la[i][0], la[i][1], la[i][2], la[i][3], lb[i][0], lb[i][1], lb[i][2], lb[i][3]}, o[db], 0, 0, 0); }
              } } }
        const float il = 1.0f / l;
        if (kg == 0) li[q16] = il;
        LDS_WAIT(); asm volatile("" ::: "memory");
        const f32x4 ilr = *(const LAS f32x4*)(li + 4 * kg);
        const int tok0 = b * SEQ + r + dil * (128 * nb + w0);
        char* dst = (char*)(F.ws + WS_OPART) + ((size_t)br * T + tok0) * (ATTN_W * 2) + (h * HD) * 2;
#pragma unroll
        for (int hf = 0; hf < 2; ++hf) {
#pragma unroll
            for (int i = 0; i < 4; ++i)
#pragma unroll
                for (int r_ = 0; r_ < 4; ++r_) stg[(4 * kg + r_) * 64 + 16 * i + q16] = (unsigned short)f2bf(o[4 * hf + i][r_] * ilr[r_]);
            LDS_WAIT(); asm volatile("" ::: "memory");
#pragma unroll
            for (int p = 0; p < 2; ++p) { const int row = lane >> 2, ch = (lane & 3) + 4 * p;
                const v4u w = *(const LAS v4u*)((const LAS unsigned char*)stg + row * 128 + ch * 16);
                *(GAS v4u*)(dst + (long)row * ((long)dil * ATTN_W * 2) + hf * 128 + ch * 16) = w; }
            LDS_WAIT(); asm volatile("" ::: "memory");
        }
        if (kg == 0) ((float*)(F.ws + WS_LSE))[((size_t)br * T + tok0 + dil * q16) * 8 + h] = MD + __builtin_amdgcn_logf(l);
        have = has_next; u = un; full = n_full;
    }
#undef DECODE
    }

    VM_WAIT(); __syncthreads();
    if (wave == 0) { unsigned sp = 0;
        while (__builtin_amdgcn_readfirstlane(__hip_atomic_load(F.ctl + CW_KVREADY, RLX_AGENT)) < 8u) { __builtin_amdgcn_s_sleep(2); if (++sp > (1u << 22)) { if (F.lane == 0) __hip_atomic_store(F.ctl + CW_TMO, 1u, RLX_AGENT); break; } }
        __builtin_amdgcn_fence(__ATOMIC_ACQUIRE, "agent"); asm volatile("s_waitcnt vmcnt(0)" ::: "memory"); }
    __syncthreads();
    for (int it = F.vcu; it < 256; it += F.G) {
        const int combo = it >> 5, part = it & 31, b = combo >> 2, hm = combo & 3;
        const char* mkv = (const char*)(F.ws + WS_MEMKV) + (size_t)(b * NMEM) * 2048 + hm * 256;
        RowMap mk{mkv, 2048, 0, false}, mv{mkv + 1024, 2048, 0, false};
        __syncthreads();
        dma_k(Kl, 0, 256, mk, wave, F.lane); dma_v(Vl, 0, 256, mv, wave, F.lane);
        VM_WAIT(); __syncthreads();
        norm_k(Kl, 0, 256, gtab + 384, tid);
        __syncthreads();
        for (int qb = 0; qb < 2; ++qb) {
            int lane = F.lane; asm volatile("" : "+v"(lane));
            const int r32 = lane & 31, hi = lane >> 5, vbase = (int)(uintptr_t)Vl + v_rd_base(lane);
            const int tok = b * SEQ + part * 512 + qb * 256 + wave * 32 + r32;
            v4u raw[8]; bf16x8 qr[8];
            load_q(raw, proj + (size_t)tok * (PROJ * 2) + (COL_MQ + hm * HD) * 2, hi);
            norm_q(raw, qr, gtab + 256, hi);
            const float mc = -MM; float l = 0.f;
            f32x16 o[4] = {};
#pragma unroll 1
            for (int hk = 0; hk < 2; ++hk) {
                bf16x8 pa[8];
#pragma unroll
                for (int kt = 0; kt < 4; ++kt) { f32x16 s = qk_tile(Kl, 128 * hk + 32 * kt, qr, r32, hi);
#pragma unroll
                    for (int r = 0; r < 16; ++r) { s[r] = __builtin_amdgcn_exp2f(fmaf(s[r], CS, mc)); l += s[r]; }
                    PK4(s, 0, pa[2 * kt]); PK4(s, 8, pa[2 * kt + 1]); }
#pragma unroll
                for (int f = 0; f < 8; ++f) { const int vb = vbase + (8 * hk + f) * 4096;
                    pv_step<0>(o[0], vb, pa[f]); pv_step<512>(o[1], vb, pa[f]); pv_step<1024>(o[2], vb, pa[f]); pv_step<1536>(o[3], vb, pa[f]); }
            }
            l = xsum32(l);
            if (hi == 0) li[r32] = 1.0f / l;
            LDS_WAIT(); asm volatile("" ::: "memory");
            char* dst = (char*)(F.ws + WS_MEMO) + (size_t)(tok - r32) * (MEM_W * 2) + hm * 256;
#pragma unroll
            for (int d0 = 0; d0 < 4; ++d0) store_block(o[d0], li, stg, dst + d0 * 64, MEM_W * 2, lane);
        }
    }
}

__device__ __forceinline__ void unpack8(const v4u w, float (&f)[8]) { f[0] = bflo(w.x); f[1] = bfhi(w.x); f[2] = bflo(w.y); f[3] = bfhi(w.y); f[4] = bflo(w.z); f[5] = bfhi(w.z); f[6] = bflo(w.w); f[7] = bfhi(w.w); }
__device__ __forceinline__ void p3_combine(Frame& F) {
    const int gw = F.vcu * NWAVES + F.wave, NGW = F.G * NWAVES, lane = F.lane;
    const bf16* proj = (const bf16*)(F.ws + WS_R1); const bf16* opart = (const bf16*)(F.ws + WS_OPART); const float* lse = (const float*)(F.ws + WS_LSE);
    const bf16* memo = (const bf16*)(F.ws + WS_MEMO); bf16* Y = (bf16*)(F.ws + WS_Y);
    for (int t = gw; t < T; t += NGW) {
        float a[16]; float ssa = 0.f;
#pragma unroll
        for (int cc = 0; cc < 2; ++cc) { const int head = 4 * cc + (lane >> 4);
            const float l0 = lse[((size_t)0 * T + t) * 8 + head], l1 = lse[((size_t)1 * T + t) * 8 + head], l2 = lse[((size_t)2 * T + t) * 8 + head];
            const float mx = fmaxf(l0, fmaxf(l1, l2)); float w0 = __builtin_amdgcn_exp2f(l0 - mx), w1 = __builtin_amdgcn_exp2f(l1 - mx), w2 = __builtin_amdgcn_exp2f(l2 - mx);
            const float inv = 1.0f / (w0 + w1 + w2); w0 *= inv; w1 *= inv; w2 *= inv;
            float f0[8], f1[8], f2[8];
            unpack8(__builtin_nontemporal_load((const GAS v4u*)(opart + ((size_t)0 * T + t) * ATTN_W + cc * 512 + 8 * lane)), f0);
            unpack8(__builtin_nontemporal_load((const GAS v4u*)(opart + ((size_t)1 * T + t) * ATTN_W + cc * 512 + 8 * lane)), f1);
            unpack8(__builtin_nontemporal_load((const GAS v4u*)(opart + ((size_t)2 * T + t) * ATTN_W + cc * 512 + 8 * lane)), f2);
#pragma unroll
            for (int jj = 0; jj < 8; ++jj) { const float v = w0 * f0[jj] + w1 * f1[jj] + w2 * f2[jj]; a[8 * cc + jj] = v; ssa += v * v; } }
        float co[8]; float ssc = 0.f;
        { const int s = t & (SEQ - 1); float bg[8], c0[8], uu0[8], c1[8], uu1[8], c2[8], uu2[8];
          const bf16* p0 = proj + (size_t)t * PROJ + 8 * lane;
          unpack8(*(const GAS v4u*)(p0 + COL_B), bg); unpack8(*(const GAS v4u*)(p0 + COL_C), c0); unpack8(*(const GAS v4u*)(p0 + COL_U), uu0);
          if (s >= 1) { unpack8(*(const GAS v4u*)(p0 - PROJ + COL_C), c1); unpack8(*(const GAS v4u*)(p0 - PROJ + COL_U), uu1); }
          if (s >= 2) { unpack8(*(const GAS v4u*)(p0 - 2 * PROJ + COL_C), c2); unpack8(*(const GAS v4u*)(p0 - 2 * PROJ + COL_U), uu2); }
#pragma unroll
          for (int jj = 0; jj < 8; ++jj) { const int c = 8 * lane + jj;
              const float z0 = c0[jj] * uu0[jj], z1 = (s >= 1) ? c1[jj] * uu1[jj] : 0.f, z2 = (s >= 2) ? c2[jj] * uu2[jj] : 0.f;
              const float v = bg[jj] * (F.conv_w[c] * z2 + F.conv_w[CONV_W + c] * z1 + F.conv_w[2 * CONV_W + c] * z0); co[jj] = v; ssc += v * v; } }
        float mo[8]; float ssm = 0.f;
        unpack8(__builtin_nontemporal_load((const GAS v4u*)(memo + (size_t)t * MEM_W + 8 * lane)), mo);
#pragma unroll
        for (int jj = 0; jj < 8; ++jj) ssm += mo[jj] * mo[jj];
#pragma unroll
        for (int o = 1; o < 64; o <<= 1) { ssa += __shfl_xor(ssa, o); ssc += __shfl_xor(ssc, o); ssm += __shfl_xor(ssm, o); }
        const float ra = 1.0f / sqrtf(ssa * (1.f / ATTN_W) + EPS), rc = 1.0f / sqrtf(ssc * (1.f / CONV_W) + EPS), rm = 1.0f / sqrtf(ssm * (1.f / MEM_W) + EPS);
        bf16* yr = Y + (size_t)t * D;
#pragma unroll
        for (int cc = 0; cc < 2; ++cc) { const float* g = F.out_norm_g + cc * 512 + 8 * lane; v4u w;
            w.x = pk2(a[8 * cc + 0] * ra * g[0], a[8 * cc + 1] * ra * g[1]); w.y = pk2(a[8 * cc + 2] * ra * g[2], a[8 * cc + 3] * ra * g[3]);
            w.z = pk2(a[8 * cc + 4] * ra * g[4], a[8 * cc + 5] * ra * g[5]); w.w = pk2(a[8 * cc + 6] * ra * g[6], a[8 * cc + 7] * ra * g[7]);
            *(GAS v4u*)(yr + cc * 512 + 8 * lane) = w; }
        { const float* g = F.out_norm_g + ATTN_W + 8 * lane; v4u w;
          w.x = pk2(co[0] * rc * g[0], co[1] * rc * g[1]); w.y = pk2(co[2] * rc * g[2], co[3] * rc * g[3]); w.z = pk2(co[4] * rc * g[4], co[5] * rc * g[5]); w.w = pk2(co[6] * rc * g[6], co[7] * rc * g[7]);
          *(GAS v4u*)(yr + ATTN_W + 8 * lane) = w; }
        { const float* g = F.out_norm_g + ATTN_W + CONV_W + 8 * lane; v4u w;
          w.x = pk2(mo[0] * rm * g[0], mo[1] * rm * g[1]); w.y = pk2(mo[2] * rm * g[2], mo[3] * rm * g[3]); w.z = pk2(mo[4] * rm * g[4], mo[5] * rm * g[5]); w.w = pk2(mo[6] * rm * g[6], mo[7] * rm * g[7]);
          *(GAS v4u*)(yr + ATTN_W + CONV_W + 8 * lane) = w; }
    }
}

__device__ __forceinline__ float max8(float v) { v = fmaxf(v, __shfl_xor(v, 1)); v = fmaxf(v, __shfl_xor(v, 2)); v = fmaxf(v, __shfl_xor(v, 4)); return v; }
namespace rt {
constexpr int KC = 128, NCH = D / KC, BP = KC * 2 + 16, BUFB = 2 * 96 * BP;
__device__ __forceinline__ void issue_b(v4u (&bst)[6], const bf16* WT, int c, int tid) {
#pragma unroll
    for (int i = 0; i < 6; ++i) { const int p = tid + 512 * i, arr = p / 1536, rem = p - arr * 1536, n = rem >> 4, ch = rem & 15;
        bst[i] = *(const GAS v4u*)(WT + ((size_t)arr * 96 + n) * 2048 + c * KC + ch * 8); }
}
__device__ __forceinline__ void write_b(const v4u (&bst)[6], LAS unsigned char* buf, int tid) {
#pragma unroll
    for (int i = 0; i < 6; ++i) { const int p = tid + 512 * i, arr = p / 1536, rem = p - arr * 1536, n = rem >> 4, ch = rem & 15;
        *(LAS v4u*)(buf + arr * (96 * BP) + n * BP + ch * 16) = bst[i]; }
}
__device__ __forceinline__ void issue_a(v4u (&a)[4], const bf16* xrow, int c) {
#pragma unroll
    for (int ks = 0; ks < 4; ++ks) a[ks] = *(const GAS v4u*)(xrow + c * KC + ks * 32);
}
__device__ __forceinline__ void compute(f32x4 (&acc)[6], float& ss, const v4u (&a)[4], const LAS unsigned char* buf, int fr, int kg) {
#pragma unroll
    for (int ks = 0; ks < 4; ++ks) {
        const v4u h = a[ks];
#pragma unroll
        for (int j = 0; j < 4; ++j) { const float lo_ = bflo(h[j]), hi_ = bfhi(h[j]); ss += lo_ * lo_ + hi_ * hi_; }
        asm volatile("" : "+v"(ss));
        const bf16x8 ah = __builtin_bit_cast(bf16x8, h);
#pragma unroll
        for (int nb = 0; nb < 6; ++nb) { const LAS unsigned char* bp = buf + (nb * 16 + fr) * BP + (ks * 32 + 8 * kg) * 2;
            const bf16x8 bh = *(const LAS bf16x8*)bp, bl = *(const LAS bf16x8*)(bp + 96 * BP);
            acc[nb] = __builtin_amdgcn_mfma_f32_16x16x32_bf16(ah, bh, acc[nb], 0, 0, 0);
            acc[nb] = __builtin_amdgcn_mfma_f32_16x16x32_bf16(ah, bl, acc[nb], 0, 0, 0); }
    }
}
}
__device__ __forceinline__ void p5_router(Frame& F) {
    using namespace rt;
    const int tid = F.tid, wave = F.wave;
    const bf16* X1 = (const bf16*)(F.ws + WS_X1H); const bf16* WT = (const bf16*)(F.ws + WS_WR);
    LAS unsigned char* Bl = F.lds;
    LAS float* Lg = (LAS float*)(F.lds + 2 * BUFB + wave * (16 * 97 * 4));
    unsigned* cnt = F.ctl + CW_CNT;
    int* tok_e = (int*)(F.ws + WS_TOK + TOK_E); int* tok_rank = (int*)(F.ws + WS_TOK + TOK_RANK);
    for (int mt = F.vcu; mt < T / 128; mt += F.G) {
        int lane = F.lane; asm volatile("" : "+v"(lane));
        const int fr = lane & 15, kg = lane >> 4;
        const int t0 = mt * 128 + wave * 16;
        const bf16* xrow = X1 + (size_t)(t0 + fr) * D + 8 * kg;
        f32x4 acc[6];
#pragma unroll
        for (int i = 0; i < 6; ++i) acc[i] = (f32x4){0.f, 0.f, 0.f, 0.f};
        float ss = 0.f;
        v4u bst[6]; v4u a0[4], a1[4];
        __syncthreads();
        issue_b(bst, WT, 0, tid); issue_a(a0, xrow, 0);
#pragma unroll 1
        for (int c = 0; c < NCH - 2; c += 2) {
            write_b(bst, Bl, tid); __syncthreads();
            issue_b(bst, WT, c + 1, tid); issue_a(a1, xrow, c + 1);
            compute(acc, ss, a0, Bl, fr, kg);
            write_b(bst, Bl + BUFB, tid); __syncthreads();
            issue_b(bst, WT, c + 2, tid); issue_a(a0, xrow, c + 2);
            compute(acc, ss, a1, Bl + BUFB, fr, kg);
        }
        write_b(bst, Bl, tid); __syncthreads();
        issue_b(bst, WT, NCH - 1, tid); issue_a(a1, xrow, NCH - 1);
        compute(acc, ss, a0, Bl, fr, kg);
        write_b(bst, Bl + BUFB, tid); __syncthreads();
        compute(acc, ss, a1, Bl + BUFB, fr, kg);
        ss += __shfl_xor(ss, 16); ss += __shfl_xor(ss, 32);
        const float rs_row = 1.0f / sqrtf(ss * (1.f / D) + EPS);
#pragma unroll
        for (int r = 0; r < 4; ++r) { const float rr = __shfl(rs_row, 4 * kg + r);
#pragma unroll
            for (int nb = 0; nb < 6; ++nb) Lg[(4 * kg + r) * 97 + nb * 16 + fr] = acc[nb][r] * rr; }
        LDS_WAIT(); asm volatile("" ::: "memory");
        const float be = F.b_re[lane], bg = F.b_rg[lane & 7];
        int my_e1 = 0, my_e2 = 0; float my_g1 = 0.f, my_g2 = 0.f;
#pragma unroll 4
        for (int tk = 0; tk < 16; ++tk) {
            const float gl = Lg[tk * 97 + 64 + (lane & 7)] + bg;
            const float el = Lg[tk * 97 + lane] + be;
            const float gmax = max8(gl);
            const int gi = __builtin_ctzll(__ballot(gl == gmax) & 0xFFull);
            float gs = __builtin_amdgcn_exp2f((gl - gmax) * LOG2E); gs += __shfl_xor(gs, 1); gs += __shfl_xor(gs, 2); gs += __shfl_xor(gs, 4);
            const float gwt = 1.0f / gs;
            const float v1 = __shfl(max8(el), 8 * gi);
            const int i1 = __builtin_ctzll((__ballot(el == v1) >> (8 * gi)) & 0xFFull);
            const float el2 = (lane == 8 * gi + i1) ? -3.0e38f : el;
            const float v2 = __shfl(max8(el2), 8 * gi);
            const int i2 = __builtin_ctzll((__ballot(el2 == v2) >> (8 * gi)) & 0xFFull);
            const float pr = __builtin_amdgcn_exp2f((v2 - v1) * LOG2E), den = 1.0f / (1.0f + pr);
            if (lane == tk) { my_e1 = 8 * gi + i1; my_e2 = 8 * gi + i2; my_g1 = gwt * den; my_g2 = gwt * pr * den; }
        }
        LAS unsigned* hist = (LAS unsigned*)(F.lds + MISC_OFF + 256);
        if (tid < 64) hist[tid] = 0u;
        __syncthreads();
        unsigned lr1 = 0u, lr2 = 0u;
        if (lane < 16) { lr1 = __hip_atomic_fetch_add(hist + my_e1, 1u, __ATOMIC_RELAXED, __HIP_MEMORY_SCOPE_WORKGROUP); lr2 = __hip_atomic_fetch_add(hist + my_e2, 1u, __ATOMIC_RELAXED, __HIP_MEMORY_SCOPE_WORKGROUP); }
        __syncthreads();
        if (tid < 64) { const unsigned c = hist[tid]; hist[64 + tid] = c ? __hip_atomic_fetch_add(cnt + 64 * tid, c, RLX_AGENT) : 0u; }
        __syncthreads();
        if (lane < 16) {
            const int t = t0 + lane;
            const int k1 = (int)(hist[64 + my_e1] + lr1), k2 = (int)(hist[64 + my_e2] + lr2);
            tok_e[2 * t] = my_e1; tok_e[2 * t + 1] = my_e2; tok_rank[2 * t] = k1; tok_rank[2 * t + 1] = k2;
            int* ltok = (int*)(F.ws + WS_LIST + LIST_TOK); float* lrs = (float*)(F.ws + WS_LIST + LIST_RSTD); float* lgt = (float*)(F.ws + WS_LIST + LIST_GATE);
            ltok[my_e1 * CAP + k1] = t; ltok[my_e2 * CAP + k2] = t; lrs[my_e1 * CAP + k1] = rs_row; lrs[my_e2 * CAP + k2] = rs_row; lgt[my_e1 * CAP + k1] = my_g1; lgt[my_e2 * CAP + k2] = my_g2;
        }
    }
}

constexpr int MOE_MT = MISC_OFF + 48, MOE_PST = MISC_OFF + 64, MOE_TE = MOE_PST + 256;
constexpr int MOE_TB = LDS_EXTRA, MOE_VR = MOE_TB + MAXTILES * 4, MOE_UT = MOE_VR + MAXTILES * 4, MOE_SCU = MOE_UT + 12 * 256 * 4;
constexpr int MOE_MAXU = 12;
static_assert(MOE_SCU + MOE_MAXU * 256 * 4 <= MISC_OFF && MOE_TE + MAXTILES * 4 <= LDS_BYTES, "LDS map");
__device__ __forceinline__ int moe_tables(Frame& F) {
    LAS int* PST = (LAS int*)(F.lds + MOE_PST); LAS int* TE = (LAS int*)(F.lds + MOE_TE); LAS int* MTp = (LAS int*)(F.lds + MOE_MT); LAS int* TB = (LAS int*)(F.lds + MOE_TB); LAS int* VR = (LAS int*)(F.lds + MOE_VR);
    __syncthreads();
    if (F.tid < 64) {
        const int c = (int)__hip_atomic_load(F.ctl + CW_CNT + 64 * F.tid, RLX_AGENT); const int nt = (c + 255) >> 8;
        int x = nt;
#pragma unroll
        for (int o = 1; o < 64; o <<= 1) { const int y = __shfl_up(x, o); if (F.lane >= o) x += y; }
        const int ex = x - nt; PST[F.tid] = ex; if (F.tid == 63) MTp[0] = x;
        for (int i = 0; i < nt; ++i) { TE[ex + i] = F.tid; TB[ex + i] = F.tid * CAP + 256 * i; VR[ex + i] = (c - 256 * i) < 256 ? (c - 256 * i) : 256; }
    }
    __syncthreads();
    return MTp[0];
}

__device__ __forceinline__ void unpack8q(const v2u w, float (&f)[8]) {
    typedef float f32x2_ __attribute__((ext_vector_type(2)));
    const f32x2_ p0 = __builtin_amdgcn_cvt_pk_f32_fp8((int)w.x, false), p1 = __builtin_amdgcn_cvt_pk_f32_fp8((int)w.x, true), p2 = __builtin_amdgcn_cvt_pk_f32_fp8((int)w.y, false), p3 = __builtin_amdgcn_cvt_pk_f32_fp8((int)w.y, true);
    constexpr float q = 1.0f / SC_Y; f[0] = p0.x * q; f[1] = p0.y * q; f[2] = p1.x * q; f[3] = p1.y * q; f[4] = p2.x * q; f[5] = p2.y * q; f[6] = p3.x * q; f[7] = p3.y * q;
}
__device__ __forceinline__ void p9_final(Frame& F) {
    (void)moe_tables(F);
    const LAS int* PST = (const LAS int*)(F.lds + MOE_PST);
    const int gw = F.vcu * NWAVES + F.wave, NGW = F.G * NWAVES, lane = F.lane;
    const int* tok_e = (const int*)(F.ws + WS_TOK + TOK_E); const int* tok_rank = (const int*)(F.ws + WS_TOK + TOK_RANK); const bf16* YB = (const bf16*)(F.ws + WS_R1);
    typedef int i32x2 __attribute__((ext_vector_type(2)));
    i32x2 ce = {0, 0}, cr = {0, 0};
    if (gw < T) { ce = *(const GAS i32x2*)(tok_e + 2 * gw); cr = *(const GAS i32x2*)(tok_rank + 2 * gw); }
    for (int t = gw; t < T; t += NGW) {
        const int s1 = PST[ce.x] * 256 + cr.x, s2 = PST[ce.y] * 256 + cr.y;
        if (t + NGW < T) { ce = *(const GAS i32x2*)(tok_e + 2 * (t + NGW)); cr = *(const GAS i32x2*)(tok_rank + 2 * (t + NGW)); }
        const GAS v2u* y1 = (const GAS v2u*)((const unsigned char*)YB + (size_t)s1 * D) + lane; const GAS v2u* y2 = (const GAS v2u*)((const unsigned char*)YB + (size_t)s2 * D) + lane;
        GAS f32x4* o = (GAS f32x4*)(F.out + (size_t)t * D) + 2 * lane; const GAS v4u* xh = (const GAS v4u*)((const bf16*)(F.ws + WS_X1H) + (size_t)t * D) + lane;
#pragma unroll
        for (int i = 0; i < 4; ++i) { float a[8], b[8], xf[8]; unpack8q(__builtin_nontemporal_load(y1 + 64 * i), a); unpack8q(__builtin_nontemporal_load(y2 + 64 * i), b); unpack8(__builtin_nontemporal_load(xh + 64 * i), xf);
            f32x4 v0 = {xf[0], xf[1], xf[2], xf[3]}, v1 = {xf[4], xf[5], xf[6], xf[7]};
            v0.x += a[0] + b[0]; v0.y += a[1] + b[1]; v0.z += a[2] + b[2]; v0.w += a[3] + b[3]; v1.x += a[4] + b[4]; v1.y += a[5] + b[5]; v1.z += a[6] + b[6]; v1.w += a[7] + b[7];
            __builtin_nontemporal_store(v0, o + 128 * i); __builtin_nontemporal_store(v1, o + 128 * i + 1); }
    }
}

constexpr int PER_PHASE = 10;
constexpr int N_LAUNCHES = MK_N_LAUNCHES;
struct Args { const float* in[21]; float* out; unsigned char* ws; int ph_lo, ph_hi, li, pad; };
__global__ void __launch_bounds__(NWAVES * 64, 2) hymba_fwd(Args args) {
    extern __shared__ __attribute__((aligned(16))) unsigned char lds[];
    Frame F;
    F.lds = (LAS unsigned char*)lds;
    F.tid = threadIdx.x; F.lane = F.tid & 63; F.wave = __builtin_amdgcn_readfirstlane(F.tid >> 6);
    F.G = gridDim.x; { const int bx = blockIdx.x; F.vcu = (F.G % 8 == 0) ? (bx % 8) * (F.G / 8) + bx / 8 : bx; }
    F.ws = args.ws; F.ctl = (unsigned*)(args.ws + WS_CTL); F.out = args.out;
    F.x = args.in[0]; F.mem = args.in[1]; F.norm1_g = args.in[2]; F.w_in = args.in[3]; F.q_norm_g = args.in[4]; F.k_norm_g = args.in[5]; F.conv_w = args.in[6];
    F.mem_norm_g = args.in[7]; F.w_mem_kv = args.in[8]; F.mem_q_norm_g = args.in[9]; F.mem_k_norm_g = args.in[10]; F.out_norm_g = args.in[11]; F.w_out = args.in[12];
    F.norm2_g = args.in[13]; F.w_rg = args.in[14]; F.b_rg = args.in[15]; F.w_re = args.in[16]; F.b_re = args.in[17]; F.w_gate = args.in[18]; F.w_up = args.in[19]; F.w_down = args.in[20];
    volatile LAS unsigned* MISC = (volatile LAS unsigned*)(F.lds + MISC_OFF);
    if (F.tid < 16) MISC[F.tid] = 0u;
    __syncthreads();
    const int lo = args.ph_lo, hi = args.ph_hi;
    const bool multi = (hi - lo) > 1;
    XcdBarrier bar; bar.bar = F.ctl + CW_BAR + args.li * XCD_BAR_WORDS; bar.x = 0; bar.st = nullptr;
    if (multi) bar = xcd_barrier_post(F.ctl + CW_BAR + args.li * XCD_BAR_WORDS, MISC + 8);
#define GRID_BAR() do { if (multi) xcd_barrier(bar); } while (0)
#define IN(k) (lo <= (k) && (k) < hi)
#define BOTH(k) (IN(k) && IN((k) + 1))
    if (IN(0)) { p0_prologue(F); if (BOTH(0)) GRID_BAR(); }
    if (IN(1)) {
        pg8::Gemm g{(const bf16*)(F.ws + WS_H), (const bf16*)(F.ws + WS_WIN), D, nullptr}; pg8::P1Order S{F.G, (int)blockIdx.x, 0, 2560};
        pg8::EpiProj E{(bf16*)(F.ws + WS_R1), (bf16*)(F.ws + WS_MEMKV)};
        pg8::gemm_phase<pg8::EpiProj, pg8::P1Order>(F.lds, g, S, E);
        if (BOTH(1)) GRID_BAR();
    }
    if (IN(2)) { p2_attention(F); if (BOTH(2)) GRID_BAR(); }
    if (IN(3)) { p3_combine(F); if (BOTH(3)) GRID_BAR(); }
    if (IN(4)) {
        pg8::Gemm g{(const bf16*)(F.ws + WS_Y), (const bf16*)(F.ws + WS_WOUT), D, nullptr}; pg8::StaticOrder S{T / 256, D / 256, F.G, (int)blockIdx.x};
        pg8::EpiResid E{F.x, (bf16*)(F.ws + WS_X1H), (bf16*)(F.ws + WS_H)};
        pg8::gemm_phase<pg8::EpiResid, pg8::StaticOrder, true>(F.lds, g, S, E);
        if (BOTH(4)) GRID_BAR();
    }
    if (IN(5)) { p5_router(F); if (BOTH(5)) GRID_BAR(); }
    if (IN(7)) {
        const int MT = moe_tables(F);
        pg8::MoeOrder S{MT, F.G, (int)blockIdx.x, (const LAS int*)(F.lds + MOE_TE)};
        { const LAS int* TB = (const LAS int*)(F.lds + MOE_TB); const LAS int* VR = (const LAS int*)(F.lds + MOE_VR); LAS int* UT = (LAS int*)(F.lds + MOE_UT);
          const int* ltok = (const int*)(F.ws + WS_LIST + LIST_TOK); const float* lrs = (const float*)(F.ws + WS_LIST + LIST_RSTD); LAS float* SCU = (LAS float*)(F.lds + MOE_SCU);
          for (int i = 0; i < MOE_MAXU; ++i) { pg8::Unit u; if (!S.next(i, u)) break;
              if (F.tid < 256) { const bool ok = F.tid < VR[u.pm]; UT[i * 256 + F.tid] = ok ? ltok[TB[u.pm] + F.tid] : 0; SCU[i * 256 + F.tid] = ok ? lrs[TB[u.pm] + F.tid] : 0.f; } }
          __syncthreads(); }
        pg8::Gemm g{(const bf16*)(F.ws + WS_H), (const bf16*)(F.ws + WS_WGU), D, (const LAS int*)(F.lds + MOE_UT)};
        pg8::EpiSwiGLU E{(bf16*)(F.ws + WS_OPART), (const LAS float*)(F.lds + MOE_SCU)};
        pg8::gemm_phase<pg8::EpiSwiGLU, pg8::MoeOrder, true, true, false, true>(F.lds, g, S, E);
        if (BOTH(7)) GRID_BAR();
    }
    if (IN(8)) {
        const int MT = moe_tables(F);
        pg8::Gemm g{(const bf16*)(F.ws + WS_OPART), (const bf16*)(F.ws + WS_WD), DEXP, nullptr}; pg8::MoeOrder S{MT, F.G, (int)blockIdx.x, (const LAS int*)(F.lds + MOE_TE)};
        { const LAS int* TB = (const LAS int*)(F.lds + MOE_TB); const LAS int* VR = (const LAS int*)(F.lds + MOE_VR); LAS float* SCU = (LAS float*)(F.lds + MOE_SCU);
          const float* lgt = (const float*)(F.ws + WS_LIST + LIST_GATE);
          for (int i = 0; i < MOE_MAXU; ++i) { pg8::Unit u; if (!S.next(i, u)) break;
              if (F.tid < 256) SCU[i * 256 + F.tid] = (F.tid < VR[u.pm]) ? lgt[TB[u.pm] + F.tid] : 0.f; }
          __syncthreads(); }
        pg8::EpiDown E{(bf16*)(F.ws + WS_R1), (const LAS float*)(F.lds + MOE_SCU)};
        pg8::gemm_phase<pg8::EpiDown, pg8::MoeOrder, true, false, false, true>(F.lds, g, S, E);
        if (BOTH(8)) GRID_BAR();
    }
    if (IN(9)) { p9_final(F); }
#undef IN
#undef BOTH
#undef GRID_BAR
}

extern "C" void kernel_launch(void* const* d_in, const int* in_sizes, int n_in, void* d_out, int out_size, void* d_ws, size_t ws_size, hipStream_t stream) {
    static int grid = 0;
    if (grid == 0) {
        if (n_in != 21 || in_sizes[0] != T * D || out_size != T * D || ws_size < WS_END) { fprintf(stderr, "kernel_launch: shape/workspace mismatch (n_in %d, ws %zu < %zu); nothing launched\n", n_in, ws_size, (size_t)WS_END); grid = -1; return; }
        int dev = 0, cus = 0, per_cu = 0;
        if (hipGetDevice(&dev) != hipSuccess || hipDeviceGetAttribute(&cus, hipDeviceAttributeMultiprocessorCount, dev) != hipSuccess) { grid = -1; return; }
        if (hipFuncSetAttribute((const void*)hymba_fwd, hipFuncAttributeMaxDynamicSharedMemorySize, LDS_BYTES) != hipSuccess) { fprintf(stderr, "kernel_launch: hipFuncSetAttribute failed\n"); grid = -1; return; }
        if (hipOccupancyMaxActiveBlocksPerMultiprocessor(&per_cu, (const void*)hymba_fwd, NWAVES * 64, LDS_BYTES) != hipSuccess || per_cu < 1) { fprintf(stderr, "kernel_launch: occupancy query reports %d\n", per_cu); }
        (void)hipGetLastError();
        grid = cus;
    }
    if (grid < 0) return;
    if (hipMemsetAsync((char*)d_ws + WS_CTL, 0, CTL_ZERO_BYTES, stream) != hipSuccess) { fprintf(stderr, "kernel_launch: memset failed\n"); return; }
    Args a{};
    for (int i = 0; i < 21; ++i) a.in[i] = (const float*)d_in[i];
    a.out = (float*)d_out; a.ws = (unsigned char*)d_ws;
    int los[4], his[4], nl = 0;
#if defined(PROBE_REPEAT)
    los[nl] = 0; his[nl] = PROBE_REPEAT + 1; ++nl; los[nl] = PROBE_REPEAT; his[nl] = PROBE_REPEAT + 1; ++nl; if (PROBE_REPEAT + 1 < PER_PHASE) { los[nl] = PROBE_REPEAT + 1; his[nl] = PER_PHASE; ++nl; }
#else
    los[nl] = 0; his[nl] = PER_PHASE; ++nl;
#endif
    for (int li = 0; li < nl; ++li) {
        a.ph_lo = los[li]; a.ph_hi = his[li]; a.li = li;
#if defined(PROBE_REPEAT)
        if (li == 1) { (void)hipMemsetAsync((char*)d_ws + WS_CTL + CW_ATTQ * 4, 0, 64, stream); if (PROBE_REPEAT == 5) (void)hipMemsetAsync((char*)d_ws + WS_CTL + CW_CNT * 4, 0, 64 * 256, stream); }
#endif
        hipLaunchKernelGGL(hymba_fwd, dim3(grid), dim3(NWAVES * 64), LDS_BYTES, stream, a);
        const hipError_t le = hipPeekAtLastError();
        if (le != hipSuccess) { fprintf(stderr, "kernel_launch: launch %d failed: %s\n", li, hipGetErrorName(le)); break; }
    }
}
```
